# Optimizing an MI355X kernel written in HIP

```python
import jax
import jax.numpy as jnp
from jax import lax
import numpy as np

D_MODEL = 2048
BATCH = 4
SEQ = 4096
DEPTH = 2

PLE_DIM = 256
HEAD_DIM = 64
BLOCK = 128
LN_EPS = 1e-5
D_FF = 5632
NEG_BIG = -1e30
F_MIN = 1e-6

A_Q_HEADS = 8
A_KV_HEADS = 2
A_GROUP = A_Q_HEADS // A_KV_HEADS
A_WINDOW = 128
A_WIDTH = A_Q_HEADS * HEAD_DIM
A_KV_WIDTH = A_KV_HEADS * HEAD_DIM

B_GROUPS = 4
B_GROUP_DIM = 128
B_CHUNK = 128
B_WIDTH = B_GROUPS * B_GROUP_DIM

C_HEADS = 4
C_KEY_DIM = 128
C_VAL_DIM = 128
C_WIDTH = C_HEADS * C_KEY_DIM
C_CHUNK = 64

D_PATTERNS = ((128, 1), (512, 4), (2048, 16))
D_N_GROUPS = 3
D_HEADS_PER_GROUP = 4
D_GROUP_WIDTH = D_HEADS_PER_GROUP * HEAD_DIM
D_WIDTH = D_N_GROUPS * D_GROUP_WIDTH

N_SOFTMAX_HEADS = A_Q_HEADS + D_N_GROUPS * D_HEADS_PER_GROUP
N_BRANCHES = 4
IN_SIZES = (A_WIDTH, A_KV_WIDTH, A_KV_WIDTH, B_WIDTH, B_WIDTH, C_WIDTH, C_WIDTH, C_WIDTH, C_WIDTH, D_WIDTH, D_WIDTH, D_WIDTH, N_BRANCHES * D_MODEL)
IN_WIDTH = A_WIDTH + 2 * A_KV_WIDTH + 2 * B_WIDTH + 4 * C_WIDTH + 3 * D_WIDTH + N_BRANCHES * D_MODEL

F32 = jnp.float32

kernel_name = 'hybrid_gated_parallel_mixer_deepnorm'


def split_cols(z, sizes):
    out = []
    off = 0
    for sz in sizes:
        out.append(z[..., off:off + sz])
        off += sz
    return out


def layer_norm(x, g, b, eps=LN_EPS):
    xf = x.astype(F32)
    mu = jnp.mean(xf, axis=-1, keepdims=True)
    var = jnp.mean(jnp.square(xf - mu), axis=-1, keepdims=True)
    y = (xf - mu) * lax.rsqrt(var + eps) * g.astype(F32) + b.astype(F32)
    return y.astype(x.dtype)


def rms_norm(x, g, eps=LN_EPS):
    xf = x.astype(F32)
    y = xf * lax.rsqrt(jnp.mean(jnp.square(xf), axis=-1, keepdims=True) + eps) * g.astype(F32)
    return y.astype(x.dtype)


def swiglu(x, w_gate, w_up, w_down):
    return (jax.nn.silu(x @ w_gate) * (x @ w_up)) @ w_down


def alibi_slopes(n):
    return jnp.exp2(-8.0 * jnp.arange(1, n + 1, dtype=F32) / n)


def banded_attention(q, k, v, slopes, max_dist, dist_unit, sinks=None):
    n, length, hkv, grp, dh = q.shape
    nb = length // BLOCK
    qb = q.reshape(n, nb, BLOCK, hkv, grp, dh)

    def with_prev(t):
        tb = t.reshape(n, nb, BLOCK, hkv, dh)
        prev = jnp.pad(tb[:, :-1], ((0, 0), (1, 0), (0, 0), (0, 0), (0, 0)))
        return jnp.concatenate([prev, tb], axis=2)

    kk = with_prev(k)
    vv = with_prev(v)
    s = jnp.einsum('nbqhgd,nbkhd->nbhgqk', qb, kk).astype(F32) * (dh ** -0.5)
    q_off = jnp.arange(BLOCK)[:, None]
    k_off = jnp.arange(2 * BLOCK)[None, :]
    dist = q_off + BLOCK - k_off
    blk = jnp.arange(nb)[:, None, None]
    mask = (dist >= 0) & (dist <= max_dist) & (blk * BLOCK + k_off - BLOCK >= 0)
    dist_pos = jnp.maximum(dist, 0) * dist_unit
    bias = -slopes.astype(F32)[:, :, None, None] * dist_pos.astype(F32)
    s = jnp.where(mask[None, :, None, None], s + bias[None, None], NEG_BIG)
    m = jnp.max(s, axis=-1)
    if sinks is not None:
        sk = sinks.astype(F32)[None, None, :, :, None]
        m = jnp.maximum(m, sk)
    pr = jnp.exp(s - m[..., None])
    denom = jnp.sum(pr, axis=-1)
    if sinks is not None:
        denom = denom + jnp.exp(sk - m)
    o = jnp.einsum('nbhgqk,nbkhd->nbqhgd', pr, vv.astype(F32))
    o = o * jnp.transpose(1.0 / denom, (0, 1, 4, 2, 3))[..., None]
    lse = jnp.transpose(m + jnp.log(denom), (0, 1, 4, 2, 3))
    return o.reshape(n, length, hkv, grp, dh).astype(q.dtype), lse.reshape(n, length, hkv, grp)


def dilated_mixture(q, k, v, slopes):
    b, s = q.shape[:2]
    outs = []
    lses = []
    for g, (window, dil) in enumerate(D_PATTERNS):
        sub = s // dil
        sub_pad = -(-sub // BLOCK) * BLOCK

        def to_res(t):
            t = t.reshape(b, sub, dil, D_HEADS_PER_GROUP, HEAD_DIM).transpose(0, 2, 1, 3, 4)
            t = t.reshape(b * dil, sub, D_HEADS_PER_GROUP, HEAD_DIM)
            return jnp.pad(t, ((0, 0), (0, sub_pad - sub), (0, 0), (0, 0)))

        qr = to_res(q[:, :, g])
        kr = to_res(k[:, :, g])
        vr = to_res(v[:, :, g])
        o, lse = banded_attention(qr[:, :, :, None], kr, vr, slopes[g][:, None], window // dil, dil)
        o = o[:, :sub, :, 0].reshape(b, dil, sub, D_HEADS_PER_GROUP, HEAD_DIM)
        o = o.transpose(0, 2, 1, 3, 4).reshape(b, s, D_HEADS_PER_GROUP, HEAD_DIM)
        lse = lse[:, :sub, :, 0].reshape(b, dil, sub, D_HEADS_PER_GROUP)
        lse = lse.transpose(0, 2, 1, 3).reshape(b, s, D_HEADS_PER_GROUP)
        outs.append(o)
        lses.append(lse)
    w = jax.nn.softmax(jnp.stack(lses, axis=0), axis=0)
    out = jnp.sum(w[..., None] * jnp.stack(outs, axis=0).astype(F32), axis=0)
    return out.reshape(b, s, D_GROUP_WIDTH).astype(q.dtype)


def chunked_spatial_gating(u_pre, v_pre, ln_g, ln_b, w_s, b_s):
    b, s, _ = u_pre.shape
    u = jax.nn.gelu(u_pre, approximate=False)
    v = layer_norm(jax.nn.gelu(v_pre, approximate=False), ln_g, ln_b)
    v = v.reshape(b, s // B_CHUNK, B_CHUNK, B_GROUPS, B_GROUP_DIM)
    w_causal = jnp.tril(w_s)
    mixed = jnp.einsum('gts,bnsgc->bntgc', w_causal, v) + jnp.transpose(b_s)[None, None, :, :, None]
    return u * mixed.reshape(b, s, B_WIDTH)


def hgrn2_chunk_scan(q, k, v, log_f):
    b, s, h, dk = q.shape
    dv = v.shape[-1]
    n = s // C_CHUNK

    def chunks(t):
        return t.astype(F32).reshape(b, n, C_CHUNK, h, t.shape[-1]).transpose(1, 0, 3, 2, 4)

    qc, kc, vc, gc = chunks(q), chunks(k), chunks(v), chunks(log_f)
    causal = jnp.tril(jnp.ones((C_CHUNK, C_CHUNK), dtype=bool))[:, :, None]

    def step(state, inp):
        qi, ki, vi, gi = inp
        G = jnp.cumsum(gi, axis=2)
        rel = G[:, :, :, None, :] - G[:, :, None, :, :]
        decay = jnp.where(causal, jnp.exp(jnp.minimum(rel, 0.0)), 0.0)
        scores = jnp.einsum('bhtk,bhtsk,bhsk->bhts', qi, decay, ki)
        o = jnp.einsum('bhts,bhsv->bhtv', scores, vi) + jnp.einsum('bhtk,bhkv->bhtv', qi * jnp.exp(G), state)
        g_last = G[:, :, -1:, :]
        state = state * jnp.exp(G[:, :, -1])[..., None] + jnp.einsum('bhsk,bhsv->bhkv', ki * jnp.exp(g_last - G), vi)
        return state, o

    state0 = jnp.zeros((b, h, dk, dv), F32)
    _, o = lax.scan(step, state0, (qc, kc, vc, gc))
    return o.transpose(1, 0, 3, 2, 4).reshape(b, s, h, dv)


def hgrn2(q, f_pre, i_in, og_pre, lower_bound, norm_g):
    b, s, _ = q.shape
    lb = lower_bound.astype(F32)
    z = f_pre.astype(F32)
    f = lb + (1.0 - lb) * jax.nn.sigmoid(z)
    log_f = jnp.log(jnp.maximum(f, F_MIN))
    k = (1.0 - lb) * jax.nn.sigmoid(-z)
    o = hgrn2_chunk_scan(q.reshape(b, s, C_HEADS, C_KEY_DIM), k.reshape(b, s, C_HEADS, C_KEY_DIM),
                         i_in.reshape(b, s, C_HEADS, C_VAL_DIM), log_f.reshape(b, s, C_HEADS, C_KEY_DIM))
    o = rms_norm(o, norm_g.reshape(C_HEADS, C_VAL_DIM)).reshape(b, s, C_WIDTH)
    return (o * jax.nn.sigmoid(og_pre.astype(F32))).astype(q.dtype)


def hybrid_mixer(h, w_in, sinks, gmlp_ln_g, gmlp_ln_b, gmlp_w_s, gmlp_b_s, lower_bound, hgrn_norm_g,
                 w_br_a, w_br_b, w_br_c, w_br_d, w_out):
    b, s, _ = h.shape
    z = h @ w_in
    qa, ka, va, ub, vb, qc, fc, ic, gc, qd, kd, vd, gate_logits = split_cols(z, IN_SIZES)
    slopes = alibi_slopes(N_SOFTMAX_HEADS)
    o_a, _ = banded_attention(qa.reshape(b, s, A_KV_HEADS, A_GROUP, HEAD_DIM),
                              ka.reshape(b, s, A_KV_HEADS, HEAD_DIM),
                              va.reshape(b, s, A_KV_HEADS, HEAD_DIM),
                              slopes[:A_Q_HEADS].reshape(A_KV_HEADS, A_GROUP),
                              A_WINDOW - 1, 1, sinks.reshape(A_KV_HEADS, A_GROUP))
    o_a = o_a.reshape(b, s, A_WIDTH)
    o_b = chunked_spatial_gating(ub, vb, gmlp_ln_g, gmlp_ln_b, gmlp_w_s, gmlp_b_s)
    o_c = hgrn2(qc, fc, ic, gc, lower_bound, hgrn_norm_g)
    dshape = (b, s, D_N_GROUPS, D_HEADS_PER_GROUP, HEAD_DIM)
    o_d = dilated_mixture(qd.reshape(dshape), kd.reshape(dshape), vd.reshape(dshape),
                          slopes[A_Q_HEADS:].reshape(D_N_GROUPS, D_HEADS_PER_GROUP))
    gates = jax.nn.sigmoid(gate_logits.astype(F32)).reshape(b, s, N_BRANCHES, D_MODEL)
    merged = (gates[:, :, 0] * (o_a @ w_br_a) + gates[:, :, 1] * (o_b @ w_br_b)
              + gates[:, :, 2] * (o_c @ w_br_c) + gates[:, :, 3] * (o_d @ w_br_d))
    return merged.astype(h.dtype) @ w_out


def setup_inputs(seed: int = 0) -> dict:
    key = jax.random.key(seed)
    ks = jax.random.split(key, 24)
    beta = (8.0 * DEPTH) ** -0.25

    def nrm(k, shape, scale):
        return jax.random.normal(k, shape, F32) * scale

    return {
        'x': nrm(ks[0], (BATCH, SEQ, D_MODEL), 1.0),
        'p': nrm(ks[1], (DEPTH, BATCH, SEQ, PLE_DIM), 1.0),
        'ln_g': 1.0 + nrm(ks[2], (DEPTH, 3, D_MODEL), 0.02),
        'ln_b': nrm(ks[3], (DEPTH, 3, D_MODEL), 0.02),
        'ffn_w_gate': nrm(ks[4], (DEPTH, 2, D_MODEL, D_FF), D_MODEL ** -0.5),
        'ffn_w_up': nrm(ks[5], (DEPTH, 2, D_MODEL, D_FF), D_MODEL ** -0.5),
        'ffn_w_down': nrm(ks[6], (DEPTH, 2, D_FF, D_MODEL), beta * D_FF ** -0.5),
        'w_in': nrm(ks[7], (DEPTH, D_MODEL, IN_WIDTH), D_MODEL ** -0.5),
        'attn_sinks': nrm(ks[8], (DEPTH, A_Q_HEADS), 0.5),
        'gmlp_ln_g': 1.0 + nrm(ks[9], (DEPTH, B_WIDTH), 0.02),
        'gmlp_ln_b': nrm(ks[10], (DEPTH, B_WIDTH), 0.02),
        'gmlp_w_s': nrm(ks[11], (DEPTH, B_GROUPS, B_CHUNK, B_CHUNK), B_CHUNK ** -0.5),
        'gmlp_b_s': 1.0 + nrm(ks[12], (DEPTH, B_GROUPS, B_CHUNK), 0.02),
        'hgrn_lb_logits': nrm(ks[13], (DEPTH, C_WIDTH), 0.5),
        'hgrn_norm_g': 1.0 + nrm(ks[14], (DEPTH, C_WIDTH), 0.02),
        'w_br_a': nrm(ks[15], (DEPTH, A_WIDTH, D_MODEL), A_WIDTH ** -0.5),
        'w_br_b': nrm(ks[16], (DEPTH, B_WIDTH, D_MODEL), B_WIDTH ** -0.5),
        'w_br_c': nrm(ks[17], (DEPTH, C_WIDTH, D_MODEL), C_WIDTH ** -0.5),
        'w_br_d': nrm(ks[18], (DEPTH, D_GROUP_WIDTH, D_MODEL), D_GROUP_WIDTH ** -0.5),
        'w_out': nrm(ks[19], (DEPTH, D_MODEL, D_MODEL), beta * D_MODEL ** -0.5),
        'ple_w_proj': nrm(ks[20], (DEPTH, PLE_DIM, D_MODEL), beta * PLE_DIM ** -0.5),
        'ple_w_gate': nrm(ks[21], (DEPTH, D_MODEL, D_MODEL), D_MODEL ** -0.5),
    }


def reference(x, p, ln_g, ln_b, ffn_w_gate, ffn_w_up, ffn_w_down, w_in, attn_sinks, gmlp_ln_g, gmlp_ln_b,
              gmlp_w_s, gmlp_b_s, hgrn_lb_logits, hgrn_norm_g, w_br_a, w_br_b, w_br_c, w_br_d, w_out,
              ple_w_proj, ple_w_gate):
    alpha = (2.0 * DEPTH) ** 0.25
    probs = jax.nn.softmax(hgrn_lb_logits.astype(F32), axis=0)
    lower_bounds = jnp.cumsum(probs.at[0].set(0.0), axis=0)
    for i in range(DEPTH):
        ffn1 = swiglu(x, ffn_w_gate[i, 0], ffn_w_up[i, 0], ffn_w_down[i, 0])
        x = layer_norm(alpha * x + 0.5 * ffn1, ln_g[i, 0], ln_b[i, 0])
        mix = hybrid_mixer(x, w_in[i], attn_sinks[i], gmlp_ln_g[i], gmlp_ln_b[i], gmlp_w_s[i], gmlp_b_s[i],
                           lower_bounds[i], hgrn_norm_g[i], w_br_a[i], w_br_b[i], w_br_c[i], w_br_d[i], w_out[i])
        x = layer_norm(alpha * x + mix, ln_g[i, 1], ln_b[i, 1])
        ffn2 = swiglu(x, ffn_w_gate[i, 1], ffn_w_up[i, 1], ffn_w_down[i, 1])
        ple = jax.nn.sigmoid(x @ ple_w_gate[i]) * (p[i] @ ple_w_proj[i])
        x = layer_norm(alpha * x + 0.5 * ffn2 + ple, ln_g[i, 2], ln_b[i, 2])
    return x
```

```cpp
#include <hip/hip_runtime.h>
#include <hip/hip_cooperative_groups.h>
#include <cstdio>
#include <cstdint>
namespace cg = cooperative_groups;

#define LAS __attribute__((address_space(3)))
typedef unsigned short bf16_t;
typedef short bf16x8 __attribute__((ext_vector_type(8)));
typedef float f32x4 __attribute__((ext_vector_type(4)));
typedef float f32x2 __attribute__((ext_vector_type(2)));
typedef unsigned u32x4 __attribute__((ext_vector_type(4)));
typedef unsigned u32x2 __attribute__((ext_vector_type(2)));

constexpr int T_ = 16384, SEQ_ = 4096, D_ = 2048, FF_ = 5632, NIN_ = 14336, NZ_ = 6144, NGT_ = 8192, NO_ = 1792, PLE_ = 256;
constexpr int ZQA = 0, ZKA = 512, ZVA = 640, ZUB = 768, ZVB = 1280, ZQC = 1792, ZFC = 2304, ZIC = 2816, ZGC = 3328, ZQD = 3840, ZKD = 4608, ZVD = 5376;
constexpr float LN_EPS = 1e-5f;
constexpr float ALPHA = 1.41421356237f;
constexpr float LOG2E = 1.44269504089f;

constexpr size_t MiB = 1u << 20;
constexpr size_t WS_CTL = 0;
constexpr size_t WS_WGU = 1 * MiB;
constexpr size_t WS_WD = WS_WGU + 88 * MiB;
constexpr size_t WS_WIN = WS_WD + 44 * MiB;
constexpr size_t WS_WBR = WS_WIN + 56 * MiB;
constexpr size_t WS_WOUT = WS_WBR + 7 * MiB;
constexpr size_t WS_WPG = WS_WOUT + 8 * MiB;
constexpr size_t WS_WPP = WS_WPG + 8 * MiB;
constexpr size_t WS_PB = WS_WPP + 1 * MiB;
constexpr size_t WS_XB = WS_PB + 16 * MiB;
constexpr size_t WS_ZH = WS_XB + 64 * MiB;
constexpr size_t WS_GATE = WS_ZH + 192 * MiB;
constexpr size_t WS_O = WS_GATE + 256 * MiB;
constexpr size_t WS_HS = WS_O + 56 * MiB;
constexpr size_t WS_DPO = WS_HS + 32 * MiB;
constexpr size_t WS_DLSE = WS_DPO + 48 * MiB;
constexpr size_t WS_END = WS_DLSE + 1 * MiB;

constexpr int LDS_BYTES = 147456;

__device__ __forceinline__ float bf2f(unsigned b) { return __uint_as_float(b << 16); }
__device__ __forceinline__ float bflo(unsigned w) { return __uint_as_float(w << 16); }
__device__ __forceinline__ float bfhi(unsigned w) { return __uint_as_float(w & 0xffff0000u); }
__device__ __forceinline__ unsigned pk2(float lo, float hi) { unsigned r; asm("v_cvt_pk_bf16_f32 %0, %1, %2" : "=v"(r) : "v"(lo), "v"(hi)); return r; }
__device__ __forceinline__ float fexp(float x) { return __builtin_amdgcn_exp2f(x * LOG2E); }
__device__ __forceinline__ float frcp(float x) { return __builtin_amdgcn_rcpf(x); }
__device__ __forceinline__ float fsigmoid(float x) { return frcp(1.0f + fexp(-x)); }
__device__ __forceinline__ float gelu_erf(float x) { return 0.5f * x * (1.0f + erff(x * 0.70710678118f)); }
__device__ __forceinline__ float wave_sum(float v) {
#pragma unroll
    for (int o = 1; o < 64; o <<= 1) v += __shfl_xor(v, o);
    return v;
}
__device__ __forceinline__ f32x4 mfma16(bf16x8 a, bf16x8 b, f32x4 c) { return __builtin_amdgcn_mfma_f32_16x16x32_bf16(a, b, c, 0, 0, 0); }
__device__ __forceinline__ bf16x8 mk8(u32x2 a, u32x2 b) { u32x4 t = {a.x, a.y, b.x, b.y}; return __builtin_bit_cast(bf16x8, t); }

namespace pg8 {
constexpr int BM = 256, BK = 64, HALF = 128, HTB = HALF * BK * 2, STAGE_BYTES = 8 * HTB, NXCD = 8, WGM = 8;
__device__ __forceinline__ int lds_byte(int r, int c) { const int st = (r >> 4) * 2 + (c >> 5), rr = r & 15, cc = c & 31, ob = rr * 64 + cc * 2; return st * 1024 + (ob ^ (((ob >> 9) & 1) << 5)); }
__device__ __forceinline__ void stage_rc(int b, int& R, int& C) { const int st = b / 1024, sb = b % 1024, swz = sb ^ (((sb >> 9) & 1) << 5); R = (st >> 1) * 16 + swz / 64; C = (st & 1) * 32 + (swz % 64) / 2; }
__device__ __forceinline__ int perm32(int rho) { const int n = rho >> 4, i = rho & 15; return 8 * (i >> 2) + 4 * n + (i & 3); }
struct Unit { int pm, pn; };
struct Gemm { const bf16_t* A; const bf16_t* Bt; int M, N, K; };
struct StaticOrder {
    int nM, nN, nwg, G, c;
    __device__ void init(int M, int N, int G_, int c_) { nM = M / BM; nN = N / BM; nwg = nM * nN; G = G_; c = c_; }
    __device__ bool next(int i, Unit& u) const {
        const long L = (long)i * G + c; if (L >= nwg) return false;
        int wgid = (int)L; { const int q = nwg / NXCD, r = nwg % NXCD, xcd = wgid % NXCD, off = wgid / NXCD; wgid = (xcd < r ? xcd * (q + 1) : r * (q + 1) + (xcd - r) * q) + off; }
        const int nig = WGM * nN, gid = wgid / nig, fm = gid * WGM, gsz = (nM - fm) < WGM ? (nM - fm) : WGM;
        u.pm = fm + ((wgid % nig) % gsz); u.pn = (wgid % nig) / gsz; return true;
    }
};

struct EpiSwiGLU {
    static constexpr bool PERM = true, HAS_MID = false;
    bf16_t* H;
    __device__ __forceinline__ void mid(int, f32x4 (&)[2][2][4][2], const Unit&, int, int, int, int) const {}
    __device__ __forceinline__ void operator()(const f32x4 (&acc)[2][2][4][2], const Unit& u, int wr, int wc, int fr, int fq) const {
        const int row0 = u.pm * BM + wr * 64 + fr, col0 = u.pn * 128 + wc * 32 + 8 * fq;
#pragma unroll
        for (int ai = 0; ai < 2; ++ai)
#pragma unroll
            for (int m = 0; m < 4; ++m) {
                bf16_t* rowp = H + (size_t)(row0 + ai * HALF + m * 16) * FF_ + col0;
                float h[8];
#pragma unroll
                for (int n = 0; n < 2; ++n)
#pragma unroll
                    for (int j = 0; j < 4; ++j) { const float g = acc[ai][0][m][n][j], up = acc[ai][1][m][n][j]; h[n * 4 + j] = g * fsigmoid(g) * up; }
                u32x4 w; w.x = pk2(h[0], h[1]); w.y = pk2(h[2], h[3]); w.z = pk2(h[4], h[5]); w.w = pk2(h[6], h[7]);
                *(u32x4*)rowp = w;
                asm volatile("" ::: "memory"); __builtin_amdgcn_sched_barrier(0);
            }
    }
};
struct EpiResid {
    static constexpr bool PERM = false, HAS_MID = false;
    float* X; float a, b;
    __device__ __forceinline__ void mid(int, f32x4 (&)[2][2][4][2], const Unit&, int, int, int, int) const {}
    __device__ __forceinline__ void operator()(const f32x4 (&acc)[2][2][4][2], const Unit& u, int wr, int wc, int fr, int fq) const {
        const int row0 = u.pm * BM + wr * 64 + fr, col0 = u.pn * BM + wc * 32 + 4 * fq;
#pragma unroll
        for (int ai = 0; ai < 2; ++ai)
#pragma unroll
            for (int m = 0; m < 4; ++m) {
                float* rowp = X + (size_t)(row0 + ai * HALF + m * 16) * D_ + col0;
#pragma unroll
                for (int bj = 0; bj < 2; ++bj)
#pragma unroll
                    for (int n = 0; n < 2; ++n) { f32x4* p = (f32x4*)(rowp + bj * HALF + n * 16); *p = a * (*p) + b * acc[ai][bj][m][n]; }
                asm volatile("" ::: "memory"); __builtin_amdgcn_sched_barrier(0);
            }
    }
};
struct EpiZ {
    static constexpr bool PERM = true, HAS_MID = false;
    bf16_t* Z; bf16_t* GATE;
    __device__ __forceinline__ void mid(int, f32x4 (&)[2][2][4][2], const Unit&, int, int, int, int) const {}
    __device__ __forceinline__ void operator()(const f32x4 (&acc)[2][2][4][2], const Unit& u, int wr, int wc, int fr, int fq) const {
        const int row0 = u.pm * BM + wr * 64 + fr;
        const bool isg = u.pn >= 24;
        bf16_t* base = isg ? GATE : Z; const int pitch = isg ? NGT_ : NZ_;
        const int col0 = (isg ? (u.pn - 24) : u.pn) * BM + wc * 32 + 8 * fq;
#pragma unroll
        for (int ai = 0; ai < 2; ++ai)
#pragma unroll
            for (int m = 0; m < 4; ++m) {
                bf16_t* rowp = base + (size_t)(row0 + ai * HALF + m * 16) * pitch + col0;
#pragma unroll
                for (int bj = 0; bj < 2; ++bj) {
                    f32x4 v0 = acc[ai][bj][m][0], v1 = acc[ai][bj][m][1];
                    if (isg) {
#pragma unroll
                        for (int j = 0; j < 4; ++j) { v0[j] = fminf(1.0f + fexp(-v0[j]), 1e30f); v1[j] = fminf(1.0f + fexp(-v1[j]), 1e30f); }
                    }
                    u32x4 w; w.x = pk2(v0[0], v0[1]); w.y = pk2(v0[2], v0[3]); w.z = pk2(v1[0], v1[1]); w.w = pk2(v1[2], v1[3]);
                    *(u32x4*)(rowp + bj * HALF) = w;
                }
                asm volatile("" ::: "memory"); __builtin_amdgcn_sched_barrier(0);
            }
    }
};
struct EpiBf16 {
    static constexpr bool PERM = true, HAS_MID = false;
    bf16_t* O; int ldc;
    __device__ __forceinline__ void mid(int, f32x4 (&)[2][2][4][2], const Unit&, int, int, int, int) const {}
    __device__ __forceinline__ void operator()(const f32x4 (&acc)[2][2][4][2], const Unit& u, int wr, int wc, int fr, int fq) const {
        const int row0 = u.pm * BM + wr * 64 + fr, col0 = u.pn * BM + wc * 32 + 8 * fq;
#pragma unroll
        for (int ai = 0; ai < 2; ++ai)
#pragma unroll
            for (int m = 0; m < 4; ++m) {
                bf16_t* rowp = O + (size_t)(row0 + ai * HALF + m * 16) * ldc + col0;
#pragma unroll
                for (int bj = 0; bj < 2; ++bj) {
                    const f32x4 v0 = acc[ai][bj][m][0], v1 = acc[ai][bj][m][1];
                    u32x4 w; w.x = pk2(v0[0], v0[1]); w.y = pk2(v0[2], v0[3]); w.z = pk2(v1[0], v1[1]); w.w = pk2(v1[2], v1[3]);
                    *(u32x4*)(rowp + bj * HALF) = w;
                }
                asm volatile("" ::: "memory"); __builtin_amdgcn_sched_barrier(0);
            }
    }
};
struct EpiBR {
    static constexpr bool PERM = true, HAS_MID = true;
    bf16_t* O; const bf16_t* GATE;
    __device__ __forceinline__ void mid(int t, f32x4 (&acc)[2][2][4][2], const Unit& u, int wr, int wc, int fr, int fq) const {
        if (t != 8 && t != 16 && t != 24) return;
        const int b = (t >> 3) - 1;
        asm volatile("" : "+v"(fr), "+v"(fq));
        const int row0 = u.pm * BM + wr * 64 + fr, col0 = u.pn * BM + wc * 32 + 8 * fq;
#pragma unroll
        for (int ai = 0; ai < 2; ++ai)
#pragma unroll
            for (int m = 0; m < 4; ++m) {
                const bf16_t* rowp = GATE + (size_t)(row0 + ai * HALF + m * 16) * NGT_ + b * D_ + col0;
#pragma unroll
                for (int bj = 0; bj < 2; ++bj) {
                    const u32x4 e0 = *(const u32x4*)(rowp + bj * HALF), e1 = *(const u32x4*)(rowp + D_ + bj * HALF);
                    f32x4 r0, r1;
                    r0[0] = bflo(e1.x) * frcp(bflo(e0.x)); r0[1] = bfhi(e1.x) * frcp(bfhi(e0.x)); r0[2] = bflo(e1.y) * frcp(bflo(e0.y)); r0[3] = bfhi(e1.y) * frcp(bfhi(e0.y));
                    r1[0] = bflo(e1.z) * frcp(bflo(e0.z)); r1[1] = bfhi(e1.z) * frcp(bfhi(e0.z)); r1[2] = bflo(e1.w) * frcp(bflo(e0.w)); r1[3] = bfhi(e1.w) * frcp(bfhi(e0.w));
                    acc[ai][bj][m][0] *= r0; acc[ai][bj][m][1] *= r1;
                }
                asm volatile("" ::: "memory"); __builtin_amdgcn_sched_barrier(0);
            }
    }
    __device__ __forceinline__ void operator()(const f32x4 (&acc)[2][2][4][2], const Unit& u, int wr, int wc, int fr, int fq) const {
        const int row0 = u.pm * BM + wr * 64 + fr, col0 = u.pn * BM + wc * 32 + 8 * fq;
#pragma unroll
        for (int ai = 0; ai < 2; ++ai)
#pragma unroll
            for (int m = 0; m < 4; ++m) {
                const size_t r = (size_t)(row0 + ai * HALF + m * 16);
                const bf16_t* gp = GATE + r * NGT_ + 3 * D_ + col0;
                bf16_t* rowp = O + r * D_ + col0;
#pragma unroll
                for (int bj = 0; bj < 2; ++bj) {
                    const u32x4 e = *(const u32x4*)(gp + bj * HALF);
                    const f32x4 a0 = acc[ai][bj][m][0], a1 = acc[ai][bj][m][1];
                    u32x4 w;
                    w.x = pk2(a0[0] * frcp(bflo(e.x)), a0[1] * frcp(bfhi(e.x))); w.y = pk2(a0[2] * frcp(bflo(e.y)), a0[3] * frcp(bfhi(e.y)));
                    w.z = pk2(a1[0] * frcp(bflo(e.z)), a1[1] * frcp(bfhi(e.z))); w.w = pk2(a1[2] * frcp(bflo(e.w)), a1[3] * frcp(bfhi(e.w)));
                    *(u32x4*)(rowp + bj * HALF) = w;
                }
                asm volatile("" ::: "memory"); __builtin_amdgcn_sched_barrier(0);
            }
    }
};
struct EpiPle {
    static constexpr bool PERM = false, HAS_MID = false;
    float* X; const bf16_t* PP; float a;
    __device__ __forceinline__ void mid(int, f32x4 (&)[2][2][4][2], const Unit&, int, int, int, int) const {}
    __device__ __forceinline__ void operator()(const f32x4 (&acc)[2][2][4][2], const Unit& u, int wr, int wc, int fr, int fq) const {
        const int row0 = u.pm * BM + wr * 64 + fr, col0 = u.pn * BM + wc * 32 + 4 * fq;
#pragma unroll
        for (int ai = 0; ai < 2; ++ai)
#pragma unroll
            for (int m = 0; m < 4; ++m) {
                const size_t off = (size_t)(row0 + ai * HALF + m * 16) * D_ + col0;
#pragma unroll
                for (int bj = 0; bj < 2; ++bj)
#pragma unroll
                    for (int n = 0; n < 2; ++n) {
                        f32x4* p = (f32x4*)(X + off + bj * HALF + n * 16);
                        const u32x2 pp = *(const u32x2*)(PP + off + bj * HALF + n * 16);
                        const f32x4 s = acc[ai][bj][m][n];
                        f32x4 x = *p;
                        x[0] = a * x[0] + fsigmoid(s[0]) * bflo(pp.x); x[1] = a * x[1] + fsigmoid(s[1]) * bfhi(pp.x);
                        x[2] = a * x[2] + fsigmoid(s[2]) * bflo(pp.y); x[3] = a * x[3] + fsigmoid(s[3]) * bfhi(pp.y);
                        *p = x;
                    }
                asm volatile("" ::: "memory"); __builtin_amdgcn_sched_barrier(0);
            }
    }
};

template <class Epi>
__device__ __forceinline__ void gemm_phase(LAS unsigned char* lds, const Gemm g, const StaticOrder& S, const Epi& E) {
    int tid = threadIdx.x; asm volatile("" : "+v"(tid));
    const int wid = __builtin_amdgcn_readfirstlane(tid >> 6), lane = tid & 63, wr = wid >> 2, wc = wid & 3, fr = lane & 15, fq = lane >> 4;
    const int K = g.K, nt = K / BK;
    unsigned voffA[2], voffB[2];
#pragma unroll
    for (int i = 0; i < 2; ++i) { int R, C; stage_rc(tid * 16 + i * 8192, R, C); const int Rb = Epi::PERM ? ((R & ~31) + perm32(R & 31)) : R;
        voffA[i] = (unsigned)(R * K + C) * 2u; voffB[i] = (unsigned)(Rb * K + C) * 2u; }
    const size_t kstep = (size_t)(BK * 2);
    const size_t hstep = (size_t)HALF * K * 2;
    const size_t tstep = 2 * hstep;
    const unsigned ldsw = (unsigned)wid * 1024u;
    const int aoff = lds_byte(wr * 64 + fr, fq * 8), boff = lds_byte(wc * 32 + fr, fq * 8);
#define PG8_SA(b, h) (((b) * 2 + (h)) * HTB)
#define PG8_SB(b, h) ((4 + (b) * 2 + (h)) * HTB)
#define PG8_STAGE(bufoff, gbase, voff) do { _Pragma("unroll") for (int _i = 0; _i < 2; ++_i) \
        __builtin_amdgcn_global_load_lds((const unsigned*)((const char*)(gbase) + (voff)[_i]), (LAS unsigned*)(lds + (bufoff) + ldsw + _i * 8192), 16, 0, 0); } while (0)
#define PG8_LDA(dst, b, h) do { _Pragma("unroll") for (int m = 0; m < 4; ++m) _Pragma("unroll") for (int k = 0; k < 2; ++k) dst[m][k] = *(const LAS bf16x8*)(lds + PG8_SA(b, h) + aoff + m * 2048 + k * 1024); } while (0)
#define PG8_LDB(dst, b, h) do { _Pragma("unroll") for (int n = 0; n < 2; ++n) _Pragma("unroll") for (int k = 0; k < 2; ++k) dst[n][k] = *(const LAS bf16x8*)(lds + PG8_SB(b, h) + boff + n * 2048 + k * 1024); } while (0)
#define PG8_MMA(ai, bj, At, Bt) do { __builtin_amdgcn_s_setprio(1); _Pragma("unroll") for (int m = 0; m < 4; ++m) _Pragma("unroll") for (int n = 0; n < 2; ++n) _Pragma("unroll") for (int k = 0; k < 2; ++k) \
        acc[ai][bj][m][n] = __builtin_amdgcn_mfma_f32_16x16x32_bf16(Bt[n][k], At[m][k], acc[ai][bj][m][n], 0, 0, 0); __builtin_amdgcn_s_setprio(0); } while (0)
#define PG8_WAIT_V(n) asm volatile("s_waitcnt vmcnt(" #n ")" ::: "memory")
#define PG8_WAIT_L(n) asm volatile("s_waitcnt lgkmcnt(" #n ")" ::: "memory")
#define PG8_BAR __builtin_amdgcn_s_barrier()
#define PG8_SCHED __builtin_amdgcn_sched_barrier(0)
    Unit cur, nxt; int ui = 0;
    if (!S.next(0, cur)) return;
    f32x4 acc[2][2][4][2];
#pragma unroll
    for (int a = 0; a < 2; ++a)
#pragma unroll
        for (int b = 0; b < 2; ++b)
#pragma unroll
            for (int m = 0; m < 4; ++m)
#pragma unroll
                for (int n = 0; n < 2; ++n) acc[a][b][m][n] = (f32x4){0.f, 0.f, 0.f, 0.f};
    bf16x8 At[4][2], B0[2][2], B1[2][2];
    const char* cA = (const char*)g.A + (size_t)cur.pm * tstep; const char* cB = (const char*)g.Bt + (size_t)cur.pn * tstep;
    PG8_STAGE(PG8_SB(0, 0), cB, voffB); PG8_STAGE(PG8_SB(0, 1), cB + hstep, voffB); PG8_STAGE(PG8_SA(0, 0), cA, voffA); PG8_STAGE(PG8_SA(0, 1), cA + hstep, voffA);
    if (wr == 1) PG8_BAR;
    PG8_WAIT_V(2); PG8_BAR;
    PG8_STAGE(PG8_SB(1, 0), cB + kstep, voffB); PG8_STAGE(PG8_SA(1, 0), cA + kstep, voffA); PG8_STAGE(PG8_SB(1, 1), cB + hstep + kstep, voffB);
    PG8_WAIT_V(6); PG8_BAR;
    for (;;) {
        const bool has_next = S.next(ui + 1, nxt);
        const char* nA = has_next ? (const char*)g.A + (size_t)nxt.pm * tstep : cA; const char* nB = has_next ? (const char*)g.Bt + (size_t)nxt.pn * tstep : cB;
        for (int t = 0; t < nt; t += 2) {
            const bool last = (t == nt - 2);
            const char* a1 = cA + (size_t)(t + 1) * kstep;
            const char* a2 = last ? nA : cA + (size_t)(t + 2) * kstep; const char* b2 = last ? nB : cB + (size_t)(t + 2) * kstep;
            const char* a3 = a2 + kstep; const char* b3 = b2 + kstep;
            if constexpr (Epi::HAS_MID) E.mid(t, acc, cur, wr, wc, fr, fq);
            PG8_LDB(B0, 0, 0); PG8_LDB(B1, 0, 1); PG8_SCHED; PG8_LDA(At, 0, 0); PG8_STAGE(PG8_SA(1, 1), a1 + hstep, voffA);
            PG8_WAIT_V(8); PG8_WAIT_L(0); PG8_BAR; PG8_MMA(0, 0, At, B0); PG8_MMA(0, 1, At, B1); PG8_BAR; PG8_SCHED;
            PG8_LDA(At, 0, 1); PG8_STAGE(PG8_SB(0, 0), b2, voffB); PG8_STAGE(PG8_SB(0, 1), b2 + hstep, voffB); PG8_STAGE(PG8_SA(0, 0), a2, voffA);
            PG8_WAIT_V(8); PG8_WAIT_L(0); PG8_BAR; PG8_MMA(1, 0, At, B0); PG8_MMA(1, 1, At, B1); PG8_BAR; PG8_SCHED;
            PG8_LDB(B0, 1, 0); PG8_LDB(B1, 1, 1); PG8_SCHED; PG8_LDA(At, 1, 0); PG8_STAGE(PG8_SA(0, 1), a2 + hstep, voffA);
            PG8_WAIT_V(8); PG8_WAIT_L(0); PG8_BAR; PG8_MMA(0, 0, At, B0); PG8_MMA(0, 1, At, B1); PG8_BAR; PG8_SCHED;
            PG8_LDA(At, 1, 1); PG8_STAGE(PG8_SB(1, 0), b3, voffB); PG8_STAGE(PG8_SB(1, 1), b3 + hstep, voffB); PG8_STAGE(PG8_SA(1, 0), a3, voffA);
            PG8_WAIT_V(8); PG8_WAIT_L(0); PG8_BAR; PG8_MMA(1, 0, At, B0); PG8_MMA(1, 1, At, B1); PG8_BAR; PG8_SCHED;
        }
        if (wr == 0) PG8_BAR;
#pragma unroll
        for (int a = 0; a < 2; ++a)
#pragma unroll
            for (int b = 0; b < 2; ++b)
#pragma unroll
                for (int m = 0; m < 4; ++m)
#pragma unroll
                    for (int n = 0; n < 2; ++n) asm volatile("" : "+v"(acc[a][b][m][n]));
        E(acc, cur, wr, wc, fr, fq);
        if (!has_next) break;
#pragma unroll
        for (int a = 0; a < 2; ++a)
#pragma unroll
            for (int b = 0; b < 2; ++b)
#pragma unroll
                for (int m = 0; m < 4; ++m)
#pragma unroll
                    for (int n = 0; n < 2; ++n) acc[a][b][m][n] = (f32x4){0.f, 0.f, 0.f, 0.f};
        cur = nxt; cA = nA; cB = nB; ++ui;
        if (wr == 1) PG8_BAR;
    }
    PG8_WAIT_V(0);
    PG8_BAR;
#undef PG8_SA
#undef PG8_SB
#undef PG8_STAGE
#undef PG8_LDA
#undef PG8_LDB
#undef PG8_MMA
#undef PG8_WAIT_V
#undef PG8_WAIT_L
#undef PG8_BAR
#undef PG8_SCHED
}
}

struct Args { const float* in[22]; float* out; unsigned char* ws; int ph_lo, ph_hi; };

typedef LAS unsigned long long* PTab;
__device__ __forceinline__ const float* ldptr(PTab pt, int k) {
    const unsigned long long v = pt[k];
    const unsigned lo = __builtin_amdgcn_readfirstlane((unsigned)v), hi = __builtin_amdgcn_readfirstlane((unsigned)(v >> 32));
    return (const float*)(((unsigned long long)hi << 32) | lo);
}

__device__ __forceinline__ void conv_mat(const float* W, int K, int N, bf16_t* WT, int pitch, int koff, int mode, LAS float* scr, int gw, int ngw, int lane) {
    const int nblk = N / 32, nitems = (K / 64) * nblk;
    for (int item = gw; item < nitems; item += ngw) {
        const int kb = item / nblk, nb = item - kb * nblk, k0 = 64 * kb, n0 = 32 * nb;
#pragma unroll 8
        for (int i = 0; i < 32; ++i) { const int kk = 2 * i + (lane >> 5); scr[kk * 33 + (lane & 31)] = W[(size_t)(k0 + kk) * N + n0 + (lane & 31)]; }
        asm volatile("s_waitcnt lgkmcnt(0)" ::: "memory");
        const int c = lane & 7;
        int r0 = n0; if (mode) r0 = (n0 >> 7) * 256 + (n0 & 127) + (mode == 2 ? 128 : 0);
#pragma unroll
        for (int j = 0; j < 4; ++j) { const int n = (lane >> 3) + 8 * j; const LAS float* s = scr + (8 * c) * 33 + n;
            u32x4 o; o.x = pk2(s[0 * 33], s[1 * 33]); o.y = pk2(s[2 * 33], s[3 * 33]); o.z = pk2(s[4 * 33], s[5 * 33]); o.w = pk2(s[6 * 33], s[7 * 33]);
            *(u32x4*)(WT + (size_t)(r0 + n) * pitch + koff + k0 + 8 * c) = o; }
        asm volatile("s_waitcnt lgkmcnt(0)" ::: "memory");
    }
}

__device__ __forceinline__ void convert_phase(PTab pt, int l, LAS unsigned char* lds, int tid, int wave, int lane, int bid, int G) {
    unsigned char* ws = (unsigned char*)ldptr(pt, 23);
    LAS float* scr = (LAS float*)(lds + wave * 16384);
    const int gw = bid * 8 + wave, ngw = G * 8;
    for (int s = 0; s < 2; ++s) {
        bf16_t* wgu = (bf16_t*)(ws + WS_WGU + (size_t)s * 44 * MiB);
        conv_mat(ldptr(pt, 4) + (size_t)(l * 2 + s) * D_ * FF_, D_, FF_, wgu, D_, 0, 1, scr, gw, ngw, lane);
        conv_mat(ldptr(pt, 5) + (size_t)(l * 2 + s) * D_ * FF_, D_, FF_, wgu, D_, 0, 2, scr, gw, ngw, lane);
        conv_mat(ldptr(pt, 6) + (size_t)(l * 2 + s) * D_ * FF_, FF_, D_, (bf16_t*)(ws + WS_WD + (size_t)s * 22 * MiB), FF_, 0, 0, scr, gw, ngw, lane);
    }
    conv_mat(ldptr(pt, 7) + (size_t)l * D_ * NIN_, D_, NIN_, (bf16_t*)(ws + WS_WIN), D_, 0, 0, scr, gw, ngw, lane);
    conv_mat(ldptr(pt, 15) + (size_t)l * 512 * D_, 512, D_, (bf16_t*)(ws + WS_WBR), NO_, 0, 0, scr, gw, ngw, lane);
    conv_mat(ldptr(pt, 16) + (size_t)l * 512 * D_, 512, D_, (bf16_t*)(ws + WS_WBR), NO_, 512, 0, scr, gw, ngw, lane);
    conv_mat(ldptr(pt, 17) + (size_t)l * 512 * D_, 512, D_, (bf16_t*)(ws + WS_WBR), NO_, 1024, 0, scr, gw, ngw, lane);
    conv_mat(ldptr(pt, 18) + (size_t)l * 256 * D_, 256, D_, (bf16_t*)(ws + WS_WBR), NO_, 1536, 0, scr, gw, ngw, lane);
    conv_mat(ldptr(pt, 19) + (size_t)l * D_ * D_, D_, D_, (bf16_t*)(ws + WS_WOUT), D_, 0, 0, scr, gw, ngw, lane);
    conv_mat(ldptr(pt, 20) + (size_t)l * PLE_ * D_, PLE_, D_, (bf16_t*)(ws + WS_WPP), PLE_, 0, 0, scr, gw, ngw, lane);
    conv_mat(ldptr(pt, 21) + (size_t)l * D_ * D_, D_, D_, (bf16_t*)(ws + WS_WPG), D_, 0, 0, scr, gw, ngw, lane);
    if (l == 0) {
        const size_t gt = (size_t)bid * 512 + tid, nth = (size_t)G * 512;
        const f32x4* x4 = (const f32x4*)ldptr(pt, 0); f32x4* o4 = (f32x4*)ldptr(pt, 22); u32x2* xb = (u32x2*)(ws + WS_XB);
        for (size_t i = gt; i < (size_t)T_ * D_ / 4; i += nth) { const f32x4 v = x4[i]; o4[i] = v; u32x2 w; w.x = pk2(v[0], v[1]); w.y = pk2(v[2], v[3]); xb[i] = w; }
        const f32x4* p4 = (const f32x4*)ldptr(pt, 1); u32x2* pb = (u32x2*)(ws + WS_PB);
        for (size_t i = gt; i < (size_t)2 * T_ * PLE_ / 4; i += nth) { const f32x4 v = p4[i]; u32x2 w; w.x = pk2(v[0], v[1]); w.y = pk2(v[2], v[3]); pb[i] = w; }
    }
}

__device__ __forceinline__ void ln_phase(float* X, bf16_t* XB, const float* g, const float* b, int wave, int lane, int bid, int G) {
    const int gw = bid * 8 + wave, ngw = G * 8;
    for (int row = gw; row < T_; row += ngw) {
        f32x4* xr = (f32x4*)(X + (size_t)row * D_) + lane;
        f32x4 v[8]; float s = 0.f;
#pragma unroll
        for (int j = 0; j < 8; ++j) { v[j] = xr[64 * j]; s += (v[j][0] + v[j][1]) + (v[j][2] + v[j][3]); }
        const float mean = wave_sum(s) * (1.f / D_); float s2 = 0.f;
#pragma unroll
        for (int j = 0; j < 8; ++j) { v[j] = v[j] - mean; s2 += (v[j][0] * v[j][0] + v[j][1] * v[j][1]) + (v[j][2] * v[j][2] + v[j][3] * v[j][3]); }
        const float rstd = 1.f / sqrtf(wave_sum(s2) * (1.f / D_) + LN_EPS);
        u32x2* o8 = (u32x2*)(XB + (size_t)row * D_) + lane;
#pragma unroll
        for (int j = 0; j < 8; ++j) {
            const f32x4 gg = ((const f32x4*)g)[lane + 64 * j], bb = ((const f32x4*)b)[lane + 64 * j];
            const f32x4 y = v[j] * rstd * gg + bb;
            xr[64 * j] = y; u32x2 w; w.x = pk2(y[0], y[1]); w.y = pk2(y[2], y[3]); o8[64 * j] = w;
        }
    }
}

__device__ __forceinline__ void attn_unit(LAS unsigned char* L, const bf16_t* Z, int unit, const float* sinks, bf16_t* O, float* DPO, float* DLSE, int tid, int wave, int lane) {
    int qcol, kcol, vcol, base, blk, dil, max_dist, grp = 0, hh = 0; float slope_u, sink = 0.f; bool isA;
    if (unit < 1024) {
        isA = true; blk = unit & 31; const int head = (unit >> 5) & 7, b = unit >> 8, kvh = head >> 2;
        qcol = ZQA + head * 64; kcol = ZKA + kvh * 64; vcol = ZVA + kvh * 64; base = b * SEQ_; dil = 1; max_dist = 127;
        slope_u = __builtin_amdgcn_exp2f(-8.0f * (float)(head + 1) / 20.0f); sink = sinks[head]; hh = head;
    } else {
        isA = false; const int u2 = unit - 1024; grp = u2 >> 9; const int u3 = u2 & 511;
        dil = (grp == 0) ? 1 : (grp == 1 ? 4 : 16); const int nbk = 32 / dil;
        blk = u3 % nbk; const int r = (u3 / nbk) % dil; hh = (u3 / 32) & 3; const int b = u3 >> 7;
        qcol = ZQD + grp * 256 + hh * 64; kcol = ZKD + grp * 256 + hh * 64; vcol = ZVD + grp * 256 + hh * 64; base = b * SEQ_ + r; max_dist = 128;
        slope_u = __builtin_amdgcn_exp2f(-8.0f * (float)(8 + 4 * grp + hh + 1) / 20.0f) * (float)dil;
    }
    LAS bf16_t* Qs = (LAS bf16_t*)L;
    LAS bf16_t* Ks = Qs + 128 * 72;
    LAS bf16_t* Vt = Ks + 272 * 72;
    for (int i = tid; i < 1024; i += 512) { const int r = i >> 3, c = i & 7; const size_t tok = (size_t)(base + (blk * 128 + r) * dil);
        *(LAS u32x4*)(Qs + r * 72 + c * 8) = *(const u32x4*)(Z + tok * NZ_ + qcol + c * 8); }
#pragma unroll 1
    for (int i = tid; i < 2176; i += 512) { const int r = i >> 3, c = i & 7; const int sub = blk * 128 - 128 + r; const bool ok = (r < 256) && (sub >= 0);
        u32x4 kv = {0u, 0u, 0u, 0u}, vv = {0u, 0u, 0u, 0u};
        if (ok) { const size_t tok = (size_t)(base + sub * dil); kv = *(const u32x4*)(Z + tok * NZ_ + kcol + c * 8); vv = *(const u32x4*)(Z + tok * NZ_ + vcol + c * 8); }
        *(LAS u32x4*)(Ks + r * 72 + c * 8) = kv;
        LAS bf16_t* vp = Vt + (c * 8) * 280 + r;
        vp[0 * 280] = (bf16_t)(vv.x & 0xffffu); vp[1 * 280] = (bf16_t)(vv.x >> 16); vp[2 * 280] = (bf16_t)(vv.y & 0xffffu); vp[3 * 280] = (bf16_t)(vv.y >> 16);
        vp[4 * 280] = (bf16_t)(vv.z & 0xffffu); vp[5 * 280] = (bf16_t)(vv.z >> 16); vp[6 * 280] = (bf16_t)(vv.w & 0xffffu); vp[7 * 280] = (bf16_t)(vv.w >> 16); }
    __syncthreads();
    const int q0 = wave * 16, qi = lane & 15, g = lane >> 4;
    bf16x8 bq[2];
#pragma unroll
    for (int ks = 0; ks < 2; ++ks) bq[ks] = *(const LAS bf16x8*)(Qs + (q0 + qi) * 72 + ks * 32 + g * 8);
    f32x4 st[10];
#pragma unroll
    for (int i = 0; i < 10; ++i) { f32x4 acc = {0.f, 0.f, 0.f, 0.f};
#pragma unroll
        for (int ks = 0; ks < 2; ++ks) { const bf16x8 ak = *(const LAS bf16x8*)(Ks + ((wave + i) * 16 + qi) * 72 + ks * 32 + g * 8); acc = mfma16(ak, bq[ks], acc); }
        st[i] = acc; }
    float mx = -3.0e38f;
    const int q = q0 + qi;
#pragma unroll
    for (int i = 0; i < 10; ++i)
#pragma unroll
        for (int j = 0; j < 4; ++j) { const int kk = (wave + i) * 16 + 4 * g + j; const int dist = q + 128 - kk;
            const bool valid = (dist >= 0) && (dist <= max_dist) && (blk > 0 || kk >= 128);
            const float s = valid ? (st[i][j] * 0.125f - slope_u * (float)dist) : -1.0e30f; st[i][j] = s; mx = fmaxf(mx, s); }
    mx = fmaxf(mx, __shfl_xor(mx, 16)); mx = fmaxf(mx, __shfl_xor(mx, 32));
    if (isA) mx = fmaxf(mx, sink);
    float den = 0.f;
#pragma unroll
    for (int i = 0; i < 10; ++i)
#pragma unroll
        for (int j = 0; j < 4; ++j) { const float p = __builtin_amdgcn_exp2f((st[i][j] - mx) * LOG2E); st[i][j] = p; den += p; }
    den += __shfl_xor(den, 16); den += __shfl_xor(den, 32);
    if (isA) den += __builtin_amdgcn_exp2f((sink - mx) * LOG2E);
    f32x4 o[4];
#pragma unroll
    for (int ht = 0; ht < 4; ++ht) o[ht] = (f32x4){0.f, 0.f, 0.f, 0.f};
#pragma unroll
    for (int i = 0; i < 5; ++i) { const int ta = wave + 2 * i, tb = ta + 1;
        u32x4 pw; pw.x = pk2(st[2 * i][0], st[2 * i][1]); pw.y = pk2(st[2 * i][2], st[2 * i][3]); pw.z = pk2(st[2 * i + 1][0], st[2 * i + 1][1]); pw.w = pk2(st[2 * i + 1][2], st[2 * i + 1][3]);
        const bf16x8 bp = __builtin_bit_cast(bf16x8, pw);
#pragma unroll
        for (int ht = 0; ht < 4; ++ht) { const LAS bf16_t* vr = Vt + (ht * 16 + qi) * 280 + 4 * g;
            const u32x2 va = *(const LAS u32x2*)(vr + ta * 16), vb = *(const LAS u32x2*)(vr + tb * 16);
            o[ht] = mfma16(mk8(va, vb), bp, o[ht]); } }
    const float inv = 1.0f / den;
    const size_t tok = (size_t)(base + (blk * 128 + q) * dil);
    if (isA) {
#pragma unroll
        for (int ht = 0; ht < 4; ++ht) { u32x2 w; w.x = pk2(o[ht][0] * inv, o[ht][1] * inv); w.y = pk2(o[ht][2] * inv, o[ht][3] * inv);
            *(u32x2*)(O + tok * NO_ + hh * 64 + ht * 16 + 4 * g) = w; }
    } else {
#pragma unroll
        for (int ht = 0; ht < 4; ++ht) *(f32x4*)(DPO + ((size_t)grp * T_ + tok) * 256 + hh * 64 + ht * 16 + 4 * g) = o[ht] * inv;
        if (g == 0) DLSE[((size_t)grp * T_ + tok) * 4 + hh] = mx + logf(den);
    }
    __syncthreads();
}

__device__ __forceinline__ void gmlp_unit(LAS unsigned char* L, const bf16_t* Z, int unit, const float* lng, const float* lnb, const float* ws_, const float* bs, bf16_t* O, int tid, int wave, int lane) {
    const int n = unit >> 2, grp = unit & 3, tok0 = n * 128;
    LAS float* stats = (LAS float*)L;
    LAS bf16_t* vnt = (LAS bf16_t*)(L + 1024);
    LAS bf16_t* Wc = vnt + 128 * 136;
#pragma unroll 1
    for (int r = 0; r < 16; ++r) { const int row = 16 * wave + r;
        const u32x4 raw = *(const u32x4*)(Z + (size_t)(tok0 + row) * NZ_ + ZVB + lane * 8);
        float x[8]; x[0] = gelu_erf(bflo(raw.x)); x[1] = gelu_erf(bfhi(raw.x)); x[2] = gelu_erf(bflo(raw.y)); x[3] = gelu_erf(bfhi(raw.y));
        x[4] = gelu_erf(bflo(raw.z)); x[5] = gelu_erf(bfhi(raw.z)); x[6] = gelu_erf(bflo(raw.w)); x[7] = gelu_erf(bfhi(raw.w));
        float s = 0.f;
#pragma unroll
        for (int e = 0; e < 8; ++e) s += x[e];
        const float mean = wave_sum(s) * (1.f / 512.f); float s2 = 0.f;
#pragma unroll
        for (int e = 0; e < 8; ++e) { const float d = x[e] - mean; s2 += d * d; }
        const float rstd = 1.f / sqrtf(wave_sum(s2) * (1.f / 512.f) + LN_EPS);
        if (lane == 0) { stats[row * 2] = mean; stats[row * 2 + 1] = rstd; } }
    for (int i = tid; i < 4096; i += 512) { const int t = i >> 5, s4 = (i & 31) * 4;
        f32x4 w = *(const f32x4*)(ws_ + (size_t)(grp * 128 + t) * 128 + s4);
#pragma unroll
        for (int e = 0; e < 4; ++e) if (s4 + e > t) w[e] = 0.f;
        u32x2 p; p.x = pk2(w[0], w[1]); p.y = pk2(w[2], w[3]); *(LAS u32x2*)(Wc + t * 136 + s4) = p; }
    __syncthreads();
#pragma unroll 1
    for (int i = tid; i < 2048; i += 512) { const int s = i >> 4, c8 = (i & 15) * 8;
        const u32x4 raw = *(const u32x4*)(Z + (size_t)(tok0 + s) * NZ_ + ZVB + grp * 128 + c8);
        const float mean = stats[s * 2], rstd = stats[s * 2 + 1];
        float x[8]; x[0] = bflo(raw.x); x[1] = bfhi(raw.x); x[2] = bflo(raw.y); x[3] = bfhi(raw.y); x[4] = bflo(raw.z); x[5] = bfhi(raw.z); x[6] = bflo(raw.w); x[7] = bfhi(raw.w);
#pragma unroll
        for (int e = 0; e < 8; ++e) { const float y = (gelu_erf(x[e]) - mean) * rstd * lng[grp * 128 + c8 + e] + lnb[grp * 128 + c8 + e];
            vnt[(c8 + e) * 136 + s] = (bf16_t)(pk2(y, 0.f) & 0xffffu); } }
    __syncthreads();
    const int qi = lane & 15, g = lane >> 4;
    f32x4 acc[8];
#pragma unroll
    for (int ct = 0; ct < 8; ++ct) acc[ct] = (f32x4){0.f, 0.f, 0.f, 0.f};
#pragma unroll
    for (int ks = 0; ks < 4; ++ks) { const bf16x8 bw = *(const LAS bf16x8*)(Wc + (16 * wave + qi) * 136 + ks * 32 + g * 8);
#pragma unroll
        for (int ct = 0; ct < 8; ++ct) { const bf16x8 av = *(const LAS bf16x8*)(vnt + (16 * ct + qi) * 136 + ks * 32 + g * 8); acc[ct] = mfma16(av, bw, acc[ct]); } }
    const int t = 16 * wave + qi; const float bias = bs[grp * 128 + t];
    const size_t tok = (size_t)(tok0 + t);
#pragma unroll
    for (int ct = 0; ct < 8; ++ct) { const int c = 16 * ct + 4 * g;
        const u32x2 ur = *(const u32x2*)(Z + tok * NZ_ + ZUB + grp * 128 + c);
        u32x2 w; w.x = pk2(gelu_erf(bflo(ur.x)) * (acc[ct][0] + bias), gelu_erf(bfhi(ur.x)) * (acc[ct][1] + bias));
        w.y = pk2(gelu_erf(bflo(ur.y)) * (acc[ct][2] + bias), gelu_erf(bfhi(ur.y)) * (acc[ct][3] + bias));
        *(u32x2*)(O + tok * NO_ + 512 + grp * 128 + c) = w; }
    __syncthreads();
}

__device__ __forceinline__ float hgrn_lb(const float* lbl, int layer, int c) { return layer == 0 ? 0.0f : 1.0f / (1.0f + expf(lbl[c] - lbl[512 + c])); }

__device__ __forceinline__ void hgrn_c1_unit(LAS unsigned char* L, const bf16_t* Z, int unit, const float* lbl, int layer, float* DS, float* DEC, int tid, int wave, int lane) {
    const int h = unit & 3, cg_ = unit >> 2, tok0 = cg_ * 64;
    const int k = tid & 127, qtr = tid >> 7;
    LAS float* qsum = (LAS float*)L;
    LAS bf16_t* kt = (LAS bf16_t*)(L + 2048);
    LAS bf16_t* vt = kt + 128 * 72;
    const float lb = hgrn_lb(lbl, layer, h * 128 + k);
    float G[16], kk[16]; float run = 0.f;
    unsigned vraw[16];
#pragma unroll
    for (int i = 0; i < 16; ++i) { const size_t tok = (size_t)(tok0 + 16 * qtr + i);
        const float zf = bf2f(Z[tok * NZ_ + ZFC + h * 128 + k]);
        vraw[i] = Z[tok * NZ_ + ZIC + h * 128 + k];
        const float e = fexp(-zf), sg = frcp(1.0f + e);
        const float f = lb + (1.0f - lb) * sg;
        run += logf(fmaxf(f, 1e-6f)); G[i] = run; kk[i] = (1.0f - lb) * e * sg; }
    qsum[qtr * 128 + k] = run;
    __syncthreads();
    float off = 0.f, tot = 0.f;
#pragma unroll
    for (int qq = 0; qq < 4; ++qq) { const float v = qsum[qq * 128 + k]; tot += v; if (qq < qtr) off += v; }
    unsigned kw[8], vw[8];
#pragma unroll
    for (int i = 0; i < 8; ++i) { const float a0 = kk[2 * i] * fexp(tot - (G[2 * i] + off)), a1 = kk[2 * i + 1] * fexp(tot - (G[2 * i + 1] + off));
        kw[i] = pk2(a0, a1); vw[i] = vraw[2 * i] | (vraw[2 * i + 1] << 16); }
    *(LAS u32x4*)(kt + k * 72 + 16 * qtr) = (u32x4){kw[0], kw[1], kw[2], kw[3]}; *(LAS u32x4*)(kt + k * 72 + 16 * qtr + 8) = (u32x4){kw[4], kw[5], kw[6], kw[7]};
    *(LAS u32x4*)(vt + k * 72 + 16 * qtr) = (u32x4){vw[0], vw[1], vw[2], vw[3]}; *(LAS u32x4*)(vt + k * 72 + 16 * qtr + 8) = (u32x4){vw[4], vw[5], vw[6], vw[7]};
    if (qtr == 0) DEC[(size_t)unit * 128 + k] = fexp(tot);
    __syncthreads();
    const int qi = lane & 15, g = lane >> 4;
    bf16x8 av[2];
#pragma unroll
    for (int ks = 0; ks < 2; ++ks) av[ks] = *(const LAS bf16x8*)(vt + (16 * wave + qi) * 72 + ks * 32 + g * 8);
    float* dst = DS + (size_t)unit * 16384;
#pragma unroll
    for (int ktile = 0; ktile < 8; ++ktile) { f32x4 acc = {0.f, 0.f, 0.f, 0.f};
#pragma unroll
        for (int ks = 0; ks < 2; ++ks) { const bf16x8 bk = *(const LAS bf16x8*)(kt + (16 * ktile + qi) * 72 + ks * 32 + g * 8); acc = mfma16(av[ks], bk, acc); }
#pragma unroll
        for (int j = 0; j < 4; ++j) dst[(16 * wave + 4 * g + j) * 128 + 16 * ktile + qi] = acc[j]; }
    __syncthreads();
}

__device__ __forceinline__ void hgrn_scan_phase(const float* DS, const float* DEC, bf16_t* HS, int tid, int bid, int G) {
    const int nth = G * 512;
    for (int p = bid * 512 + tid; p < 16 * 8192; p += nth) {
        const int bh = p >> 13, idx = (p & 8191) * 2, k = idx & 127, b = bh >> 2, h = bh & 3;
        f32x2 S = {0.f, 0.f};
#pragma unroll 8
        for (int c = 0; c < 64; ++c) { const size_t u = (size_t)(((b * 64 + c) << 2) | h);
            *(unsigned*)(HS + u * 16384 + idx) = pk2(S[0], S[1]);
            const f32x2 d = *(const f32x2*)(DEC + u * 128 + k), ds = *(const f32x2*)(DS + u * 16384 + idx);
            S = d * S + ds; }
    }
}

__device__ __forceinline__ void hgrn_c3_unit(LAS unsigned char* L, const bf16_t* Z, int unit, const float* lbl, int layer, const bf16_t* HS, const float* ng, bf16_t* O, int tid, int wave, int lane) {
    const int h = unit & 3, cg_ = unit >> 2, tok0 = cg_ * 64;
    const int k = tid & 127, qtr = tid >> 7;
    LAS float* qsum = (LAS float*)L;
    LAS bf16_t* kT = (LAS bf16_t*)(L + 2048);
    LAS bf16_t* qT = kT + 64 * 136;
    LAS bf16_t* qC = qT + 64 * 136;
    LAS bf16_t* vt = qC + 64 * 136;
    LAS float* oL = (LAS float*)(L + 2048 + 3 * 64 * 136 * 2 + 128 * 72 * 2);
    const float lb = hgrn_lb(lbl, layer, h * 128 + k);
    float G[16], kk[16], qv[16]; float run = 0.f;
    unsigned vraw[16];
#pragma unroll
    for (int i = 0; i < 16; ++i) { const size_t tok = (size_t)(tok0 + 16 * qtr + i);
        const float zf = bf2f(Z[tok * NZ_ + ZFC + h * 128 + k]);
        qv[i] = bf2f(Z[tok * NZ_ + ZQC + h * 128 + k]);
        vraw[i] = Z[tok * NZ_ + ZIC + h * 128 + k];
        const float e = fexp(-zf), sg = frcp(1.0f + e);
        const float f = lb + (1.0f - lb) * sg;
        run += logf(fmaxf(f, 1e-6f)); G[i] = run; kk[i] = (1.0f - lb) * e * sg; }
    qsum[qtr * 128 + k] = run;
    __syncthreads();
    float off = 0.f;
#pragma unroll
    for (int qq = 0; qq < 4; ++qq) { const float v = qsum[qq * 128 + k]; if (qq < qtr) off += v; }
    const float Gm = qsum[k] + qsum[128 + k];
#pragma unroll
    for (int i = 0; i < 16; ++i) { const int t = 16 * qtr + i; const float Gi = G[i] + off;
        const float d = fminf(fmaxf(Gi - Gm, -80.f), 80.f);
        const float e1 = fexp(d), e2 = fexp(-d);
        kT[t * 136 + k] = (bf16_t)(pk2(kk[i] * e2, 0.f) & 0xffffu);
        qT[t * 136 + k] = (bf16_t)(pk2(qv[i] * e1, 0.f) & 0xffffu);
        qC[t * 136 + k] = (bf16_t)(pk2(qv[i] * fexp(Gi), 0.f) & 0xffffu); }
    {
        unsigned vw[8];
#pragma unroll
        for (int i = 0; i < 8; ++i) vw[i] = vraw[2 * i] | (vraw[2 * i + 1] << 16);
        *(LAS u32x4*)(vt + k * 72 + 16 * qtr) = (u32x4){vw[0], vw[1], vw[2], vw[3]}; *(LAS u32x4*)(vt + k * 72 + 16 * qtr + 8) = (u32x4){vw[4], vw[5], vw[6], vw[7]};
    }
    __syncthreads();
    const int qi = lane & 15, g = lane >> 4, tt = wave & 3, vh = wave >> 2;
    f32x4 sc[4];
#pragma unroll
    for (int st = 0; st < 4; ++st) { sc[st] = (f32x4){0.f, 0.f, 0.f, 0.f};
        if (st <= tt) {
#pragma unroll
            for (int ks = 0; ks < 4; ++ks) { const bf16x8 a = *(const LAS bf16x8*)(kT + (16 * st + qi) * 136 + ks * 32 + g * 8), b = *(const LAS bf16x8*)(qT + (16 * tt + qi) * 136 + ks * 32 + g * 8);
                sc[st] = mfma16(a, b, sc[st]); }
#pragma unroll
            for (int j = 0; j < 4; ++j) if (16 * st + 4 * g + j > 16 * tt + qi) sc[st][j] = 0.f;
        } }
    f32x4 o[4];
#pragma unroll
    for (int v_ = 0; v_ < 4; ++v_) o[v_] = (f32x4){0.f, 0.f, 0.f, 0.f};
#pragma unroll
    for (int i = 0; i < 2; ++i) {
        u32x4 pw; pw.x = pk2(sc[2 * i][0], sc[2 * i][1]); pw.y = pk2(sc[2 * i][2], sc[2 * i][3]); pw.z = pk2(sc[2 * i + 1][0], sc[2 * i + 1][1]); pw.w = pk2(sc[2 * i + 1][2], sc[2 * i + 1][3]);
        const bf16x8 bp = __builtin_bit_cast(bf16x8, pw);
#pragma unroll
        for (int v_ = 0; v_ < 4; ++v_) { const LAS bf16_t* vr = vt + (16 * (4 * vh + v_) + qi) * 72 + 4 * g;
            const u32x2 va = *(const LAS u32x2*)(vr + (2 * i) * 16), vb = *(const LAS u32x2*)(vr + (2 * i + 1) * 16);
            o[v_] = mfma16(mk8(va, vb), bp, o[v_]); } }
    const bf16_t* hs = HS + (size_t)unit * 16384;
#pragma unroll
    for (int ks = 0; ks < 4; ++ks) { const bf16x8 b = *(const LAS bf16x8*)(qC + (16 * tt + qi) * 136 + ks * 32 + g * 8);
#pragma unroll
        for (int v_ = 0; v_ < 4; ++v_) { const bf16x8 a = *(const bf16x8*)(hs + (16 * (4 * vh + v_) + qi) * 128 + ks * 32 + g * 8); o[v_] = mfma16(a, b, o[v_]); } }
#pragma unroll
    for (int v_ = 0; v_ < 4; ++v_) *(LAS f32x4*)(oL + (16 * tt + qi) * 132 + 16 * (4 * vh + v_) + 4 * g) = o[v_];
    __syncthreads();
#pragma unroll 1
    for (int r = 0; r < 8; ++r) { const int t = 8 * wave + r;
        const float x0 = oL[t * 132 + lane], x1 = oL[t * 132 + 64 + lane];
        const float ss = wave_sum(x0 * x0 + x1 * x1);
        const float rs = 1.0f / sqrtf(ss * (1.f / 128.f) + LN_EPS);
        const size_t tok = (size_t)(tok0 + t);
        const float g0 = bf2f(Z[tok * NZ_ + ZGC + h * 128 + lane]), g1 = bf2f(Z[tok * NZ_ + ZGC + h * 128 + 64 + lane]);
        const float y0 = x0 * rs * ng[h * 128 + lane] * fsigmoid(g0), y1 = x1 * rs * ng[h * 128 + 64 + lane] * fsigmoid(g1);
        O[tok * NO_ + 1024 + h * 128 + lane] = (bf16_t)(pk2(y0, 0.f) & 0xffffu);
        O[tok * NO_ + 1024 + h * 128 + 64 + lane] = (bf16_t)(pk2(y1, 0.f) & 0xffffu); }
    __syncthreads();
}

__device__ __forceinline__ void dcomb_phase(const float* DPO, const float* DLSE, bf16_t* O, int tid, int bid, int G) {
    const int nth = G * 512;
    for (int i = bid * 512 + tid; i < T_ * 64; i += nth) { const int t = i >> 6, c4 = (i & 63) * 4, h = c4 >> 6;
        const float l0 = DLSE[((size_t)0 * T_ + t) * 4 + h], l1 = DLSE[((size_t)1 * T_ + t) * 4 + h], l2 = DLSE[((size_t)2 * T_ + t) * 4 + h];
        const float m = fmaxf(l0, fmaxf(l1, l2));
        float w0 = fexp(l0 - m), w1 = fexp(l1 - m), w2 = fexp(l2 - m); const float inv = 1.0f / (w0 + w1 + w2); w0 *= inv; w1 *= inv; w2 *= inv;
        const f32x4 a = *(const f32x4*)(DPO + ((size_t)0 * T_ + t) * 256 + c4), b = *(const f32x4*)(DPO + ((size_t)1 * T_ + t) * 256 + c4), c = *(const f32x4*)(DPO + ((size_t)2 * T_ + t) * 256 + c4);
        const f32x4 r = w0 * a + w1 * b + w2 * c;
        u32x2 w; w.x = pk2(r[0], r[1]); w.y = pk2(r[2], r[3]);
        *(u32x2*)(O + (size_t)t * NO_ + 1536 + c4) = w; }
}

constexpr int NPH_LAYER = 14, NPH = 2 * NPH_LAYER;
__global__ void __launch_bounds__(512, 2) hybrid_fwd(Args a) {
    extern __shared__ __attribute__((aligned(16))) unsigned char lds_raw[];
    LAS unsigned char* lds = (LAS unsigned char*)lds_raw;
    PTab pt = (PTab)(lds + 131072);
    if (threadIdx.x == 0) {
#pragma unroll
        for (int i = 0; i < 22; ++i) pt[i] = (unsigned long long)a.in[i];
        pt[22] = (unsigned long long)a.out; pt[23] = (unsigned long long)a.ws;
    }
    __syncthreads();
    const int ph_lo = a.ph_lo, ph_hi = a.ph_hi;
    for (int ph = ph_lo; ph < ph_hi; ++ph) {
        const int l = ph / NPH_LAYER, p = ph - l * NPH_LAYER;
        pg8::StaticOrder S;
        int tid = threadIdx.x; asm volatile("" : "+v"(tid));
        int bid = blockIdx.x, G = gridDim.x; asm volatile("" : "+s"(bid), "+s"(G));
        const int lane = tid & 63, wave = __builtin_amdgcn_readfirstlane(tid >> 6);
        unsigned char* ws = (unsigned char*)ldptr(pt, 23);
#define P_X ((float*)ldptr(pt, 22))
#define P_XB ((bf16_t*)(ws + WS_XB))
#define P_ZH ((bf16_t*)(ws + WS_ZH))
#define P_GATE ((bf16_t*)(ws + WS_GATE))
#define P_O ((bf16_t*)(ws + WS_O))
#define P_DS ((float*)(ws + WS_XB))
#define P_DEC ((float*)(ws + WS_CTL))
#define P_HS ((bf16_t*)(ws + WS_HS))
#define P_DPO ((float*)(ws + WS_DPO))
#define P_DLSE ((float*)(ws + WS_DLSE))
        switch (p) {
        case 0: if (l == 0) convert_phase(pt, 0, lds, tid, wave, lane, bid, G); break;
        case 1: case 11: {
            const int s = (p == 1) ? 0 : 1;
            pg8::Gemm g{P_XB, (const bf16_t*)(ws + WS_WGU + (size_t)s * 44 * MiB), T_, 2 * FF_, D_}; S.init(T_, 2 * FF_, G, bid);
            pg8::EpiSwiGLU E{P_ZH}; pg8::gemm_phase(lds, g, S, E);
            if (p == 11) { int kp = PLE_; asm volatile("" : "+s"(kp)); pg8::Gemm g2{(const bf16_t*)(ws + WS_PB) + (size_t)l * T_ * PLE_, (const bf16_t*)(ws + WS_WPP), T_, D_, kp}; S.init(T_, D_, G, bid);
                pg8::EpiBf16 E2{P_GATE, D_}; pg8::gemm_phase(lds, g2, S, E2); }
        } break;
        case 2: {
            pg8::Gemm g{P_ZH, (const bf16_t*)(ws + WS_WD), T_, D_, FF_}; S.init(T_, D_, G, bid);
            pg8::EpiResid E{P_X, ALPHA, 0.5f}; pg8::gemm_phase(lds, g, S, E);
        } break;
        case 3: case 10: case 13: {
            const int which = (p == 3) ? 0 : (p == 10 ? 1 : 2);
            ln_phase(P_X, P_XB, ldptr(pt, 2) + (size_t)(l * 3 + which) * D_, ldptr(pt, 3) + (size_t)(l * 3 + which) * D_, wave, lane, bid, G);
            if (p == 13 && l == 0) convert_phase(pt, 1, lds, tid, wave, lane, bid, G);
        } break;
        case 4: {
            pg8::Gemm g{P_XB, (const bf16_t*)(ws + WS_WIN), T_, NIN_, D_}; S.init(T_, NIN_, G, bid);
            pg8::EpiZ E{P_ZH, P_GATE}; pg8::gemm_phase(lds, g, S, E);
        } break;
        case 5: {
            for (int u = bid; u < 2560; u += G) attn_unit(lds, P_ZH, u, ldptr(pt, 8) + l * 8, P_O, P_DPO, P_DLSE, tid, wave, lane);
            for (int u = bid; u < 512; u += G) gmlp_unit(lds, P_ZH, u, ldptr(pt, 9) + l * 512, ldptr(pt, 10) + l * 512, ldptr(pt, 11) + (size_t)l * 65536, ldptr(pt, 12) + l * 512, P_O, tid, wave, lane);
            for (int u = bid; u < 1024; u += G) hgrn_c1_unit(lds, P_ZH, u, ldptr(pt, 13), l, P_DS, P_DEC, tid, wave, lane);
        } break;
        case 6: hgrn_scan_phase(P_DS, P_DEC, P_HS, tid, bid, G); break;
        case 7: {
            for (int u = bid; u < 1024; u += G) hgrn_c3_unit(lds, P_ZH, u, ldptr(pt, 13), l, P_HS, ldptr(pt, 14) + l * 512, P_O, tid, wave, lane);
            dcomb_phase(P_DPO, P_DLSE, P_O, tid, bid, G);
        } break;
        case 8: {
            pg8::Gemm g{P_O, (const bf16_t*)(ws + WS_WBR), T_, D_, NO_}; S.init(T_, D_, G, bid);
            pg8::EpiBR E{P_ZH, P_GATE}; pg8::gemm_phase(lds, g, S, E);
        } break;
        case 9: {
            pg8::Gemm g{P_ZH, (const bf16_t*)(ws + WS_WOUT), T_, D_, D_}; S.init(T_, D_, G, bid);
            pg8::EpiResid E{P_X, ALPHA, 1.0f}; pg8::gemm_phase(lds, g, S, E);
        } break;
        case 12: {
            { pg8::Gemm g{P_XB, (const bf16_t*)(ws + WS_WPG), T_, D_, D_}; S.init(T_, D_, G, bid);
              pg8::EpiPle E{P_X, P_GATE, ALPHA}; pg8::gemm_phase(lds, g, S, E); }
            { pg8::Gemm g{P_ZH, (const bf16_t*)(ws + WS_WD + (size_t)22 * MiB), T_, D_, FF_}; S.init(T_, D_, G, bid);
              pg8::EpiResid E{P_X, 1.0f, 0.5f}; pg8::gemm_phase(lds, g, S, E); }
        } break;
        default: break;
        }
        if (ph + 1 < ph_hi) { __threadfence(); cg::this_grid().sync(); }
    }
}

extern "C" void kernel_launch(void* const* d_in, const int* in_sizes, int n_in, void* d_out, int out_size, void* d_ws, size_t ws_size, hipStream_t stream) {
    static int grid = 0;
    if (grid == 0) {
        if (n_in != 22 || out_size != T_ * D_ || ws_size < WS_END) { fprintf(stderr, "kernel_launch: unexpected shapes (n_in %d out %d ws %zu need %zu)\n", n_in, out_size, ws_size, (size_t)WS_END); grid = -1; return; }
        int dev = 0, cus = 0, per_cu = 0;
        hipGetDevice(&dev); hipDeviceGetAttribute(&cus, hipDeviceAttributeMultiprocessorCount, dev);
        if (hipFuncSetAttribute((const void*)hybrid_fwd, hipFuncAttributeMaxDynamicSharedMemorySize, LDS_BYTES) != hipSuccess) { fprintf(stderr, "kernel_launch: hipFuncSetAttribute failed\n"); grid = -1; return; }
        hipOccupancyMaxActiveBlocksPerMultiprocessor(&per_cu, (const void*)hybrid_fwd, 512, LDS_BYTES);
        (void)hipGetLastError();
        if (per_cu < 1) per_cu = 1;
        grid = cus * 1;
    }
    if (grid < 0) return;
    Args a{};
    for (int i = 0; i < 22; ++i) a.in[i] = (const float*)d_in[i];
    a.out = (float*)d_out; a.ws = (unsigned char*)d_ws; a.ph_lo = 0; a.ph_hi = NPH;
    void* args[] = {&a};
    hipError_t e = hipLaunchCooperativeKernel((const void*)hybrid_fwd, dim3(grid), dim3(512), args, LDS_BYTES, stream);
    if (e != hipSuccess) fprintf(stderr, "cooperative launch failed: %s (grid %d)\n", hipGetErrorString(e), grid);
}
```

```cpp
#include <hip/hip_runtime.h>
#include <hip/hip_cooperative_groups.h>
#include <cstdio>
#include <cstdint>
namespace cg = cooperative_groups;

#define LAS __attribute__((address_space(3)))
typedef unsigned short bf16_t;
typedef short bf16x8 __attribute__((ext_vector_type(8)));
typedef float f32x4 __attribute__((ext_vector_type(4)));
typedef float f32x2 __attribute__((ext_vector_type(2)));
typedef unsigned u32x4 __attribute__((ext_vector_type(4)));
typedef unsigned u32x2 __attribute__((ext_vector_type(2)));

constexpr int T_ = 16384, SEQ_ = 4096, D_ = 2048, FF_ = 5632, NIN_ = 14336, NZ_ = 6144, NGT_ = 8192, NO_ = 1792, PLE_ = 256;
constexpr int ZQA = 0, ZKA = 512, ZVA = 640, ZUB = 768, ZVB = 1280, ZQC = 1792, ZFC = 2304, ZIC = 2816, ZGC = 3328, ZQD = 3840, ZKD = 4608, ZVD = 5376;
constexpr float LN_EPS = 1e-5f;
constexpr float ALPHA = 1.41421356237f;
constexpr float LOG2E = 1.44269504089f;

constexpr size_t MiB = 1u << 20;
constexpr size_t WS_CTL = 0;
constexpr size_t WS_BAR = 768 * 1024, BAR_BYTES = 16384;
constexpr size_t WS_WGU = 1 * MiB;
constexpr size_t WS_WPG = WS_WGU + 88 * MiB;
constexpr size_t WS_WD = WS_WPG + 8 * MiB;
constexpr size_t WS_WIN = WS_WD + 44 * MiB;
constexpr size_t WS_WBR = WS_WIN + 56 * MiB;
constexpr size_t WS_WOUT = WS_WBR + 7 * MiB;
constexpr size_t WS_WPP = WS_WOUT + 8 * MiB;
constexpr size_t WS_PB = WS_WPP + 1 * MiB;
constexpr size_t WS_XB = WS_PB + 16 * MiB;
constexpr size_t WS_ZH = WS_XB + 64 * MiB;
constexpr size_t WS_GATE = WS_ZH + 192 * MiB;
constexpr size_t WS_O = WS_GATE + 256 * MiB;
constexpr size_t WS_HS = WS_O + 56 * MiB;
constexpr size_t WS_DPO = WS_HS + 32 * MiB;
constexpr size_t WS_DLSE = WS_DPO + 48 * MiB;
constexpr size_t WS_DS = WS_DLSE + 1 * MiB;
constexpr size_t WS_END = WS_DS + 64 * MiB;

constexpr int LDS_BYTES = 147456;

__device__ __forceinline__ float bf2f(unsigned b) { return __uint_as_float(b << 16); }
__device__ __forceinline__ float bflo(unsigned w) { return __uint_as_float(w << 16); }
__device__ __forceinline__ float bfhi(unsigned w) { return __uint_as_float(w & 0xffff0000u); }
__device__ __forceinline__ unsigned pk2(float lo, float hi) { unsigned r; asm("v_cvt_pk_bf16_f32 %0, %1, %2" : "=v"(r) : "v"(lo), "v"(hi)); return r; }
__device__ __forceinline__ float fexp(float x) { return __builtin_amdgcn_exp2f(x * LOG2E); }
__device__ __forceinline__ float frcp(float x) { return __builtin_amdgcn_rcpf(x); }
__device__ __forceinline__ float fsigmoid(float x) { return frcp(1.0f + fexp(-x)); }
__device__ __forceinline__ float gelu_erf(float x) { return 0.5f * x * (1.0f + erff(x * 0.70710678118f)); }
__device__ __forceinline__ float gelu_fast(float v) {
    const float av = fabsf(v), t = frcp(av * 0.2316418882f + 1.0f);
    float q = t * 0.5307027145f + (-0.7265760135f); q = q * t + 0.7107068705f; q = q * t + (-0.142248368f); q = q * t + 0.127414796f; q = q * t;
    const float e = __builtin_amdgcn_exp2f((v * v) * (-0.72134752044f));
    const float m = v * (q * e);
    return v < 0.f ? m : v - m;
}
__device__ __forceinline__ float wave_sum(float v) {
#pragma unroll
    for (int o = 1; o < 64; o <<= 1) v += __shfl_xor(v, o);
    return v;
}
__device__ __forceinline__ f32x4 mfma16(bf16x8 a, bf16x8 b, f32x4 c) { return __builtin_amdgcn_mfma_f32_16x16x32_bf16(a, b, c, 0, 0, 0); }
__device__ __forceinline__ bf16x8 mk8(u32x2 a, u32x2 b) { u32x4 t = {a.x, a.y, b.x, b.y}; return __builtin_bit_cast(bf16x8, t); }

namespace pg8 {
constexpr int BM = 256, BK = 64, HALF = 128, HTB = HALF * BK * 2, STAGE_BYTES = 8 * HTB, NXCD = 8, WGM = 8;
__device__ __forceinline__ int lds_byte(int r, int c) { const int st = (r >> 4) * 2 + (c >> 5), rr = r & 15, cc = c & 31, ob = rr * 64 + cc * 2; return st * 1024 + (ob ^ (((ob >> 9) & 1) << 5)); }
__device__ __forceinline__ void stage_rc(int b, int& R, int& C) { const int st = b / 1024, sb = b % 1024, swz = sb ^ (((sb >> 9) & 1) << 5); R = (st >> 1) * 16 + swz / 64; C = (st & 1) * 32 + (swz % 64) / 2; }
__device__ __forceinline__ int perm32(int rho) { const int n = rho >> 4, i = rho & 15; return 8 * (i >> 2) + 4 * n + (i & 3); }
struct Unit { int pm, pn; };
struct Gemm { const bf16_t* A; const bf16_t* Bt; int M, N, K; };
struct StaticOrder {
    int nM, nN, nwg, G, c;
    __device__ void init(int M, int N, int G_, int c_) { nM = M / BM; nN = N / BM; nwg = nM * nN; G = G_; c = c_; }
    __device__ bool next(int i, Unit& u) const {
        const long L = (long)i * G + c; if (L >= nwg) return false;
        int wgid = (int)L; { const int q = nwg / NXCD, r = nwg % NXCD, xcd = wgid % NXCD, off = wgid / NXCD; wgid = (xcd < r ? xcd * (q + 1) : r * (q + 1) + (xcd - r) * q) + off; }
        const int nig = WGM * nN, gid = wgid / nig, fm = gid * WGM, gsz = (nM - fm) < WGM ? (nM - fm) : WGM;
        u.pm = fm + ((wgid % nig) % gsz); u.pn = (wgid % nig) / gsz; return true;
    }
};

struct EpiSwiGLU {
    static constexpr bool PERM = true, HAS_MID = false;
    bf16_t* H; bf16_t* PP;
    __device__ __forceinline__ void mid(int, f32x4 (&)[2][2][4][2], const Unit&, int, int, int, int) const {}
    __device__ __forceinline__ void operator()(const f32x4 (&acc)[2][2][4][2], const Unit& u, int wr, int wc, int fr, int fq) const {
        const int row0 = u.pm * BM + wr * 64 + fr;
        if (u.pn < 44) {
            const int col0 = u.pn * 128 + wc * 32 + 8 * fq;
#pragma unroll
            for (int ai = 0; ai < 2; ++ai)
#pragma unroll
                for (int m = 0; m < 4; ++m) {
                    bf16_t* rowp = H + (size_t)(row0 + ai * HALF + m * 16) * FF_ + col0;
                    float h[8];
#pragma unroll
                    for (int n = 0; n < 2; ++n)
#pragma unroll
                        for (int j = 0; j < 4; ++j) { const float g = acc[ai][0][m][n][j], up = acc[ai][1][m][n][j]; h[n * 4 + j] = g * fsigmoid(g) * up; }
                    u32x4 w; w.x = pk2(h[0], h[1]); w.y = pk2(h[2], h[3]); w.z = pk2(h[4], h[5]); w.w = pk2(h[6], h[7]);
                    *(u32x4*)rowp = w;
                    asm volatile("" ::: "memory"); __builtin_amdgcn_sched_barrier(0);
                }
        } else {
            const int col0 = (u.pn - 44) * BM + wc * 32 + 8 * fq;
#pragma unroll
            for (int am = 0; am < 4; ++am) { const int ai = am >> 1, mb = (am & 1) * 2;
                u32x4 pv[2][2];
#pragma unroll
                for (int mm = 0; mm < 2; ++mm)
#pragma unroll
                    for (int bj = 0; bj < 2; ++bj) pv[mm][bj] = *(const u32x4*)(PP + (size_t)(row0 + ai * HALF + (mb + mm) * 16) * D_ + col0 + bj * HALF);
#pragma unroll
                for (int mm = 0; mm < 2; ++mm) { const int m = mb + mm;
                    bf16_t* rowp = PP + (size_t)(row0 + ai * HALF + m * 16) * D_ + col0;
#pragma unroll
                    for (int bj = 0; bj < 2; ++bj) {
                        const u32x4 p = pv[mm][bj];
                        const f32x4 a0 = acc[ai][bj][m][0], a1 = acc[ai][bj][m][1];
                        u32x4 w;
                        w.x = pk2(fsigmoid(a0[0]) * bflo(p.x), fsigmoid(a0[1]) * bfhi(p.x)); w.y = pk2(fsigmoid(a0[2]) * bflo(p.y), fsigmoid(a0[3]) * bfhi(p.y));
                        w.z = pk2(fsigmoid(a1[0]) * bflo(p.z), fsigmoid(a1[1]) * bfhi(p.z)); w.w = pk2(fsigmoid(a1[2]) * bflo(p.w), fsigmoid(a1[3]) * bfhi(p.w));
                        *(u32x4*)(rowp + bj * HALF) = w;
                    }
                }
                asm volatile("" ::: "memory"); __builtin_amdgcn_sched_barrier(0);
            }
        }
    }
};
template <bool ADD> struct EpiResidT {
    static constexpr bool PERM = false, HAS_MID = false;
    float* Y; const bf16_t* XB; const bf16_t* PP; float a, b;
    __device__ __forceinline__ void mid(int, f32x4 (&)[2][2][4][2], const Unit&, int, int, int, int) const {}
    __device__ __forceinline__ void operator()(const f32x4 (&acc)[2][2][4][2], const Unit& u, int wr, int wc, int fr, int fq) const {
        const int row0 = u.pm * BM + wr * 64 + fr, col0 = u.pn * BM + wc * 32 + 4 * fq;
        constexpr int GM = ADD ? 2 : 4;
#pragma unroll
        for (int ai = 0; ai < 2; ++ai)
#pragma unroll
            for (int m0 = 0; m0 < 4; m0 += GM) {
                u32x2 xb[GM][2][2], pp[GM][2][2];
#pragma unroll
                for (int mm = 0; mm < GM; ++mm) { const size_t off = (size_t)(row0 + ai * HALF + (m0 + mm) * 16) * D_ + col0;
#pragma unroll
                    for (int bj = 0; bj < 2; ++bj)
#pragma unroll
                        for (int n = 0; n < 2; ++n) { xb[mm][bj][n] = *(const u32x2*)(XB + off + bj * HALF + n * 16); if (ADD) pp[mm][bj][n] = *(const u32x2*)(PP + off + bj * HALF + n * 16); } }
#pragma unroll
                for (int mm = 0; mm < GM; ++mm) { const int m = m0 + mm; const size_t off = (size_t)(row0 + ai * HALF + m * 16) * D_ + col0;
#pragma unroll
                    for (int bj = 0; bj < 2; ++bj)
#pragma unroll
                        for (int n = 0; n < 2; ++n) { const u32x2 x = xb[mm][bj][n]; const f32x4 s = acc[ai][bj][m][n];
                            f32x4 y; y[0] = a * bflo(x.x) + b * s[0]; y[1] = a * bfhi(x.x) + b * s[1]; y[2] = a * bflo(x.y) + b * s[2]; y[3] = a * bfhi(x.y) + b * s[3];
                            if (ADD) { const u32x2 q = pp[mm][bj][n]; y[0] += bflo(q.x); y[1] += bfhi(q.x); y[2] += bflo(q.y); y[3] += bfhi(q.y); }
                            *(f32x4*)(Y + off + bj * HALF + n * 16) = y; } }
                asm volatile("" ::: "memory"); __builtin_amdgcn_sched_barrier(0);
            }
    }
};
struct EpiZ {
    static constexpr bool PERM = true, HAS_MID = false;
    bf16_t* Z; bf16_t* GATE;
    __device__ __forceinline__ void mid(int, f32x4 (&)[2][2][4][2], const Unit&, int, int, int, int) const {}
    __device__ __forceinline__ void operator()(const f32x4 (&acc)[2][2][4][2], const Unit& u, int wr, int wc, int fr, int fq) const {
        const int row0 = u.pm * BM + wr * 64 + fr;
        if (u.pn < 24) {
            const bool isgelu = (u.pn >= 3) && (u.pn <= 6);
            const int col0 = u.pn * BM + wc * 32 + 8 * fq;
#pragma unroll
            for (int ai = 0; ai < 2; ++ai)
#pragma unroll
                for (int m = 0; m < 4; ++m) {
                    bf16_t* rowp = Z + (size_t)(row0 + ai * HALF + m * 16) * NZ_ + col0;
#pragma unroll
                    for (int bj = 0; bj < 2; ++bj) {
                        f32x4 v0 = acc[ai][bj][m][0], v1 = acc[ai][bj][m][1];
                        if (isgelu) {
#pragma unroll
                            for (int j = 0; j < 4; ++j) { v0[j] = gelu_fast(v0[j]); v1[j] = gelu_fast(v1[j]); }
                        }
                        u32x4 w; w.x = pk2(v0[0], v0[1]); w.y = pk2(v0[2], v0[3]); w.z = pk2(v1[0], v1[1]); w.w = pk2(v1[2], v1[3]);
                        *(u32x4*)(rowp + bj * HALF) = w;
                    }
                    asm volatile("" ::: "memory"); __builtin_amdgcn_sched_barrier(0);
                }
        } else {
            const int mc0 = (u.pn - 24) * 64 + wc * 16 + 4 * fq;
#pragma unroll
            for (int ai = 0; ai < 2; ++ai)
#pragma unroll
                for (int m = 0; m < 4; ++m) {
                    bf16_t* rowp = GATE + (size_t)(row0 + ai * HALF + m * 16) * D_ + mc0;
                    f32x4 e[4];
#pragma unroll
                    for (int br = 0; br < 4; ++br)
#pragma unroll
                        for (int j = 0; j < 4; ++j) e[br][j] = fminf(1.0f + fexp(-acc[ai][br >> 1][m][br & 1][j]), 1e30f);
                    f32x4 i0, i1, i2, i3;
#pragma unroll
                    for (int j = 0; j < 4; ++j) { i0[j] = frcp(e[0][j]); i1[j] = frcp(e[1][j]); i2[j] = frcp(e[2][j]); i3[j] = frcp(e[3][j]); }
                    const f32x4 r0 = e[1] * i0, r1 = e[2] * i1, r2 = e[3] * i2;
                    u32x2 w;
                    w.x = pk2(r0[0], r0[1]); w.y = pk2(r0[2], r0[3]); *(u32x2*)(rowp) = w;
                    w.x = pk2(r1[0], r1[1]); w.y = pk2(r1[2], r1[3]); *(u32x2*)(rowp + (size_t)T_ * D_) = w;
                    w.x = pk2(r2[0], r2[1]); w.y = pk2(r2[2], r2[3]); *(u32x2*)(rowp + (size_t)2 * T_ * D_) = w;
                    w.x = pk2(i3[0], i3[1]); w.y = pk2(i3[2], i3[3]); *(u32x2*)(rowp + (size_t)3 * T_ * D_) = w;
                    asm volatile("" ::: "memory"); __builtin_amdgcn_sched_barrier(0);
                }
        }
    }
};
struct EpiBf16 {
    static constexpr bool PERM = true, HAS_MID = false;
    bf16_t* O; int ldc;
    __device__ __forceinline__ void mid(int, f32x4 (&)[2][2][4][2], const Unit&, int, int, int, int) const {}
    __device__ __forceinline__ void operator()(const f32x4 (&acc)[2][2][4][2], const Unit& u, int wr, int wc, int fr, int fq) const {
        const int row0 = u.pm * BM + wr * 64 + fr, col0 = u.pn * BM + wc * 32 + 8 * fq;
#pragma unroll
        for (int ai = 0; ai < 2; ++ai)
#pragma unroll
            for (int m = 0; m < 4; ++m) {
                bf16_t* rowp = O + (size_t)(row0 + ai * HALF + m * 16) * ldc + col0;
#pragma unroll
                for (int bj = 0; bj < 2; ++bj) {
                    const f32x4 v0 = acc[ai][bj][m][0], v1 = acc[ai][bj][m][1];
                    u32x4 w; w.x = pk2(v0[0], v0[1]); w.y = pk2(v0[2], v0[3]); w.z = pk2(v1[0], v1[1]); w.w = pk2(v1[2], v1[3]);
                    *(u32x4*)(rowp + bj * HALF) = w;
                }
                asm volatile("" ::: "memory"); __builtin_amdgcn_sched_barrier(0);
            }
    }
};
struct EpiBR {
    static constexpr bool PERM = true, HAS_MID = true;
    bf16_t* O; const bf16_t* GATE;
    __device__ __forceinline__ void scale(const bf16_t* plane, f32x4 (&acc)[2][2][4][2], const Unit& u, int wr, int wc, int fr, int fq) const {
        const int row0 = u.pm * BM + wr * 64 + fr, col0 = u.pn * BM + wc * 32 + 8 * fq;
        u32x4 r[2][4][2];
#pragma unroll
        for (int ai = 0; ai < 2; ++ai)
#pragma unroll
            for (int m = 0; m < 4; ++m)
#pragma unroll
                for (int bj = 0; bj < 2; ++bj) r[ai][m][bj] = *(const u32x4*)(plane + (size_t)(row0 + ai * HALF + m * 16) * D_ + col0 + bj * HALF);
#pragma unroll
        for (int ai = 0; ai < 2; ++ai)
#pragma unroll
            for (int m = 0; m < 4; ++m)
#pragma unroll
                for (int bj = 0; bj < 2; ++bj) { const u32x4 e = r[ai][m][bj];
                    acc[ai][bj][m][0] *= (f32x4){bflo(e.x), bfhi(e.x), bflo(e.y), bfhi(e.y)}; acc[ai][bj][m][1] *= (f32x4){bflo(e.z), bfhi(e.z), bflo(e.w), bfhi(e.w)}; }
    }
    __device__ __forceinline__ void mid(int t, f32x4 (&acc)[2][2][4][2], const Unit& u, int wr, int wc, int fr, int fq) const {
        if (t != 8 && t != 16 && t != 24) return;
        asm volatile("" : "+v"(fr), "+v"(fq));
        scale(GATE + (size_t)((t >> 3) - 1) * T_ * D_, acc, u, wr, wc, fr, fq);
    }
    __device__ __forceinline__ void operator()(f32x4 (&acc)[2][2][4][2], const Unit& u, int wr, int wc, int fr, int fq) const {
        scale(GATE + (size_t)3 * T_ * D_, acc, u, wr, wc, fr, fq);
        const int row0 = u.pm * BM + wr * 64 + fr, col0 = u.pn * BM + wc * 32 + 8 * fq;
#pragma unroll
        for (int ai = 0; ai < 2; ++ai)
#pragma unroll
            for (int m = 0; m < 4; ++m) {
                bf16_t* rowp = O + (size_t)(row0 + ai * HALF + m * 16) * D_ + col0;
#pragma unroll
                for (int bj = 0; bj < 2; ++bj) {
                    const f32x4 a0 = acc[ai][bj][m][0], a1 = acc[ai][bj][m][1];
                    u32x4 w; w.x = pk2(a0[0], a0[1]); w.y = pk2(a0[2], a0[3]); w.z = pk2(a1[0], a1[1]); w.w = pk2(a1[2], a1[3]);
                    *(u32x4*)(rowp + bj * HALF) = w;
                }
            }
    }
};

template <class Epi, bool KREV = false>
__device__ __forceinline__ void gemm_phase(LAS unsigned char* lds, const Gemm g, const StaticOrder& S, const Epi& E) {
    int tid = threadIdx.x; asm volatile("" : "+v"(tid));
    const int wid = __builtin_amdgcn_readfirstlane(tid >> 6), lane = tid & 63, wr = wid >> 2, wc = wid & 3, fr = lane & 15, fq = lane >> 4;
    const int K = g.K, nt = K / BK;
    unsigned voffA[2], voffB[2];
#pragma unroll
    for (int i = 0; i < 2; ++i) { int R, C; stage_rc(tid * 16 + i * 8192, R, C); const int Rb = Epi::PERM ? ((R & ~31) + perm32(R & 31)) : R;
        voffA[i] = (unsigned)(R * K + C) * 2u; voffB[i] = (unsigned)(Rb * K + C) * 2u; }
    const long kstep = KREV ? -(long)(BK * 2) : (long)(BK * 2);
    const size_t kbase = KREV ? (size_t)(nt - 1) * (BK * 2) : 0;
    const size_t hstep = (size_t)HALF * K * 2;
    const size_t tstep = 2 * hstep;
    const unsigned ldsw = (unsigned)wid * 1024u;
    const int aoff = lds_byte(wr * 64 + fr, fq * 8), boff = lds_byte(wc * 32 + fr, fq * 8);
#define PG8_SA(b, h) (((b) * 2 + (h)) * HTB)
#define PG8_SB(b, h) ((4 + (b) * 2 + (h)) * HTB)
#define PG8_STAGE(bufoff, gbase, voff) do { _Pragma("unroll") for (int _i = 0; _i < 2; ++_i) \
        __builtin_amdgcn_global_load_lds((const unsigned*)((const char*)(gbase) + (voff)[_i]), (LAS unsigned*)(lds + (bufoff) + ldsw + _i * 8192), 16, 0, 0); } while (0)
#define PG8_LDA(dst, b, h) do { _Pragma("unroll") for (int m = 0; m < 4; ++m) _Pragma("unroll") for (int k = 0; k < 2; ++k) dst[m][k] = *(const LAS bf16x8*)(lds + PG8_SA(b, h) + aoff + m * 2048 + k * 1024); } while (0)
#define PG8_LDB(dst, b, h) do { _Pragma("unroll") for (int n = 0; n < 2; ++n) _Pragma("unroll") for (int k = 0; k < 2; ++k) dst[n][k] = *(const LAS bf16x8*)(lds + PG8_SB(b, h) + boff + n * 2048 + k * 1024); } while (0)
#define PG8_MMA(ai, bj, At, Bt) do { __builtin_amdgcn_s_setprio(1); _Pragma("unroll") for (int m = 0; m < 4; ++m) _Pragma("unroll") for (int n = 0; n < 2; ++n) _Pragma("unroll") for (int k = 0; k < 2; ++k) \
        acc[ai][bj][m][n] = __builtin_amdgcn_mfma_f32_16x16x32_bf16(Bt[n][k], At[m][k], acc[ai][bj][m][n], 0, 0, 0); __builtin_amdgcn_s_setprio(0); } while (0)
#define PG8_WAIT_V(n) asm volatile("s_waitcnt vmcnt(" #n ")" ::: "memory")
#define PG8_WAIT_L(n) asm volatile("s_waitcnt lgkmcnt(" #n ")" ::: "memory")
#define PG8_BAR __builtin_amdgcn_s_barrier()
#define PG8_SCHED __builtin_amdgcn_sched_barrier(0)
    Unit cur, nxt; int ui = 0;
    if (!S.next(0, cur)) return;
    f32x4 acc[2][2][4][2];
#pragma unroll
    for (int a = 0; a < 2; ++a)
#pragma unroll
        for (int b = 0; b < 2; ++b)
#pragma unroll
            for (int m = 0; m < 4; ++m)
#pragma unroll
                for (int n = 0; n < 2; ++n) acc[a][b][m][n] = (f32x4){0.f, 0.f, 0.f, 0.f};
    bf16x8 At[4][2], B0[2][2], B1[2][2];
    const char* cA = (const char*)g.A + (size_t)cur.pm * tstep + kbase; const char* cB = (const char*)g.Bt + (size_t)cur.pn * tstep + kbase;
    PG8_STAGE(PG8_SB(0, 0), cB, voffB); PG8_STAGE(PG8_SB(0, 1), cB + hstep, voffB); PG8_STAGE(PG8_SA(0, 0), cA, voffA); PG8_STAGE(PG8_SA(0, 1), cA + hstep, voffA);
    if (wr == 1) PG8_BAR;
    PG8_WAIT_V(2); PG8_BAR;
    PG8_STAGE(PG8_SB(1, 0), cB + kstep, voffB); PG8_STAGE(PG8_SA(1, 0), cA + kstep, voffA); PG8_STAGE(PG8_SB(1, 1), cB + hstep + kstep, voffB);
    PG8_WAIT_V(6); PG8_BAR;
    for (;;) {
        const bool has_next = S.next(ui + 1, nxt);
        const char* nA = has_next ? (const char*)g.A + (size_t)nxt.pm * tstep + kbase : cA; const char* nB = has_next ? (const char*)g.Bt + (size_t)nxt.pn * tstep + kbase : cB;
        for (int t = 0; t < nt; t += 2) {
            const bool last = (t == nt - 2);
            const char* a1 = cA + (long)(t + 1) * kstep;
            const char* a2 = last ? nA : cA + (long)(t + 2) * kstep; const char* b2 = last ? nB : cB + (long)(t + 2) * kstep;
            const char* a3 = a2 + kstep; const char* b3 = b2 + kstep;
            if constexpr (Epi::HAS_MID) E.mid(t, acc, cur, wr, wc, fr, fq);
            PG8_LDB(B0, 0, 0); PG8_LDB(B1, 0, 1); PG8_SCHED; PG8_LDA(At, 0, 0); PG8_STAGE(PG8_SA(1, 1), a1 + hstep, voffA);
            PG8_WAIT_V(8); PG8_WAIT_L(0); PG8_BAR; PG8_MMA(0, 0, At, B0); PG8_MMA(0, 1, At, B1); PG8_BAR; PG8_SCHED;
            PG8_LDA(At, 0, 1); PG8_STAGE(PG8_SB(0, 0), b2, voffB); PG8_STAGE(PG8_SB(0, 1), b2 + hstep, voffB); PG8_STAGE(PG8_SA(0, 0), a2, voffA);
            PG8_WAIT_V(8); PG8_WAIT_L(0); PG8_BAR; PG8_MMA(1, 0, At, B0); PG8_MMA(1, 1, At, B1); PG8_BAR; PG8_SCHED;
            PG8_LDB(B0, 1, 0); PG8_LDB(B1, 1, 1); PG8_SCHED; PG8_LDA(At, 1, 0); PG8_STAGE(PG8_SA(0, 1), a2 + hstep, voffA);
            PG8_WAIT_V(8); PG8_WAIT_L(0); PG8_BAR; PG8_MMA(0, 0, At, B0); PG8_MMA(0, 1, At, B1); PG8_BAR; PG8_SCHED;
            PG8_LDA(At, 1, 1); PG8_STAGE(PG8_SB(1, 0), b3, voffB); PG8_STAGE(PG8_SB(1, 1), b3 + hstep, voffB); PG8_STAGE(PG8_SA(1, 0), a3, voffA);
            PG8_WAIT_V(8); PG8_WAIT_L(0); PG8_BAR; PG8_MMA(1, 0, At, B0); PG8_MMA(1, 1, At, B1); PG8_BAR; PG8_SCHED;
        }
        if (wr == 0) PG8_BAR;
#pragma unroll
        for (int a = 0; a < 2; ++a)
#pragma unroll
            for (int b = 0; b < 2; ++b)
#pragma unroll
                for (int m = 0; m < 4; ++m)
#pragma unroll
                    for (int n = 0; n < 2; ++n) asm volatile("" : "+v"(acc[a][b][m][n]));
        E(acc, cur, wr, wc, fr, fq);
        if (!has_next) break;
#pragma unroll
        for (int a = 0; a < 2; ++a)
#pragma unroll
            for (int b = 0; b < 2; ++b)
#pragma unroll
                for (int m = 0; m < 4; ++m)
#pragma unroll
                    for (int n = 0; n < 2; ++n) acc[a][b][m][n] = (f32x4){0.f, 0.f, 0.f, 0.f};
        cur = nxt; cA = nA; cB = nB; ++ui;
        if (wr == 1) PG8_BAR;
    }
    PG8_WAIT_V(0);
    PG8_BAR;
#undef PG8_SA
#undef PG8_SB
#undef PG8_STAGE
#undef PG8_LDA
#undef PG8_LDB
#undef PG8_MMA
#undef PG8_WAIT_V
#undef PG8_WAIT_L
#undef PG8_BAR
#undef PG8_SCHED
}
}

typedef __attribute__((address_space(1))) unsigned gu32;
#define XB_TMO      128
#define XB_XCNT(j)  (256  + 64 * (j))
#define XB_XSUB(j)  (1280 + 64 * (j))
#define XB_XGEN(j)  (2304 + 64 * (j))
#define XB_TOP      3328
#define XB_TOPGEN   3392
#define XCD_BAR_WORDS 3456
#define XB_SPIN_CAP (1u << 18)

__device__ __forceinline__ unsigned xb_ld(unsigned* p)              { return __hip_atomic_load(p, __ATOMIC_RELAXED, __HIP_MEMORY_SCOPE_AGENT); }
__device__ __forceinline__ unsigned xb_add(unsigned* p, unsigned v) { return __hip_atomic_fetch_add(p, v, __ATOMIC_RELAXED, __HIP_MEMORY_SCOPE_AGENT); }
__device__ __forceinline__ unsigned xb_xcc_id() { return (unsigned)__builtin_amdgcn_s_getreg((3 << 11) | 20) & 0xFu; }
#define XB_SPIN(cond, bar) do { unsigned _sp = 0; while (cond) { __builtin_amdgcn_s_sleep(1); \
    if ((++_sp & 255u) == 0u) { if (xb_ld(&(bar)[XB_TMO])) break; if (_sp > XB_SPIN_CAP) { atomicAdd(&(bar)[XB_TMO], 1u); break; } } } } while (0)

struct XcdBarrier {
    unsigned* bar; unsigned x;
    volatile LAS unsigned* st;
};

__device__ __forceinline__ XcdBarrier xcd_barrier_post(unsigned* bar, volatile LAS unsigned* st) {
    XcdBarrier b; b.bar = bar; b.x = xb_xcc_id(); b.st = st;
    if (threadIdx.x == 0) (void)xb_add(&bar[XB_XCNT(b.x)], 1u);
    return b;
}
__device__ __forceinline__ void xcd_barrier_complete(unsigned* bar, unsigned x, unsigned& nloc, unsigned& nx) {
    const unsigned G = gridDim.x * gridDim.y * gridDim.z;
    unsigned sum, cnt, mine, sp = 0u;
    for (;;) {
        sum = 0u; cnt = 0u; mine = 0u;
#pragma unroll
        for (unsigned j = 0; j < 16; ++j) { const unsigned c = xb_ld(&bar[XB_XCNT(j)]); sum += c; cnt += (c > 0u) ? 1u : 0u; mine = (j == x) ? c : mine; }
        if (sum == G) break;
        __builtin_amdgcn_s_sleep(1);
        if ((++sp & 255u) == 0u) { if (xb_ld(&bar[XB_TMO])) break; if (sp > XB_SPIN_CAP) { atomicAdd(&bar[XB_TMO], 1u); break; } }
    }
    nloc = mine > 0u ? mine : 1u; nx = cnt > 0u ? cnt : 1u;
}

__device__ __forceinline__ void xcd_barrier(const XcdBarrier& b) {
    asm volatile("s_waitcnt vmcnt(0)" ::: "memory");
    __syncthreads();
    if (threadIdx.x == 0) {
        unsigned* bar = b.bar;
        __builtin_amdgcn_s_waitcnt(0);
        unsigned nloc = b.st[0], nx = b.st[1];
        if (nloc == 0u) { xcd_barrier_complete(bar, b.x, nloc, nx); b.st[0] = nloc; b.st[1] = nx; }
        const unsigned old = xb_add(&bar[XB_XSUB(b.x)], 1u);
        const unsigned gen = old / nloc;
        if (old + 1u == (gen + 1u) * nloc) {
            __builtin_amdgcn_fence(__ATOMIC_RELEASE, "agent");
            asm volatile("s_waitcnt vmcnt(0)" ::: "memory");
            const unsigned og = xb_add(&bar[XB_TOP], 1u);
            const unsigned tg = og / nx;
            if (og + 1u == (tg + 1u) * nx) xb_add(&bar[XB_TOPGEN], 1u);
            else XB_SPIN(xb_ld(&bar[XB_TOPGEN]) == tg, bar);
            __builtin_amdgcn_fence(__ATOMIC_ACQUIRE, "agent");
            xb_add(&bar[XB_XGEN(b.x)], 1u);
            asm volatile("s_waitcnt vmcnt(0)" ::: "memory");
        } else {
            XB_SPIN(xb_ld(&bar[XB_XGEN(b.x)]) == gen, bar);
            __builtin_amdgcn_fence(__ATOMIC_ACQUIRE, "agent");
            asm volatile("s_waitcnt vmcnt(0)" ::: "memory");
        }
    }
    __syncthreads();
}


struct Args { const float* in[22]; float* out; unsigned char* ws; int ph_lo, ph_hi; };

typedef LAS unsigned long long* PTab;
__device__ __forceinline__ const float* ldptr(PTab pt, int k) {
    const unsigned long long v = pt[k];
    const unsigned lo = __builtin_amdgcn_readfirstlane((unsigned)v), hi = __builtin_amdgcn_readfirstlane((unsigned)(v >> 32));
    return (const float*)(((unsigned long long)hi << 32) | lo);
}

__device__ __forceinline__ int conv_row(int n, int mode, int rowoff) {
    if (mode == 0) return rowoff + n;
    if (mode == 3) { const int br = n >> 11, mc = n & 2047, q = mc >> 6, mcl = mc & 63; return rowoff + 256 * q + 128 * (br >> 1) + 32 * (mcl >> 4) + 8 * ((mcl >> 2) & 3) + 4 * (br & 1) + (mcl & 3); }
    return (n >> 7) * 256 + (n & 127) + (mode == 2 ? 128 : 0);
}
__device__ __forceinline__ void conv_mat(const float* W, int ldw, int K, int N, bf16_t* WT, int pitch, int koff, int mode, int rowoff, int gw, int ngw, int lane) {
    const int nblk = N / 64, nitems = (K / 64) * nblk;
    const int c = lane & 15, q = lane >> 4;
    f32x4 v[16];
    if (gw < nitems) { const int kb = gw / nblk, nb = gw - kb * nblk; const float* src = W + (size_t)(64 * kb + 16 * q) * ldw + 64 * nb + 4 * c;
#pragma unroll
        for (int j = 0; j < 16; ++j) v[j] = __builtin_nontemporal_load((const f32x4*)(src + (size_t)j * ldw)); }
    for (int item = gw; item < nitems; item += ngw) {
        const int kb = item / nblk, nb = item - kb * nblk, k0 = 64 * kb, n0 = 64 * nb;
        u32x4 o[8];
#pragma unroll
        for (int i = 0; i < 4; ++i) {
            o[2 * i].x = pk2(v[0][i], v[1][i]); o[2 * i].y = pk2(v[2][i], v[3][i]); o[2 * i].z = pk2(v[4][i], v[5][i]); o[2 * i].w = pk2(v[6][i], v[7][i]);
            o[2 * i + 1].x = pk2(v[8][i], v[9][i]); o[2 * i + 1].y = pk2(v[10][i], v[11][i]); o[2 * i + 1].z = pk2(v[12][i], v[13][i]); o[2 * i + 1].w = pk2(v[14][i], v[15][i]);
        }
        const int nx = item + ngw;
        if (nx < nitems) { const int kb2 = nx / nblk, nb2 = nx - kb2 * nblk; const float* src = W + (size_t)(64 * kb2 + 16 * q) * ldw + 64 * nb2 + 4 * c;
#pragma unroll
            for (int j = 0; j < 16; ++j) v[j] = __builtin_nontemporal_load((const f32x4*)(src + (size_t)j * ldw)); }
        const int rb = conv_row(n0 + 4 * c, mode, rowoff);
#pragma unroll
        for (int i = 0; i < 4; ++i) {
            bf16_t* dst = WT + (size_t)(rb + i) * pitch + koff + k0 + 16 * q;
            *(u32x4*)dst = o[2 * i]; *(u32x4*)(dst + 8) = o[2 * i + 1];
        }
    }
}

__device__ __forceinline__ void convert_phase(PTab pt, int l, LAS unsigned char* lds, int tid, int wave, int lane, int bid, int G) {
    unsigned char* ws = (unsigned char*)ldptr(pt, 23);
    const int gw = bid * 8 + wave, ngw = G * 8;
    for (int s = 0; s < 2; ++s) {
        bf16_t* wgu = (bf16_t*)(ws + WS_WGU + (size_t)s * 44 * MiB);
        conv_mat(ldptr(pt, 4) + (size_t)(l * 2 + s) * D_ * FF_, FF_, D_, FF_, wgu, D_, 0, 1, 0, gw, ngw, lane);
        conv_mat(ldptr(pt, 5) + (size_t)(l * 2 + s) * D_ * FF_, FF_, D_, FF_, wgu, D_, 0, 2, 0, gw, ngw, lane);
        conv_mat(ldptr(pt, 6) + (size_t)(l * 2 + s) * D_ * FF_, D_, FF_, D_, (bf16_t*)(ws + WS_WD + (size_t)s * 22 * MiB), FF_, 0, 0, 0, gw, ngw, lane);
    }
    conv_mat(ldptr(pt, 7) + (size_t)l * D_ * NIN_, NIN_, D_, NZ_, (bf16_t*)(ws + WS_WIN), D_, 0, 0, 0, gw, ngw, lane);
    conv_mat(ldptr(pt, 7) + (size_t)l * D_ * NIN_ + NZ_, NIN_, D_, NGT_, (bf16_t*)(ws + WS_WIN), D_, 0, 3, NZ_, gw, ngw, lane);
    conv_mat(ldptr(pt, 15) + (size_t)l * 512 * D_, D_, 512, D_, (bf16_t*)(ws + WS_WBR), NO_, 0, 0, 0, gw, ngw, lane);
    conv_mat(ldptr(pt, 16) + (size_t)l * 512 * D_, D_, 512, D_, (bf16_t*)(ws + WS_WBR), NO_, 512, 0, 0, gw, ngw, lane);
    conv_mat(ldptr(pt, 17) + (size_t)l * 512 * D_, D_, 512, D_, (bf16_t*)(ws + WS_WBR), NO_, 1024, 0, 0, gw, ngw, lane);
    conv_mat(ldptr(pt, 18) + (size_t)l * 256 * D_, D_, 256, D_, (bf16_t*)(ws + WS_WBR), NO_, 1536, 0, 0, gw, ngw, lane);
    conv_mat(ldptr(pt, 19) + (size_t)l * D_ * D_, D_, D_, D_, (bf16_t*)(ws + WS_WOUT), D_, 0, 0, 0, gw, ngw, lane);
    conv_mat(ldptr(pt, 20) + (size_t)l * PLE_ * D_, D_, PLE_, D_, (bf16_t*)(ws + WS_WPP), PLE_, 0, 0, 0, gw, ngw, lane);
    conv_mat(ldptr(pt, 21) + (size_t)l * D_ * D_, D_, D_, D_, (bf16_t*)(ws + WS_WPG), D_, 0, 0, 0, gw, ngw, lane);
    if (l == 0) {
        const size_t gt = (size_t)bid * 512 + tid, nth = (size_t)G * 512;
        const f32x4* x4 = (const f32x4*)ldptr(pt, 0); u32x2* xb = (u32x2*)(ws + WS_XB);
        for (size_t i = gt; i < (size_t)T_ * D_ / 4; i += nth) { const f32x4 v = x4[i]; u32x2 w; w.x = pk2(v[0], v[1]); w.y = pk2(v[2], v[3]); xb[i] = w; }
        const f32x4* p4 = (const f32x4*)ldptr(pt, 1); u32x2* pb = (u32x2*)(ws + WS_PB);
        for (size_t i = gt; i < (size_t)2 * T_ * PLE_ / 4; i += nth) { const f32x4 v = p4[i]; u32x2 w; w.x = pk2(v[0], v[1]); w.y = pk2(v[2], v[3]); pb[i] = w; }
    }
}

__device__ __forceinline__ void ln_phase(float* X, bf16_t* XB, const float* g, const float* b, bool final_, int wave, int lane, int bid, int G) {
    const int gw = bid * 8 + wave, ngw = G * 8;
    for (int row0 = gw; row0 < T_; row0 += 4 * ngw) {
        f32x4 v[4][8];
#pragma unroll
        for (int r = 0; r < 4; ++r) { const int row = min(row0 + r * ngw, T_ - 1); const f32x4* xr = (const f32x4*)(X + (size_t)row * D_) + lane;
#pragma unroll
            for (int j = 0; j < 8; ++j) v[r][j] = xr[64 * j]; }
        float mean[4], rstd[4];
#pragma unroll
        for (int r = 0; r < 4; ++r) { float s = 0.f;
#pragma unroll
            for (int j = 0; j < 8; ++j) s += (v[r][j][0] + v[r][j][1]) + (v[r][j][2] + v[r][j][3]);
            mean[r] = s; }
#pragma unroll
        for (int o = 1; o < 64; o <<= 1) {
#pragma unroll
            for (int r = 0; r < 4; ++r) mean[r] += __shfl_xor(mean[r], o); }
#pragma unroll
        for (int r = 0; r < 4; ++r) { mean[r] *= (1.f / D_); float s2 = 0.f;
#pragma unroll
            for (int j = 0; j < 8; ++j) { v[r][j] = v[r][j] - mean[r]; s2 += (v[r][j][0] * v[r][j][0] + v[r][j][1] * v[r][j][1]) + (v[r][j][2] * v[r][j][2] + v[r][j][3] * v[r][j][3]); }
            rstd[r] = s2; }
#pragma unroll
        for (int o = 1; o < 64; o <<= 1) {
#pragma unroll
            for (int r = 0; r < 4; ++r) rstd[r] += __shfl_xor(rstd[r], o); }
#pragma unroll
        for (int r = 0; r < 4; ++r) rstd[r] = 1.f / sqrtf(rstd[r] * (1.f / D_) + LN_EPS);
#pragma unroll
        for (int j = 0; j < 8; ++j) {
            const f32x4 gg = ((const f32x4*)g)[lane + 64 * j], bb = ((const f32x4*)b)[lane + 64 * j];
#pragma unroll
            for (int r = 0; r < 4; ++r) { const int row = row0 + r * ngw;
                if (row < T_) { const f32x4 y = v[r][j] * rstd[r] * gg + bb;
                    if (final_) ((f32x4*)(X + (size_t)row * D_))[lane + 64 * j] = y;
                    else { u32x2 w; w.x = pk2(y[0], y[1]); w.y = pk2(y[2], y[3]); ((u32x2*)(XB + (size_t)row * D_))[lane + 64 * j] = w; } } }
        }
    }
}

__device__ __forceinline__ void attn_unit(LAS unsigned char* L, const bf16_t* Z, int unit, const float* sinks, bf16_t* O, float* DPO, float* DLSE, int tid, int wave, int lane) {
    int qcol, kcol, vcol, base, blk, dil, max_dist, grp = 0, hh = 0; float slope_u, sink = 0.f; bool isA;
    if (unit < 1024) {
        isA = true; blk = unit & 31; const int head = (unit >> 5) & 7, b = unit >> 8, kvh = head >> 2;
        qcol = ZQA + head * 64; kcol = ZKA + kvh * 64; vcol = ZVA + kvh * 64; base = b * SEQ_; dil = 1; max_dist = 127;
        slope_u = __builtin_amdgcn_exp2f(-8.0f * (float)(head + 1) / 20.0f); sink = sinks[head]; hh = head;
    } else {
        isA = false; const int u2 = unit - 1024; grp = u2 >> 9; const int u3 = u2 & 511;
        dil = (grp == 0) ? 1 : (grp == 1 ? 4 : 16); const int nbk = 32 / dil;
        blk = u3 % nbk; const int r = (u3 / nbk) % dil; hh = (u3 / 32) & 3; const int b = u3 >> 7;
        qcol = ZQD + grp * 256 + hh * 64; kcol = ZKD + grp * 256 + hh * 64; vcol = ZVD + grp * 256 + hh * 64; base = b * SEQ_ + r; max_dist = 128;
        slope_u = __builtin_amdgcn_exp2f(-8.0f * (float)(8 + 4 * grp + hh + 1) / 20.0f) * (float)dil;
    }
    LAS bf16_t* Qs = (LAS bf16_t*)L;
    LAS bf16_t* Ks = Qs + 128 * 72;
    LAS bf16_t* Vt = Ks + 272 * 72;
    for (int i = tid; i < 1024; i += 512) { const int r = i >> 3, c = i & 7; const size_t tok = (size_t)(base + (blk * 128 + r) * dil);
        *(LAS u32x4*)(Qs + r * 72 + c * 8) = *(const u32x4*)(Z + tok * NZ_ + qcol + c * 8); }
    {
        u32x4 kv[5], vv[5];
#pragma unroll
        for (int it = 0; it < 5; ++it) { const int i = tid + it * 512; const int r = i >> 3, c = i & 7; const int sub = blk * 128 - 128 + r; const bool ok = (i < 2176) && (r < 256) && (sub >= 0);
            kv[it] = (u32x4){0u, 0u, 0u, 0u}; vv[it] = (u32x4){0u, 0u, 0u, 0u};
            if (ok) { const size_t tok = (size_t)(base + sub * dil); kv[it] = *(const u32x4*)(Z + tok * NZ_ + kcol + c * 8); vv[it] = *(const u32x4*)(Z + tok * NZ_ + vcol + c * 8); } }
#pragma unroll
        for (int it = 0; it < 5; ++it) { const int i = tid + it * 512; const int r = i >> 3, c = i & 7;
            if (i < 2176) {
                *(LAS u32x4*)(Ks + r * 72 + c * 8) = kv[it];
                LAS bf16_t* vp = Vt + (c * 8) * 280 + r; const u32x4 v = vv[it];
                vp[0 * 280] = (bf16_t)(v.x & 0xffffu); vp[1 * 280] = (bf16_t)(v.x >> 16); vp[2 * 280] = (bf16_t)(v.y & 0xffffu); vp[3 * 280] = (bf16_t)(v.y >> 16);
                vp[4 * 280] = (bf16_t)(v.z & 0xffffu); vp[5 * 280] = (bf16_t)(v.z >> 16); vp[6 * 280] = (bf16_t)(v.w & 0xffffu); vp[7 * 280] = (bf16_t)(v.w >> 16); } }
    }
    __syncthreads();
    const int q0 = wave * 16, qi = lane & 15, g = lane >> 4;
    bf16x8 bq[2];
#pragma unroll
    for (int ks = 0; ks < 2; ++ks) bq[ks] = *(const LAS bf16x8*)(Qs + (q0 + qi) * 72 + ks * 32 + g * 8);
    f32x4 st[10];
#pragma unroll
    for (int i = 0; i < 10; ++i) { f32x4 acc = {0.f, 0.f, 0.f, 0.f};
#pragma unroll
        for (int ks = 0; ks < 2; ++ks) { const bf16x8 ak = *(const LAS bf16x8*)(Ks + ((wave + i) * 16 + qi) * 72 + ks * 32 + g * 8); acc = mfma16(ak, bq[ks], acc); }
        st[i] = acc; }
    float mx = -3.0e38f;
    const int q = q0 + qi;
#pragma unroll
    for (int i = 0; i < 10; ++i)
#pragma unroll
        for (int j = 0; j < 4; ++j) { const int kk = (wave + i) * 16 + 4 * g + j; const int dist = q + 128 - kk;
            const bool valid = (dist >= 0) && (dist <= max_dist) && (blk > 0 || kk >= 128);
            const float s = valid ? (st[i][j] * 0.125f - slope_u * (float)dist) : -1.0e30f; st[i][j] = s; mx = fmaxf(mx, s); }
    mx = fmaxf(mx, __shfl_xor(mx, 16)); mx = fmaxf(mx, __shfl_xor(mx, 32));
    if (isA) mx = fmaxf(mx, sink);
    float den = 0.f;
#pragma unroll
    for (int i = 0; i < 10; ++i)
#pragma unroll
        for (int j = 0; j < 4; ++j) { const float p = __builtin_amdgcn_exp2f((st[i][j] - mx) * LOG2E); st[i][j] = p; den += p; }
    den += __shfl_xor(den, 16); den += __shfl_xor(den, 32);
    if (isA) den += __builtin_amdgcn_exp2f((sink - mx) * LOG2E);
    f32x4 o[4];
#pragma unroll
    for (int ht = 0; ht < 4; ++ht) o[ht] = (f32x4){0.f, 0.f, 0.f, 0.f};
#pragma unroll
    for (int i = 0; i < 5; ++i) { const int ta = wave + 2 * i, tb = ta + 1;
        u32x4 pw; pw.x = pk2(st[2 * i][0], st[2 * i][1]); pw.y = pk2(st[2 * i][2], st[2 * i][3]); pw.z = pk2(st[2 * i + 1][0], st[2 * i + 1][1]); pw.w = pk2(st[2 * i + 1][2], st[2 * i + 1][3]);
        const bf16x8 bp = __builtin_bit_cast(bf16x8, pw);
#pragma unroll
        for (int ht = 0; ht < 4; ++ht) { const LAS bf16_t* vr = Vt + (ht * 16 + qi) * 280 + 4 * g;
            const u32x2 va = *(const LAS u32x2*)(vr + ta * 16), vb = *(const LAS u32x2*)(vr + tb * 16);
            o[ht] = mfma16(mk8(va, vb), bp, o[ht]); } }
    const float inv = 1.0f / den;
    const size_t tok = (size_t)(base + (blk * 128 + q) * dil);
    if (isA) {
#pragma unroll
        for (int ht = 0; ht < 4; ++ht) { u32x2 w; w.x = pk2(o[ht][0] * inv, o[ht][1] * inv); w.y = pk2(o[ht][2] * inv, o[ht][3] * inv);
            *(u32x2*)(O + tok * NO_ + hh * 64 + ht * 16 + 4 * g) = w; }
    } else {
#pragma unroll
        for (int ht = 0; ht < 4; ++ht) *(f32x4*)(DPO + ((size_t)grp * T_ + tok) * 256 + hh * 64 + ht * 16 + 4 * g) = o[ht] * inv;
        if (g == 0) DLSE[((size_t)grp * T_ + tok) * 4 + hh] = mx + logf(den);
    }
    __syncthreads();
}

__device__ __forceinline__ void gmlp_unit(LAS unsigned char* L, const bf16_t* Z, int unit, const float* lng, const float* lnb, const float* ws_, const float* bs, bf16_t* O, int tid, int wave, int lane) {
    const int n = unit >> 2, grp = unit & 3, tok0 = n * 128;
    LAS float* stats = (LAS float*)L;
    LAS bf16_t* vnt = (LAS bf16_t*)(L + 1024);
    LAS bf16_t* Wc = vnt + 128 * 136;
    {
        u32x4 raw[16];
#pragma unroll
        for (int r = 0; r < 16; ++r) raw[r] = *(const u32x4*)(Z + (size_t)(tok0 + 16 * wave + r) * NZ_ + ZVB + lane * 8);
        float s[16], ss[16];
#pragma unroll
        for (int r = 0; r < 16; ++r) { const float x0 = bflo(raw[r].x), x1 = bfhi(raw[r].x), x2 = bflo(raw[r].y), x3 = bfhi(raw[r].y), x4 = bflo(raw[r].z), x5 = bfhi(raw[r].z), x6 = bflo(raw[r].w), x7 = bfhi(raw[r].w);
            s[r] = ((x0 + x1) + (x2 + x3)) + ((x4 + x5) + (x6 + x7)); ss[r] = ((x0 * x0 + x1 * x1) + (x2 * x2 + x3 * x3)) + ((x4 * x4 + x5 * x5) + (x6 * x6 + x7 * x7)); }
#pragma unroll
        for (int o = 1; o < 64; o <<= 1) {
#pragma unroll
            for (int r = 0; r < 16; ++r) { s[r] += __shfl_xor(s[r], o); ss[r] += __shfl_xor(ss[r], o); } }
        if (lane < 16) { float m = 0.f, q = 0.f;
#pragma unroll
            for (int r = 0; r < 16; ++r) if (lane == r) { m = s[r]; q = ss[r]; }
            m *= (1.f / 512.f); const float var = fmaxf(q * (1.f / 512.f) - m * m, 0.f);
            stats[(16 * wave + lane) * 2] = m; stats[(16 * wave + lane) * 2 + 1] = 1.f / sqrtf(var + LN_EPS); }
    }
#pragma unroll
    for (int it = 0; it < 8; ++it) { const int i = tid + it * 512; const int t = i >> 5, s4 = (i & 31) * 4;
        f32x4 w = *(const f32x4*)(ws_ + (size_t)(grp * 128 + t) * 128 + s4);
#pragma unroll
        for (int e = 0; e < 4; ++e) if (s4 + e > t) w[e] = 0.f;
        u32x2 p; p.x = pk2(w[0], w[1]); p.y = pk2(w[2], w[3]); *(LAS u32x2*)(Wc + t * 136 + s4) = p; }
    u32x4 vraw[4];
#pragma unroll
    for (int it = 0; it < 4; ++it) { const int i = tid + it * 512; const int s = i >> 4, c8 = (i & 15) * 8;
        vraw[it] = *(const u32x4*)(Z + (size_t)(tok0 + s) * NZ_ + ZVB + grp * 128 + c8); }
    __syncthreads();
#pragma unroll
    for (int it = 0; it < 4; ++it) { const int i = tid + it * 512; const int s = i >> 4, c8 = (i & 15) * 8;
        const u32x4 raw = vraw[it];
        const float mean = stats[s * 2], rstd = stats[s * 2 + 1];
        float x[8]; x[0] = bflo(raw.x); x[1] = bfhi(raw.x); x[2] = bflo(raw.y); x[3] = bfhi(raw.y); x[4] = bflo(raw.z); x[5] = bfhi(raw.z); x[6] = bflo(raw.w); x[7] = bfhi(raw.w);
        const f32x4 g0 = *(const f32x4*)(lng + grp * 128 + c8), g1 = *(const f32x4*)(lng + grp * 128 + c8 + 4), b0 = *(const f32x4*)(lnb + grp * 128 + c8), b1 = *(const f32x4*)(lnb + grp * 128 + c8 + 4);
#pragma unroll
        for (int e = 0; e < 8; ++e) { const float y = (x[e] - mean) * rstd * (e < 4 ? g0[e & 3] : g1[e & 3]) + (e < 4 ? b0[e & 3] : b1[e & 3]);
            vnt[(c8 + e) * 136 + s] = (bf16_t)(pk2(y, 0.f) & 0xffffu); } }
    __syncthreads();
    const int qi = lane & 15, g = lane >> 4;
    const int t = 16 * wave + qi; const float bias = bs[grp * 128 + t];
    const size_t tok = (size_t)(tok0 + t);
    u32x2 ur[8];
#pragma unroll
    for (int ct = 0; ct < 8; ++ct) ur[ct] = *(const u32x2*)(Z + tok * NZ_ + ZUB + grp * 128 + 16 * ct + 4 * g);
    f32x4 acc[8];
#pragma unroll
    for (int ct = 0; ct < 8; ++ct) acc[ct] = (f32x4){0.f, 0.f, 0.f, 0.f};
#pragma unroll
    for (int ks = 0; ks < 4; ++ks) { const bf16x8 bw = *(const LAS bf16x8*)(Wc + (16 * wave + qi) * 136 + ks * 32 + g * 8);
#pragma unroll
        for (int ct = 0; ct < 8; ++ct) { const bf16x8 av = *(const LAS bf16x8*)(vnt + (16 * ct + qi) * 136 + ks * 32 + g * 8); acc[ct] = mfma16(av, bw, acc[ct]); } }
#pragma unroll
    for (int ct = 0; ct < 8; ++ct) { const int c = 16 * ct + 4 * g;
        u32x2 w; w.x = pk2(bflo(ur[ct].x) * (acc[ct][0] + bias), bfhi(ur[ct].x) * (acc[ct][1] + bias));
        w.y = pk2(bflo(ur[ct].y) * (acc[ct][2] + bias), bfhi(ur[ct].y) * (acc[ct][3] + bias));
        *(u32x2*)(O + tok * NO_ + 512 + grp * 128 + c) = w; }
    __syncthreads();
}

__device__ __forceinline__ float hgrn_lb(const float* lbl, int layer, int c) { return layer == 0 ? 0.0f : 1.0f / (1.0f + expf(lbl[c] - lbl[512 + c])); }

__device__ __forceinline__ void hgrn_c1_unit(LAS unsigned char* L, const bf16_t* Z, int unit, const float* lbl, int layer, float* DS, float* DEC, int tid, int wave, int lane) {
    const int h = unit & 3, cg_ = unit >> 2, tok0 = cg_ * 64;
    const int k = tid & 127, qtr = tid >> 7;
    LAS float* qsum = (LAS float*)L;
    LAS bf16_t* kt = (LAS bf16_t*)(L + 2048);
    LAS bf16_t* vt = kt + 128 * 72;
    const float lb = hgrn_lb(lbl, layer, h * 128 + k);
    float G[16], kk[16]; float run = 0.f;
    unsigned vraw[16];
#pragma unroll
    for (int i = 0; i < 16; ++i) { const size_t tok = (size_t)(tok0 + 16 * qtr + i);
        const float zf = bf2f(Z[tok * NZ_ + ZFC + h * 128 + k]);
        vraw[i] = Z[tok * NZ_ + ZIC + h * 128 + k];
        const float e = fexp(-zf), sg = frcp(1.0f + e);
        const float f = lb + (1.0f - lb) * sg;
        run += logf(fmaxf(f, 1e-6f)); G[i] = run; kk[i] = (1.0f - lb) * e * sg; }
    qsum[qtr * 128 + k] = run;
    __syncthreads();
    float off = 0.f, tot = 0.f;
#pragma unroll
    for (int qq = 0; qq < 4; ++qq) { const float v = qsum[qq * 128 + k]; tot += v; if (qq < qtr) off += v; }
    unsigned kw[8], vw[8];
#pragma unroll
    for (int i = 0; i < 8; ++i) { const float a0 = kk[2 * i] * fexp(tot - (G[2 * i] + off)), a1 = kk[2 * i + 1] * fexp(tot - (G[2 * i + 1] + off));
        kw[i] = pk2(a0, a1); vw[i] = vraw[2 * i] | (vraw[2 * i + 1] << 16); }
    *(LAS u32x4*)(kt + k * 72 + 16 * qtr) = (u32x4){kw[0], kw[1], kw[2], kw[3]}; *(LAS u32x4*)(kt + k * 72 + 16 * qtr + 8) = (u32x4){kw[4], kw[5], kw[6], kw[7]};
    *(LAS u32x4*)(vt + k * 72 + 16 * qtr) = (u32x4){vw[0], vw[1], vw[2], vw[3]}; *(LAS u32x4*)(vt + k * 72 + 16 * qtr + 8) = (u32x4){vw[4], vw[5], vw[6], vw[7]};
    if (qtr == 0) DEC[(size_t)unit * 128 + k] = fexp(tot);
    __syncthreads();
    const int qi = lane & 15, g = lane >> 4;
    bf16x8 av[2];
#pragma unroll
    for (int ks = 0; ks < 2; ++ks) av[ks] = *(const LAS bf16x8*)(vt + (16 * wave + qi) * 72 + ks * 32 + g * 8);
    float* dst = DS + (size_t)unit * 16384;
#pragma unroll
    for (int ktile = 0; ktile < 8; ++ktile) { f32x4 acc = {0.f, 0.f, 0.f, 0.f};
#pragma unroll
        for (int ks = 0; ks < 2; ++ks) { const bf16x8 bk = *(const LAS bf16x8*)(kt + (16 * ktile + qi) * 72 + ks * 32 + g * 8); acc = mfma16(av[ks], bk, acc); }
#pragma unroll
        for (int j = 0; j < 4; ++j) dst[(16 * wave + 4 * g + j) * 128 + 16 * ktile + qi] = acc[j]; }
    __syncthreads();
}

__device__ __forceinline__ void hgrn_scan_phase(const float* DS, const float* DEC, bf16_t* HS, int tid, int bid, int G) {
    const int nth = G * 512;
    for (int p = bid * 512 + tid; p < 16 * 8192; p += nth) {
        const int bh = p >> 13, idx = (p & 8191) * 2, k = idx & 127, b = bh >> 2, h = bh & 3;
        f32x2 S = {0.f, 0.f};
#pragma unroll 16
        for (int c = 0; c < 64; ++c) { const size_t u = (size_t)(((b * 64 + c) << 2) | h);
            *(unsigned*)(HS + u * 16384 + idx) = pk2(S[0], S[1]);
            const f32x2 d = *(const f32x2*)(DEC + u * 128 + k), ds = *(const f32x2*)(DS + u * 16384 + idx);
            S = d * S + ds; }
    }
}

__device__ __forceinline__ void hgrn_c3_unit(LAS unsigned char* L, const bf16_t* Z, int unit, const float* lbl, int layer, const bf16_t* HS, const float* ng, bf16_t* O, int tid, int wave, int lane) {
    const int h = unit & 3, cg_ = unit >> 2, tok0 = cg_ * 64;
    const int k = tid & 127, qtr = tid >> 7;
    LAS float* qsum = (LAS float*)L;
    LAS bf16_t* kT = (LAS bf16_t*)(L + 2048);
    LAS bf16_t* qT = kT + 64 * 136;
    LAS bf16_t* qC = qT + 64 * 136;
    LAS bf16_t* vt = qC + 64 * 136;
    LAS float* oL = (LAS float*)(L + 2048 + 3 * 64 * 136 * 2 + 128 * 72 * 2);
    const float lb = hgrn_lb(lbl, layer, h * 128 + k);
    float G[16], kk[16], qv[16]; float run = 0.f;
    unsigned vraw[16];
#pragma unroll
    for (int i = 0; i < 16; ++i) { const size_t tok = (size_t)(tok0 + 16 * qtr + i);
        const float zf = bf2f(Z[tok * NZ_ + ZFC + h * 128 + k]);
        qv[i] = bf2f(Z[tok * NZ_ + ZQC + h * 128 + k]);
        vraw[i] = Z[tok * NZ_ + ZIC + h * 128 + k];
        const float e = fexp(-zf), sg = frcp(1.0f + e);
        const float f = lb + (1.0f - lb) * sg;
        run += logf(fmaxf(f, 1e-6f)); G[i] = run; kk[i] = (1.0f - lb) * e * sg; }
    qsum[qtr * 128 + k] = run;
    __syncthreads();
    float off = 0.f;
#pragma unroll
    for (int qq = 0; qq < 4; ++qq) { const float v = qsum[qq * 128 + k]; if (qq < qtr) off += v; }
    const float Gm = qsum[k] + qsum[128 + k];
#pragma unroll
    for (int i = 0; i < 16; ++i) { const int t = 16 * qtr + i; const float Gi = G[i] + off;
        const float d = fminf(fmaxf(Gi - Gm, -80.f), 80.f);
        const float e1 = fexp(d), e2 = fexp(-d);
        kT[t * 136 + k] = (bf16_t)(pk2(kk[i] * e2, 0.f) & 0xffffu);
        qT[t * 136 + k] = (bf16_t)(pk2(qv[i] * e1, 0.f) & 0xffffu);
        qC[t * 136 + k] = (bf16_t)(pk2(qv[i] * fexp(Gi), 0.f) & 0xffffu); }
    {
        unsigned vw[8];
#pragma unroll
        for (int i = 0; i < 8; ++i) vw[i] = vraw[2 * i] | (vraw[2 * i + 1] << 16);
        *(LAS u32x4*)(vt + k * 72 + 16 * qtr) = (u32x4){vw[0], vw[1], vw[2], vw[3]}; *(LAS u32x4*)(vt + k * 72 + 16 * qtr + 8) = (u32x4){vw[4], vw[5], vw[6], vw[7]};
    }
    __syncthreads();
    const int qi = lane & 15, g = lane >> 4, tt = wave & 3, vh = wave >> 2;
    const bf16_t* hs = HS + (size_t)unit * 16384;
    bf16x8 ahs[4][4];
#pragma unroll
    for (int ks = 0; ks < 4; ++ks)
#pragma unroll
        for (int v_ = 0; v_ < 4; ++v_) ahs[ks][v_] = *(const bf16x8*)(hs + (16 * (4 * vh + v_) + qi) * 128 + ks * 32 + g * 8);
    unsigned graw[8][2];
#pragma unroll
    for (int r = 0; r < 8; ++r) { const size_t tok = (size_t)(tok0 + 8 * wave + r); graw[r][0] = Z[tok * NZ_ + ZGC + h * 128 + lane]; graw[r][1] = Z[tok * NZ_ + ZGC + h * 128 + 64 + lane]; }
    f32x4 sc[4];
#pragma unroll
    for (int st = 0; st < 4; ++st) { sc[st] = (f32x4){0.f, 0.f, 0.f, 0.f};
        if (st <= tt) {
#pragma unroll
            for (int ks = 0; ks < 4; ++ks) { const bf16x8 a = *(const LAS bf16x8*)(kT + (16 * st + qi) * 136 + ks * 32 + g * 8), b = *(const LAS bf16x8*)(qT + (16 * tt + qi) * 136 + ks * 32 + g * 8);
                sc[st] = mfma16(a, b, sc[st]); }
#pragma unroll
            for (int j = 0; j < 4; ++j) if (16 * st + 4 * g + j > 16 * tt + qi) sc[st][j] = 0.f;
        } }
    f32x4 o[4];
#pragma unroll
    for (int v_ = 0; v_ < 4; ++v_) o[v_] = (f32x4){0.f, 0.f, 0.f, 0.f};
#pragma unroll
    for (int i = 0; i < 2; ++i) {
        u32x4 pw; pw.x = pk2(sc[2 * i][0], sc[2 * i][1]); pw.y = pk2(sc[2 * i][2], sc[2 * i][3]); pw.z = pk2(sc[2 * i + 1][0], sc[2 * i + 1][1]); pw.w = pk2(sc[2 * i + 1][2], sc[2 * i + 1][3]);
        const bf16x8 bp = __builtin_bit_cast(bf16x8, pw);
#pragma unroll
        for (int v_ = 0; v_ < 4; ++v_) { const LAS bf16_t* vr = vt + (16 * (4 * vh + v_) + qi) * 72 + 4 * g;
            const u32x2 va = *(const LAS u32x2*)(vr + (2 * i) * 16), vb = *(const LAS u32x2*)(vr + (2 * i + 1) * 16);
            o[v_] = mfma16(mk8(va, vb), bp, o[v_]); } }
#pragma unroll
    for (int ks = 0; ks < 4; ++ks) { const bf16x8 b = *(const LAS bf16x8*)(qC + (16 * tt + qi) * 136 + ks * 32 + g * 8);
#pragma unroll
        for (int v_ = 0; v_ < 4; ++v_) o[v_] = mfma16(ahs[ks][v_], b, o[v_]); }
#pragma unroll
    for (int v_ = 0; v_ < 4; ++v_) *(LAS f32x4*)(oL + (16 * tt + qi) * 132 + 16 * (4 * vh + v_) + 4 * g) = o[v_];
    __syncthreads();
    const float ng0 = ng[h * 128 + lane], ng1 = ng[h * 128 + 64 + lane];
#pragma unroll
    for (int r = 0; r < 8; ++r) { const int t = 8 * wave + r;
        const float x0 = oL[t * 132 + lane], x1 = oL[t * 132 + 64 + lane];
        const float ss = wave_sum(x0 * x0 + x1 * x1);
        const float rs = 1.0f / sqrtf(ss * (1.f / 128.f) + LN_EPS);
        const size_t tok = (size_t)(tok0 + t);
        const float g0 = bf2f(graw[r][0]), g1 = bf2f(graw[r][1]);
        const float y0 = x0 * rs * ng0 * fsigmoid(g0), y1 = x1 * rs * ng1 * fsigmoid(g1);
        O[tok * NO_ + 1024 + h * 128 + lane] = (bf16_t)(pk2(y0, 0.f) & 0xffffu);
        O[tok * NO_ + 1024 + h * 128 + 64 + lane] = (bf16_t)(pk2(y1, 0.f) & 0xffffu); }
    __syncthreads();
}

__device__ __forceinline__ void dcomb_phase(const float* DPO, const float* DLSE, bf16_t* O, int tid, int bid, int G) {
    const int nth = G * 512;
#pragma unroll 4
    for (int i = bid * 512 + tid; i < T_ * 64; i += nth) { const int t = i >> 6, c4 = (i & 63) * 4, h = c4 >> 6;
        const float l0 = DLSE[((size_t)0 * T_ + t) * 4 + h], l1 = DLSE[((size_t)1 * T_ + t) * 4 + h], l2 = DLSE[((size_t)2 * T_ + t) * 4 + h];
        const float m = fmaxf(l0, fmaxf(l1, l2));
        float w0 = fexp(l0 - m), w1 = fexp(l1 - m), w2 = fexp(l2 - m); const float inv = 1.0f / (w0 + w1 + w2); w0 *= inv; w1 *= inv; w2 *= inv;
        const f32x4 a = *(const f32x4*)(DPO + ((size_t)0 * T_ + t) * 256 + c4), b = *(const f32x4*)(DPO + ((size_t)1 * T_ + t) * 256 + c4), c = *(const f32x4*)(DPO + ((size_t)2 * T_ + t) * 256 + c4);
        const f32x4 r = w0 * a + w1 * b + w2 * c;
        u32x2 w; w.x = pk2(r[0], r[1]); w.y = pk2(r[2], r[3]);
        *(u32x2*)(O + (size_t)t * NO_ + 1536 + c4) = w; }
}

constexpr int NPH_LAYER = 14, NPH = 2 * NPH_LAYER;
__global__ void __launch_bounds__(512, 2) hybrid_fwd(Args a) {
    extern __shared__ __attribute__((aligned(16))) unsigned char lds_raw[];
    LAS unsigned char* lds = (LAS unsigned char*)lds_raw;
    PTab pt = (PTab)(lds + 131072);
    if (threadIdx.x == 0) {
#pragma unroll
        for (int i = 0; i < 22; ++i) pt[i] = (unsigned long long)a.in[i];
        pt[22] = (unsigned long long)a.out; pt[23] = (unsigned long long)a.ws;
    }
    if (threadIdx.x < 8) ((LAS unsigned*)(lds + 131072 + 512))[threadIdx.x] = 0u;
    __syncthreads();
    const int ph_lo = a.ph_lo, ph_hi = a.ph_hi;
    XcdBarrier bar = xcd_barrier_post((unsigned*)(a.ws + WS_CTL + WS_BAR), (volatile LAS unsigned*)(lds + 131072 + 512));
    for (int ph = ph_lo; ph < ph_hi; ++ph) {
        const int l = ph / NPH_LAYER, p = ph - l * NPH_LAYER;
        pg8::StaticOrder S;
        int tid = threadIdx.x; asm volatile("" : "+v"(tid));
        int bid = blockIdx.x, G = gridDim.x; asm volatile("" : "+s"(bid), "+s"(G));
        const int lane = tid & 63, wave = __builtin_amdgcn_readfirstlane(tid >> 6);
        unsigned char* ws = (unsigned char*)ldptr(pt, 23);
#define P_X ((float*)ldptr(pt, 22))
#define P_XB ((bf16_t*)(ws + WS_XB))
#define P_ZH ((bf16_t*)(ws + WS_ZH))
#define P_GATE ((bf16_t*)(ws + WS_GATE))
#define P_O ((bf16_t*)(ws + WS_O))
#define P_DS ((float*)(ws + WS_DS))
#define P_DEC ((float*)(ws + WS_CTL))
#define P_HS ((bf16_t*)(ws + WS_HS))
#define P_DPO ((float*)(ws + WS_DPO))
#define P_DLSE ((float*)(ws + WS_DLSE))
        switch (p) {
        case 0: if (l == 0) convert_phase(pt, 0, lds, tid, wave, lane, bid, G); break;
        case 1: case 11: {
            const int s = (p == 1) ? 0 : 1; const int n_ = (p == 1) ? 2 * FF_ : 2 * FF_ + D_;
            pg8::Gemm g{P_XB, (const bf16_t*)(ws + WS_WGU + (size_t)s * 44 * MiB), T_, n_, D_}; S.init(T_, n_, G, bid);
            pg8::EpiSwiGLU E{P_ZH, P_GATE}; pg8::gemm_phase(lds, g, S, E);
        } break;
        case 2: {
            pg8::Gemm g{P_ZH, (const bf16_t*)(ws + WS_WD), T_, D_, FF_}; S.init(T_, D_, G, bid);
            pg8::EpiResidT<false> E{P_X, P_XB, nullptr, ALPHA, 0.5f}; pg8::gemm_phase<pg8::EpiResidT<false>, true>(lds, g, S, E);
        } break;
        case 3: case 10: case 13: {
            const int which = (p == 3) ? 0 : (p == 10 ? 1 : 2);
            ln_phase(P_X, P_XB, ldptr(pt, 2) + (size_t)(l * 3 + which) * D_, ldptr(pt, 3) + (size_t)(l * 3 + which) * D_, (l == 1 && p == 13), wave, lane, bid, G);
            if (p == 13 && l == 0) convert_phase(pt, 1, lds, tid, wave, lane, bid, G);
            if (p == 10) { int kp = PLE_; asm volatile("" : "+s"(kp)); pg8::Gemm g2{(const bf16_t*)(ws + WS_PB) + (size_t)l * T_ * PLE_, (const bf16_t*)(ws + WS_WPP), T_, D_, kp}; S.init(T_, D_, G, bid);
                pg8::EpiBf16 E2{P_GATE, D_}; pg8::gemm_phase(lds, g2, S, E2); }
        } break;
        case 4: {
            pg8::Gemm g{P_XB, (const bf16_t*)(ws + WS_WIN), T_, NIN_, D_}; S.init(T_, NIN_, G, bid);
            pg8::EpiZ E{P_ZH, P_GATE}; pg8::gemm_phase(lds, g, S, E);
        } break;
        case 5: {
            for (int u = bid; u < 2560; u += G) attn_unit(lds, P_ZH, u, ldptr(pt, 8) + l * 8, P_O, P_DPO, P_DLSE, tid, wave, lane);
            for (int u = bid; u < 512; u += G) gmlp_unit(lds, P_ZH, u, ldptr(pt, 9) + l * 512, ldptr(pt, 10) + l * 512, ldptr(pt, 11) + (size_t)l * 65536, ldptr(pt, 12) + l * 512, P_O, tid, wave, lane);
            for (int u = bid; u < 1024; u += G) hgrn_c1_unit(lds, P_ZH, u, ldptr(pt, 13), l, P_DS, P_DEC, tid, wave, lane);
        } break;
        case 6: hgrn_scan_phase(P_DS, P_DEC, P_HS, tid, bid, G); break;
        case 7: {
            for (int u = bid; u < 1024; u += G) hgrn_c3_unit(lds, P_ZH, u, ldptr(pt, 13), l, P_HS, ldptr(pt, 14) + l * 512, P_O, tid, wave, lane);
            dcomb_phase(P_DPO, P_DLSE, P_O, tid, bid, G);
        } break;
        case 8: {
            pg8::Gemm g{P_O, (const bf16_t*)(ws + WS_WBR), T_, D_, NO_}; S.init(T_, D_, G, bid);
            pg8::EpiBR E{P_ZH, P_GATE}; pg8::gemm_phase(lds, g, S, E);
        } break;
        case 9: {
            pg8::Gemm g{P_ZH, (const bf16_t*)(ws + WS_WOUT), T_, D_, D_}; S.init(T_, D_, G, bid);
            pg8::EpiResidT<false> E{P_X, P_XB, nullptr, ALPHA, 1.0f}; pg8::gemm_phase(lds, g, S, E);
        } break;
        case 12: {
            pg8::Gemm g{P_ZH, (const bf16_t*)(ws + WS_WD + (size_t)22 * MiB), T_, D_, FF_}; S.init(T_, D_, G, bid);
            pg8::EpiResidT<true> E{P_X, P_XB, P_GATE, ALPHA, 0.5f}; pg8::gemm_phase<pg8::EpiResidT<true>, true>(lds, g, S, E);
        } break;
        default: break;
        }
        if (ph + 1 < ph_hi) { if (ph_hi > 1000) { __threadfence(); cg::this_grid().sync(); } else xcd_barrier(bar); }
    }
}

extern "C" void kernel_launch(void* const* d_in, const int* in_sizes, int n_in, void* d_out, int out_size, void* d_ws, size_t ws_size, hipStream_t stream) {
    static int grid = 0;
    if (grid == 0) {
        if (n_in != 22 || out_size != T_ * D_ || ws_size < WS_END) { fprintf(stderr, "kernel_launch: unexpected shapes (n_in %d out %d ws %zu need %zu)\n", n_in, out_size, ws_size, (size_t)WS_END); grid = -1; return; }
        int dev = 0, cus = 0, per_cu = 0;
        hipGetDevice(&dev); hipDeviceGetAttribute(&cus, hipDeviceAttributeMultiprocessorCount, dev);
        if (hipFuncSetAttribute((const void*)hybrid_fwd, hipFuncAttributeMaxDynamicSharedMemorySize, LDS_BYTES) != hipSuccess) { fprintf(stderr, "kernel_launch: hipFuncSetAttribute failed\n"); grid = -1; return; }
        hipOccupancyMaxActiveBlocksPerMultiprocessor(&per_cu, (const void*)hybrid_fwd, 512, LDS_BYTES);
        (void)hipGetLastError();
        if (per_cu < 1) per_cu = 1;
        grid = cus * 1;
    }
    if (grid < 0) return;
    if (hipMemsetAsync((char*)d_ws + WS_CTL + WS_BAR, 0, BAR_BYTES, stream) != hipSuccess) { fprintf(stderr, "kernel_launch: memset failed\n"); return; }
    Args a{};
    for (int i = 0; i < 22; ++i) a.in[i] = (const float*)d_in[i];
    a.out = (float*)d_out; a.ws = (unsigned char*)d_ws; a.ph_lo = 0; a.ph_hi = NPH;
    void* args[] = {&a};
    hipError_t e = hipLaunchCooperativeKernel((const void*)hybrid_fwd, dim3(grid), dim3(512), args, LDS_BYTES, stream);
    if (e != hipSuccess) fprintf(stderr, "cooperative launch failed: %s (grid %d)\n", hipGetErrorString(e), grid);
}
```

```cpp
#include <hip/hip_runtime.h>
#include <hip/hip_cooperative_groups.h>
#include <cstdio>
#include <cstdint>
namespace cg = cooperative_groups;

#define LAS __attribute__((address_space(3)))
typedef unsigned short bf16_t;
typedef short bf16x8 __attribute__((ext_vector_type(8)));
typedef float f32x4 __attribute__((ext_vector_type(4)));
typedef float f32x2 __attribute__((ext_vector_type(2)));
typedef unsigned u32x4 __attribute__((ext_vector_type(4)));
typedef unsigned u32x2 __attribute__((ext_vector_type(2)));

constexpr int T_ = 16384, SEQ_ = 4096, D_ = 2048, FF_ = 5632, NIN_ = 14336, NZ_ = 6144, NGT_ = 8192, NO_ = 1792, PLE_ = 256;
constexpr int ZQA = 0, ZKA = 512, ZVA = 640, ZUB = 768, ZVB = 1280, ZQC = 1792, ZFC = 2304, ZIC = 2816, ZGC = 3328, ZQD = 3840, ZKD = 4608, ZVD = 5376;
constexpr float LN_EPS = 1e-5f;
constexpr float ALPHA = 1.41421356237f;
constexpr float LOG2E = 1.44269504089f;

constexpr size_t MiB = 1u << 20;
constexpr size_t WS_CTL = 0;
constexpr size_t WS_BAR = 768 * 1024, BAR_BYTES = 16384;
constexpr size_t WS_WGU = 1 * MiB;
constexpr size_t WS_WPG = WS_WGU + 88 * MiB;
constexpr size_t WS_WD = WS_WPG + 8 * MiB;
constexpr size_t WS_WIN = WS_WD + 44 * MiB;
constexpr size_t WS_WBR = WS_WIN + 56 * MiB;
constexpr size_t WS_WOUT = WS_WBR + 7 * MiB;
constexpr size_t WS_WPP = WS_WOUT + 8 * MiB;
constexpr size_t WS_PB = WS_WPP + 1 * MiB;
constexpr size_t WS_XB = WS_PB + 16 * MiB;
constexpr size_t WS_ZH = WS_XB + 64 * MiB;
constexpr size_t WS_GATE = WS_ZH + 192 * MiB;
constexpr size_t WS_O = WS_GATE + 256 * MiB;
constexpr size_t WS_HS = WS_O + 56 * MiB;
constexpr size_t WS_DPO = WS_HS + 32 * MiB;
constexpr size_t WS_DLSE = WS_DPO + 48 * MiB;
constexpr size_t WS_DS = WS_DLSE + 1 * MiB;
constexpr size_t WS_END = WS_DS + 64 * MiB;

constexpr int LDS_BYTES = 147456;

__device__ __forceinline__ float bf2f(unsigned b) { return __uint_as_float(b << 16); }
__device__ __forceinline__ float bflo(unsigned w) { return __uint_as_float(w << 16); }
__device__ __forceinline__ float bfhi(unsigned w) { return __uint_as_float(w & 0xffff0000u); }
__device__ __forceinline__ unsigned pk2(float lo, float hi) { unsigned r; asm("v_cvt_pk_bf16_f32 %0, %1, %2" : "=v"(r) : "v"(lo), "v"(hi)); return r; }
__device__ __forceinline__ float fexp(float x) { return __builtin_amdgcn_exp2f(x * LOG2E); }
__device__ __forceinline__ float frcp(float x) { return __builtin_amdgcn_rcpf(x); }
__device__ __forceinline__ float fsigmoid(float x) { return frcp(1.0f + fexp(-x)); }
__device__ __forceinline__ float gelu_erf(float x) { return 0.5f * x * (1.0f + erff(x * 0.70710678118f)); }
__device__ __forceinline__ float gelu_fast(float v) {
    const float av = fabsf(v), t = frcp(av * 0.2316418882f + 1.0f);
    float q = t * 0.5307027145f + (-0.7265760135f); q = q * t + 0.7107068705f; q = q * t + (-0.142248368f); q = q * t + 0.127414796f; q = q * t;
    const float e = __builtin_amdgcn_exp2f((v * v) * (-0.72134752044f));
    const float m = v * (q * e);
    return v < 0.f ? m : v - m;
}
__device__ __forceinline__ float wave_sum(float v) {
#pragma unroll
    for (int o = 1; o < 64; o <<= 1) v += __shfl_xor(v, o);
    return v;
}
__device__ __forceinline__ f32x4 mfma16(bf16x8 a, bf16x8 b, f32x4 c) { return __builtin_amdgcn_mfma_f32_16x16x32_bf16(a, b, c, 0, 0, 0); }
typedef short s16x4 __attribute__((ext_vector_type(4)));
__device__ __forceinline__ u32x2 tr16(const LAS bf16_t* p) { const s16x4 r = __builtin_amdgcn_ds_read_tr16_b64_v4i16((LAS s16x4*)p); return __builtin_bit_cast(u32x2, r); }
__device__ __forceinline__ bf16x8 mk8(u32x2 a, u32x2 b) { u32x4 t = {a.x, a.y, b.x, b.y}; return __builtin_bit_cast(bf16x8, t); }

namespace pg8 {
constexpr int BM = 256, BK = 64, HALF = 128, HTB = HALF * BK * 2, STAGE_BYTES = 8 * HTB, NXCD = 8, WGM = 8;
__device__ __forceinline__ int lds_byte(int r, int c) { const int st = (r >> 4) * 2 + (c >> 5), rr = r & 15, cc = c & 31, ob = rr * 64 + cc * 2; return st * 1024 + (ob ^ (((ob >> 9) & 1) << 5)); }
__device__ __forceinline__ void stage_rc(int b, int& R, int& C) { const int st = b / 1024, sb = b % 1024, swz = sb ^ (((sb >> 9) & 1) << 5); R = (st >> 1) * 16 + swz / 64; C = (st & 1) * 32 + (swz % 64) / 2; }
__device__ __forceinline__ int perm32(int rho) { const int n = rho >> 4, i = rho & 15; return 8 * (i >> 2) + 4 * n + (i & 3); }
struct Unit { int pm, pn; };
struct Gemm { const bf16_t* A; const bf16_t* Bt; int M, N, K; };
struct StaticOrder {
    int nM, nN, nwg, G, c;
    __device__ void init(int M, int N, int G_, int c_) { nM = M / BM; nN = N / BM; nwg = nM * nN; G = G_; c = c_; }
    __device__ bool next(int i, Unit& u) const {
        const long L = (long)i * G + c; if (L >= nwg) return false;
        int wgid = (int)L; { const int q = nwg / NXCD, r = nwg % NXCD, xcd = wgid % NXCD, off = wgid / NXCD; wgid = (xcd < r ? xcd * (q + 1) : r * (q + 1) + (xcd - r) * q) + off; }
        const int nig = WGM * nN, gid = wgid / nig, fm = gid * WGM, gsz = (nM - fm) < WGM ? (nM - fm) : WGM;
        u.pm = fm + ((wgid % nig) % gsz); u.pn = (wgid % nig) / gsz; return true;
    }
};

struct EpiSwiGLU {
    static constexpr bool PERM = true, HAS_MID = false;
    bf16_t* H; bf16_t* PP;
    __device__ __forceinline__ void mid(int, f32x4 (&)[2][2][4][2], const Unit&, int, int, int, int) const {}
    __device__ __forceinline__ void operator()(const f32x4 (&acc)[2][2][4][2], const Unit& u, int wr, int wc, int fr, int fq) const {
        const int row0 = u.pm * BM + wr * 64 + fr;
        if (u.pn < 44) {
            const int col0 = u.pn * 128 + wc * 32 + 8 * fq;
#pragma unroll
            for (int ai = 0; ai < 2; ++ai)
#pragma unroll
                for (int m = 0; m < 4; ++m) {
                    bf16_t* rowp = H + (size_t)(row0 + ai * HALF + m * 16) * FF_ + col0;
                    float h[8];
#pragma unroll
                    for (int n = 0; n < 2; ++n)
#pragma unroll
                        for (int j = 0; j < 4; ++j) { const float g = acc[ai][0][m][n][j], up = acc[ai][1][m][n][j]; h[n * 4 + j] = g * fsigmoid(g) * up; }
                    u32x4 w; w.x = pk2(h[0], h[1]); w.y = pk2(h[2], h[3]); w.z = pk2(h[4], h[5]); w.w = pk2(h[6], h[7]);
                    *(u32x4*)rowp = w;
                    asm volatile("" ::: "memory"); __builtin_amdgcn_sched_barrier(0);
                }
        } else {
            const int col0 = (u.pn - 44) * BM + wc * 32 + 8 * fq;
#pragma unroll
            for (int am = 0; am < 4; ++am) { const int ai = am >> 1, mb = (am & 1) * 2;
                u32x4 pv[2][2];
#pragma unroll
                for (int mm = 0; mm < 2; ++mm)
#pragma unroll
                    for (int bj = 0; bj < 2; ++bj) pv[mm][bj] = *(const u32x4*)(PP + (size_t)(row0 + ai * HALF + (mb + mm) * 16) * D_ + col0 + bj * HALF);
#pragma unroll
                for (int mm = 0; mm < 2; ++mm) { const int m = mb + mm;
                    bf16_t* rowp = PP + (size_t)(row0 + ai * HALF + m * 16) * D_ + col0;
#pragma unroll
                    for (int bj = 0; bj < 2; ++bj) {
                        const u32x4 p = pv[mm][bj];
                        const f32x4 a0 = acc[ai][bj][m][0], a1 = acc[ai][bj][m][1];
                        u32x4 w;
                        w.x = pk2(fsigmoid(a0[0]) * bflo(p.x), fsigmoid(a0[1]) * bfhi(p.x)); w.y = pk2(fsigmoid(a0[2]) * bflo(p.y), fsigmoid(a0[3]) * bfhi(p.y));
                        w.z = pk2(fsigmoid(a1[0]) * bflo(p.z), fsigmoid(a1[1]) * bfhi(p.z)); w.w = pk2(fsigmoid(a1[2]) * bflo(p.w), fsigmoid(a1[3]) * bfhi(p.w));
                        *(u32x4*)(rowp + bj * HALF) = w;
                    }
                }
                asm volatile("" ::: "memory"); __builtin_amdgcn_sched_barrier(0);
            }
        }
    }
};
template <bool ADD> struct EpiResidT {
    static constexpr bool PERM = false, HAS_MID = false;
    float* Y; const bf16_t* XB; const bf16_t* PP; float a, b;
    __device__ __forceinline__ void mid(int, f32x4 (&)[2][2][4][2], const Unit&, int, int, int, int) const {}
    __device__ __forceinline__ void operator()(const f32x4 (&acc)[2][2][4][2], const Unit& u, int wr, int wc, int fr, int fq) const {
        const int row0 = u.pm * BM + wr * 64 + fr, col0 = u.pn * BM + wc * 32 + 4 * fq;
        constexpr int GM = ADD ? 2 : 4;
#pragma unroll
        for (int ai = 0; ai < 2; ++ai)
#pragma unroll
            for (int m0 = 0; m0 < 4; m0 += GM) {
                u32x2 xb[GM][2][2], pp[GM][2][2];
#pragma unroll
                for (int mm = 0; mm < GM; ++mm) { const size_t off = (size_t)(row0 + ai * HALF + (m0 + mm) * 16) * D_ + col0;
#pragma unroll
                    for (int bj = 0; bj < 2; ++bj)
#pragma unroll
                        for (int n = 0; n < 2; ++n) { xb[mm][bj][n] = *(const u32x2*)(XB + off + bj * HALF + n * 16); if (ADD) pp[mm][bj][n] = *(const u32x2*)(PP + off + bj * HALF + n * 16); } }
#pragma unroll
                for (int mm = 0; mm < GM; ++mm) { const int m = m0 + mm; const size_t off = (size_t)(row0 + ai * HALF + m * 16) * D_ + col0;
#pragma unroll
                    for (int bj = 0; bj < 2; ++bj)
#pragma unroll
                        for (int n = 0; n < 2; ++n) { const u32x2 x = xb[mm][bj][n]; const f32x4 s = acc[ai][bj][m][n];
                            f32x4 y; y[0] = a * bflo(x.x) + b * s[0]; y[1] = a * bfhi(x.x) + b * s[1]; y[2] = a * bflo(x.y) + b * s[2]; y[3] = a * bfhi(x.y) + b * s[3];
                            if (ADD) { const u32x2 q = pp[mm][bj][n]; y[0] += bflo(q.x); y[1] += bfhi(q.x); y[2] += bflo(q.y); y[3] += bfhi(q.y); }
                            *(f32x4*)(Y + off + bj * HALF + n * 16) = y; } }
                asm volatile("" ::: "memory"); __builtin_amdgcn_sched_barrier(0);
            }
    }
};
struct EpiZ {
    static constexpr bool PERM = true, HAS_MID = false;
    bf16_t* Z; bf16_t* GATE;
    __device__ __forceinline__ void mid(int, f32x4 (&)[2][2][4][2], const Unit&, int, int, int, int) const {}
    __device__ __forceinline__ void operator()(const f32x4 (&acc)[2][2][4][2], const Unit& u, int wr, int wc, int fr, int fq) const {
        const int row0 = u.pm * BM + wr * 64 + fr;
        if (u.pn < 24) {
            const bool isgelu = (u.pn >= 3) && (u.pn <= 6);
            const int col0 = u.pn * BM + wc * 32 + 8 * fq;
#pragma unroll
            for (int ai = 0; ai < 2; ++ai)
#pragma unroll
                for (int m = 0; m < 4; ++m) {
                    bf16_t* rowp = Z + (size_t)(row0 + ai * HALF + m * 16) * NZ_ + col0;
#pragma unroll
                    for (int bj = 0; bj < 2; ++bj) {
                        f32x4 v0 = acc[ai][bj][m][0], v1 = acc[ai][bj][m][1];
                        if (isgelu) {
#pragma unroll
                            for (int j = 0; j < 4; ++j) { v0[j] = gelu_fast(v0[j]); v1[j] = gelu_fast(v1[j]); }
                        }
                        u32x4 w; w.x = pk2(v0[0], v0[1]); w.y = pk2(v0[2], v0[3]); w.z = pk2(v1[0], v1[1]); w.w = pk2(v1[2], v1[3]);
                        *(u32x4*)(rowp + bj * HALF) = w;
                    }
                    asm volatile("" ::: "memory"); __builtin_amdgcn_sched_barrier(0);
                }
        } else {
            const int mc0 = (u.pn - 24) * 64 + wc * 16 + 4 * fq;
#pragma unroll
            for (int ai = 0; ai < 2; ++ai)
#pragma unroll
                for (int m = 0; m < 4; ++m) {
                    bf16_t* rowp = GATE + (size_t)(row0 + ai * HALF + m * 16) * D_ + mc0;
                    f32x4 e[4];
#pragma unroll
                    for (int br = 0; br < 4; ++br)
#pragma unroll
                        for (int j = 0; j < 4; ++j) e[br][j] = fminf(1.0f + fexp(-acc[ai][br >> 1][m][br & 1][j]), 1e30f);
                    f32x4 i0, i1, i2, i3;
#pragma unroll
                    for (int j = 0; j < 4; ++j) { i0[j] = frcp(e[0][j]); i1[j] = frcp(e[1][j]); i2[j] = frcp(e[2][j]); i3[j] = frcp(e[3][j]); }
                    const f32x4 r0 = e[1] * i0, r1 = e[2] * i1, r2 = e[3] * i2;
                    u32x2 w;
                    w.x = pk2(r0[0], r0[1]); w.y = pk2(r0[2], r0[3]); *(u32x2*)(rowp) = w;
                    w.x = pk2(r1[0], r1[1]); w.y = pk2(r1[2], r1[3]); *(u32x2*)(rowp + (size_t)T_ * D_) = w;
                    w.x = pk2(r2[0], r2[1]); w.y = pk2(r2[2], r2[3]); *(u32x2*)(rowp + (size_t)2 * T_ * D_) = w;
                    w.x = pk2(i3[0], i3[1]); w.y = pk2(i3[2], i3[3]); *(u32x2*)(rowp + (size_t)3 * T_ * D_) = w;
                    asm volatile("" ::: "memory"); __builtin_amdgcn_sched_barrier(0);
                }
        }
    }
};
struct EpiBf16 {
    static constexpr bool PERM = true, HAS_MID = false;
    bf16_t* O; int ldc;
    __device__ __forceinline__ void mid(int, f32x4 (&)[2][2][4][2], const Unit&, int, int, int, int) const {}
    __device__ __forceinline__ void operator()(const f32x4 (&acc)[2][2][4][2], const Unit& u, int wr, int wc, int fr, int fq) const {
        const int row0 = u.pm * BM + wr * 64 + fr, col0 = u.pn * BM + wc * 32 + 8 * fq;
#pragma unroll
        for (int ai = 0; ai < 2; ++ai)
#pragma unroll
            for (int m = 0; m < 4; ++m) {
                bf16_t* rowp = O + (size_t)(row0 + ai * HALF + m * 16) * ldc + col0;
#pragma unroll
                for (int bj = 0; bj < 2; ++bj) {
                    const f32x4 v0 = acc[ai][bj][m][0], v1 = acc[ai][bj][m][1];
                    u32x4 w; w.x = pk2(v0[0], v0[1]); w.y = pk2(v0[2], v0[3]); w.z = pk2(v1[0], v1[1]); w.w = pk2(v1[2], v1[3]);
                    *(u32x4*)(rowp + bj * HALF) = w;
                }
                asm volatile("" ::: "memory"); __builtin_amdgcn_sched_barrier(0);
            }
    }
};
struct EpiBR {
    static constexpr bool PERM = true, HAS_MID = true;
    bf16_t* O; const bf16_t* GATE;
    __device__ __forceinline__ void scale(const bf16_t* plane, f32x4 (&acc)[2][2][4][2], const Unit& u, int wr, int wc, int fr, int fq) const {
        const int row0 = u.pm * BM + wr * 64 + fr, col0 = u.pn * BM + wc * 32 + 8 * fq;
        u32x4 r[2][4][2];
#pragma unroll
        for (int ai = 0; ai < 2; ++ai)
#pragma unroll
            for (int m = 0; m < 4; ++m)
#pragma unroll
                for (int bj = 0; bj < 2; ++bj) r[ai][m][bj] = *(const u32x4*)(plane + (size_t)(row0 + ai * HALF + m * 16) * D_ + col0 + bj * HALF);
#pragma unroll
        for (int ai = 0; ai < 2; ++ai)
#pragma unroll
            for (int m = 0; m < 4; ++m)
#pragma unroll
                for (int bj = 0; bj < 2; ++bj) { const u32x4 e = r[ai][m][bj];
                    acc[ai][bj][m][0] *= (f32x4){bflo(e.x), bfhi(e.x), bflo(e.y), bfhi(e.y)}; acc[ai][bj][m][1] *= (f32x4){bflo(e.z), bfhi(e.z), bflo(e.w), bfhi(e.w)}; }
    }
    __device__ __forceinline__ void mid(int t, f32x4 (&acc)[2][2][4][2], const Unit& u, int wr, int wc, int fr, int fq) const {
        if (t != 8 && t != 16 && t != 24) return;
        asm volatile("" : "+v"(fr), "+v"(fq));
        scale(GATE + (size_t)((t >> 3) - 1) * T_ * D_, acc, u, wr, wc, fr, fq);
    }
    __device__ __forceinline__ void operator()(f32x4 (&acc)[2][2][4][2], const Unit& u, int wr, int wc, int fr, int fq) const {
        scale(GATE + (size_t)3 * T_ * D_, acc, u, wr, wc, fr, fq);
        const int row0 = u.pm * BM + wr * 64 + fr, col0 = u.pn * BM + wc * 32 + 8 * fq;
#pragma unroll
        for (int ai = 0; ai < 2; ++ai)
#pragma unroll
            for (int m = 0; m < 4; ++m) {
                bf16_t* rowp = O + (size_t)(row0 + ai * HALF + m * 16) * D_ + col0;
#pragma unroll
                for (int bj = 0; bj < 2; ++bj) {
                    const f32x4 a0 = acc[ai][bj][m][0], a1 = acc[ai][bj][m][1];
                    u32x4 w; w.x = pk2(a0[0], a0[1]); w.y = pk2(a0[2], a0[3]); w.z = pk2(a1[0], a1[1]); w.w = pk2(a1[2], a1[3]);
                    *(u32x4*)(rowp + bj * HALF) = w;
                }
            }
    }
};

template <class Epi, bool KREV = false>
__device__ __forceinline__ void gemm_phase(LAS unsigned char* lds, const Gemm g, const StaticOrder& S, const Epi& E) {
    int tid = threadIdx.x; asm volatile("" : "+v"(tid));
    const int wid = __builtin_amdgcn_readfirstlane(tid >> 6), lane = tid & 63, wr = wid >> 2, wc = wid & 3, fr = lane & 15, fq = lane >> 4;
    const int K = g.K, nt = K / BK;
    unsigned voffA[2], voffB[2];
#pragma unroll
    for (int i = 0; i < 2; ++i) { int R, C; stage_rc(tid * 16 + i * 8192, R, C); const int Rb = Epi::PERM ? ((R & ~31) + perm32(R & 31)) : R;
        voffA[i] = (unsigned)(R * K + C) * 2u; voffB[i] = (unsigned)(Rb * K + C) * 2u; }
    const long kstep = KREV ? -(long)(BK * 2) : (long)(BK * 2);
    const size_t kbase = KREV ? (size_t)(nt - 1) * (BK * 2) : 0;
    const size_t hstep = (size_t)HALF * K * 2;
    const size_t tstep = 2 * hstep;
    const unsigned ldsw = (unsigned)wid * 1024u;
    const int aoff = lds_byte(wr * 64 + fr, fq * 8), boff = lds_byte(wc * 32 + fr, fq * 8);
#define PG8_SA(b, h) (((b) * 2 + (h)) * HTB)
#define PG8_SB(b, h) ((4 + (b) * 2 + (h)) * HTB)
#define PG8_STAGE(bufoff, gbase, voff) do { _Pragma("unroll") for (int _i = 0; _i < 2; ++_i) \
        __builtin_amdgcn_global_load_lds((const unsigned*)((const char*)(gbase) + (voff)[_i]), (LAS unsigned*)(lds + (bufoff) + ldsw + _i * 8192), 16, 0, 0); } while (0)
#define PG8_LDA(dst, b, h) do { _Pragma("unroll") for (int m = 0; m < 4; ++m) _Pragma("unroll") for (int k = 0; k < 2; ++k) dst[m][k] = *(const LAS bf16x8*)(lds + PG8_SA(b, h) + aoff + m * 2048 + k * 1024); } while (0)
#define PG8_LDB(dst, b, h) do { _Pragma("unroll") for (int n = 0; n < 2; ++n) _Pragma("unroll") for (int k = 0; k < 2; ++k) dst[n][k] = *(const LAS bf16x8*)(lds + PG8_SB(b, h) + boff + n * 2048 + k * 1024); } while (0)
#define PG8_MMA(ai, bj, At, Bt) do { __builtin_amdgcn_s_setprio(1); _Pragma("unroll") for (int m = 0; m < 4; ++m) _Pragma("unroll") for (int n = 0; n < 2; ++n) _Pragma("unroll") for (int k = 0; k < 2; ++k) \
        acc[ai][bj][m][n] = __builtin_amdgcn_mfma_f32_16x16x32_bf16(Bt[n][k], At[m][k], acc[ai][bj][m][n], 0, 0, 0); __builtin_amdgcn_s_setprio(0); } while (0)
#define PG8_WAIT_V(n) asm volatile("s_waitcnt vmcnt(" #n ")" ::: "memory")
#define PG8_WAIT_L(n) asm volatile("s_waitcnt lgkmcnt(" #n ")" ::: "memory")
#define PG8_BAR __builtin_amdgcn_s_barrier()
#define PG8_SCHED __builtin_amdgcn_sched_barrier(0)
    Unit cur, nxt; int ui = 0;
    if (!S.next(0, cur)) return;
    f32x4 acc[2][2][4][2];
#pragma unroll
    for (int a = 0; a < 2; ++a)
#pragma unroll
        for (int b = 0; b < 2; ++b)
#pragma unroll
            for (int m = 0; m < 4; ++m)
#pragma unroll
                for (int n = 0; n < 2; ++n) acc[a][b][m][n] = (f32x4){0.f, 0.f, 0.f, 0.f};
    bf16x8 At[4][2], B0[2][2], B1[2][2];
    const char* cA = (const char*)g.A + (size_t)cur.pm * tstep + kbase; const char* cB = (const char*)g.Bt + (size_t)cur.pn * tstep + kbase;
    PG8_STAGE(PG8_SB(0, 0), cB, voffB); PG8_STAGE(PG8_SB(0, 1), cB + hstep, voffB); PG8_STAGE(PG8_SA(0, 0), cA, voffA); PG8_STAGE(PG8_SA(0, 1), cA + hstep, voffA);
    if (wr == 1) PG8_BAR;
    PG8_WAIT_V(2); PG8_BAR;
    PG8_STAGE(PG8_SB(1, 0), cB + kstep, voffB); PG8_STAGE(PG8_SA(1, 0), cA + kstep, voffA); PG8_STAGE(PG8_SB(1, 1), cB + hstep + kstep, voffB);
    PG8_WAIT_V(6); PG8_BAR;
    for (;;) {
        const bool has_next = S.next(ui + 1, nxt);
        const char* nA = has_next ? (const char*)g.A + (size_t)nxt.pm * tstep + kbase : cA; const char* nB = has_next ? (const char*)g.Bt + (size_t)nxt.pn * tstep + kbase : cB;
        for (int t = 0; t < nt; t += 2) {
            const bool last = (t == nt - 2);
            const char* a1 = cA + (long)(t + 1) * kstep;
            const char* a2 = last ? nA : cA + (long)(t + 2) * kstep; const char* b2 = last ? nB : cB + (long)(t + 2) * kstep;
            const char* a3 = a2 + kstep; const char* b3 = b2 + kstep;
            if constexpr (Epi::HAS_MID) E.mid(t, acc, cur, wr, wc, fr, fq);
            PG8_LDB(B0, 0, 0); PG8_LDB(B1, 0, 1); PG8_SCHED; PG8_LDA(At, 0, 0); PG8_STAGE(PG8_SA(1, 1), a1 + hstep, voffA);
            PG8_WAIT_V(8); PG8_WAIT_L(0); PG8_BAR; PG8_MMA(0, 0, At, B0); PG8_MMA(0, 1, At, B1); PG8_BAR; PG8_SCHED;
            PG8_LDA(At, 0, 1); PG8_STAGE(PG8_SB(0, 0), b2, voffB); PG8_STAGE(PG8_SB(0, 1), b2 + hstep, voffB); PG8_STAGE(PG8_SA(0, 0), a2, voffA);
            PG8_WAIT_V(8); PG8_WAIT_L(0); PG8_BAR; PG8_MMA(1, 0, At, B0); PG8_MMA(1, 1, At, B1); PG8_BAR; PG8_SCHED;
            PG8_LDB(B0, 1, 0); PG8_LDB(B1, 1, 1); PG8_SCHED; PG8_LDA(At, 1, 0); PG8_STAGE(PG8_SA(0, 1), a2 + hstep, voffA);
            PG8_WAIT_V(8); PG8_WAIT_L(0); PG8_BAR; PG8_MMA(0, 0, At, B0); PG8_MMA(0, 1, At, B1); PG8_BAR; PG8_SCHED;
            PG8_LDA(At, 1, 1); PG8_STAGE(PG8_SB(1, 0), b3, voffB); PG8_STAGE(PG8_SB(1, 1), b3 + hstep, voffB); PG8_STAGE(PG8_SA(1, 0), a3, voffA);
            PG8_WAIT_V(8); PG8_WAIT_L(0); PG8_BAR; PG8_MMA(1, 0, At, B0); PG8_MMA(1, 1, At, B1); PG8_BAR; PG8_SCHED;
        }
        if (wr == 0) PG8_BAR;
#pragma unroll
        for (int a = 0; a < 2; ++a)
#pragma unroll
            for (int b = 0; b < 2; ++b)
#pragma unroll
                for (int m = 0; m < 4; ++m)
#pragma unroll
                    for (int n = 0; n < 2; ++n) asm volatile("" : "+v"(acc[a][b][m][n]));
        E(acc, cur, wr, wc, fr, fq);
        if (!has_next) break;
#pragma unroll
        for (int a = 0; a < 2; ++a)
#pragma unroll
            for (int b = 0; b < 2; ++b)
#pragma unroll
                for (int m = 0; m < 4; ++m)
#pragma unroll
                    for (int n = 0; n < 2; ++n) acc[a][b][m][n] = (f32x4){0.f, 0.f, 0.f, 0.f};
        cur = nxt; cA = nA; cB = nB; ++ui;
        if (wr == 1) PG8_BAR;
    }
    PG8_WAIT_V(0);
    PG8_BAR;
#undef PG8_SA
#undef PG8_SB
#undef PG8_STAGE
#undef PG8_LDA
#undef PG8_LDB
#undef PG8_MMA
#undef PG8_WAIT_V
#undef PG8_WAIT_L
#undef PG8_BAR
#undef PG8_SCHED
}
}

typedef __attribute__((address_space(1))) unsigned gu32;
#define XB_TMO      128
#define XB_XCNT(j)  (256  + 64 * (j))
#define XB_XSUB(j)  (1280 + 64 * (j))
#define XB_XGEN(j)  (2304 + 64 * (j))
#define XB_TOP      3328
#define XB_TOPGEN   3392
#define XCD_BAR_WORDS 3456
#define XB_SPIN_CAP (1u << 18)

__device__ __forceinline__ unsigned xb_ld(unsigned* p)              { return __hip_atomic_load(p, __ATOMIC_RELAXED, __HIP_MEMORY_SCOPE_AGENT); }
__device__ __forceinline__ unsigned xb_add(unsigned* p, unsigned v) { return __hip_atomic_fetch_add(p, v, __ATOMIC_RELAXED, __HIP_MEMORY_SCOPE_AGENT); }
__device__ __forceinline__ unsigned xb_xcc_id() { return (unsigned)__builtin_amdgcn_s_getreg((3 << 11) | 20) & 0xFu; }
#define XB_SPIN(cond, bar) do { unsigned _sp = 0; while (cond) { __builtin_amdgcn_s_sleep(1); \
    if ((++_sp & 255u) == 0u) { if (xb_ld(&(bar)[XB_TMO])) break; if (_sp > XB_SPIN_CAP) { atomicAdd(&(bar)[XB_TMO], 1u); break; } } } } while (0)

struct XcdBarrier {
    unsigned* bar; unsigned x;
    volatile LAS unsigned* st;
};

__device__ __forceinline__ XcdBarrier xcd_barrier_post(unsigned* bar, volatile LAS unsigned* st) {
    XcdBarrier b; b.bar = bar; b.x = xb_xcc_id(); b.st = st;
    if (threadIdx.x == 0) (void)xb_add(&bar[XB_XCNT(b.x)], 1u);
    return b;
}
__device__ __forceinline__ void xcd_barrier_complete(unsigned* bar, unsigned x, unsigned& nloc, unsigned& nx) {
    const unsigned G = gridDim.x * gridDim.y * gridDim.z;
    unsigned sum, cnt, mine, sp = 0u;
    for (;;) {
        sum = 0u; cnt = 0u; mine = 0u;
#pragma unroll
        for (unsigned j = 0; j < 16; ++j) { const unsigned c = xb_ld(&bar[XB_XCNT(j)]); sum += c; cnt += (c > 0u) ? 1u : 0u; mine = (j == x) ? c : mine; }
        if (sum == G) break;
        __builtin_amdgcn_s_sleep(1);
        if ((++sp & 255u) == 0u) { if (xb_ld(&bar[XB_TMO])) break; if (sp > XB_SPIN_CAP) { atomicAdd(&bar[XB_TMO], 1u); break; } }
    }
    nloc = mine > 0u ? mine : 1u; nx = cnt > 0u ? cnt : 1u;
}

__device__ __forceinline__ void xcd_barrier(const XcdBarrier& b) {
    asm volatile("s_waitcnt vmcnt(0)" ::: "memory");
    __syncthreads();
    if (threadIdx.x == 0) {
        unsigned* bar = b.bar;
        __builtin_amdgcn_s_waitcnt(0);
        unsigned nloc = b.st[0], nx = b.st[1];
        if (nloc == 0u) { xcd_barrier_complete(bar, b.x, nloc, nx); b.st[0] = nloc; b.st[1] = nx; }
        const unsigned old = xb_add(&bar[XB_XSUB(b.x)], 1u);
        const unsigned gen = old / nloc;
        if (old + 1u == (gen + 1u) * nloc) {
            __builtin_amdgcn_fence(__ATOMIC_RELEASE, "agent");
            asm volatile("s_waitcnt vmcnt(0)" ::: "memory");
            const unsigned og = xb_add(&bar[XB_TOP], 1u);
            const unsigned tg = og / nx;
            if (og + 1u == (tg + 1u) * nx) xb_add(&bar[XB_TOPGEN], 1u);
            else XB_SPIN(xb_ld(&bar[XB_TOPGEN]) == tg, bar);
            __builtin_amdgcn_fence(__ATOMIC_ACQUIRE, "agent");
            xb_add(&bar[XB_XGEN(b.x)], 1u);
            asm volatile("s_waitcnt vmcnt(0)" ::: "memory");
        } else {
            XB_SPIN(xb_ld(&bar[XB_XGEN(b.x)]) == gen, bar);
            __builtin_amdgcn_fence(__ATOMIC_ACQUIRE, "agent");
            asm volatile("s_waitcnt vmcnt(0)" ::: "memory");
        }
    }
    __syncthreads();
}


struct Args { const float* in[22]; float* out; unsigned char* ws; int ph_lo, ph_hi; };

typedef LAS unsigned long long* PTab;
__device__ __forceinline__ const float* ldptr(PTab pt, int k) {
    const unsigned long long v = pt[k];
    const unsigned lo = __builtin_amdgcn_readfirstlane((unsigned)v), hi = __builtin_amdgcn_readfirstlane((unsigned)(v >> 32));
    return (const float*)(((unsigned long long)hi << 32) | lo);
}

__device__ __forceinline__ int conv_row(int n, int mode, int rowoff) {
    if (mode == 0) return rowoff + n;
    if (mode == 3) { const int br = n >> 11, mc = n & 2047, q = mc >> 6, mcl = mc & 63; return rowoff + 256 * q + 128 * (br >> 1) + 32 * (mcl >> 4) + 8 * ((mcl >> 2) & 3) + 4 * (br & 1) + (mcl & 3); }
    return (n >> 7) * 256 + (n & 127) + (mode == 2 ? 128 : 0);
}
__device__ __forceinline__ void conv_mat(const float* W, int ldw, int K, int N, bf16_t* WT, int pitch, int koff, int mode, int rowoff, int gw, int ngw, int lane) {
    const int nblk = N / 64, nitems = (K / 64) * nblk;
    const int c = lane & 15, q = lane >> 4;
    f32x4 v[16];
    if (gw < nitems) { const int kb = gw / nblk, nb = gw - kb * nblk; const float* src = W + (size_t)(64 * kb + 16 * q) * ldw + 64 * nb + 4 * c;
#pragma unroll
        for (int j = 0; j < 16; ++j) v[j] = __builtin_nontemporal_load((const f32x4*)(src + (size_t)j * ldw)); }
    for (int item = gw; item < nitems; item += ngw) {
        const int kb = item / nblk, nb = item - kb * nblk, k0 = 64 * kb, n0 = 64 * nb;
        u32x4 o[8];
#pragma unroll
        for (int i = 0; i < 4; ++i) {
            o[2 * i].x = pk2(v[0][i], v[1][i]); o[2 * i].y = pk2(v[2][i], v[3][i]); o[2 * i].z = pk2(v[4][i], v[5][i]); o[2 * i].w = pk2(v[6][i], v[7][i]);
            o[2 * i + 1].x = pk2(v[8][i], v[9][i]); o[2 * i + 1].y = pk2(v[10][i], v[11][i]); o[2 * i + 1].z = pk2(v[12][i], v[13][i]); o[2 * i + 1].w = pk2(v[14][i], v[15][i]);
        }
        const int nx = item + ngw;
        if (nx < nitems) { const int kb2 = nx / nblk, nb2 = nx - kb2 * nblk; const float* src = W + (size_t)(64 * kb2 + 16 * q) * ldw + 64 * nb2 + 4 * c;
#pragma unroll
            for (int j = 0; j < 16; ++j) v[j] = __builtin_nontemporal_load((const f32x4*)(src + (size_t)j * ldw)); }
        const int rb = conv_row(n0 + 4 * c, mode, rowoff);
#pragma unroll
        for (int i = 0; i < 4; ++i) {
            bf16_t* dst = WT + (size_t)(rb + i) * pitch + koff + k0 + 16 * q;
            *(u32x4*)dst = o[2 * i]; *(u32x4*)(dst + 8) = o[2 * i + 1];
        }
    }
}

__device__ __forceinline__ void convert_phase(PTab pt, int l, LAS unsigned char* lds, int tid, int wave, int lane, int bid, int G) {
    unsigned char* ws = (unsigned char*)ldptr(pt, 23);
    const int gw = bid * 8 + wave, ngw = G * 8;
    for (int s = 0; s < 2; ++s) {
        bf16_t* wgu = (bf16_t*)(ws + WS_WGU + (size_t)s * 44 * MiB);
        conv_mat(ldptr(pt, 4) + (size_t)(l * 2 + s) * D_ * FF_, FF_, D_, FF_, wgu, D_, 0, 1, 0, gw, ngw, lane);
        conv_mat(ldptr(pt, 5) + (size_t)(l * 2 + s) * D_ * FF_, FF_, D_, FF_, wgu, D_, 0, 2, 0, gw, ngw, lane);
        conv_mat(ldptr(pt, 6) + (size_t)(l * 2 + s) * D_ * FF_, D_, FF_, D_, (bf16_t*)(ws + WS_WD + (size_t)s * 22 * MiB), FF_, 0, 0, 0, gw, ngw, lane);
    }
    conv_mat(ldptr(pt, 7) + (size_t)l * D_ * NIN_, NIN_, D_, NZ_, (bf16_t*)(ws + WS_WIN), D_, 0, 0, 0, gw, ngw, lane);
    conv_mat(ldptr(pt, 7) + (size_t)l * D_ * NIN_ + NZ_, NIN_, D_, NGT_, (bf16_t*)(ws + WS_WIN), D_, 0, 3, NZ_, gw, ngw, lane);
    conv_mat(ldptr(pt, 15) + (size_t)l * 512 * D_, D_, 512, D_, (bf16_t*)(ws + WS_WBR), NO_, 0, 0, 0, gw, ngw, lane);
    conv_mat(ldptr(pt, 16) + (size_t)l * 512 * D_, D_, 512, D_, (bf16_t*)(ws + WS_WBR), NO_, 512, 0, 0, gw, ngw, lane);
    conv_mat(ldptr(pt, 17) + (size_t)l * 512 * D_, D_, 512, D_, (bf16_t*)(ws + WS_WBR), NO_, 1024, 0, 0, gw, ngw, lane);
    conv_mat(ldptr(pt, 18) + (size_t)l * 256 * D_, D_, 256, D_, (bf16_t*)(ws + WS_WBR), NO_, 1536, 0, 0, gw, ngw, lane);
    conv_mat(ldptr(pt, 19) + (size_t)l * D_ * D_, D_, D_, D_, (bf16_t*)(ws + WS_WOUT), D_, 0, 0, 0, gw, ngw, lane);
    conv_mat(ldptr(pt, 20) + (size_t)l * PLE_ * D_, D_, PLE_, D_, (bf16_t*)(ws + WS_WPP), PLE_, 0, 0, 0, gw, ngw, lane);
    conv_mat(ldptr(pt, 21) + (size_t)l * D_ * D_, D_, D_, D_, (bf16_t*)(ws + WS_WPG), D_, 0, 0, 0, gw, ngw, lane);
    if (l == 0) {
        const size_t gt = (size_t)bid * 512 + tid, nth = (size_t)G * 512;
        const f32x4* x4 = (const f32x4*)ldptr(pt, 0); u32x2* xb = (u32x2*)(ws + WS_XB);
        for (size_t i = gt; i < (size_t)T_ * D_ / 4; i += nth) { const f32x4 v = x4[i]; u32x2 w; w.x = pk2(v[0], v[1]); w.y = pk2(v[2], v[3]); xb[i] = w; }
        const f32x4* p4 = (const f32x4*)ldptr(pt, 1); u32x2* pb = (u32x2*)(ws + WS_PB);
        for (size_t i = gt; i < (size_t)2 * T_ * PLE_ / 4; i += nth) { const f32x4 v = p4[i]; u32x2 w; w.x = pk2(v[0], v[1]); w.y = pk2(v[2], v[3]); pb[i] = w; }
    }
}

__device__ __forceinline__ void ln_phase(float* X, bf16_t* XB, const float* g, const float* b, bool final_, int wave, int lane, int bid, int G) {
    const int gw = bid * 8 + wave, ngw = G * 8;
    for (int row0 = gw; row0 < T_; row0 += 4 * ngw) {
        f32x4 v[4][8];
#pragma unroll
        for (int r = 0; r < 4; ++r) { const int row = min(row0 + r * ngw, T_ - 1); const f32x4* xr = (const f32x4*)(X + (size_t)row * D_) + lane;
#pragma unroll
            for (int j = 0; j < 8; ++j) v[r][j] = xr[64 * j]; }
        float mean[4], rstd[4];
#pragma unroll
        for (int r = 0; r < 4; ++r) { float s = 0.f;
#pragma unroll
            for (int j = 0; j < 8; ++j) s += (v[r][j][0] + v[r][j][1]) + (v[r][j][2] + v[r][j][3]);
            mean[r] = s; }
#pragma unroll
        for (int o = 1; o < 64; o <<= 1) {
#pragma unroll
            for (int r = 0; r < 4; ++r) mean[r] += __shfl_xor(mean[r], o); }
#pragma unroll
        for (int r = 0; r < 4; ++r) { mean[r] *= (1.f / D_); float s2 = 0.f;
#pragma unroll
            for (int j = 0; j < 8; ++j) { v[r][j] = v[r][j] - mean[r]; s2 += (v[r][j][0] * v[r][j][0] + v[r][j][1] * v[r][j][1]) + (v[r][j][2] * v[r][j][2] + v[r][j][3] * v[r][j][3]); }
            rstd[r] = s2; }
#pragma unroll
        for (int o = 1; o < 64; o <<= 1) {
#pragma unroll
            for (int r = 0; r < 4; ++r) rstd[r] += __shfl_xor(rstd[r], o); }
#pragma unroll
        for (int r = 0; r < 4; ++r) rstd[r] = 1.f / sqrtf(rstd[r] * (1.f / D_) + LN_EPS);
#pragma unroll
        for (int j = 0; j < 8; ++j) {
            const f32x4 gg = ((const f32x4*)g)[lane + 64 * j], bb = ((const f32x4*)b)[lane + 64 * j];
#pragma unroll
            for (int r = 0; r < 4; ++r) { const int row = row0 + r * ngw;
                if (row < T_) { const f32x4 y = v[r][j] * rstd[r] * gg + bb;
                    if (final_) ((f32x4*)(X + (size_t)row * D_))[lane + 64 * j] = y;
                    else { u32x2 w; w.x = pk2(y[0], y[1]); w.y = pk2(y[2], y[3]); ((u32x2*)(XB + (size_t)row * D_))[lane + 64 * j] = w; } } }
        }
    }
}

__device__ __forceinline__ void attn_unit(LAS unsigned char* L, const bf16_t* Z, int unit, const float* sinks, bf16_t* O, float* DPO, float* DLSE, int tid, int wave, int lane) {
    int qcol, kcol, vcol, base, blk, dil, max_dist, grp = 0, hh = 0; float slope_u, sink = 0.f; bool isA;
    if (unit < 1024) {
        isA = true; blk = unit & 31; const int head = (unit >> 5) & 7, b = unit >> 8, kvh = head >> 2;
        qcol = ZQA + head * 64; kcol = ZKA + kvh * 64; vcol = ZVA + kvh * 64; base = b * SEQ_; dil = 1; max_dist = 127;
        slope_u = __builtin_amdgcn_exp2f(-8.0f * (float)(head + 1) / 20.0f); sink = sinks[head]; hh = head;
    } else {
        isA = false; const int u2 = unit - 1024; grp = u2 >> 9; const int u3 = u2 & 511;
        dil = (grp == 0) ? 1 : (grp == 1 ? 4 : 16); const int nbk = 32 / dil;
        blk = u3 % nbk; const int r = (u3 / nbk) % dil; hh = (u3 / 32) & 3; const int b = u3 >> 7;
        qcol = ZQD + grp * 256 + hh * 64; kcol = ZKD + grp * 256 + hh * 64; vcol = ZVD + grp * 256 + hh * 64; base = b * SEQ_ + r; max_dist = 128;
        slope_u = __builtin_amdgcn_exp2f(-8.0f * (float)(8 + 4 * grp + hh + 1) / 20.0f) * (float)dil;
    }
    LAS bf16_t* Qs = (LAS bf16_t*)L;
    LAS bf16_t* Ks = Qs + 128 * 72;
    LAS bf16_t* Vs = Ks + 272 * 72;
    for (int i = tid; i < 1024; i += 512) { const int r = i >> 3, c = i & 7; const size_t tok = (size_t)(base + (blk * 128 + r) * dil);
        *(LAS u32x4*)(Qs + r * 72 + c * 8) = *(const u32x4*)(Z + tok * NZ_ + qcol + c * 8); }
    {
        u32x4 kv[5], vv[5];
#pragma unroll
        for (int it = 0; it < 5; ++it) { const int i = tid + it * 512; const int r = i >> 3, c = i & 7; const int sub = blk * 128 - 128 + r; const bool ok = (i < 2176) && (r < 256) && (sub >= 0);
            kv[it] = (u32x4){0u, 0u, 0u, 0u}; vv[it] = (u32x4){0u, 0u, 0u, 0u};
            if (ok) { const size_t tok = (size_t)(base + sub * dil); kv[it] = *(const u32x4*)(Z + tok * NZ_ + kcol + c * 8); vv[it] = *(const u32x4*)(Z + tok * NZ_ + vcol + c * 8); } }
#pragma unroll
        for (int it = 0; it < 5; ++it) { const int i = tid + it * 512; const int r = i >> 3, c = i & 7;
            if (i < 2176) {
                *(LAS u32x4*)(Ks + r * 72 + c * 8) = kv[it];
                *(LAS u32x4*)(Vs + r * 72 + c * 8) = vv[it]; } }
    }
    __syncthreads();
    const int q0 = wave * 16, qi = lane & 15, g = lane >> 4;
    bf16x8 bq[2];
#pragma unroll
    for (int ks = 0; ks < 2; ++ks) bq[ks] = *(const LAS bf16x8*)(Qs + (q0 + qi) * 72 + ks * 32 + g * 8);
    f32x4 st[10];
#pragma unroll
    for (int i = 0; i < 10; ++i) { f32x4 acc = {0.f, 0.f, 0.f, 0.f};
#pragma unroll
        for (int ks = 0; ks < 2; ++ks) { const bf16x8 ak = *(const LAS bf16x8*)(Ks + ((wave + i) * 16 + qi) * 72 + ks * 32 + g * 8); acc = mfma16(ak, bq[ks], acc); }
        st[i] = acc; }
    float mx = -3.0e38f;
    const int q = q0 + qi;
#pragma unroll
    for (int i = 0; i < 10; ++i)
#pragma unroll
        for (int j = 0; j < 4; ++j) { const int kk = (wave + i) * 16 + 4 * g + j; const int dist = q + 128 - kk;
            const bool valid = (dist >= 0) && (dist <= max_dist) && (blk > 0 || kk >= 128);
            const float s = valid ? (st[i][j] * 0.125f - slope_u * (float)dist) : -1.0e30f; st[i][j] = s; mx = fmaxf(mx, s); }
    mx = fmaxf(mx, __shfl_xor(mx, 16)); mx = fmaxf(mx, __shfl_xor(mx, 32));
    if (isA) mx = fmaxf(mx, sink);
    float den = 0.f;
#pragma unroll
    for (int i = 0; i < 10; ++i)
#pragma unroll
        for (int j = 0; j < 4; ++j) { const float p = __builtin_amdgcn_exp2f((st[i][j] - mx) * LOG2E); st[i][j] = p; den += p; }
    den += __shfl_xor(den, 16); den += __shfl_xor(den, 32);
    if (isA) den += __builtin_amdgcn_exp2f((sink - mx) * LOG2E);
    f32x4 o[4];
#pragma unroll
    for (int ht = 0; ht < 4; ++ht) o[ht] = (f32x4){0.f, 0.f, 0.f, 0.f};
    const LAS bf16_t* vbase = Vs + (wave * 16 + 4 * g + (qi >> 2)) * 72 + 4 * (qi & 3);
#pragma unroll
    for (int i = 0; i < 5; ++i) {
        u32x4 pw; pw.x = pk2(st[2 * i][0], st[2 * i][1]); pw.y = pk2(st[2 * i][2], st[2 * i][3]); pw.z = pk2(st[2 * i + 1][0], st[2 * i + 1][1]); pw.w = pk2(st[2 * i + 1][2], st[2 * i + 1][3]);
        const bf16x8 bp = __builtin_bit_cast(bf16x8, pw);
#pragma unroll
        for (int ht = 0; ht < 4; ++ht) { const LAS bf16_t* vr = vbase + (2 * i * 16) * 72 + ht * 16;
            const u32x2 va = tr16(vr), vb = tr16(vr + 16 * 72);
            o[ht] = mfma16(mk8(va, vb), bp, o[ht]); } }
    const float inv = 1.0f / den;
    const size_t tok = (size_t)(base + (blk * 128 + q) * dil);
    if (isA) {
#pragma unroll
        for (int ht = 0; ht < 4; ++ht) { u32x2 w; w.x = pk2(o[ht][0] * inv, o[ht][1] * inv); w.y = pk2(o[ht][2] * inv, o[ht][3] * inv);
            *(u32x2*)(O + tok * NO_ + hh * 64 + ht * 16 + 4 * g) = w; }
    } else {
#pragma unroll
        for (int ht = 0; ht < 4; ++ht) *(f32x4*)(DPO + ((size_t)grp * T_ + tok) * 256 + hh * 64 + ht * 16 + 4 * g) = o[ht] * inv;
        if (g == 0) DLSE[((size_t)grp * T_ + tok) * 4 + hh] = mx + logf(den);
    }
    __syncthreads();
}

__device__ __forceinline__ void gmlp_unit(LAS unsigned char* L, const bf16_t* Z, int unit, const float* lng, const float* lnb, const float* ws_, const float* bs, bf16_t* O, int tid, int wave, int lane) {
    const int n = unit >> 2, grp = unit & 3, tok0 = n * 128;
    LAS float* stats = (LAS float*)L;
    LAS bf16_t* vnt = (LAS bf16_t*)(L + 1024);
    LAS bf16_t* Wc = vnt + 128 * 136;
    {
        u32x4 raw[16];
#pragma unroll
        for (int r = 0; r < 16; ++r) raw[r] = *(const u32x4*)(Z + (size_t)(tok0 + 16 * wave + r) * NZ_ + ZVB + lane * 8);
        float s[16], ss[16];
#pragma unroll
        for (int r = 0; r < 16; ++r) { const float x0 = bflo(raw[r].x), x1 = bfhi(raw[r].x), x2 = bflo(raw[r].y), x3 = bfhi(raw[r].y), x4 = bflo(raw[r].z), x5 = bfhi(raw[r].z), x6 = bflo(raw[r].w), x7 = bfhi(raw[r].w);
            s[r] = ((x0 + x1) + (x2 + x3)) + ((x4 + x5) + (x6 + x7)); ss[r] = ((x0 * x0 + x1 * x1) + (x2 * x2 + x3 * x3)) + ((x4 * x4 + x5 * x5) + (x6 * x6 + x7 * x7)); }
#pragma unroll
        for (int o = 1; o < 64; o <<= 1) {
#pragma unroll
            for (int r = 0; r < 16; ++r) { s[r] += __shfl_xor(s[r], o); ss[r] += __shfl_xor(ss[r], o); } }
        if (lane < 16) { float m = 0.f, q = 0.f;
#pragma unroll
            for (int r = 0; r < 16; ++r) if (lane == r) { m = s[r]; q = ss[r]; }
            m *= (1.f / 512.f); const float var = fmaxf(q * (1.f / 512.f) - m * m, 0.f);
            stats[(16 * wave + lane) * 2] = m; stats[(16 * wave + lane) * 2 + 1] = 1.f / sqrtf(var + LN_EPS); }
    }
#pragma unroll
    for (int it = 0; it < 8; ++it) { const int i = tid + it * 512; const int t = i >> 5, s4 = (i & 31) * 4;
        f32x4 w = *(const f32x4*)(ws_ + (size_t)(grp * 128 + t) * 128 + s4);
#pragma unroll
        for (int e = 0; e < 4; ++e) if (s4 + e > t) w[e] = 0.f;
        u32x2 p; p.x = pk2(w[0], w[1]); p.y = pk2(w[2], w[3]); *(LAS u32x2*)(Wc + t * 136 + s4) = p; }
    u32x4 vraw[4];
#pragma unroll
    for (int it = 0; it < 4; ++it) { const int i = tid + it * 512; const int s = i >> 4, c8 = (i & 15) * 8;
        vraw[it] = *(const u32x4*)(Z + (size_t)(tok0 + s) * NZ_ + ZVB + grp * 128 + c8); }
    __syncthreads();
#pragma unroll
    for (int it = 0; it < 4; ++it) { const int i = tid + it * 512; const int s = i >> 4, c8 = (i & 15) * 8;
        const u32x4 raw = vraw[it];
        const float mean = stats[s * 2], rstd = stats[s * 2 + 1];
        float x[8]; x[0] = bflo(raw.x); x[1] = bfhi(raw.x); x[2] = bflo(raw.y); x[3] = bfhi(raw.y); x[4] = bflo(raw.z); x[5] = bfhi(raw.z); x[6] = bflo(raw.w); x[7] = bfhi(raw.w);
        const f32x4 g0 = *(const f32x4*)(lng + grp * 128 + c8), g1 = *(const f32x4*)(lng + grp * 128 + c8 + 4), b0 = *(const f32x4*)(lnb + grp * 128 + c8), b1 = *(const f32x4*)(lnb + grp * 128 + c8 + 4);
        float y[8];
#pragma unroll
        for (int e = 0; e < 8; ++e) y[e] = (x[e] - mean) * rstd * (e < 4 ? g0[e & 3] : g1[e & 3]) + (e < 4 ? b0[e & 3] : b1[e & 3]);
        u32x4 w; w.x = pk2(y[0], y[1]); w.y = pk2(y[2], y[3]); w.z = pk2(y[4], y[5]); w.w = pk2(y[6], y[7]);
        *(LAS u32x4*)(vnt + s * 136 + c8) = w; }
    __syncthreads();
    const int qi = lane & 15, g = lane >> 4;
    const int t = 16 * wave + qi; const float bias = bs[grp * 128 + t];
    const size_t tok = (size_t)(tok0 + t);
    u32x2 ur[8];
#pragma unroll
    for (int ct = 0; ct < 8; ++ct) ur[ct] = *(const u32x2*)(Z + tok * NZ_ + ZUB + grp * 128 + 16 * ct + 4 * g);
    f32x4 acc[8];
#pragma unroll
    for (int ct = 0; ct < 8; ++ct) acc[ct] = (f32x4){0.f, 0.f, 0.f, 0.f};
#pragma unroll
    for (int ks = 0; ks < 4; ++ks) { const bf16x8 bw = *(const LAS bf16x8*)(Wc + (16 * wave + qi) * 136 + ks * 32 + g * 8);
#pragma unroll
        for (int ct = 0; ct < 8; ++ct) { const LAS bf16_t* vr = vnt + (ks * 32 + 8 * g + (qi >> 2)) * 136 + 16 * ct + 4 * (qi & 3);
            acc[ct] = mfma16(mk8(tr16(vr), tr16(vr + 4 * 136)), bw, acc[ct]); } }
#pragma unroll
    for (int ct = 0; ct < 8; ++ct) { const int c = 16 * ct + 4 * g;
        u32x2 w; w.x = pk2(bflo(ur[ct].x) * (acc[ct][0] + bias), bfhi(ur[ct].x) * (acc[ct][1] + bias));
        w.y = pk2(bflo(ur[ct].y) * (acc[ct][2] + bias), bfhi(ur[ct].y) * (acc[ct][3] + bias));
        *(u32x2*)(O + tok * NO_ + 512 + grp * 128 + c) = w; }
    __syncthreads();
}

__device__ __forceinline__ float hgrn_lb(const float* lbl, int layer, int c) { return layer == 0 ? 0.0f : 1.0f / (1.0f + expf(lbl[c] - lbl[512 + c])); }

__device__ __forceinline__ void hgrn_c1_unit(LAS unsigned char* L, const bf16_t* Z, int unit, const float* lbl, int layer, float* DS, float* DEC, int tid, int wave, int lane) {
    const int h = unit & 3, cg_ = unit >> 2, tok0 = cg_ * 64;
    const int k = tid & 127, qtr = tid >> 7;
    LAS float* qsum = (LAS float*)L;
    LAS bf16_t* kt = (LAS bf16_t*)(L + 2048);
    LAS bf16_t* vt = kt + 128 * 72;
    const float lb = hgrn_lb(lbl, layer, h * 128 + k);
    float G[16], kk[16]; float run = 0.f;
    unsigned vraw[16];
#pragma unroll
    for (int i = 0; i < 16; ++i) { const size_t tok = (size_t)(tok0 + 16 * qtr + i);
        const float zf = bf2f(Z[tok * NZ_ + ZFC + h * 128 + k]);
        vraw[i] = Z[tok * NZ_ + ZIC + h * 128 + k];
        const float e = fexp(-zf), sg = frcp(1.0f + e);
        const float f = lb + (1.0f - lb) * sg;
        run += logf(fmaxf(f, 1e-6f)); G[i] = run; kk[i] = (1.0f - lb) * e * sg; }
    qsum[qtr * 128 + k] = run;
    __syncthreads();
    float off = 0.f, tot = 0.f;
#pragma unroll
    for (int qq = 0; qq < 4; ++qq) { const float v = qsum[qq * 128 + k]; tot += v; if (qq < qtr) off += v; }
    unsigned kw[8], vw[8];
#pragma unroll
    for (int i = 0; i < 8; ++i) { const float a0 = kk[2 * i] * fexp(tot - (G[2 * i] + off)), a1 = kk[2 * i + 1] * fexp(tot - (G[2 * i + 1] + off));
        kw[i] = pk2(a0, a1); vw[i] = vraw[2 * i] | (vraw[2 * i + 1] << 16); }
    *(LAS u32x4*)(kt + k * 72 + 16 * qtr) = (u32x4){kw[0], kw[1], kw[2], kw[3]}; *(LAS u32x4*)(kt + k * 72 + 16 * qtr + 8) = (u32x4){kw[4], kw[5], kw[6], kw[7]};
    *(LAS u32x4*)(vt + k * 72 + 16 * qtr) = (u32x4){vw[0], vw[1], vw[2], vw[3]}; *(LAS u32x4*)(vt + k * 72 + 16 * qtr + 8) = (u32x4){vw[4], vw[5], vw[6], vw[7]};
    if (qtr == 0) DEC[(size_t)unit * 128 + k] = fexp(tot);
    __syncthreads();
    const int qi = lane & 15, g = lane >> 4;
    bf16x8 av[2];
#pragma unroll
    for (int ks = 0; ks < 2; ++ks) av[ks] = *(const LAS bf16x8*)(vt + (16 * wave + qi) * 72 + ks * 32 + g * 8);
    float* dst = DS + (size_t)unit * 16384;
#pragma unroll
    for (int ktile = 0; ktile < 8; ++ktile) { f32x4 acc = {0.f, 0.f, 0.f, 0.f};
#pragma unroll
        for (int ks = 0; ks < 2; ++ks) { const bf16x8 bk = *(const LAS bf16x8*)(kt + (16 * ktile + qi) * 72 + ks * 32 + g * 8); acc = mfma16(av[ks], bk, acc); }
#pragma unroll
        for (int j = 0; j < 4; ++j) dst[(16 * wave + 4 * g + j) * 128 + 16 * ktile + qi] = acc[j]; }
    __syncthreads();
}

__device__ __forceinline__ void hgrn_scan_phase(const float* DS, const float* DEC, bf16_t* HS, int tid, int bid, int G) {
    const int nth = G * 512;
    for (int p = bid * 512 + tid; p < 16 * 8192; p += nth) {
        const int bh = p >> 13, idx = (p & 8191) * 2, k = idx & 127, b = bh >> 2, h = bh & 3;
        f32x2 S = {0.f, 0.f};
#pragma unroll 16
        for (int c = 0; c < 64; ++c) { const size_t u = (size_t)(((b * 64 + c) << 2) | h);
            *(unsigned*)(HS + u * 16384 + idx) = pk2(S[0], S[1]);
            const f32x2 d = *(const f32x2*)(DEC + u * 128 + k), ds = *(const f32x2*)(DS + u * 16384 + idx);
            S = d * S + ds; }
    }
}

__device__ __forceinline__ void hgrn_c3_unit(LAS unsigned char* L, const bf16_t* Z, int unit, const float* lbl, int layer, const bf16_t* HS, const float* ng, bf16_t* O, int tid, int wave, int lane) {
    const int h = unit & 3, cg_ = unit >> 2, tok0 = cg_ * 64;
    const int k = tid & 127, qtr = tid >> 7;
    LAS float* qsum = (LAS float*)L;
    LAS bf16_t* kT = (LAS bf16_t*)(L + 2048);
    LAS bf16_t* qT = kT + 128 * 72;
    LAS bf16_t* qC = qT + 128 * 72;
    LAS bf16_t* vt = qC + 128 * 72;
    LAS float* oL = (LAS float*)(L + 2048 + 4 * 128 * 72 * 2);
    const float lb = hgrn_lb(lbl, layer, h * 128 + k);
    float G[16], kk[16], qv[16]; float run = 0.f;
    unsigned vraw[16];
#pragma unroll
    for (int i = 0; i < 16; ++i) { const size_t tok = (size_t)(tok0 + 16 * qtr + i);
        const float zf = bf2f(Z[tok * NZ_ + ZFC + h * 128 + k]);
        qv[i] = bf2f(Z[tok * NZ_ + ZQC + h * 128 + k]);
        vraw[i] = Z[tok * NZ_ + ZIC + h * 128 + k];
        const float e = fexp(-zf), sg = frcp(1.0f + e);
        const float f = lb + (1.0f - lb) * sg;
        run += logf(fmaxf(f, 1e-6f)); G[i] = run; kk[i] = (1.0f - lb) * e * sg; }
    qsum[qtr * 128 + k] = run;
    __syncthreads();
    float off = 0.f;
#pragma unroll
    for (int qq = 0; qq < 4; ++qq) { const float v = qsum[qq * 128 + k]; if (qq < qtr) off += v; }
    const float Gm = qsum[k] + qsum[128 + k];
    {
        unsigned kw[8], qw[8], cw[8];
#pragma unroll
        for (int i = 0; i < 8; ++i) { float a[2], b[2], c[2];
#pragma unroll
            for (int e = 0; e < 2; ++e) { const float Gi = G[2 * i + e] + off; const float d = fminf(fmaxf(Gi - Gm, -80.f), 80.f);
                a[e] = kk[2 * i + e] * fexp(-d); b[e] = qv[2 * i + e] * fexp(d); c[e] = qv[2 * i + e] * fexp(Gi); }
            kw[i] = pk2(a[0], a[1]); qw[i] = pk2(b[0], b[1]); cw[i] = pk2(c[0], c[1]); }
        *(LAS u32x4*)(kT + k * 72 + 16 * qtr) = (u32x4){kw[0], kw[1], kw[2], kw[3]}; *(LAS u32x4*)(kT + k * 72 + 16 * qtr + 8) = (u32x4){kw[4], kw[5], kw[6], kw[7]};
        *(LAS u32x4*)(qT + k * 72 + 16 * qtr) = (u32x4){qw[0], qw[1], qw[2], qw[3]}; *(LAS u32x4*)(qT + k * 72 + 16 * qtr + 8) = (u32x4){qw[4], qw[5], qw[6], qw[7]};
        *(LAS u32x4*)(qC + k * 72 + 16 * qtr) = (u32x4){cw[0], cw[1], cw[2], cw[3]}; *(LAS u32x4*)(qC + k * 72 + 16 * qtr + 8) = (u32x4){cw[4], cw[5], cw[6], cw[7]};
    }
    {
        unsigned vw[8];
#pragma unroll
        for (int i = 0; i < 8; ++i) vw[i] = vraw[2 * i] | (vraw[2 * i + 1] << 16);
        *(LAS u32x4*)(vt + k * 72 + 16 * qtr) = (u32x4){vw[0], vw[1], vw[2], vw[3]}; *(LAS u32x4*)(vt + k * 72 + 16 * qtr + 8) = (u32x4){vw[4], vw[5], vw[6], vw[7]};
    }
    __syncthreads();
    const int qi = lane & 15, g = lane >> 4, tt = wave & 3, vh = wave >> 2;
    const bf16_t* hs = HS + (size_t)unit * 16384;
    bf16x8 ahs[4][4];
#pragma unroll
    for (int ks = 0; ks < 4; ++ks)
#pragma unroll
        for (int v_ = 0; v_ < 4; ++v_) ahs[ks][v_] = *(const bf16x8*)(hs + (16 * (4 * vh + v_) + qi) * 128 + ks * 32 + g * 8);
    unsigned graw[8][2];
#pragma unroll
    for (int r = 0; r < 8; ++r) { const size_t tok = (size_t)(tok0 + 8 * wave + r); graw[r][0] = Z[tok * NZ_ + ZGC + h * 128 + lane]; graw[r][1] = Z[tok * NZ_ + ZGC + h * 128 + 64 + lane]; }
    f32x4 sc[4];
#pragma unroll
    for (int st = 0; st < 4; ++st) { sc[st] = (f32x4){0.f, 0.f, 0.f, 0.f};
        if (st <= tt) {
#pragma unroll
            for (int ks = 0; ks < 4; ++ks) { const int ro = (ks * 32 + 8 * g + (qi >> 2)) * 72 + 4 * (qi & 3);
                const bf16x8 a = mk8(tr16(kT + ro + 16 * st), tr16(kT + ro + 4 * 72 + 16 * st)), b = mk8(tr16(qT + ro + 16 * tt), tr16(qT + ro + 4 * 72 + 16 * tt));
                sc[st] = mfma16(a, b, sc[st]); }
#pragma unroll
            for (int j = 0; j < 4; ++j) if (16 * st + 4 * g + j > 16 * tt + qi) sc[st][j] = 0.f;
        } }
    f32x4 o[4];
#pragma unroll
    for (int v_ = 0; v_ < 4; ++v_) o[v_] = (f32x4){0.f, 0.f, 0.f, 0.f};
#pragma unroll
    for (int i = 0; i < 2; ++i) {
        u32x4 pw; pw.x = pk2(sc[2 * i][0], sc[2 * i][1]); pw.y = pk2(sc[2 * i][2], sc[2 * i][3]); pw.z = pk2(sc[2 * i + 1][0], sc[2 * i + 1][1]); pw.w = pk2(sc[2 * i + 1][2], sc[2 * i + 1][3]);
        const bf16x8 bp = __builtin_bit_cast(bf16x8, pw);
#pragma unroll
        for (int v_ = 0; v_ < 4; ++v_) { const LAS bf16_t* vr = vt + (16 * (4 * vh + v_) + qi) * 72 + 4 * g;
            const u32x2 va = *(const LAS u32x2*)(vr + (2 * i) * 16), vb = *(const LAS u32x2*)(vr + (2 * i + 1) * 16);
            o[v_] = mfma16(mk8(va, vb), bp, o[v_]); } }
#pragma unroll
    for (int ks = 0; ks < 4; ++ks) { const int ro = (ks * 32 + 8 * g + (qi >> 2)) * 72 + 4 * (qi & 3) + 16 * tt; const bf16x8 b = mk8(tr16(qC + ro), tr16(qC + ro + 4 * 72));
#pragma unroll
        for (int v_ = 0; v_ < 4; ++v_) o[v_] = mfma16(ahs[ks][v_], b, o[v_]); }
#pragma unroll
    for (int v_ = 0; v_ < 4; ++v_) *(LAS f32x4*)(oL + (16 * tt + qi) * 132 + 16 * (4 * vh + v_) + 4 * g) = o[v_];
    __syncthreads();
    const float ng0 = ng[h * 128 + lane], ng1 = ng[h * 128 + 64 + lane];
#pragma unroll
    for (int r = 0; r < 8; ++r) { const int t = 8 * wave + r;
        const float x0 = oL[t * 132 + lane], x1 = oL[t * 132 + 64 + lane];
        const float ss = wave_sum(x0 * x0 + x1 * x1);
        const float rs = 1.0f / sqrtf(ss * (1.f / 128.f) + LN_EPS);
        const size_t tok = (size_t)(tok0 + t);
        const float g0 = bf2f(graw[r][0]), g1 = bf2f(graw[r][1]);
        const float y0 = x0 * rs * ng0 * fsigmoid(g0), y1 = x1 * rs * ng1 * fsigmoid(g1);
        O[tok * NO_ + 1024 + h * 128 + lane] = (bf16_t)(pk2(y0, 0.f) & 0xffffu);
        O[tok * NO_ + 1024 + h * 128 + 64 + lane] = (bf16_t)(pk2(y1, 0.f) & 0xffffu); }
    __syncthreads();
}

__device__ __forceinline__ void dcomb_phase(const float* DPO, const float* DLSE, bf16_t* O, int tid, int bid, int G) {
    const int nth = G * 512;
#pragma unroll 4
    for (int i = bid * 512 + tid; i < T_ * 64; i += nth) { const int t = i >> 6, c4 = (i & 63) * 4, h = c4 >> 6;
        const float l0 = DLSE[((size_t)0 * T_ + t) * 4 + h], l1 = DLSE[((size_t)1 * T_ + t) * 4 + h], l2 = DLSE[((size_t)2 * T_ + t) * 4 + h];
        const float m = fmaxf(l0, fmaxf(l1, l2));
        float w0 = fexp(l0 - m), w1 = fexp(l1 - m), w2 = fexp(l2 - m); const float inv = 1.0f / (w0 + w1 + w2); w0 *= inv; w1 *= inv; w2 *= inv;
        const f32x4 a = *(const f32x4*)(DPO + ((size_t)0 * T_ + t) * 256 + c4), b = *(const f32x4*)(DPO + ((size_t)1 * T_ + t) * 256 + c4), c = *(const f32x4*)(DPO + ((size_t)2 * T_ + t) * 256 + c4);
        const f32x4 r = w0 * a + w1 * b + w2 * c;
        u32x2 w; w.x = pk2(r[0], r[1]); w.y = pk2(r[2], r[3]);
        *(u32x2*)(O + (size_t)t * NO_ + 1536 + c4) = w; }
}

constexpr int NPH_LAYER = 14, NPH = 2 * NPH_LAYER;
__global__ void __launch_bounds__(512, 2) hybrid_fwd(Args a) {
    extern __shared__ __attribute__((aligned(16))) unsigned char lds_raw[];
    LAS unsigned char* lds = (LAS unsigned char*)lds_raw;
    PTab pt = (PTab)(lds + 131072);
    if (threadIdx.x == 0) {
#pragma unroll
        for (int i = 0; i < 22; ++i) pt[i] = (unsigned long long)a.in[i];
        pt[22] = (unsigned long long)a.out; pt[23] = (unsigned long long)a.ws;
    }
    if (threadIdx.x < 8) ((LAS unsigned*)(lds + 131072 + 512))[threadIdx.x] = 0u;
    __syncthreads();
    const int ph_lo = a.ph_lo, ph_hi = a.ph_hi;
    XcdBarrier bar = xcd_barrier_post((unsigned*)(a.ws + WS_CTL + WS_BAR), (volatile LAS unsigned*)(lds + 131072 + 512));
    for (int ph = ph_lo; ph < ph_hi; ++ph) {
        const int l = ph / NPH_LAYER, p = ph - l * NPH_LAYER;
        pg8::StaticOrder S;
        int tid = threadIdx.x; asm volatile("" : "+v"(tid));
        int bid = blockIdx.x, G = gridDim.x; asm volatile("" : "+s"(bid), "+s"(G));
        const int lane = tid & 63, wave = __builtin_amdgcn_readfirstlane(tid >> 6);
        unsigned char* ws = (unsigned char*)ldptr(pt, 23);
#define P_X ((float*)ldptr(pt, 22))
#define P_XB ((bf16_t*)(ws + WS_XB))
#define P_ZH ((bf16_t*)(ws + WS_ZH))
#define P_GATE ((bf16_t*)(ws + WS_GATE))
#define P_O ((bf16_t*)(ws + WS_O))
#define P_DS ((float*)(ws + WS_DS))
#define P_DEC ((float*)(ws + WS_CTL))
#define P_HS ((bf16_t*)(ws + WS_HS))
#define P_DPO ((float*)(ws + WS_DPO))
#define P_DLSE ((float*)(ws + WS_DLSE))
        switch (p) {
        case 0: if (l == 0) convert_phase(pt, 0, lds, tid, wave, lane, bid, G); break;
        case 1: case 11: {
            const int s = (p == 1) ? 0 : 1; const int n_ = (p == 1) ? 2 * FF_ : 2 * FF_ + D_;
            pg8::Gemm g{P_XB, (const bf16_t*)(ws + WS_WGU + (size_t)s * 44 * MiB), T_, n_, D_}; S.init(T_, n_, G, bid);
            pg8::EpiSwiGLU E{P_ZH, P_GATE}; pg8::gemm_phase(lds, g, S, E);
        } break;
        case 2: {
            pg8::Gemm g{P_ZH, (const bf16_t*)(ws + WS_WD), T_, D_, FF_}; S.init(T_, D_, G, bid);
            pg8::EpiResidT<false> E{P_X, P_XB, nullptr, ALPHA, 0.5f}; pg8::gemm_phase<pg8::EpiResidT<false>, true>(lds, g, S, E);
        } break;
        case 3: case 10: case 13: {
            const int which = (p == 3) ? 0 : (p == 10 ? 1 : 2);
            ln_phase(P_X, P_XB, ldptr(pt, 2) + (size_t)(l * 3 + which) * D_, ldptr(pt, 3) + (size_t)(l * 3 + which) * D_, (l == 1 && p == 13), wave, lane, bid, G);
            if (p == 13 && l == 0) convert_phase(pt, 1, lds, tid, wave, lane, bid, G);
            if (p == 10) { int kp = PLE_; asm volatile("" : "+s"(kp)); pg8::Gemm g2{(const bf16_t*)(ws + WS_PB) + (size_t)l * T_ * PLE_, (const bf16_t*)(ws + WS_WPP), T_, D_, kp}; S.init(T_, D_, G, bid);
                pg8::EpiBf16 E2{P_GATE, D_}; pg8::gemm_phase(lds, g2, S, E2); }
        } break;
        case 4: {
            pg8::Gemm g{P_XB, (const bf16_t*)(ws + WS_WIN), T_, NIN_, D_}; S.init(T_, NIN_, G, bid);
            pg8::EpiZ E{P_ZH, P_GATE}; pg8::gemm_phase(lds, g, S, E);
        } break;
        case 5: {
            for (int u = bid; u < 2560; u += G) attn_unit(lds, P_ZH, u, ldptr(pt, 8) + l * 8, P_O, P_DPO, P_DLSE, tid, wave, lane);
            for (int u = bid; u < 512; u += G) gmlp_unit(lds, P_ZH, u, ldptr(pt, 9) + l * 512, ldptr(pt, 10) + l * 512, ldptr(pt, 11) + (size_t)l * 65536, ldptr(pt, 12) + l * 512, P_O, tid, wave, lane);
            for (int u = bid; u < 1024; u += G) hgrn_c1_unit(lds, P_ZH, u, ldptr(pt, 13), l, P_DS, P_DEC, tid, wave, lane);
        } break;
        case 6: hgrn_scan_phase(P_DS, P_DEC, P_HS, tid, bid, G); break;
        case 7: {
            for (int u = bid; u < 1024; u += G) hgrn_c3_unit(lds, P_ZH, u, ldptr(pt, 13), l, P_HS, ldptr(pt, 14) + l * 512, P_O, tid, wave, lane);
            dcomb_phase(P_DPO, P_DLSE, P_O, tid, bid, G);
        } break;
        case 8: {
            pg8::Gemm g{P_O, (const bf16_t*)(ws + WS_WBR), T_, D_, NO_}; S.init(T_, D_, G, bid);
            pg8::EpiBR E{P_ZH, P_GATE}; pg8::gemm_phase(lds, g, S, E);
        } break;
        case 9: {
            pg8::Gemm g{P_ZH, (const bf16_t*)(ws + WS_WOUT), T_, D_, D_}; S.init(T_, D_, G, bid);
            pg8::EpiResidT<false> E{P_X, P_XB, nullptr, ALPHA, 1.0f}; pg8::gemm_phase(lds, g, S, E);
        } break;
        case 12: {
            pg8::Gemm g{P_ZH, (const bf16_t*)(ws + WS_WD + (size_t)22 * MiB), T_, D_, FF_}; S.init(T_, D_, G, bid);
            pg8::EpiResidT<true> E{P_X, P_XB, P_GATE, ALPHA, 0.5f}; pg8::gemm_phase<pg8::EpiResidT<true>, true>(lds, g, S, E);
        } break;
        default: break;
        }
        if (ph + 1 < ph_hi) { if (ph_hi > 1000) { __threadfence(); cg::this_grid().sync(); } else xcd_barrier(bar); }
    }
}

extern "C" void kernel_launch(void* const* d_in, const int* in_sizes, int n_in, void* d_out, int out_size, void* d_ws, size_t ws_size, hipStream_t stream) {
    static int grid = 0;
    if (grid == 0) {
        if (n_in != 22 || out_size != T_ * D_ || ws_size < WS_END) { fprintf(stderr, "kernel_launch: unexpected shapes (n_in %d out %d ws %zu need %zu)\n", n_in, out_size, ws_size, (size_t)WS_END); grid = -1; return; }
        int dev = 0, cus = 0, per_cu = 0;
        hipGetDevice(&dev); hipDeviceGetAttribute(&cus, hipDeviceAttributeMultiprocessorCount, dev);
        if (hipFuncSetAttribute((const void*)hybrid_fwd, hipFuncAttributeMaxDynamicSharedMemorySize, LDS_BYTES) != hipSuccess) { fprintf(stderr, "kernel_launch: hipFuncSetAttribute failed\n"); grid = -1; return; }
        hipOccupancyMaxActiveBlocksPerMultiprocessor(&per_cu, (const void*)hybrid_fwd, 512, LDS_BYTES);
        (void)hipGetLastError();
        if (per_cu < 1) per_cu = 1;
        grid = cus * 1;
    }
    if (grid < 0) return;
    if (hipMemsetAsync((char*)d_ws + WS_CTL + WS_BAR, 0, BAR_BYTES, stream) != hipSuccess) { fprintf(stderr, "kernel_launch: memset failed\n"); return; }
    Args a{};
    for (int i = 0; i < 22; ++i) a.in[i] = (const float*)d_in[i];
    a.out = (float*)d_out; a.ws = (unsigned char*)d_ws; a.ph_lo = 0; a.ph_hi = NPH;
    void* args[] = {&a};
    hipError_t e = hipLaunchCooperativeKernel((const void*)hybrid_fwd, dim3(grid), dim3(512), args, LDS_BYTES, stream);
    if (e != hipSuccess) fprintf(stderr, "cooperative launch failed: %s (grid %d)\n", hipGetErrorString(e), grid);
}
```

```cpp
#include <hip/hip_runtime.h>
#include <hip/hip_cooperative_groups.h>
#include <cstdio>
#include <cstdint>
namespace cg = cooperative_groups;

#define LAS __attribute__((address_space(3)))
typedef unsigned short bf16_t;
typedef short bf16x8 __attribute__((ext_vector_type(8)));
typedef float f32x4 __attribute__((ext_vector_type(4)));
typedef float f32x2 __attribute__((ext_vector_type(2)));
typedef unsigned u32x4 __attribute__((ext_vector_type(4)));
typedef unsigned u32x2 __attribute__((ext_vector_type(2)));

constexpr int T_ = 16384, SEQ_ = 4096, D_ = 2048, FF_ = 5632, NIN_ = 14336, NZ_ = 6144, NGT_ = 8192, NO_ = 1792, PLE_ = 256;
constexpr int ZQA = 0, ZKA = 512, ZVA = 640, ZUB = 768, ZVB = 1280, ZQC = 1792, ZFC = 2304, ZIC = 2816, ZGC = 3328, ZQD = 3840, ZKD = 4608, ZVD = 5376;
constexpr float LN_EPS = 1e-5f;
constexpr float ALPHA = 1.41421356237f;
constexpr float LOG2E = 1.44269504089f;

constexpr size_t MiB = 1u << 20;
constexpr size_t WS_CTL = 0;
constexpr size_t WS_BAR = 768 * 1024, BAR_BYTES = 16384;
constexpr size_t WS_WGU = 1 * MiB;
constexpr size_t WS_WPG = WS_WGU + 88 * MiB;
constexpr size_t WS_WD = WS_WPG + 8 * MiB;
constexpr size_t WS_WIN = WS_WD + 44 * MiB;
constexpr size_t WS_WBR = WS_WIN + 56 * MiB;
constexpr size_t WS_WOUT = WS_WBR + 7 * MiB;
constexpr size_t WS_WPP = WS_WOUT + 8 * MiB;
constexpr size_t WS_PB = WS_WPP + 1 * MiB;
constexpr size_t WS_XB = WS_PB + 16 * MiB;
constexpr size_t WS_ZH = WS_XB + 64 * MiB;
constexpr size_t WS_GATE = WS_ZH + 192 * MiB;
constexpr size_t WS_O = WS_GATE + 256 * MiB;
constexpr size_t WS_HS = WS_O + 56 * MiB;
constexpr size_t WS_DPO = WS_HS + 32 * MiB;
constexpr size_t WS_DLSE = WS_DPO + 48 * MiB;
constexpr size_t WS_DS = WS_DLSE + 1 * MiB;
constexpr size_t WS_END = WS_DS + 64 * MiB;

constexpr int LDS_BYTES = 147456;

__device__ __forceinline__ float bf2f(unsigned b) { return __uint_as_float(b << 16); }
__device__ __forceinline__ float bflo(unsigned w) { return __uint_as_float(w << 16); }
__device__ __forceinline__ float bfhi(unsigned w) { return __uint_as_float(w & 0xffff0000u); }
__device__ __forceinline__ unsigned pk2(float lo, float hi) { unsigned r; asm("v_cvt_pk_bf16_f32 %0, %1, %2" : "=v"(r) : "v"(lo), "v"(hi)); return r; }
__device__ __forceinline__ float fexp(float x) { return __builtin_amdgcn_exp2f(x * LOG2E); }
__device__ __forceinline__ float frcp(float x) { return __builtin_amdgcn_rcpf(x); }
__device__ __forceinline__ float fsigmoid(float x) { return frcp(1.0f + fexp(-x)); }
__device__ __forceinline__ float gelu_erf(float x) { return 0.5f * x * (1.0f + erff(x * 0.70710678118f)); }
__device__ __forceinline__ float gelu_fast(float v) {
    const float av = fabsf(v), t = frcp(av * 0.2316418882f + 1.0f);
    float q = t * 0.5307027145f + (-0.7265760135f); q = q * t + 0.7107068705f; q = q * t + (-0.142248368f); q = q * t + 0.127414796f; q = q * t;
    const float e = __builtin_amdgcn_exp2f((v * v) * (-0.72134752044f));
    const float m = v * (q * e);
    return v < 0.f ? m : v - m;
}
__device__ __forceinline__ float wave_sum(float v) {
#pragma unroll
    for (int o = 1; o < 64; o <<= 1) v += __shfl_xor(v, o);
    return v;
}
__device__ __forceinline__ f32x4 mfma16(bf16x8 a, bf16x8 b, f32x4 c) { return __builtin_amdgcn_mfma_f32_16x16x32_bf16(a, b, c, 0, 0, 0); }
typedef short s16x4 __attribute__((ext_vector_type(4)));
__device__ __forceinline__ u32x2 tr16(const LAS bf16_t* p) { const s16x4 r = __builtin_amdgcn_ds_read_tr16_b64_v4i16((LAS s16x4*)p); return __builtin_bit_cast(u32x2, r); }
__device__ __forceinline__ bf16x8 mk8(u32x2 a, u32x2 b) { u32x4 t = {a.x, a.y, b.x, b.y}; return __builtin_bit_cast(bf16x8, t); }

namespace pg8 {
constexpr int BM = 256, BK = 64, HALF = 128, HTB = HALF * BK * 2, STAGE_BYTES = 8 * HTB, NXCD = 8, WGM = 8;
__device__ __forceinline__ int lds_byte(int r, int c) { const int st = (r >> 4) * 2 + (c >> 5), rr = r & 15, cc = c & 31, ob = rr * 64 + cc * 2; return st * 1024 + (ob ^ (((ob >> 9) & 1) << 5)); }
__device__ __forceinline__ void stage_rc(int b, int& R, int& C) { const int st = b / 1024, sb = b % 1024, swz = sb ^ (((sb >> 9) & 1) << 5); R = (st >> 1) * 16 + swz / 64; C = (st & 1) * 32 + (swz % 64) / 2; }
__device__ __forceinline__ int perm32(int rho) { const int n = rho >> 4, i = rho & 15; return 8 * (i >> 2) + 4 * n + (i & 3); }
struct Unit { int pm, pn; };
struct Gemm { const bf16_t* A; const bf16_t* Bt; int M, N, K; };
struct StaticOrder {
    int nM, nN, nwg, G, c;
    __device__ void init(int M, int N, int G_, int c_) { nM = M / BM; nN = N / BM; nwg = nM * nN; G = G_; c = c_; }
    __device__ bool next(int i, Unit& u) const {
        const long L = (long)i * G + c; if (L >= nwg) return false;
        int wgid = (int)L; { const int q = nwg / NXCD, r = nwg % NXCD, xcd = wgid % NXCD, off = wgid / NXCD; wgid = (xcd < r ? xcd * (q + 1) : r * (q + 1) + (xcd - r) * q) + off; }
        const int nig = WGM * nN, gid = wgid / nig, fm = gid * WGM, gsz = (nM - fm) < WGM ? (nM - fm) : WGM;
        u.pm = fm + ((wgid % nig) % gsz); u.pn = (wgid % nig) / gsz; return true;
    }
};

struct EpiSwiGLU {
    static constexpr bool PERM = true, HAS_MID = false;
    bf16_t* H; bf16_t* PP;
    __device__ __forceinline__ void mid(int, f32x4 (&)[2][2][4][2], const Unit&, int, int, int, int) const {}
    __device__ __forceinline__ void operator()(const f32x4 (&acc)[2][2][4][2], const Unit& u, int wr, int wc, int fr, int fq) const {
        const int row0 = u.pm * BM + wr * 64 + fr;
        if (u.pn < 44) {
            const int col0 = u.pn * 128 + wc * 32 + 8 * fq;
#pragma unroll
            for (int ai = 0; ai < 2; ++ai)
#pragma unroll
                for (int m = 0; m < 4; ++m) {
                    bf16_t* rowp = H + (size_t)(row0 + ai * HALF + m * 16) * FF_ + col0;
                    float h[8];
#pragma unroll
                    for (int n = 0; n < 2; ++n)
#pragma unroll
                        for (int j = 0; j < 4; ++j) { const float g = acc[ai][0][m][n][j], up = acc[ai][1][m][n][j]; h[n * 4 + j] = g * fsigmoid(g) * up; }
                    u32x4 w; w.x = pk2(h[0], h[1]); w.y = pk2(h[2], h[3]); w.z = pk2(h[4], h[5]); w.w = pk2(h[6], h[7]);
                    *(u32x4*)rowp = w;
                    asm volatile("" ::: "memory"); __builtin_amdgcn_sched_barrier(0);
                }
        } else {
            const int col0 = (u.pn - 44) * BM + wc * 32 + 8 * fq;
#pragma unroll
            for (int am = 0; am < 4; ++am) { const int ai = am >> 1, mb = (am & 1) * 2;
                u32x4 pv[2][2];
#pragma unroll
                for (int mm = 0; mm < 2; ++mm)
#pragma unroll
                    for (int bj = 0; bj < 2; ++bj) pv[mm][bj] = *(const u32x4*)(PP + (size_t)(row0 + ai * HALF + (mb + mm) * 16) * D_ + col0 + bj * HALF);
#pragma unroll
                for (int mm = 0; mm < 2; ++mm) { const int m = mb + mm;
                    bf16_t* rowp = PP + (size_t)(row0 + ai * HALF + m * 16) * D_ + col0;
#pragma unroll
                    for (int bj = 0; bj < 2; ++bj) {
                        const u32x4 p = pv[mm][bj];
                        const f32x4 a0 = acc[ai][bj][m][0], a1 = acc[ai][bj][m][1];
                        u32x4 w;
                        w.x = pk2(fsigmoid(a0[0]) * bflo(p.x), fsigmoid(a0[1]) * bfhi(p.x)); w.y = pk2(fsigmoid(a0[2]) * bflo(p.y), fsigmoid(a0[3]) * bfhi(p.y));
                        w.z = pk2(fsigmoid(a1[0]) * bflo(p.z), fsigmoid(a1[1]) * bfhi(p.z)); w.w = pk2(fsigmoid(a1[2]) * bflo(p.w), fsigmoid(a1[3]) * bfhi(p.w));
                        *(u32x4*)(rowp + bj * HALF) = w;
                    }
                }
                asm volatile("" ::: "memory"); __builtin_amdgcn_sched_barrier(0);
            }
        }
    }
};
template <bool ADD> struct EpiResidT {
    static constexpr bool PERM = false, HAS_MID = false;
    float* Y; const bf16_t* XB; const bf16_t* PP; float a, b;
    __device__ __forceinline__ void mid(int, f32x4 (&)[2][2][4][2], const Unit&, int, int, int, int) const {}
    __device__ __forceinline__ void operator()(const f32x4 (&acc)[2][2][4][2], const Unit& u, int wr, int wc, int fr, int fq) const {
        const int row0 = u.pm * BM + wr * 64 + fr, col0 = u.pn * BM + wc * 32 + 4 * fq;
        constexpr int GM = ADD ? 2 : 4;
#pragma unroll
        for (int ai = 0; ai < 2; ++ai)
#pragma unroll
            for (int m0 = 0; m0 < 4; m0 += GM) {
                u32x2 xb[GM][2][2], pp[GM][2][2];
#pragma unroll
                for (int mm = 0; mm < GM; ++mm) { const size_t off = (size_t)(row0 + ai * HALF + (m0 + mm) * 16) * D_ + col0;
#pragma unroll
                    for (int bj = 0; bj < 2; ++bj)
#pragma unroll
                        for (int n = 0; n < 2; ++n) { xb[mm][bj][n] = *(const u32x2*)(XB + off + bj * HALF + n * 16); if (ADD) pp[mm][bj][n] = *(const u32x2*)(PP + off + bj * HALF + n * 16); } }
#pragma unroll
                for (int mm = 0; mm < GM; ++mm) { const int m = m0 + mm; const size_t off = (size_t)(row0 + ai * HALF + m * 16) * D_ + col0;
#pragma unroll
                    for (int bj = 0; bj < 2; ++bj)
#pragma unroll
                        for (int n = 0; n < 2; ++n) { const u32x2 x = xb[mm][bj][n]; const f32x4 s = acc[ai][bj][m][n];
                            f32x4 y; y[0] = a * bflo(x.x) + b * s[0]; y[1] = a * bfhi(x.x) + b * s[1]; y[2] = a * bflo(x.y) + b * s[2]; y[3] = a * bfhi(x.y) + b * s[3];
                            if (ADD) { const u32x2 q = pp[mm][bj][n]; y[0] += bflo(q.x); y[1] += bfhi(q.x); y[2] += bflo(q.y); y[3] += bfhi(q.y); }
                            *(f32x4*)(Y + off + bj * HALF + n * 16) = y; } }
                asm volatile("" ::: "memory"); __builtin_amdgcn_sched_barrier(0);
            }
    }
};
struct EpiZ {
    static constexpr bool PERM = true, HAS_MID = false;
    bf16_t* Z; bf16_t* GATE;
    __device__ __forceinline__ void mid(int, f32x4 (&)[2][2][4][2], const Unit&, int, int, int, int) const {}
    __device__ __forceinline__ void operator()(const f32x4 (&acc)[2][2][4][2], const Unit& u, int wr, int wc, int fr, int fq) const {
        const int row0 = u.pm * BM + wr * 64 + fr;
        if (u.pn < 24) {
            const bool isgelu = (u.pn >= 3) && (u.pn <= 6);
            const int col0 = u.pn * BM + wc * 32 + 8 * fq;
#pragma unroll
            for (int ai = 0; ai < 2; ++ai)
#pragma unroll
                for (int m = 0; m < 4; ++m) {
                    bf16_t* rowp = Z + (size_t)(row0 + ai * HALF + m * 16) * NZ_ + col0;
#pragma unroll
                    for (int bj = 0; bj < 2; ++bj) {
                        f32x4 v0 = acc[ai][bj][m][0], v1 = acc[ai][bj][m][1];
                        if (isgelu) {
#pragma unroll
                            for (int j = 0; j < 4; ++j) { v0[j] = gelu_fast(v0[j]); v1[j] = gelu_fast(v1[j]); }
                        }
                        u32x4 w; w.x = pk2(v0[0], v0[1]); w.y = pk2(v0[2], v0[3]); w.z = pk2(v1[0], v1[1]); w.w = pk2(v1[2], v1[3]);
                        *(u32x4*)(rowp + bj * HALF) = w;
                    }
                    asm volatile("" ::: "memory"); __builtin_amdgcn_sched_barrier(0);
                }
        } else {
            const int mc0 = (u.pn - 24) * 64 + wc * 16 + 4 * fq;
#pragma unroll
            for (int ai = 0; ai < 2; ++ai)
#pragma unroll
                for (int m = 0; m < 4; ++m) {
                    bf16_t* rowp = GATE + (size_t)(row0 + ai * HALF + m * 16) * D_ + mc0;
                    f32x4 e[4];
#pragma unroll
                    for (int br = 0; br < 4; ++br)
#pragma unroll
                        for (int j = 0; j < 4; ++j) e[br][j] = fminf(1.0f + fexp(-acc[ai][br >> 1][m][br & 1][j]), 1e30f);
                    f32x4 i0, i1, i2, i3;
#pragma unroll
                    for (int j = 0; j < 4; ++j) { i0[j] = frcp(e[0][j]); i1[j] = frcp(e[1][j]); i2[j] = frcp(e[2][j]); i3[j] = frcp(e[3][j]); }
                    const f32x4 r0 = e[1] * i0, r1 = e[2] * i1, r2 = e[3] * i2;
                    u32x2 w;
                    w.x = pk2(r0[0], r0[1]); w.y = pk2(r0[2], r0[3]); *(u32x2*)(rowp) = w;
                    w.x = pk2(r1[0], r1[1]); w.y = pk2(r1[2], r1[3]); *(u32x2*)(rowp + (size_t)T_ * D_) = w;
                    w.x = pk2(r2[0], r2[1]); w.y = pk2(r2[2], r2[3]); *(u32x2*)(rowp + (size_t)2 * T_ * D_) = w;
                    w.x = pk2(i3[0], i3[1]); w.y = pk2(i3[2], i3[3]); *(u32x2*)(rowp + (size_t)3 * T_ * D_) = w;
                    asm volatile("" ::: "memory"); __builtin_amdgcn_sched_barrier(0);
                }
        }
    }
};
struct EpiBf16 {
    static constexpr bool PERM = true, HAS_MID = false;
    bf16_t* O; int ldc;
    __device__ __forceinline__ void mid(int, f32x4 (&)[2][2][4][2], const Unit&, int, int, int, int) const {}
    __device__ __forceinline__ void operator()(const f32x4 (&acc)[2][2][4][2], const Unit& u, int wr, int wc, int fr, int fq) const {
        const int row0 = u.pm * BM + wr * 64 + fr, col0 = u.pn * BM + wc * 32 + 8 * fq;
#pragma unroll
        for (int ai = 0; ai < 2; ++ai)
#pragma unroll
            for (int m = 0; m < 4; ++m) {
                bf16_t* rowp = O + (size_t)(row0 + ai * HALF + m * 16) * ldc + col0;
#pragma unroll
                for (int bj = 0; bj < 2; ++bj) {
                    const f32x4 v0 = acc[ai][bj][m][0], v1 = acc[ai][bj][m][1];
                    u32x4 w; w.x = pk2(v0[0], v0[1]); w.y = pk2(v0[2], v0[3]); w.z = pk2(v1[0], v1[1]); w.w = pk2(v1[2], v1[3]);
                    *(u32x4*)(rowp + bj * HALF) = w;
                }
                asm volatile("" ::: "memory"); __builtin_amdgcn_sched_barrier(0);
            }
    }
};
struct EpiBR {
    static constexpr bool PERM = true, HAS_MID = true;
    bf16_t* O; const bf16_t* GATE;
    __device__ __forceinline__ void scale(const bf16_t* plane, f32x4 (&acc)[2][2][4][2], const Unit& u, int wr, int wc, int fr, int fq) const {
        const int row0 = u.pm * BM + wr * 64 + fr, col0 = u.pn * BM + wc * 32 + 8 * fq;
        u32x4 r[2][4][2];
#pragma unroll
        for (int ai = 0; ai < 2; ++ai)
#pragma unroll
            for (int m = 0; m < 4; ++m)
#pragma unroll
                for (int bj = 0; bj < 2; ++bj) r[ai][m][bj] = *(const u32x4*)(plane + (size_t)(row0 + ai * HALF + m * 16) * D_ + col0 + bj * HALF);
#pragma unroll
        for (int ai = 0; ai < 2; ++ai)
#pragma unroll
            for (int m = 0; m < 4; ++m)
#pragma unroll
                for (int bj = 0; bj < 2; ++bj) { const u32x4 e = r[ai][m][bj];
                    acc[ai][bj][m][0] *= (f32x4){bflo(e.x), bfhi(e.x), bflo(e.y), bfhi(e.y)}; acc[ai][bj][m][1] *= (f32x4){bflo(e.z), bfhi(e.z), bflo(e.w), bfhi(e.w)}; }
    }
    __device__ __forceinline__ void mid(int t, f32x4 (&acc)[2][2][4][2], const Unit& u, int wr, int wc, int fr, int fq) const {
        if (t != 8 && t != 16 && t != 24) return;
        asm volatile("" : "+v"(fr), "+v"(fq));
        scale(GATE + (size_t)((t >> 3) - 1) * T_ * D_, acc, u, wr, wc, fr, fq);
    }
    __device__ __forceinline__ void operator()(f32x4 (&acc)[2][2][4][2], const Unit& u, int wr, int wc, int fr, int fq) const {
        scale(GATE + (size_t)3 * T_ * D_, acc, u, wr, wc, fr, fq);
        const int row0 = u.pm * BM + wr * 64 + fr, col0 = u.pn * BM + wc * 32 + 8 * fq;
#pragma unroll
        for (int ai = 0; ai < 2; ++ai)
#pragma unroll
            for (int m = 0; m < 4; ++m) {
                bf16_t* rowp = O + (size_t)(row0 + ai * HALF + m * 16) * D_ + col0;
#pragma unroll
                for (int bj = 0; bj < 2; ++bj) {
                    const f32x4 a0 = acc[ai][bj][m][0], a1 = acc[ai][bj][m][1];
                    u32x4 w; w.x = pk2(a0[0], a0[1]); w.y = pk2(a0[2], a0[3]); w.z = pk2(a1[0], a1[1]); w.w = pk2(a1[2], a1[3]);
                    *(u32x4*)(rowp + bj * HALF) = w;
                }
            }
    }
};

template <class Epi, bool KREV = false>
__device__ __forceinline__ void gemm_phase(LAS unsigned char* lds, const Gemm g, const StaticOrder& S, const Epi& E) {
    int tid = threadIdx.x; asm volatile("" : "+v"(tid));
    const int wid = __builtin_amdgcn_readfirstlane(tid >> 6), lane = tid & 63, wr = wid >> 2, wc = wid & 3, fr = lane & 15, fq = lane >> 4;
    const int K = g.K, nt = K / BK;
    unsigned voffA[2], voffB[2];
#pragma unroll
    for (int i = 0; i < 2; ++i) { int R, C; stage_rc(tid * 16 + i * 8192, R, C); const int Rb = Epi::PERM ? ((R & ~31) + perm32(R & 31)) : R;
        voffA[i] = (unsigned)(R * K + C) * 2u; voffB[i] = (unsigned)(Rb * K + C) * 2u; }
    const long kstep = KREV ? -(long)(BK * 2) : (long)(BK * 2);
    const size_t kbase = KREV ? (size_t)(nt - 1) * (BK * 2) : 0;
    const size_t hstep = (size_t)HALF * K * 2;
    const size_t tstep = 2 * hstep;
    const unsigned ldsw = (unsigned)wid * 1024u;
    const int aoff = lds_byte(wr * 64 + fr, fq * 8), boff = lds_byte(wc * 32 + fr, fq * 8);
#define PG8_SA(b, h) (((b) * 2 + (h)) * HTB)
#define PG8_SB(b, h) ((4 + (b) * 2 + (h)) * HTB)
#define PG8_STAGE(bufoff, gbase, voff) do { _Pragma("unroll") for (int _i = 0; _i < 2; ++_i) \
        __builtin_amdgcn_global_load_lds((const unsigned*)((const char*)(gbase) + (voff)[_i]), (LAS unsigned*)(lds + (bufoff) + ldsw + _i * 8192), 16, 0, 0); } while (0)
#define PG8_LDA(dst, b, h) do { _Pragma("unroll") for (int m = 0; m < 4; ++m) _Pragma("unroll") for (int k = 0; k < 2; ++k) dst[m][k] = *(const LAS bf16x8*)(lds + PG8_SA(b, h) + aoff + m * 2048 + k * 1024); } while (0)
#define PG8_LDB(dst, b, h) do { _Pragma("unroll") for (int n = 0; n < 2; ++n) _Pragma("unroll") for (int k = 0; k < 2; ++k) dst[n][k] = *(const LAS bf16x8*)(lds + PG8_SB(b, h) + boff + n * 2048 + k * 1024); } while (0)
#define PG8_MMA(ai, bj, At, Bt) do { __builtin_amdgcn_s_setprio(1); _Pragma("unroll") for (int m = 0; m < 4; ++m) _Pragma("unroll") for (int n = 0; n < 2; ++n) _Pragma("unroll") for (int k = 0; k < 2; ++k) \
        acc[ai][bj][m][n] = __builtin_amdgcn_mfma_f32_16x16x32_bf16(Bt[n][k], At[m][k], acc[ai][bj][m][n], 0, 0, 0); __builtin_amdgcn_s_setprio(0); } while (0)
#define PG8_WAIT_V(n) asm volatile("s_waitcnt vmcnt(" #n ")" ::: "memory")
#define PG8_WAIT_L(n) asm volatile("s_waitcnt lgkmcnt(" #n ")" ::: "memory")
#define PG8_BAR __builtin_amdgcn_s_barrier()
#define PG8_SCHED __builtin_amdgcn_sched_barrier(0)
    Unit cur, nxt; int ui = 0;
    if (!S.next(0, cur)) return;
    f32x4 acc[2][2][4][2];
#pragma unroll
    for (int a = 0; a < 2; ++a)
#pragma unroll
        for (int b = 0; b < 2; ++b)
#pragma unroll
            for (int m = 0; m < 4; ++m)
#pragma unroll
                for (int n = 0; n < 2; ++n) acc[a][b][m][n] = (f32x4){0.f, 0.f, 0.f, 0.f};
    bf16x8 At[4][2], B0[2][2], B1[2][2];
    const char* cA = (const char*)g.A + (size_t)cur.pm * tstep + kbase; const char* cB = (const char*)g.Bt + (size_t)cur.pn * tstep + kbase;
    PG8_STAGE(PG8_SB(0, 0), cB, voffB); PG8_STAGE(PG8_SB(0, 1), cB + hstep, voffB); PG8_STAGE(PG8_SA(0, 0), cA, voffA); PG8_STAGE(PG8_SA(0, 1), cA + hstep, voffA);
    if (wr == 1) PG8_BAR;
    PG8_WAIT_V(2); PG8_BAR;
    PG8_STAGE(PG8_SB(1, 0), cB + kstep, voffB); PG8_STAGE(PG8_SA(1, 0), cA + kstep, voffA); PG8_STAGE(PG8_SB(1, 1), cB + hstep + kstep, voffB);
    PG8_WAIT_V(6); PG8_BAR;
    for (;;) {
        const bool has_next = S.next(ui + 1, nxt);
        const char* nA = has_next ? (const char*)g.A + (size_t)nxt.pm * tstep + kbase : cA; const char* nB = has_next ? (const char*)g.Bt + (size_t)nxt.pn * tstep + kbase : cB;
        for (int t = 0; t < nt; t += 2) {
            const bool last = (t == nt - 2);
            const char* a1 = cA + (long)(t + 1) * kstep;
            const char* a2 = last ? nA : cA + (long)(t + 2) * kstep; const char* b2 = last ? nB : cB + (long)(t + 2) * kstep;
            const char* a3 = a2 + kstep; const char* b3 = b2 + kstep;
            if constexpr (Epi::HAS_MID) E.mid(t, acc, cur, wr, wc, fr, fq);
            PG8_LDB(B0, 0, 0); PG8_LDB(B1, 0, 1); PG8_SCHED; PG8_LDA(At, 0, 0); PG8_STAGE(PG8_SA(1, 1), a1 + hstep, voffA);
            PG8_WAIT_V(8); PG8_WAIT_L(0); PG8_BAR; PG8_MMA(0, 0, At, B0); PG8_MMA(0, 1, At, B1); PG8_BAR; PG8_SCHED;
            PG8_LDA(At, 0, 1); PG8_STAGE(PG8_SB(0, 0), b2, voffB); PG8_STAGE(PG8_SB(0, 1), b2 + hstep, voffB); PG8_STAGE(PG8_SA(0, 0), a2, voffA);
            PG8_WAIT_V(8); PG8_WAIT_L(0); PG8_BAR; PG8_MMA(1, 0, At, B0); PG8_MMA(1, 1, At, B1); PG8_BAR; PG8_SCHED;
            PG8_LDB(B0, 1, 0); PG8_LDB(B1, 1, 1); PG8_SCHED; PG8_LDA(At, 1, 0); PG8_STAGE(PG8_SA(0, 1), a2 + hstep, voffA);
            PG8_WAIT_V(8); PG8_WAIT_L(0); PG8_BAR; PG8_MMA(0, 0, At, B0); PG8_MMA(0, 1, At, B1); PG8_BAR; PG8_SCHED;
            PG8_LDA(At, 1, 1); PG8_STAGE(PG8_SB(1, 0), b3, voffB); PG8_STAGE(PG8_SB(1, 1), b3 + hstep, voffB); PG8_STAGE(PG8_SA(1, 0), a3, voffA);
            PG8_WAIT_V(8); PG8_WAIT_L(0); PG8_BAR; PG8_MMA(1, 0, At, B0); PG8_MMA(1, 1, At, B1); PG8_BAR; PG8_SCHED;
        }
        if (wr == 0) PG8_BAR;
#pragma unroll
        for (int a = 0; a < 2; ++a)
#pragma unroll
            for (int b = 0; b < 2; ++b)
#pragma unroll
                for (int m = 0; m < 4; ++m)
#pragma unroll
                    for (int n = 0; n < 2; ++n) asm volatile("" : "+v"(acc[a][b][m][n]));
        E(acc, cur, wr, wc, fr, fq);
        if (!has_next) break;
#pragma unroll
        for (int a = 0; a < 2; ++a)
#pragma unroll
            for (int b = 0; b < 2; ++b)
#pragma unroll
                for (int m = 0; m < 4; ++m)
#pragma unroll
                    for (int n = 0; n < 2; ++n) acc[a][b][m][n] = (f32x4){0.f, 0.f, 0.f, 0.f};
        cur = nxt; cA = nA; cB = nB; ++ui;
        if (wr == 1) PG8_BAR;
    }
    PG8_WAIT_V(0);
    PG8_BAR;
#undef PG8_SA
#undef PG8_SB
#undef PG8_STAGE
#undef PG8_LDA
#undef PG8_LDB
#undef PG8_MMA
#undef PG8_WAIT_V
#undef PG8_WAIT_L
#undef PG8_BAR
#undef PG8_SCHED
}
}

typedef __attribute__((address_space(1))) unsigned gu32;
#define XB_TMO      128
#define XB_XCNT(j)  (256  + 64 * (j))
#define XB_XSUB(j)  (1280 + 64 * (j))
#define XB_XGEN(j)  (2304 + 64 * (j))
#define XB_TOP      3328
#define XB_TOPGEN   3392
#define XCD_BAR_WORDS 3456
#define XB_SPIN_CAP (1u << 18)

__device__ __forceinline__ unsigned xb_ld(unsigned* p)              { return __hip_atomic_load(p, __ATOMIC_RELAXED, __HIP_MEMORY_SCOPE_AGENT); }
__device__ __forceinline__ unsigned xb_add(unsigned* p, unsigned v) { return __hip_atomic_fetch_add(p, v, __ATOMIC_RELAXED, __HIP_MEMORY_SCOPE_AGENT); }
__device__ __forceinline__ unsigned xb_xcc_id() { return (unsigned)__builtin_amdgcn_s_getreg((3 << 11) | 20) & 0xFu; }
#define XB_SPIN(cond, bar) do { unsigned _sp = 0; while (cond) { __builtin_amdgcn_s_sleep(1); \
    if ((++_sp & 255u) == 0u) { if (xb_ld(&(bar)[XB_TMO])) break; if (_sp > XB_SPIN_CAP) { atomicAdd(&(bar)[XB_TMO], 1u); break; } } } } while (0)

struct XcdBarrier {
    unsigned* bar; unsigned x;
    volatile LAS unsigned* st;
};

__device__ __forceinline__ XcdBarrier xcd_barrier_post(unsigned* bar, volatile LAS unsigned* st) {
    XcdBarrier b; b.bar = bar; b.x = xb_xcc_id(); b.st = st;
    if (threadIdx.x == 0) (void)xb_add(&bar[XB_XCNT(b.x)], 1u);
    return b;
}
__device__ __forceinline__ void xcd_barrier_complete(unsigned* bar, unsigned x, unsigned& nloc, unsigned& nx) {
    const unsigned G = gridDim.x * gridDim.y * gridDim.z;
    unsigned sum, cnt, mine, sp = 0u;
    for (;;) {
        sum = 0u; cnt = 0u; mine = 0u;
#pragma unroll
        for (unsigned j = 0; j < 16; ++j) { const unsigned c = xb_ld(&bar[XB_XCNT(j)]); sum += c; cnt += (c > 0u) ? 1u : 0u; mine = (j == x) ? c : mine; }
        if (sum == G) break;
        __builtin_amdgcn_s_sleep(1);
        if ((++sp & 255u) == 0u) { if (xb_ld(&bar[XB_TMO])) break; if (sp > XB_SPIN_CAP) { atomicAdd(&bar[XB_TMO], 1u); break; } }
    }
    nloc = mine > 0u ? mine : 1u; nx = cnt > 0u ? cnt : 1u;
}

__device__ __forceinline__ void xcd_barrier(const XcdBarrier& b) {
    asm volatile("s_waitcnt vmcnt(0)" ::: "memory");
    __syncthreads();
    if (threadIdx.x == 0) {
        unsigned* bar = b.bar;
        __builtin_amdgcn_s_waitcnt(0);
        unsigned nloc = b.st[0], nx = b.st[1];
        if (nloc == 0u) { xcd_barrier_complete(bar, b.x, nloc, nx); b.st[0] = nloc; b.st[1] = nx; }
        const unsigned old = xb_add(&bar[XB_XSUB(b.x)], 1u);
        const unsigned gen = old / nloc;
        if (old + 1u == (gen + 1u) * nloc) {
            __builtin_amdgcn_fence(__ATOMIC_RELEASE, "agent");
            asm volatile("s_waitcnt vmcnt(0)" ::: "memory");
            const unsigned og = xb_add(&bar[XB_TOP], 1u);
            const unsigned tg = og / nx;
            if (og + 1u == (tg + 1u) * nx) xb_add(&bar[XB_TOPGEN], 1u);
            else XB_SPIN(xb_ld(&bar[XB_TOPGEN]) == tg, bar);
            __builtin_amdgcn_fence(__ATOMIC_ACQUIRE, "agent");
            xb_add(&bar[XB_XGEN(b.x)], 1u);
            asm volatile("s_waitcnt vmcnt(0)" ::: "memory");
        } else {
            XB_SPIN(xb_ld(&bar[XB_XGEN(b.x)]) == gen, bar);
            __builtin_amdgcn_fence(__ATOMIC_ACQUIRE, "agent");
            asm volatile("s_waitcnt vmcnt(0)" ::: "memory");
        }
    }
    __syncthreads();
}


struct Args { const float* in[22]; float* out; unsigned char* ws; int ph_lo, ph_hi; };

typedef LAS unsigned long long* PTab;
__device__ __forceinline__ const float* ldptr(PTab pt, int k) {
    const unsigned long long v = pt[k];
    const unsigned lo = __builtin_amdgcn_readfirstlane((unsigned)v), hi = __builtin_amdgcn_readfirstlane((unsigned)(v >> 32));
    return (const float*)(__attribute__((address_space(1))) const float*)(((unsigned long long)hi << 32) | lo);
}

__device__ __forceinline__ int conv_row(int n, int mode, int rowoff) {
    if (mode == 0) return rowoff + n;
    if (mode == 3) { const int br = n >> 11, mc = n & 2047, q = mc >> 6, mcl = mc & 63; return rowoff + 256 * q + 128 * (br >> 1) + 32 * (mcl >> 4) + 8 * ((mcl >> 2) & 3) + 4 * (br & 1) + (mcl & 3); }
    return (n >> 7) * 256 + (n & 127) + (mode == 2 ? 128 : 0);
}
__device__ __forceinline__ void conv_mat(const float* W, int ldw, int K, int N, bf16_t* WT, int pitch, int koff, int mode, int rowoff, int gw, int ngw, int lane) {
    const int nblk = N / 64, nitems = (K / 64) * nblk;
    const int c = lane & 15, q = lane >> 4;
    f32x4 v[16];
    if (gw < nitems) { const int kb = gw / nblk, nb = gw - kb * nblk; const float* src = W + (size_t)(64 * kb + 16 * q) * ldw + 64 * nb + 4 * c;
#pragma unroll
        for (int j = 0; j < 16; ++j) v[j] = __builtin_nontemporal_load((const f32x4*)(src + (size_t)j * ldw)); }
    for (int item = gw; item < nitems; item += ngw) {
        const int kb = item / nblk, nb = item - kb * nblk, k0 = 64 * kb, n0 = 64 * nb;
        u32x4 o[8];
#pragma unroll
        for (int i = 0; i < 4; ++i) {
            o[2 * i].x = pk2(v[0][i], v[1][i]); o[2 * i].y = pk2(v[2][i], v[3][i]); o[2 * i].z = pk2(v[4][i], v[5][i]); o[2 * i].w = pk2(v[6][i], v[7][i]);
            o[2 * i + 1].x = pk2(v[8][i], v[9][i]); o[2 * i + 1].y = pk2(v[10][i], v[11][i]); o[2 * i + 1].z = pk2(v[12][i], v[13][i]); o[2 * i + 1].w = pk2(v[14][i], v[15][i]);
        }
        const int nx = item + ngw;
        if (nx < nitems) { const int kb2 = nx / nblk, nb2 = nx - kb2 * nblk; const float* src = W + (size_t)(64 * kb2 + 16 * q) * ldw + 64 * nb2 + 4 * c;
#pragma unroll
            for (int j = 0; j < 16; ++j) v[j] = __builtin_nontemporal_load((const f32x4*)(src + (size_t)j * ldw)); }
        const int rb = conv_row(n0 + 4 * c, mode, rowoff);
#pragma unroll
        for (int i = 0; i < 4; ++i) {
            bf16_t* dst = WT + (size_t)(rb + i) * pitch + koff + k0 + 16 * q;
            *(u32x4*)dst = o[2 * i]; *(u32x4*)(dst + 8) = o[2 * i + 1];
        }
    }
}

__device__ __forceinline__ void convert_phase(PTab pt, int l, LAS unsigned char* lds, int tid, int wave, int lane, int bid, int G) {
    unsigned char* ws = (unsigned char*)ldptr(pt, 23);
    const int gw = bid * 8 + wave, ngw = G * 8;
    for (int s = 0; s < 2; ++s) {
        bf16_t* wgu = (bf16_t*)(ws + WS_WGU + (size_t)s * 44 * MiB);
        conv_mat(ldptr(pt, 4) + (size_t)(l * 2 + s) * D_ * FF_, FF_, D_, FF_, wgu, D_, 0, 1, 0, gw, ngw, lane);
        conv_mat(ldptr(pt, 5) + (size_t)(l * 2 + s) * D_ * FF_, FF_, D_, FF_, wgu, D_, 0, 2, 0, gw, ngw, lane);
        conv_mat(ldptr(pt, 6) + (size_t)(l * 2 + s) * D_ * FF_, D_, FF_, D_, (bf16_t*)(ws + WS_WD + (size_t)s * 22 * MiB), FF_, 0, 0, 0, gw, ngw, lane);
    }
    conv_mat(ldptr(pt, 7) + (size_t)l * D_ * NIN_, NIN_, D_, NZ_, (bf16_t*)(ws + WS_WIN), D_, 0, 0, 0, gw, ngw, lane);
    conv_mat(ldptr(pt, 7) + (size_t)l * D_ * NIN_ + NZ_, NIN_, D_, NGT_, (bf16_t*)(ws + WS_WIN), D_, 0, 3, NZ_, gw, ngw, lane);
    conv_mat(ldptr(pt, 15) + (size_t)l * 512 * D_, D_, 512, D_, (bf16_t*)(ws + WS_WBR), NO_, 0, 0, 0, gw, ngw, lane);
    conv_mat(ldptr(pt, 16) + (size_t)l * 512 * D_, D_, 512, D_, (bf16_t*)(ws + WS_WBR), NO_, 512, 0, 0, gw, ngw, lane);
    conv_mat(ldptr(pt, 17) + (size_t)l * 512 * D_, D_, 512, D_, (bf16_t*)(ws + WS_WBR), NO_, 1024, 0, 0, gw, ngw, lane);
    conv_mat(ldptr(pt, 18) + (size_t)l * 256 * D_, D_, 256, D_, (bf16_t*)(ws + WS_WBR), NO_, 1536, 0, 0, gw, ngw, lane);
    conv_mat(ldptr(pt, 19) + (size_t)l * D_ * D_, D_, D_, D_, (bf16_t*)(ws + WS_WOUT), D_, 0, 0, 0, gw, ngw, lane);
    conv_mat(ldptr(pt, 20) + (size_t)l * PLE_ * D_, D_, PLE_, D_, (bf16_t*)(ws + WS_WPP), PLE_, 0, 0, 0, gw, ngw, lane);
    conv_mat(ldptr(pt, 21) + (size_t)l * D_ * D_, D_, D_, D_, (bf16_t*)(ws + WS_WPG), D_, 0, 0, 0, gw, ngw, lane);
    if (l == 0) {
        const size_t gt = (size_t)bid * 512 + tid, nth = (size_t)G * 512;
        const f32x4* x4 = (const f32x4*)ldptr(pt, 0); u32x2* xb = (u32x2*)(ws + WS_XB);
        for (size_t i = gt; i < (size_t)T_ * D_ / 4; i += nth) { const f32x4 v = x4[i]; u32x2 w; w.x = pk2(v[0], v[1]); w.y = pk2(v[2], v[3]); xb[i] = w; }
        const f32x4* p4 = (const f32x4*)ldptr(pt, 1); u32x2* pb = (u32x2*)(ws + WS_PB);
        for (size_t i = gt; i < (size_t)2 * T_ * PLE_ / 4; i += nth) { const f32x4 v = p4[i]; u32x2 w; w.x = pk2(v[0], v[1]); w.y = pk2(v[2], v[3]); pb[i] = w; }
    }
}

__device__ __forceinline__ void ln_phase(float* X, bf16_t* XB, const float* g, const float* b, bool final_, int wave, int lane, int bid, int G) {
    const int gw = bid * 8 + wave, ngw = G * 8;
    for (int row0 = gw; row0 < T_; row0 += 4 * ngw) {
        f32x4 v[4][8];
#pragma unroll
        for (int r = 0; r < 4; ++r) { const int row = min(row0 + r * ngw, T_ - 1); const f32x4* xr = (const f32x4*)(X + (size_t)row * D_) + lane;
#pragma unroll
            for (int j = 0; j < 8; ++j) v[r][j] = xr[64 * j]; }
        float mean[4], rstd[4];
#pragma unroll
        for (int r = 0; r < 4; ++r) { float s = 0.f;
#pragma unroll
            for (int j = 0; j < 8; ++j) s += (v[r][j][0] + v[r][j][1]) + (v[r][j][2] + v[r][j][3]);
            mean[r] = s; }
#pragma unroll
        for (int o = 1; o < 64; o <<= 1) {
#pragma unroll
            for (int r = 0; r < 4; ++r) mean[r] += __shfl_xor(mean[r], o); }
#pragma unroll
        for (int r = 0; r < 4; ++r) { mean[r] *= (1.f / D_); float s2 = 0.f;
#pragma unroll
            for (int j = 0; j < 8; ++j) { v[r][j] = v[r][j] - mean[r]; s2 += (v[r][j][0] * v[r][j][0] + v[r][j][1] * v[r][j][1]) + (v[r][j][2] * v[r][j][2] + v[r][j][3] * v[r][j][3]); }
            rstd[r] = s2; }
#pragma unroll
        for (int o = 1; o < 64; o <<= 1) {
#pragma unroll
            for (int r = 0; r < 4; ++r) rstd[r] += __shfl_xor(rstd[r], o); }
#pragma unroll
        for (int r = 0; r < 4; ++r) rstd[r] = 1.f / sqrtf(rstd[r] * (1.f / D_) + LN_EPS);
#pragma unroll
        for (int j = 0; j < 8; ++j) {
            const f32x4 gg = ((const f32x4*)g)[lane + 64 * j], bb = ((const f32x4*)b)[lane + 64 * j];
#pragma unroll
            for (int r = 0; r < 4; ++r) { const int row = row0 + r * ngw;
                if (row < T_) { const f32x4 y = v[r][j] * rstd[r] * gg + bb;
                    if (final_) ((f32x4*)(X + (size_t)row * D_))[lane + 64 * j] = y;
                    else { u32x2 w; w.x = pk2(y[0], y[1]); w.y = pk2(y[2], y[3]); ((u32x2*)(XB + (size_t)row * D_))[lane + 64 * j] = w; } } }
        }
    }
}

__device__ __forceinline__ void attn_unit(LAS unsigned char* L, const bf16_t* Z, int unit, const float* sinks, bf16_t* O, float* DPO, float* DLSE, int tid, int wave, int lane) {
    int qcol, kcol, vcol, base, blk, dil, max_dist, grp = 0, hh = 0; float slope_u, sink = 0.f; bool isA;
    if (unit < 1024) {
        isA = true; blk = unit & 31; const int head = (unit >> 5) & 7, b = unit >> 8, kvh = head >> 2;
        qcol = ZQA + head * 64; kcol = ZKA + kvh * 64; vcol = ZVA + kvh * 64; base = b * SEQ_; dil = 1; max_dist = 127;
        slope_u = __builtin_amdgcn_exp2f(-8.0f * (float)(head + 1) / 20.0f); sink = sinks[head]; hh = head;
    } else {
        isA = false; const int u2 = unit - 1024; grp = u2 >> 9; const int u3 = u2 & 511;
        dil = (grp == 0) ? 1 : (grp == 1 ? 4 : 16); const int nbk = 32 / dil;
        blk = u3 % nbk; const int r = (u3 / nbk) % dil; hh = (u3 / 32) & 3; const int b = u3 >> 7;
        qcol = ZQD + grp * 256 + hh * 64; kcol = ZKD + grp * 256 + hh * 64; vcol = ZVD + grp * 256 + hh * 64; base = b * SEQ_ + r; max_dist = 128;
        slope_u = __builtin_amdgcn_exp2f(-8.0f * (float)(8 + 4 * grp + hh + 1) / 20.0f) * (float)dil;
    }
    LAS bf16_t* Qs = (LAS bf16_t*)L;
    LAS bf16_t* Ks = Qs + 128 * 72;
    LAS bf16_t* Vs = Ks + 272 * 72;
    for (int i = tid; i < 1024; i += 512) { const int r = i >> 3, c = i & 7; const size_t tok = (size_t)(base + (blk * 128 + r) * dil);
        *(LAS u32x4*)(Qs + r * 72 + c * 8) = *(const u32x4*)(Z + tok * NZ_ + qcol + c * 8); }
    {
        u32x4 kv[5], vv[5];
#pragma unroll
        for (int it = 0; it < 5; ++it) { const int i = tid + it * 512; const int r = i >> 3, c = i & 7; const int sub = blk * 128 - 128 + r; const bool ok = (i < 2176) && (r < 256) && (sub >= 0);
            kv[it] = (u32x4){0u, 0u, 0u, 0u}; vv[it] = (u32x4){0u, 0u, 0u, 0u};
            if (ok) { const size_t tok = (size_t)(base + sub * dil); kv[it] = *(const u32x4*)(Z + tok * NZ_ + kcol + c * 8); vv[it] = *(const u32x4*)(Z + tok * NZ_ + vcol + c * 8); } }
#pragma unroll
        for (int it = 0; it < 5; ++it) { const int i = tid + it * 512; const int r = i >> 3, c = i & 7;
            if (i < 2176) {
                *(LAS u32x4*)(Ks + r * 72 + c * 8) = kv[it];
                *(LAS u32x4*)(Vs + r * 72 + c * 8) = vv[it]; } }
    }
    __syncthreads();
    const int q0 = wave * 16, qi = lane & 15, g = lane >> 4;
    bf16x8 bq[2];
#pragma unroll
    for (int ks = 0; ks < 2; ++ks) bq[ks] = *(const LAS bf16x8*)(Qs + (q0 + qi) * 72 + ks * 32 + g * 8);
    f32x4 st[10];
#pragma unroll
    for (int i = 0; i < 10; ++i) { f32x4 acc = {0.f, 0.f, 0.f, 0.f};
#pragma unroll
        for (int ks = 0; ks < 2; ++ks) { const bf16x8 ak = *(const LAS bf16x8*)(Ks + ((wave + i) * 16 + qi) * 72 + ks * 32 + g * 8); acc = mfma16(ak, bq[ks], acc); }
        st[i] = acc; }
    float mx = -3.0e38f;
    const int q = q0 + qi;
#pragma unroll
    for (int i = 0; i < 10; ++i)
#pragma unroll
        for (int j = 0; j < 4; ++j) { const int kk = (wave + i) * 16 + 4 * g + j; const int dist = q + 128 - kk;
            const bool valid = (dist >= 0) && (dist <= max_dist) && (blk > 0 || kk >= 128);
            const float s = valid ? (st[i][j] * 0.125f - slope_u * (float)dist) : -1.0e30f; st[i][j] = s; mx = fmaxf(mx, s); }
    mx = fmaxf(mx, __shfl_xor(mx, 16)); mx = fmaxf(mx, __shfl_xor(mx, 32));
    if (isA) mx = fmaxf(mx, sink);
    float den = 0.f;
#pragma unroll
    for (int i = 0; i < 10; ++i)
#pragma unroll
        for (int j = 0; j < 4; ++j) { const float p = __builtin_amdgcn_exp2f((st[i][j] - mx) * LOG2E); st[i][j] = p; den += p; }
    den += __shfl_xor(den, 16); den += __shfl_xor(den, 32);
    if (isA) den += __builtin_amdgcn_exp2f((sink - mx) * LOG2E);
    f32x4 o[4];
#pragma unroll
    for (int ht = 0; ht < 4; ++ht) o[ht] = (f32x4){0.f, 0.f, 0.f, 0.f};
    const LAS bf16_t* vbase = Vs + (wave * 16 + 4 * g + (qi >> 2)) * 72 + 4 * (qi & 3);
#pragma unroll
    for (int i = 0; i < 5; ++i) {
        u32x4 pw; pw.x = pk2(st[2 * i][0], st[2 * i][1]); pw.y = pk2(st[2 * i][2], st[2 * i][3]); pw.z = pk2(st[2 * i + 1][0], st[2 * i + 1][1]); pw.w = pk2(st[2 * i + 1][2], st[2 * i + 1][3]);
        const bf16x8 bp = __builtin_bit_cast(bf16x8, pw);
#pragma unroll
        for (int ht = 0; ht < 4; ++ht) { const LAS bf16_t* vr = vbase + (2 * i * 16) * 72 + ht * 16;
            const u32x2 va = tr16(vr), vb = tr16(vr + 16 * 72);
            o[ht] = mfma16(mk8(va, vb), bp, o[ht]); } }
    const float inv = 1.0f / den;
    const size_t tok = (size_t)(base + (blk * 128 + q) * dil);
    if (isA) {
#pragma unroll
        for (int ht = 0; ht < 4; ++ht) { u32x2 w; w.x = pk2(o[ht][0] * inv, o[ht][1] * inv); w.y = pk2(o[ht][2] * inv, o[ht][3] * inv);
            *(u32x2*)(O + tok * NO_ + hh * 64 + ht * 16 + 4 * g) = w; }
    } else {
#pragma unroll
        for (int ht = 0; ht < 4; ++ht) *(f32x4*)(DPO + ((size_t)grp * T_ + tok) * 256 + hh * 64 + ht * 16 + 4 * g) = o[ht] * inv;
        if (g == 0) DLSE[((size_t)grp * T_ + tok) * 4 + hh] = mx + logf(den);
    }
    __syncthreads();
}

__device__ __forceinline__ void gmlp_unit(LAS unsigned char* L, const bf16_t* Z, int unit, const float* lng, const float* lnb, const float* ws_, const float* bs, bf16_t* O, int tid, int wave, int lane) {
    const int n = unit >> 2, grp = unit & 3, tok0 = n * 128;
    LAS float* stats = (LAS float*)L;
    LAS bf16_t* vnt = (LAS bf16_t*)(L + 1024);
    LAS bf16_t* Wc = vnt + 128 * 136;
    {
        u32x4 raw[16];
#pragma unroll
        for (int r = 0; r < 16; ++r) raw[r] = *(const u32x4*)(Z + (size_t)(tok0 + 16 * wave + r) * NZ_ + ZVB + lane * 8);
        float s[16], ss[16];
#pragma unroll
        for (int r = 0; r < 16; ++r) { const float x0 = bflo(raw[r].x), x1 = bfhi(raw[r].x), x2 = bflo(raw[r].y), x3 = bfhi(raw[r].y), x4 = bflo(raw[r].z), x5 = bfhi(raw[r].z), x6 = bflo(raw[r].w), x7 = bfhi(raw[r].w);
            s[r] = ((x0 + x1) + (x2 + x3)) + ((x4 + x5) + (x6 + x7)); ss[r] = ((x0 * x0 + x1 * x1) + (x2 * x2 + x3 * x3)) + ((x4 * x4 + x5 * x5) + (x6 * x6 + x7 * x7)); }
#pragma unroll
        for (int o = 1; o < 64; o <<= 1) {
#pragma unroll
            for (int r = 0; r < 16; ++r) { s[r] += __shfl_xor(s[r], o); ss[r] += __shfl_xor(ss[r], o); } }
        if (lane < 16) { float m = 0.f, q = 0.f;
#pragma unroll
            for (int r = 0; r < 16; ++r) if (lane == r) { m = s[r]; q = ss[r]; }
            m *= (1.f / 512.f); const float var = fmaxf(q * (1.f / 512.f) - m * m, 0.f);
            stats[(16 * wave + lane) * 2] = m; stats[(16 * wave + lane) * 2 + 1] = 1.f / sqrtf(var + LN_EPS); }
    }
#pragma unroll
    for (int it = 0; it < 8; ++it) { const int i = tid + it * 512; const int t = i >> 5, s4 = (i & 31) * 4;
        f32x4 w = *(const f32x4*)(ws_ + (size_t)(grp * 128 + t) * 128 + s4);
#pragma unroll
        for (int e = 0; e < 4; ++e) if (s4 + e > t) w[e] = 0.f;
        u32x2 p; p.x = pk2(w[0], w[1]); p.y = pk2(w[2], w[3]); *(LAS u32x2*)(Wc + t * 136 + s4) = p; }
    u32x4 vraw[4];
#pragma unroll
    for (int it = 0; it < 4; ++it) { const int i = tid + it * 512; const int s = i >> 4, c8 = (i & 15) * 8;
        vraw[it] = *(const u32x4*)(Z + (size_t)(tok0 + s) * NZ_ + ZVB + grp * 128 + c8); }
    __syncthreads();
#pragma unroll
    for (int it = 0; it < 4; ++it) { const int i = tid + it * 512; const int s = i >> 4, c8 = (i & 15) * 8;
        const u32x4 raw = vraw[it];
        const float mean = stats[s * 2], rstd = stats[s * 2 + 1];
        float x[8]; x[0] = bflo(raw.x); x[1] = bfhi(raw.x); x[2] = bflo(raw.y); x[3] = bfhi(raw.y); x[4] = bflo(raw.z); x[5] = bfhi(raw.z); x[6] = bflo(raw.w); x[7] = bfhi(raw.w);
        const f32x4 g0 = *(const f32x4*)(lng + grp * 128 + c8), g1 = *(const f32x4*)(lng + grp * 128 + c8 + 4), b0 = *(const f32x4*)(lnb + grp * 128 + c8), b1 = *(const f32x4*)(lnb + grp * 128 + c8 + 4);
        float y[8];
#pragma unroll
        for (int e = 0; e < 8; ++e) y[e] = (x[e] - mean) * rstd * (e < 4 ? g0[e & 3] : g1[e & 3]) + (e < 4 ? b0[e & 3] : b1[e & 3]);
        u32x4 w; w.x = pk2(y[0], y[1]); w.y = pk2(y[2], y[3]); w.z = pk2(y[4], y[5]); w.w = pk2(y[6], y[7]);
        *(LAS u32x4*)(vnt + s * 136 + c8) = w; }
    __syncthreads();
    const int qi = lane & 15, g = lane >> 4;
    const int t = 16 * wave + qi; const float bias = bs[grp * 128 + t];
    const size_t tok = (size_t)(tok0 + t);
    u32x2 ur[8];
#pragma unroll
    for (int ct = 0; ct < 8; ++ct) ur[ct] = *(const u32x2*)(Z + tok * NZ_ + ZUB + grp * 128 + 16 * ct + 4 * g);
    f32x4 acc[8];
#pragma unroll
    for (int ct = 0; ct < 8; ++ct) acc[ct] = (f32x4){0.f, 0.f, 0.f, 0.f};
#pragma unroll
    for (int ks = 0; ks < 4; ++ks) { const bf16x8 bw = *(const LAS bf16x8*)(Wc + (16 * wave + qi) * 136 + ks * 32 + g * 8);
#pragma unroll
        for (int ct = 0; ct < 8; ++ct) { const LAS bf16_t* vr = vnt + (ks * 32 + 8 * g + (qi >> 2)) * 136 + 16 * ct + 4 * (qi & 3);
            acc[ct] = mfma16(mk8(tr16(vr), tr16(vr + 4 * 136)), bw, acc[ct]); } }
#pragma unroll
    for (int ct = 0; ct < 8; ++ct) { const int c = 16 * ct + 4 * g;
        u32x2 w; w.x = pk2(bflo(ur[ct].x) * (acc[ct][0] + bias), bfhi(ur[ct].x) * (acc[ct][1] + bias));
        w.y = pk2(bflo(ur[ct].y) * (acc[ct][2] + bias), bfhi(ur[ct].y) * (acc[ct][3] + bias));
        *(u32x2*)(O + tok * NO_ + 512 + grp * 128 + c) = w; }
    __syncthreads();
}

__device__ __forceinline__ float hgrn_lb(const float* lbl, int layer, int c) { return layer == 0 ? 0.0f : 1.0f / (1.0f + expf(lbl[c] - lbl[512 + c])); }

__device__ __forceinline__ void hgrn_c1_unit(LAS unsigned char* L, const bf16_t* Z, int unit, const float* lbl, int layer, float* DS, float* DEC, int tid, int wave, int lane) {
    const int h = unit & 3, cg_ = unit >> 2, tok0 = cg_ * 64;
    const int k = tid & 127, qtr = tid >> 7;
    LAS float* qsum = (LAS float*)L;
    LAS bf16_t* kt = (LAS bf16_t*)(L + 2048);
    LAS bf16_t* vt = kt + 128 * 72;
    const float lb = hgrn_lb(lbl, layer, h * 128 + k);
    float G[16], kk[16]; float run = 0.f;
    unsigned vraw[16];
#pragma unroll
    for (int i = 0; i < 16; ++i) { const size_t tok = (size_t)(tok0 + 16 * qtr + i);
        const float zf = bf2f(Z[tok * NZ_ + ZFC + h * 128 + k]);
        vraw[i] = Z[tok * NZ_ + ZIC + h * 128 + k];
        const float e = fexp(-zf), sg = frcp(1.0f + e);
        const float f = lb + (1.0f - lb) * sg;
        run += logf(fmaxf(f, 1e-6f)); G[i] = run; kk[i] = (1.0f - lb) * e * sg; }
    qsum[qtr * 128 + k] = run;
    __syncthreads();
    float off = 0.f, tot = 0.f;
#pragma unroll
    for (int qq = 0; qq < 4; ++qq) { const float v = qsum[qq * 128 + k]; tot += v; if (qq < qtr) off += v; }
    unsigned kw[8], vw[8];
#pragma unroll
    for (int i = 0; i < 8; ++i) { const float a0 = kk[2 * i] * fexp(tot - (G[2 * i] + off)), a1 = kk[2 * i + 1] * fexp(tot - (G[2 * i + 1] + off));
        kw[i] = pk2(a0, a1); vw[i] = vraw[2 * i] | (vraw[2 * i + 1] << 16); }
    *(LAS u32x4*)(kt + k * 72 + 16 * qtr) = (u32x4){kw[0], kw[1], kw[2], kw[3]}; *(LAS u32x4*)(kt + k * 72 + 16 * qtr + 8) = (u32x4){kw[4], kw[5], kw[6], kw[7]};
    *(LAS u32x4*)(vt + k * 72 + 16 * qtr) = (u32x4){vw[0], vw[1], vw[2], vw[3]}; *(LAS u32x4*)(vt + k * 72 + 16 * qtr + 8) = (u32x4){vw[4], vw[5], vw[6], vw[7]};
    if (qtr == 0) DEC[(size_t)unit * 128 + k] = fexp(tot);
    __syncthreads();
    const int qi = lane & 15, g = lane >> 4;
    bf16x8 av[2];
#pragma unroll
    for (int ks = 0; ks < 2; ++ks) av[ks] = *(const LAS bf16x8*)(vt + (16 * wave + qi) * 72 + ks * 32 + g * 8);
    float* dst = DS + (size_t)unit * 16384;
#pragma unroll
    for (int ktile = 0; ktile < 8; ++ktile) { f32x4 acc = {0.f, 0.f, 0.f, 0.f};
#pragma unroll
        for (int ks = 0; ks < 2; ++ks) { const bf16x8 bk = *(const LAS bf16x8*)(kt + (16 * ktile + qi) * 72 + ks * 32 + g * 8); acc = mfma16(av[ks], bk, acc); }
#pragma unroll
        for (int j = 0; j < 4; ++j) dst[(16 * wave + 4 * g + j) * 128 + 16 * ktile + qi] = acc[j]; }
    __syncthreads();
}

__device__ __forceinline__ void hgrn_scan_phase(const float* DS, const float* DEC, bf16_t* HS, int tid, int bid, int G) {
    const int nth = G * 512;
    for (int p = bid * 512 + tid; p < 16 * 8192; p += nth) {
        const int bh = p >> 13, idx = (p & 8191) * 2, k = idx & 127, b = bh >> 2, h = bh & 3;
        f32x2 S = {0.f, 0.f};
#pragma unroll 16
        for (int c = 0; c < 64; ++c) { const size_t u = (size_t)(((b * 64 + c) << 2) | h);
            *(unsigned*)(HS + u * 16384 + idx) = pk2(S[0], S[1]);
            const f32x2 d = *(const f32x2*)(DEC + u * 128 + k), ds = *(const f32x2*)(DS + u * 16384 + idx);
            S = d * S + ds; }
    }
}

__device__ __forceinline__ void hgrn_c3_unit(LAS unsigned char* L, const bf16_t* Z, int unit, const float* lbl, int layer, const bf16_t* HS, const float* ng, bf16_t* O, int tid, int wave, int lane) {
    const int h = unit & 3, cg_ = unit >> 2, tok0 = cg_ * 64;
    const int k = tid & 127, qtr = tid >> 7;
    LAS float* qsum = (LAS float*)L;
    LAS bf16_t* kT = (LAS bf16_t*)(L + 2048);
    LAS bf16_t* qT = kT + 128 * 72;
    LAS bf16_t* qC = qT + 128 * 72;
    LAS bf16_t* vt = qC + 128 * 72;
    LAS float* oL = (LAS float*)(L + 2048 + 4 * 128 * 72 * 2);
    const float lb = hgrn_lb(lbl, layer, h * 128 + k);
    float G[16], kk[16], qv[16]; float run = 0.f;
    unsigned vraw[16];
#pragma unroll
    for (int i = 0; i < 16; ++i) { const size_t tok = (size_t)(tok0 + 16 * qtr + i);
        const float zf = bf2f(Z[tok * NZ_ + ZFC + h * 128 + k]);
        qv[i] = bf2f(Z[tok * NZ_ + ZQC + h * 128 + k]);
        vraw[i] = Z[tok * NZ_ + ZIC + h * 128 + k];
        const float e = fexp(-zf), sg = frcp(1.0f + e);
        const float f = lb + (1.0f - lb) * sg;
        run += logf(fmaxf(f, 1e-6f)); G[i] = run; kk[i] = (1.0f - lb) * e * sg; }
    qsum[qtr * 128 + k] = run;
    __syncthreads();
    float off = 0.f;
#pragma unroll
    for (int qq = 0; qq < 4; ++qq) { const float v = qsum[qq * 128 + k]; if (qq < qtr) off += v; }
    const float Gm = qsum[k] + qsum[128 + k];
    {
        unsigned kw[8], qw[8], cw[8];
#pragma unroll
        for (int i = 0; i < 8; ++i) { float a[2], b[2], c[2];
#pragma unroll
            for (int e = 0; e < 2; ++e) { const float Gi = G[2 * i + e] + off; const float d = fminf(fmaxf(Gi - Gm, -80.f), 80.f);
                a[e] = kk[2 * i + e] * fexp(-d); b[e] = qv[2 * i + e] * fexp(d); c[e] = qv[2 * i + e] * fexp(Gi); }
            kw[i] = pk2(a[0], a[1]); qw[i] = pk2(b[0], b[1]); cw[i] = pk2(c[0], c[1]); }
        *(LAS u32x4*)(kT + k * 72 + 16 * qtr) = (u32x4){kw[0], kw[1], kw[2], kw[3]}; *(LAS u32x4*)(kT + k * 72 + 16 * qtr + 8) = (u32x4){kw[4], kw[5], kw[6], kw[7]};
        *(LAS u32x4*)(qT + k * 72 + 16 * qtr) = (u32x4){qw[0], qw[1], qw[2], qw[3]}; *(LAS u32x4*)(qT + k * 72 + 16 * qtr + 8) = (u32x4){qw[4], qw[5], qw[6], qw[7]};
        *(LAS u32x4*)(qC + k * 72 + 16 * qtr) = (u32x4){cw[0], cw[1], cw[2], cw[3]}; *(LAS u32x4*)(qC + k * 72 + 16 * qtr + 8) = (u32x4){cw[4], cw[5], cw[6], cw[7]};
    }
    {
        unsigned vw[8];
#pragma unroll
        for (int i = 0; i < 8; ++i) vw[i] = vraw[2 * i] | (vraw[2 * i + 1] << 16);
        *(LAS u32x4*)(vt + k * 72 + 16 * qtr) = (u32x4){vw[0], vw[1], vw[2], vw[3]}; *(LAS u32x4*)(vt + k * 72 + 16 * qtr + 8) = (u32x4){vw[4], vw[5], vw[6], vw[7]};
    }
    __syncthreads();
    const int qi = lane & 15, g = lane >> 4, tt = wave & 3, vh = wave >> 2;
    const bf16_t* hs = HS + (size_t)unit * 16384;
    bf16x8 ahs[4][4];
#pragma unroll
    for (int ks = 0; ks < 4; ++ks)
#pragma unroll
        for (int v_ = 0; v_ < 4; ++v_) ahs[ks][v_] = *(const bf16x8*)(hs + (16 * (4 * vh + v_) + qi) * 128 + ks * 32 + g * 8);
    unsigned graw[8][2];
#pragma unroll
    for (int r = 0; r < 8; ++r) { const size_t tok = (size_t)(tok0 + 8 * wave + r); graw[r][0] = Z[tok * NZ_ + ZGC + h * 128 + lane]; graw[r][1] = Z[tok * NZ_ + ZGC + h * 128 + 64 + lane]; }
    f32x4 sc[4];
#pragma unroll
    for (int st = 0; st < 4; ++st) { sc[st] = (f32x4){0.f, 0.f, 0.f, 0.f};
        if (st <= tt) {
#pragma unroll
            for (int ks = 0; ks < 4; ++ks) { const int ro = (ks * 32 + 8 * g + (qi >> 2)) * 72 + 4 * (qi & 3);
                const bf16x8 a = mk8(tr16(kT + ro + 16 * st), tr16(kT + ro + 4 * 72 + 16 * st)), b = mk8(tr16(qT + ro + 16 * tt), tr16(qT + ro + 4 * 72 + 16 * tt));
                sc[st] = mfma16(a, b, sc[st]); }
#pragma unroll
            for (int j = 0; j < 4; ++j) if (16 * st + 4 * g + j > 16 * tt + qi) sc[st][j] = 0.f;
        } }
    f32x4 o[4];
#pragma unroll
    for (int v_ = 0; v_ < 4; ++v_) o[v_] = (f32x4){0.f, 0.f, 0.f, 0.f};
#pragma unroll
    for (int i = 0; i < 2; ++i) {
        u32x4 pw; pw.x = pk2(sc[2 * i][0], sc[2 * i][1]); pw.y = pk2(sc[2 * i][2], sc[2 * i][3]); pw.z = pk2(sc[2 * i + 1][0], sc[2 * i + 1][1]); pw.w = pk2(sc[2 * i + 1][2], sc[2 * i + 1][3]);
        const bf16x8 bp = __builtin_bit_cast(bf16x8, pw);
#pragma unroll
        for (int v_ = 0; v_ < 4; ++v_) { const LAS bf16_t* vr = vt + (16 * (4 * vh + v_) + qi) * 72 + 4 * g;
            const u32x2 va = *(const LAS u32x2*)(vr + (2 * i) * 16), vb = *(const LAS u32x2*)(vr + (2 * i + 1) * 16);
            o[v_] = mfma16(mk8(va, vb), bp, o[v_]); } }
#pragma unroll
    for (int ks = 0; ks < 4; ++ks) { const int ro = (ks * 32 + 8 * g + (qi >> 2)) * 72 + 4 * (qi & 3) + 16 * tt; const bf16x8 b = mk8(tr16(qC + ro), tr16(qC + ro + 4 * 72));
#pragma unroll
        for (int v_ = 0; v_ < 4; ++v_) o[v_] = mfma16(ahs[ks][v_], b, o[v_]); }
#pragma unroll
    for (int v_ = 0; v_ < 4; ++v_) *(LAS f32x4*)(oL + (16 * tt + qi) * 132 + 16 * (4 * vh + v_) + 4 * g) = o[v_];
    __syncthreads();
    const float ng0 = ng[h * 128 + lane], ng1 = ng[h * 128 + 64 + lane];
#pragma unroll
    for (int r = 0; r < 8; ++r) { const int t = 8 * wave + r;
        const float x0 = oL[t * 132 + lane], x1 = oL[t * 132 + 64 + lane];
        const float ss = wave_sum(x0 * x0 + x1 * x1);
        const float rs = 1.0f / sqrtf(ss * (1.f / 128.f) + LN_EPS);
        const size_t tok = (size_t)(tok0 + t);
        const float g0 = bf2f(graw[r][0]), g1 = bf2f(graw[r][1]);
        const float y0 = x0 * rs * ng0 * fsigmoid(g0), y1 = x1 * rs * ng1 * fsigmoid(g1);
        O[tok * NO_ + 1024 + h * 128 + lane] = (bf16_t)(pk2(y0, 0.f) & 0xffffu);
        O[tok * NO_ + 1024 + h * 128 + 64 + lane] = (bf16_t)(pk2(y1, 0.f) & 0xffffu); }
    __syncthreads();
}

__device__ __forceinline__ void dcomb_phase(const float* DPO, const float* DLSE, bf16_t* O, int tid, int bid, int G) {
    const int nth = G * 512;
#pragma unroll 4
    for (int i = bid * 512 + tid; i < T_ * 64; i += nth) { const int t = i >> 6, c4 = (i & 63) * 4, h = c4 >> 6;
        const float l0 = DLSE[((size_t)0 * T_ + t) * 4 + h], l1 = DLSE[((size_t)1 * T_ + t) * 4 + h], l2 = DLSE[((size_t)2 * T_ + t) * 4 + h];
        const float m = fmaxf(l0, fmaxf(l1, l2));
        float w0 = fexp(l0 - m), w1 = fexp(l1 - m), w2 = fexp(l2 - m); const float inv = 1.0f / (w0 + w1 + w2); w0 *= inv; w1 *= inv; w2 *= inv;
        const f32x4 a = *(const f32x4*)(DPO + ((size_t)0 * T_ + t) * 256 + c4), b = *(const f32x4*)(DPO + ((size_t)1 * T_ + t) * 256 + c4), c = *(const f32x4*)(DPO + ((size_t)2 * T_ + t) * 256 + c4);
        const f32x4 r = w0 * a + w1 * b + w2 * c;
        u32x2 w; w.x = pk2(r[0], r[1]); w.y = pk2(r[2], r[3]);
        *(u32x2*)(O + (size_t)t * NO_ + 1536 + c4) = w; }
}

constexpr int NPH_LAYER = 14, NPH = 2 * NPH_LAYER;
__global__ void __launch_bounds__(512, 2) hybrid_fwd(Args a) {
    extern __shared__ __attribute__((aligned(16))) unsigned char lds_raw[];
    LAS unsigned char* lds = (LAS unsigned char*)lds_raw;
    PTab pt = (PTab)(lds + 131072);
    if (threadIdx.x == 0) {
#pragma unroll
        for (int i = 0; i < 22; ++i) pt[i] = (unsigned long long)a.in[i];
        pt[22] = (unsigned long long)a.out; pt[23] = (unsigned long long)a.ws;
    }
    if (threadIdx.x < 8) ((LAS unsigned*)(lds + 131072 + 512))[threadIdx.x] = 0u;
    __syncthreads();
    const int ph_lo = a.ph_lo, ph_hi = a.ph_hi;
    XcdBarrier bar = xcd_barrier_post((unsigned*)(a.ws + WS_CTL + WS_BAR), (volatile LAS unsigned*)(lds + 131072 + 512));
    for (int ph = ph_lo; ph < ph_hi; ++ph) {
        const int l = ph / NPH_LAYER, p = ph - l * NPH_LAYER;
        pg8::StaticOrder S;
        int tid = threadIdx.x; asm volatile("" : "+v"(tid));
        int bid = blockIdx.x, G = gridDim.x; asm volatile("" : "+s"(bid), "+s"(G));
        const int lane = tid & 63, wave = __builtin_amdgcn_readfirstlane(tid >> 6);
        unsigned char* ws = (unsigned char*)ldptr(pt, 23);
#define P_X ((float*)ldptr(pt, 22))
#define P_XB ((bf16_t*)(ws + WS_XB))
#define P_ZH ((bf16_t*)(ws + WS_ZH))
#define P_GATE ((bf16_t*)(ws + WS_GATE))
#define P_O ((bf16_t*)(ws + WS_O))
#define P_DS ((float*)(ws + WS_DS))
#define P_DEC ((float*)(ws + WS_CTL))
#define P_HS ((bf16_t*)(ws + WS_HS))
#define P_DPO ((float*)(ws + WS_DPO))
#define P_DLSE ((float*)(ws + WS_DLSE))
        switch (p) {
        case 0: if (l == 0) convert_phase(pt, 0, lds, tid, wave, lane, bid, G); break;
        case 1: case 11: {
            const int s = (p == 1) ? 0 : 1; const int n_ = (p == 1) ? 2 * FF_ : 2 * FF_ + D_;
            pg8::Gemm g{P_XB, (const bf16_t*)(ws + WS_WGU + (size_t)s * 44 * MiB), T_, n_, D_}; S.init(T_, n_, G, bid);
            pg8::EpiSwiGLU E{P_ZH, P_GATE}; pg8::gemm_phase(lds, g, S, E);
        } break;
        case 2: {
            pg8::Gemm g{P_ZH, (const bf16_t*)(ws + WS_WD), T_, D_, FF_}; S.init(T_, D_, G, bid);
            pg8::EpiResidT<false> E{P_X, P_XB, nullptr, ALPHA, 0.5f}; pg8::gemm_phase<pg8::EpiResidT<false>, true>(lds, g, S, E);
        } break;
        case 3: case 10: case 13: {
            const int which = (p == 3) ? 0 : (p == 10 ? 1 : 2);
            ln_phase(P_X, P_XB, ldptr(pt, 2) + (size_t)(l * 3 + which) * D_, ldptr(pt, 3) + (size_t)(l * 3 + which) * D_, (l == 1 && p == 13), wave, lane, bid, G);
            if (p == 13 && l == 0) convert_phase(pt, 1, lds, tid, wave, lane, bid, G);
            if (p == 10) { int kp = PLE_; asm volatile("" : "+s"(kp)); pg8::Gemm g2{(const bf16_t*)(ws + WS_PB) + (size_t)l * T_ * PLE_, (const bf16_t*)(ws + WS_WPP), T_, D_, kp}; S.init(T_, D_, G, bid);
                pg8::EpiBf16 E2{P_GATE, D_}; pg8::gemm_phase(lds, g2, S, E2); }
        } break;
        case 4: {
            pg8::Gemm g{P_XB, (const bf16_t*)(ws + WS_WIN), T_, NIN_, D_}; S.init(T_, NIN_, G, bid);
            pg8::EpiZ E{P_ZH, P_GATE}; pg8::gemm_phase(lds, g, S, E);
        } break;
        case 5: {
            for (int u = bid; u < 2560; u += G) attn_unit(lds, P_ZH, u, ldptr(pt, 8) + l * 8, P_O, P_DPO, P_DLSE, tid, wave, lane);
            for (int u = bid; u < 512; u += G) gmlp_unit(lds, P_ZH, u, ldptr(pt, 9) + l * 512, ldptr(pt, 10) + l * 512, ldptr(pt, 11) + (size_t)l * 65536, ldptr(pt, 12) + l * 512, P_O, tid, wave, lane);
            for (int u = bid; u < 1024; u += G) hgrn_c1_unit(lds, P_ZH, u, ldptr(pt, 13), l, P_DS, P_DEC, tid, wave, lane);
        } break;
        case 6: hgrn_scan_phase(P_DS, P_DEC, P_HS, tid, bid, G); break;
        case 7: {
            for (int u = bid; u < 1024; u += G) hgrn_c3_unit(lds, P_ZH, u, ldptr(pt, 13), l, P_HS, ldptr(pt, 14) + l * 512, P_O, tid, wave, lane);
            dcomb_phase(P_DPO, P_DLSE, P_O, tid, bid, G);
        } break;
        case 8: {
            pg8::Gemm g{P_O, (const bf16_t*)(ws + WS_WBR), T_, D_, NO_}; S.init(T_, D_, G, bid);
            pg8::EpiBR E{P_ZH, P_GATE}; pg8::gemm_phase(lds, g, S, E);
        } break;
        case 9: {
            pg8::Gemm g{P_ZH, (const bf16_t*)(ws + WS_WOUT), T_, D_, D_}; S.init(T_, D_, G, bid);
            pg8::EpiResidT<false> E{P_X, P_XB, nullptr, ALPHA, 1.0f}; pg8::gemm_phase(lds, g, S, E);
        } break;
        case 12: {
            pg8::Gemm g{P_ZH, (const bf16_t*)(ws + WS_WD + (size_t)22 * MiB), T_, D_, FF_}; S.init(T_, D_, G, bid);
            pg8::EpiResidT<true> E{P_X, P_XB, P_GATE, ALPHA, 0.5f}; pg8::gemm_phase<pg8::EpiResidT<true>, true>(lds, g, S, E);
        } break;
        default: break;
        }
        if (ph + 1 < ph_hi) { if (ph_hi > 1000) { __threadfence(); cg::this_grid().sync(); } else xcd_barrier(bar); }
    }
}

extern "C" void kernel_launch(void* const* d_in, const int* in_sizes, int n_in, void* d_out, int out_size, void* d_ws, size_t ws_size, hipStream_t stream) {
    static int grid = 0;
    if (grid == 0) {
        if (n_in != 22 || out_size != T_ * D_ || ws_size < WS_END) { fprintf(stderr, "kernel_launch: unexpected shapes (n_in %d out %d ws %zu need %zu)\n", n_in, out_size, ws_size, (size_t)WS_END); grid = -1; return; }
        int dev = 0, cus = 0, per_cu = 0;
        hipGetDevice(&dev); hipDeviceGetAttribute(&cus, hipDeviceAttributeMultiprocessorCount, dev);
        if (hipFuncSetAttribute((const void*)hybrid_fwd, hipFuncAttributeMaxDynamicSharedMemorySize, LDS_BYTES) != hipSuccess) { fprintf(stderr, "kernel_launch: hipFuncSetAttribute failed\n"); grid = -1; return; }
        hipOccupancyMaxActiveBlocksPerMultiprocessor(&per_cu, (const void*)hybrid_fwd, 512, LDS_BYTES);
        (void)hipGetLastError();
        if (per_cu < 1) per_cu = 1;
        grid = cus * 1;
    }
    if (grid < 0) return;
    if (hipMemsetAsync((char*)d_ws + WS_CTL + WS_BAR, 0, BAR_BYTES, stream) != hipSuccess) { fprintf(stderr, "kernel_launch: memset failed\n"); return; }
    Args a{};
    for (int i = 0; i < 22; ++i) a.in[i] = (const float*)d_in[i];
    a.out = (float*)d_out; a.ws = (unsigned char*)d_ws; a.ph_lo = 0; a.ph_hi = NPH;
    void* args[] = {&a};
    hipError_t e = hipLaunchCooperativeKernel((const void*)hybrid_fwd, dim3(grid), dim3(512), args, LDS_BYTES, stream);
    if (e != hipSuccess) fprintf(stderr, "cooperative launch failed: %s (grid %d)\n", hipGetErrorString(e), grid);
}
```

```cpp
#include <hip/hip_runtime.h>
#include <hip/hip_cooperative_groups.h>
#include <cstdio>
#include <cstdint>
namespace cg = cooperative_groups;

#define LAS __attribute__((address_space(3)))
typedef unsigned short bf16_t;
typedef short bf16x8 __attribute__((ext_vector_type(8)));
typedef float f32x4 __attribute__((ext_vector_type(4)));
typedef float f32x2 __attribute__((ext_vector_type(2)));
typedef unsigned u32x4 __attribute__((ext_vector_type(4)));
typedef unsigned u32x2 __attribute__((ext_vector_type(2)));

constexpr int T_ = 16384, SEQ_ = 4096, D_ = 2048, FF_ = 5632, NIN_ = 14336, NZ_ = 6144, NGT_ = 8192, NO_ = 1792, PLE_ = 256;
constexpr int ZQA = 0, ZKA = 512, ZVA = 640, ZUB = 768, ZVB = 1280, ZQC = 1792, ZFC = 2304, ZIC = 2816, ZGC = 3328, ZQD = 3840, ZKD = 4608, ZVD = 5376;
constexpr float LN_EPS = 1e-5f;
constexpr float ALPHA = 1.41421356237f;
constexpr float LOG2E = 1.44269504089f;

constexpr size_t MiB = 1u << 20;
constexpr size_t WS_CTL = 0;
constexpr size_t WS_BAR = 768 * 1024, BAR_BYTES = 32768;
constexpr size_t WS_WGU = 1 * MiB;
constexpr size_t WS_WPG = WS_WGU + 88 * MiB;
constexpr size_t WS_WD = WS_WPG + 8 * MiB;
constexpr size_t WS_WIN = WS_WD + 44 * MiB;
constexpr size_t WS_WBR = WS_WIN + 56 * MiB;
constexpr size_t WS_WOUT = WS_WBR + 7 * MiB;
constexpr size_t WS_WPP = WS_WOUT + 8 * MiB;
constexpr size_t WS_PB = WS_WPP + 1 * MiB;
constexpr size_t WS_XB = WS_PB + 16 * MiB;
constexpr size_t WS_ZH = WS_XB + 64 * MiB;
constexpr size_t WS_GATE = WS_ZH + 192 * MiB;
constexpr size_t WS_O = WS_GATE + 256 * MiB;
constexpr size_t WS_HS = WS_O + 56 * MiB;
constexpr size_t WS_DPO = WS_HS + 32 * MiB;
constexpr size_t WS_DLSE = WS_DPO + 48 * MiB;
constexpr size_t WS_DS = WS_DLSE + 1 * MiB;
constexpr size_t WS_END = WS_DS + 64 * MiB;

constexpr int LDS_BYTES = 147456;

__device__ __forceinline__ float bf2f(unsigned b) { return __uint_as_float(b << 16); }
__device__ __forceinline__ float bflo(unsigned w) { return __uint_as_float(w << 16); }
__device__ __forceinline__ float bfhi(unsigned w) { return __uint_as_float(w & 0xffff0000u); }
__device__ __forceinline__ unsigned pk2(float lo, float hi) { unsigned r; asm("v_cvt_pk_bf16_f32 %0, %1, %2" : "=v"(r) : "v"(lo), "v"(hi)); return r; }
__device__ __forceinline__ float fexp(float x) { return __builtin_amdgcn_exp2f(x * LOG2E); }
__device__ __forceinline__ float frcp(float x) { return __builtin_amdgcn_rcpf(x); }
__device__ __forceinline__ float fsigmoid(float x) { return frcp(1.0f + fexp(-x)); }
__device__ __forceinline__ float gelu_erf(float x) { return 0.5f * x * (1.0f + erff(x * 0.70710678118f)); }
__device__ __forceinline__ float gelu_fast(float v) {
    const float av = fabsf(v), t = frcp(av * 0.2316418882f + 1.0f);
    float q = t * 0.5307027145f + (-0.7265760135f); q = q * t + 0.7107068705f; q = q * t + (-0.142248368f); q = q * t + 0.127414796f; q = q * t;
    const float e = __builtin_amdgcn_exp2f((v * v) * (-0.72134752044f));
    const float m = v * (q * e);
    return v < 0.f ? m : v - m;
}
__device__ __forceinline__ float wave_sum(float v) {
#pragma unroll
    for (int o = 1; o < 64; o <<= 1) v += __shfl_xor(v, o);
    return v;
}
__device__ __forceinline__ f32x4 mfma16(bf16x8 a, bf16x8 b, f32x4 c) { return __builtin_amdgcn_mfma_f32_16x16x32_bf16(a, b, c, 0, 0, 0); }
typedef short s16x4 __attribute__((ext_vector_type(4)));
__device__ __forceinline__ u32x2 tr16(const LAS bf16_t* p) { const s16x4 r = __builtin_amdgcn_ds_read_tr16_b64_v4i16((LAS s16x4*)p); return __builtin_bit_cast(u32x2, r); }
__device__ __forceinline__ bf16x8 mk8(u32x2 a, u32x2 b) { u32x4 t = {a.x, a.y, b.x, b.y}; return __builtin_bit_cast(bf16x8, t); }

namespace pg8 {
constexpr int BM = 256, BK = 64, HALF = 128, HTB = HALF * BK * 2, STAGE_BYTES = 8 * HTB, NXCD = 8, WGM = 8;
__device__ __forceinline__ int lds_byte(int r, int c) { const int st = (r >> 4) * 2 + (c >> 5), rr = r & 15, cc = c & 31, ob = rr * 64 + cc * 2; return st * 1024 + (ob ^ (((ob >> 9) & 1) << 5)); }
__device__ __forceinline__ void stage_rc(int b, int& R, int& C) { const int st = b / 1024, sb = b % 1024, swz = sb ^ (((sb >> 9) & 1) << 5); R = (st >> 1) * 16 + swz / 64; C = (st & 1) * 32 + (swz % 64) / 2; }
__device__ __forceinline__ int perm32(int rho) { const int n = rho >> 4, i = rho & 15; return 8 * (i >> 2) + 4 * n + (i & 3); }
struct Unit { int pm, pn; };
struct Gemm { const bf16_t* A; const bf16_t* Bt; int M, N, K; };
struct StaticOrder {
    int nM, nN, nwg, G, c;
    __device__ void init(int M, int N, int G_, int c_) { nM = M / BM; nN = N / BM; nwg = nM * nN; G = G_; c = c_; }
    __device__ bool next(int i, Unit& u) const {
        const long L = (long)i * G + c; if (L >= nwg) return false;
        int wgid = (int)L; { const int q = nwg / NXCD, r = nwg % NXCD, xcd = wgid % NXCD, off = wgid / NXCD; wgid = (xcd < r ? xcd * (q + 1) : r * (q + 1) + (xcd - r) * q) + off; }
        const int nig = WGM * nN, gid = wgid / nig, fm = gid * WGM, gsz = (nM - fm) < WGM ? (nM - fm) : WGM;
        u.pm = fm + ((wgid % nig) % gsz); u.pn = (wgid % nig) / gsz; return true;
    }
};

struct EpiSwiGLU {
    static constexpr bool PERM = true, HAS_MID = false;
    bf16_t* H; bf16_t* PP;
    __device__ __forceinline__ void mid(int, f32x4 (&)[2][2][4][2], const Unit&, int, int, int, int) const {}
    __device__ __forceinline__ void operator()(const f32x4 (&acc)[2][2][4][2], const Unit& u, int wr, int wc, int fr, int fq) const {
        const int row0 = u.pm * BM + wr * 64 + fr;
        if (u.pn < 44) {
            const int col0 = u.pn * 128 + wc * 32 + 8 * fq;
#pragma unroll
            for (int ai = 0; ai < 2; ++ai)
#pragma unroll
                for (int m = 0; m < 4; ++m) {
                    bf16_t* rowp = H + (size_t)(row0 + ai * HALF + m * 16) * FF_ + col0;
                    float h[8];
#pragma unroll
                    for (int n = 0; n < 2; ++n)
#pragma unroll
                        for (int j = 0; j < 4; ++j) { const float g = acc[ai][0][m][n][j], up = acc[ai][1][m][n][j]; h[n * 4 + j] = g * fsigmoid(g) * up; }
                    u32x4 w; w.x = pk2(h[0], h[1]); w.y = pk2(h[2], h[3]); w.z = pk2(h[4], h[5]); w.w = pk2(h[6], h[7]);
                    *(u32x4*)rowp = w;
                    asm volatile("" ::: "memory"); __builtin_amdgcn_sched_barrier(0);
                }
        } else {
            const int col0 = (u.pn - 44) * BM + wc * 32 + 8 * fq;
#pragma unroll
            for (int am = 0; am < 4; ++am) { const int ai = am >> 1, mb = (am & 1) * 2;
                u32x4 pv[2][2];
#pragma unroll
                for (int mm = 0; mm < 2; ++mm)
#pragma unroll
                    for (int bj = 0; bj < 2; ++bj) pv[mm][bj] = *(const u32x4*)(PP + (size_t)(row0 + ai * HALF + (mb + mm) * 16) * D_ + col0 + bj * HALF);
#pragma unroll
                for (int mm = 0; mm < 2; ++mm) { const int m = mb + mm;
                    bf16_t* rowp = PP + (size_t)(row0 + ai * HALF + m * 16) * D_ + col0;
#pragma unroll
                    for (int bj = 0; bj < 2; ++bj) {
                        const u32x4 p = pv[mm][bj];
                        const f32x4 a0 = acc[ai][bj][m][0], a1 = acc[ai][bj][m][1];
                        u32x4 w;
                        w.x = pk2(fsigmoid(a0[0]) * bflo(p.x), fsigmoid(a0[1]) * bfhi(p.x)); w.y = pk2(fsigmoid(a0[2]) * bflo(p.y), fsigmoid(a0[3]) * bfhi(p.y));
                        w.z = pk2(fsigmoid(a1[0]) * bflo(p.z), fsigmoid(a1[1]) * bfhi(p.z)); w.w = pk2(fsigmoid(a1[2]) * bflo(p.w), fsigmoid(a1[3]) * bfhi(p.w));
                        *(u32x4*)(rowp + bj * HALF) = w;
                    }
                }
                asm volatile("" ::: "memory"); __builtin_amdgcn_sched_barrier(0);
            }
        }
    }
};
template <bool ADD> struct EpiResidT {
    static constexpr bool PERM = false, HAS_MID = false;
    float* Y; const bf16_t* XB; const bf16_t* PP; float a, b;
    __device__ __forceinline__ void mid(int, f32x4 (&)[2][2][4][2], const Unit&, int, int, int, int) const {}
    __device__ __forceinline__ void operator()(const f32x4 (&acc)[2][2][4][2], const Unit& u, int wr, int wc, int fr, int fq) const {
        const int row0 = u.pm * BM + wr * 64 + fr, col0 = u.pn * BM + wc * 32 + 4 * fq;
        constexpr int GM = ADD ? 2 : 4;
#pragma unroll
        for (int ai = 0; ai < 2; ++ai)
#pragma unroll
            for (int m0 = 0; m0 < 4; m0 += GM) {
                u32x2 xb[GM][2][2], pp[GM][2][2];
#pragma unroll
                for (int mm = 0; mm < GM; ++mm) { const size_t off = (size_t)(row0 + ai * HALF + (m0 + mm) * 16) * D_ + col0;
#pragma unroll
                    for (int bj = 0; bj < 2; ++bj)
#pragma unroll
                        for (int n = 0; n < 2; ++n) { xb[mm][bj][n] = *(const u32x2*)(XB + off + bj * HALF + n * 16); if (ADD) pp[mm][bj][n] = *(const u32x2*)(PP + off + bj * HALF + n * 16); } }
#pragma unroll
                for (int mm = 0; mm < GM; ++mm) { const int m = m0 + mm; const size_t off = (size_t)(row0 + ai * HALF + m * 16) * D_ + col0;
#pragma unroll
                    for (int bj = 0; bj < 2; ++bj)
#pragma unroll
                        for (int n = 0; n < 2; ++n) { const u32x2 x = xb[mm][bj][n]; const f32x4 s = acc[ai][bj][m][n];
                            f32x4 y; y[0] = a * bflo(x.x) + b * s[0]; y[1] = a * bfhi(x.x) + b * s[1]; y[2] = a * bflo(x.y) + b * s[2]; y[3] = a * bfhi(x.y) + b * s[3];
                            if (ADD) { const u32x2 q = pp[mm][bj][n]; y[0] += bflo(q.x); y[1] += bfhi(q.x); y[2] += bflo(q.y); y[3] += bfhi(q.y); }
                            *(f32x4*)(Y + off + bj * HALF + n * 16) = y; } }
                asm volatile("" ::: "memory"); __builtin_amdgcn_sched_barrier(0);
            }
    }
};
struct EpiZ {
    static constexpr bool PERM = true, HAS_MID = false;
    bf16_t* Z; bf16_t* GATE;
    __device__ __forceinline__ void mid(int, f32x4 (&)[2][2][4][2], const Unit&, int, int, int, int) const {}
    __device__ __forceinline__ void operator()(const f32x4 (&acc)[2][2][4][2], const Unit& u, int wr, int wc, int fr, int fq) const {
        const int row0 = u.pm * BM + wr * 64 + fr;
        if (u.pn < 24) {
            const bool isgelu = (u.pn >= 3) && (u.pn <= 6);
            const int col0 = u.pn * BM + wc * 32 + 8 * fq;
#pragma unroll
            for (int ai = 0; ai < 2; ++ai)
#pragma unroll
                for (int m = 0; m < 4; ++m) {
                    bf16_t* rowp = Z + (size_t)(row0 + ai * HALF + m * 16) * NZ_ + col0;
#pragma unroll
                    for (int bj = 0; bj < 2; ++bj) {
                        f32x4 v0 = acc[ai][bj][m][0], v1 = acc[ai][bj][m][1];
                        if (isgelu) {
#pragma unroll
                            for (int j = 0; j < 4; ++j) { v0[j] = gelu_fast(v0[j]); v1[j] = gelu_fast(v1[j]); }
                        }
                        u32x4 w; w.x = pk2(v0[0], v0[1]); w.y = pk2(v0[2], v0[3]); w.z = pk2(v1[0], v1[1]); w.w = pk2(v1[2], v1[3]);
                        *(u32x4*)(rowp + bj * HALF) = w;
                    }
                    asm volatile("" ::: "memory"); __builtin_amdgcn_sched_barrier(0);
                }
        } else {
            const int mc0 = (u.pn - 24) * 64 + wc * 16 + 4 * fq;
#pragma unroll
            for (int ai = 0; ai < 2; ++ai)
#pragma unroll
                for (int m = 0; m < 4; ++m) {
                    bf16_t* rowp = GATE + (size_t)(row0 + ai * HALF + m * 16) * D_ + mc0;
                    f32x4 e[4];
#pragma unroll
                    for (int br = 0; br < 4; ++br)
#pragma unroll
                        for (int j = 0; j < 4; ++j) e[br][j] = fminf(1.0f + fexp(-acc[ai][br >> 1][m][br & 1][j]), 1e30f);
                    f32x4 i0, i1, i2, i3;
#pragma unroll
                    for (int j = 0; j < 4; ++j) { i0[j] = frcp(e[0][j]); i1[j] = frcp(e[1][j]); i2[j] = frcp(e[2][j]); i3[j] = frcp(e[3][j]); }
                    const f32x4 r0 = e[1] * i0, r1 = e[2] * i1, r2 = e[3] * i2;
                    u32x2 w;
                    w.x = pk2(r0[0], r0[1]); w.y = pk2(r0[2], r0[3]); *(u32x2*)(rowp) = w;
                    w.x = pk2(r1[0], r1[1]); w.y = pk2(r1[2], r1[3]); *(u32x2*)(rowp + (size_t)T_ * D_) = w;
                    w.x = pk2(r2[0], r2[1]); w.y = pk2(r2[2], r2[3]); *(u32x2*)(rowp + (size_t)2 * T_ * D_) = w;
                    w.x = pk2(i3[0], i3[1]); w.y = pk2(i3[2], i3[3]); *(u32x2*)(rowp + (size_t)3 * T_ * D_) = w;
                    asm volatile("" ::: "memory"); __builtin_amdgcn_sched_barrier(0);
                }
        }
    }
};
struct EpiBf16 {
    static constexpr bool PERM = true, HAS_MID = false;
    bf16_t* O; int ldc;
    __device__ __forceinline__ void mid(int, f32x4 (&)[2][2][4][2], const Unit&, int, int, int, int) const {}
    __device__ __forceinline__ void operator()(const f32x4 (&acc)[2][2][4][2], const Unit& u, int wr, int wc, int fr, int fq) const {
        const int row0 = u.pm * BM + wr * 64 + fr, col0 = u.pn * BM + wc * 32 + 8 * fq;
#pragma unroll
        for (int ai = 0; ai < 2; ++ai)
#pragma unroll
            for (int m = 0; m < 4; ++m) {
                bf16_t* rowp = O + (size_t)(row0 + ai * HALF + m * 16) * ldc + col0;
#pragma unroll
                for (int bj = 0; bj < 2; ++bj) {
                    const f32x4 v0 = acc[ai][bj][m][0], v1 = acc[ai][bj][m][1];
                    u32x4 w; w.x = pk2(v0[0], v0[1]); w.y = pk2(v0[2], v0[3]); w.z = pk2(v1[0], v1[1]); w.w = pk2(v1[2], v1[3]);
                    *(u32x4*)(rowp + bj * HALF) = w;
                }
                asm volatile("" ::: "memory"); __builtin_amdgcn_sched_barrier(0);
            }
    }
};
struct EpiBR {
    static constexpr bool PERM = true, HAS_MID = true;
    bf16_t* O; const bf16_t* GATE;
    __device__ __forceinline__ void scale(const bf16_t* plane, f32x4 (&acc)[2][2][4][2], const Unit& u, int wr, int wc, int fr, int fq) const {
        const int row0 = u.pm * BM + wr * 64 + fr, col0 = u.pn * BM + wc * 32 + 8 * fq;
        u32x4 r[2][4][2];
#pragma unroll
        for (int ai = 0; ai < 2; ++ai)
#pragma unroll
            for (int m = 0; m < 4; ++m)
#pragma unroll
                for (int bj = 0; bj < 2; ++bj) r[ai][m][bj] = *(const u32x4*)(plane + (size_t)(row0 + ai * HALF + m * 16) * D_ + col0 + bj * HALF);
#pragma unroll
        for (int ai = 0; ai < 2; ++ai)
#pragma unroll
            for (int m = 0; m < 4; ++m)
#pragma unroll
                for (int bj = 0; bj < 2; ++bj) { const u32x4 e = r[ai][m][bj];
                    acc[ai][bj][m][0] *= (f32x4){bflo(e.x), bfhi(e.x), bflo(e.y), bfhi(e.y)}; acc[ai][bj][m][1] *= (f32x4){bflo(e.z), bfhi(e.z), bflo(e.w), bfhi(e.w)}; }
    }
    __device__ __forceinline__ void mid(int t, f32x4 (&acc)[2][2][4][2], const Unit& u, int wr, int wc, int fr, int fq) const {
        if (t != 8 && t != 16 && t != 24) return;
        asm volatile("" : "+v"(fr), "+v"(fq));
        scale(GATE + (size_t)((t >> 3) - 1) * T_ * D_, acc, u, wr, wc, fr, fq);
    }
    __device__ __forceinline__ void operator()(f32x4 (&acc)[2][2][4][2], const Unit& u, int wr, int wc, int fr, int fq) const {
        scale(GATE + (size_t)3 * T_ * D_, acc, u, wr, wc, fr, fq);
        const int row0 = u.pm * BM + wr * 64 + fr, col0 = u.pn * BM + wc * 32 + 8 * fq;
#pragma unroll
        for (int ai = 0; ai < 2; ++ai)
#pragma unroll
            for (int m = 0; m < 4; ++m) {
                bf16_t* rowp = O + (size_t)(row0 + ai * HALF + m * 16) * D_ + col0;
#pragma unroll
                for (int bj = 0; bj < 2; ++bj) {
                    const f32x4 a0 = acc[ai][bj][m][0], a1 = acc[ai][bj][m][1];
                    u32x4 w; w.x = pk2(a0[0], a0[1]); w.y = pk2(a0[2], a0[3]); w.z = pk2(a1[0], a1[1]); w.w = pk2(a1[2], a1[3]);
                    *(u32x4*)(rowp + bj * HALF) = w;
                }
            }
    }
};

template <class Epi, bool KREV = false>
__device__ __forceinline__ void gemm_phase(LAS unsigned char* lds, const Gemm g, const StaticOrder& S, const Epi& E) {
    int tid = threadIdx.x; asm volatile("" : "+v"(tid));
    const int wid = __builtin_amdgcn_readfirstlane(tid >> 6), lane = tid & 63, wr = wid >> 2, wc = wid & 3, fr = lane & 15, fq = lane >> 4;
    const int K = g.K, nt = K / BK;
    unsigned voffA[2], voffB[2];
#pragma unroll
    for (int i = 0; i < 2; ++i) { int R, C; stage_rc(tid * 16 + i * 8192, R, C); const int Rb = Epi::PERM ? ((R & ~31) + perm32(R & 31)) : R;
        voffA[i] = (unsigned)(R * K + C) * 2u; voffB[i] = (unsigned)(Rb * K + C) * 2u; }
    const long kstep = KREV ? -(long)(BK * 2) : (long)(BK * 2);
    const size_t kbase = KREV ? (size_t)(nt - 1) * (BK * 2) : 0;
    const size_t hstep = (size_t)HALF * K * 2;
    const size_t tstep = 2 * hstep;
    const unsigned ldsw = (unsigned)wid * 1024u;
    const int aoff = lds_byte(wr * 64 + fr, fq * 8), boff = lds_byte(wc * 32 + fr, fq * 8);
#define PG8_SA(b, h) (((b) * 2 + (h)) * HTB)
#define PG8_SB(b, h) ((4 + (b) * 2 + (h)) * HTB)
#define PG8_STAGE(bufoff, gbase, voff) do { _Pragma("unroll") for (int _i = 0; _i < 2; ++_i) \
        __builtin_amdgcn_global_load_lds((const unsigned*)((const char*)(gbase) + (voff)[_i]), (LAS unsigned*)(lds + (bufoff) + ldsw + _i * 8192), 16, 0, 0); } while (0)
#define PG8_LDA(dst, b, h) do { _Pragma("unroll") for (int m = 0; m < 4; ++m) _Pragma("unroll") for (int k = 0; k < 2; ++k) dst[m][k] = *(const LAS bf16x8*)(lds + PG8_SA(b, h) + aoff + m * 2048 + k * 1024); } while (0)
#define PG8_LDB(dst, b, h) do { _Pragma("unroll") for (int n = 0; n < 2; ++n) _Pragma("unroll") for (int k = 0; k < 2; ++k) dst[n][k] = *(const LAS bf16x8*)(lds + PG8_SB(b, h) + boff + n * 2048 + k * 1024); } while (0)
#define PG8_MMA(ai, bj, At, Bt) do { __builtin_amdgcn_s_setprio(1); _Pragma("unroll") for (int m = 0; m < 4; ++m) _Pragma("unroll") for (int n = 0; n < 2; ++n) _Pragma("unroll") for (int k = 0; k < 2; ++k) \
        acc[ai][bj][m][n] = __builtin_amdgcn_mfma_f32_16x16x32_bf16(Bt[n][k], At[m][k], acc[ai][bj][m][n], 0, 0, 0); __builtin_amdgcn_s_setprio(0); } while (0)
#define PG8_WAIT_V(n) asm volatile("s_waitcnt vmcnt(" #n ")" ::: "memory")
#define PG8_WAIT_L(n) asm volatile("s_waitcnt lgkmcnt(" #n ")" ::: "memory")
#define PG8_BAR __builtin_amdgcn_s_barrier()
#define PG8_SCHED __builtin_amdgcn_sched_barrier(0)
    Unit cur, nxt; int ui = 0;
    if (!S.next(0, cur)) return;
    f32x4 acc[2][2][4][2];
#pragma unroll
    for (int a = 0; a < 2; ++a)
#pragma unroll
        for (int b = 0; b < 2; ++b)
#pragma unroll
            for (int m = 0; m < 4; ++m)
#pragma unroll
                for (int n = 0; n < 2; ++n) acc[a][b][m][n] = (f32x4){0.f, 0.f, 0.f, 0.f};
    bf16x8 At[4][2], B0[2][2], B1[2][2];
    const char* cA = (const char*)g.A + (size_t)cur.pm * tstep + kbase; const char* cB = (const char*)g.Bt + (size_t)cur.pn * tstep + kbase;
    PG8_STAGE(PG8_SB(0, 0), cB, voffB); PG8_STAGE(PG8_SB(0, 1), cB + hstep, voffB); PG8_STAGE(PG8_SA(0, 0), cA, voffA); PG8_STAGE(PG8_SA(0, 1), cA + hstep, voffA);
    if (wr == 1) PG8_BAR;
    PG8_WAIT_V(2); PG8_BAR;
    PG8_STAGE(PG8_SB(1, 0), cB + kstep, voffB); PG8_STAGE(PG8_SA(1, 0), cA + kstep, voffA); PG8_STAGE(PG8_SB(1, 1), cB + hstep + kstep, voffB);
    PG8_WAIT_V(6); PG8_BAR;
    for (;;) {
        const bool has_next = S.next(ui + 1, nxt);
        const char* nA = has_next ? (const char*)g.A + (size_t)nxt.pm * tstep + kbase : cA; const char* nB = has_next ? (const char*)g.Bt + (size_t)nxt.pn * tstep + kbase : cB;
        for (int t = 0; t < nt; t += 2) {
            const bool last = (t == nt - 2);
            const char* a1 = cA + (long)(t + 1) * kstep;
            const char* a2 = last ? nA : cA + (long)(t + 2) * kstep; const char* b2 = last ? nB : cB + (long)(t + 2) * kstep;
            const char* a3 = a2 + kstep; const char* b3 = b2 + kstep;
            if constexpr (Epi::HAS_MID) E.mid(t, acc, cur, wr, wc, fr, fq);
            PG8_LDB(B0, 0, 0); PG8_LDB(B1, 0, 1); PG8_SCHED; PG8_LDA(At, 0, 0); PG8_STAGE(PG8_SA(1, 1), a1 + hstep, voffA);
            PG8_WAIT_V(8); PG8_WAIT_L(0); PG8_BAR; PG8_MMA(0, 0, At, B0); PG8_MMA(0, 1, At, B1); PG8_BAR; PG8_SCHED;
            PG8_LDA(At, 0, 1); PG8_STAGE(PG8_SB(0, 0), b2, voffB); PG8_STAGE(PG8_SB(0, 1), b2 + hstep, voffB); PG8_STAGE(PG8_SA(0, 0), a2, voffA);
            PG8_WAIT_V(8); PG8_WAIT_L(0); PG8_BAR; PG8_MMA(1, 0, At, B0); PG8_MMA(1, 1, At, B1); PG8_BAR; PG8_SCHED;
            PG8_LDB(B0, 1, 0); PG8_LDB(B1, 1, 1); PG8_SCHED; PG8_LDA(At, 1, 0); PG8_STAGE(PG8_SA(0, 1), a2 + hstep, voffA);
            PG8_WAIT_V(8); PG8_WAIT_L(0); PG8_BAR; PG8_MMA(0, 0, At, B0); PG8_MMA(0, 1, At, B1); PG8_BAR; PG8_SCHED;
            PG8_LDA(At, 1, 1); PG8_STAGE(PG8_SB(1, 0), b3, voffB); PG8_STAGE(PG8_SB(1, 1), b3 + hstep, voffB); PG8_STAGE(PG8_SA(1, 0), a3, voffA);
            PG8_WAIT_V(8); PG8_WAIT_L(0); PG8_BAR; PG8_MMA(1, 0, At, B0); PG8_MMA(1, 1, At, B1); PG8_BAR; PG8_SCHED;
        }
        if (wr == 0) PG8_BAR;
#pragma unroll
        for (int a = 0; a < 2; ++a)
#pragma unroll
            for (int b = 0; b < 2; ++b)
#pragma unroll
                for (int m = 0; m < 4; ++m)
#pragma unroll
                    for (int n = 0; n < 2; ++n) asm volatile("" : "+v"(acc[a][b][m][n]));
        E(acc, cur, wr, wc, fr, fq);
        if (!has_next) break;
#pragma unroll
        for (int a = 0; a < 2; ++a)
#pragma unroll
            for (int b = 0; b < 2; ++b)
#pragma unroll
                for (int m = 0; m < 4; ++m)
#pragma unroll
                    for (int n = 0; n < 2; ++n) acc[a][b][m][n] = (f32x4){0.f, 0.f, 0.f, 0.f};
        cur = nxt; cA = nA; cB = nB; ++ui;
        if (wr == 1) PG8_BAR;
    }
    PG8_WAIT_V(0);
    PG8_BAR;
#undef PG8_SA
#undef PG8_SB
#undef PG8_STAGE
#undef PG8_LDA
#undef PG8_LDB
#undef PG8_MMA
#undef PG8_WAIT_V
#undef PG8_WAIT_L
#undef PG8_BAR
#undef PG8_SCHED
}
}

typedef __attribute__((address_space(1))) unsigned gu32;
#define XB_TMO      128
#define XB_XCNT(j)  (256  + 64 * (j))
#define XB_XSUB(j)  (1280 + 64 * (j))
#define XB_XGEN(j)  (2304 + 64 * (j))
#define XB_TOP      3328
#define XB_TOPGEN   3392
#define XCD_BAR_WORDS 3456
#define XB_SPIN_CAP (1u << 18)

__device__ __forceinline__ unsigned xb_ld(unsigned* p)              { return __hip_atomic_load(p, __ATOMIC_RELAXED, __HIP_MEMORY_SCOPE_AGENT); }
__device__ __forceinline__ unsigned xb_add(unsigned* p, unsigned v) { return __hip_atomic_fetch_add(p, v, __ATOMIC_RELAXED, __HIP_MEMORY_SCOPE_AGENT); }
__device__ __forceinline__ unsigned xb_xcc_id() { return (unsigned)__builtin_amdgcn_s_getreg((3 << 11) | 20) & 0xFu; }
#define XB_SPIN(cond, bar) do { unsigned _sp = 0; while (cond) { __builtin_amdgcn_s_sleep(1); \
    if ((++_sp & 255u) == 0u) { if (xb_ld(&(bar)[XB_TMO])) break; if (_sp > XB_SPIN_CAP) { atomicAdd(&(bar)[XB_TMO], 1u); break; } } } } while (0)

struct XcdBarrier {
    unsigned* bar; unsigned x;
    volatile LAS unsigned* st;
};

__device__ __forceinline__ XcdBarrier xcd_barrier_post(unsigned* bar, volatile LAS unsigned* st) {
    XcdBarrier b; b.bar = bar; b.x = xb_xcc_id(); b.st = st;
    if (threadIdx.x == 0) (void)xb_add(&bar[XB_XCNT(b.x)], 1u);
    return b;
}
__device__ __forceinline__ void xcd_barrier_complete(unsigned* bar, unsigned x, unsigned& nloc, unsigned& nx) {
    const unsigned G = gridDim.x * gridDim.y * gridDim.z;
    unsigned sum, cnt, mine, sp = 0u;
    for (;;) {
        sum = 0u; cnt = 0u; mine = 0u;
#pragma unroll
        for (unsigned j = 0; j < 16; ++j) { const unsigned c = xb_ld(&bar[XB_XCNT(j)]); sum += c; cnt += (c > 0u) ? 1u : 0u; mine = (j == x) ? c : mine; }
        if (sum == G) break;
        __builtin_amdgcn_s_sleep(1);
        if ((++sp & 255u) == 0u) { if (xb_ld(&bar[XB_TMO])) break; if (sp > XB_SPIN_CAP) { atomicAdd(&bar[XB_TMO], 1u); break; } }
    }
    nloc = mine > 0u ? mine : 1u; nx = cnt > 0u ? cnt : 1u;
}

__device__ __forceinline__ void xcd_barrier(const XcdBarrier& b) {
    asm volatile("s_waitcnt vmcnt(0)" ::: "memory");
    __syncthreads();
    if (threadIdx.x == 0) {
        unsigned* bar = b.bar;
        __builtin_amdgcn_s_waitcnt(0);
        unsigned nloc = b.st[0], nx = b.st[1];
        if (nloc == 0u) { xcd_barrier_complete(bar, b.x, nloc, nx); b.st[0] = nloc; b.st[1] = nx; }
        const unsigned old = xb_add(&bar[XB_XSUB(b.x)], 1u);
        const unsigned gen = old / nloc;
        if (old + 1u == (gen + 1u) * nloc) {
            __builtin_amdgcn_fence(__ATOMIC_RELEASE, "agent");
            asm volatile("s_waitcnt vmcnt(0)" ::: "memory");
            const unsigned og = xb_add(&bar[XB_TOP], 1u);
            const unsigned tg = og / nx;
            if (og + 1u == (tg + 1u) * nx) xb_add(&bar[XB_TOPGEN], 1u);
            else XB_SPIN(xb_ld(&bar[XB_TOPGEN]) == tg, bar);
            __builtin_amdgcn_fence(__ATOMIC_ACQUIRE, "agent");
            xb_add(&bar[XB_XGEN(b.x)], 1u);
            asm volatile("s_waitcnt vmcnt(0)" ::: "memory");
        } else {
            XB_SPIN(xb_ld(&bar[XB_XGEN(b.x)]) == gen, bar);
            __builtin_amdgcn_fence(__ATOMIC_ACQUIRE, "agent");
            asm volatile("s_waitcnt vmcnt(0)" ::: "memory");
        }
    }
    __syncthreads();
}


__device__ __forceinline__ void panel_barrier(unsigned* cnt, unsigned& epoch) {
    asm volatile("s_waitcnt vmcnt(0)" ::: "memory");
    __syncthreads();
    ++epoch;
    if (threadIdx.x == 0) {
        (void)xb_add(cnt, 1u);
        unsigned sp = 0u;
        while (xb_ld(cnt) < 4u * epoch) { __builtin_amdgcn_s_sleep(1); if (++sp > (1u << 22)) break; }
        __builtin_amdgcn_fence(__ATOMIC_ACQUIRE, "agent");
        asm volatile("s_waitcnt vmcnt(0)" ::: "memory");
    }
    __syncthreads();
}

struct Args { const float* in[22]; float* out; unsigned char* ws; int ph_lo, ph_hi; };

typedef LAS unsigned long long* PTab;
__device__ __forceinline__ const float* ldptr(PTab pt, int k) {
    const unsigned long long v = pt[k];
    const unsigned lo = __builtin_amdgcn_readfirstlane((unsigned)v), hi = __builtin_amdgcn_readfirstlane((unsigned)(v >> 32));
    return (const float*)(__attribute__((address_space(1))) const float*)(((unsigned long long)hi << 32) | lo);
}

__device__ __forceinline__ int conv_row(int n, int mode, int rowoff) {
    if (mode == 0) return rowoff + n;
    if (mode == 3) { const int br = n >> 11, mc = n & 2047, q = mc >> 6, mcl = mc & 63; return rowoff + 256 * q + 128 * (br >> 1) + 32 * (mcl >> 4) + 8 * ((mcl >> 2) & 3) + 4 * (br & 1) + (mcl & 3); }
    return (n >> 7) * 256 + (n & 127) + (mode == 2 ? 128 : 0);
}
__device__ __forceinline__ void conv_mat(const float* W, int ldw, int K, int N, bf16_t* WT, int pitch, int koff, int mode, int rowoff, int gw, int ngw, int lane) {
    const int nblk = N / 64, nitems = (K / 64) * nblk;
    const int c = lane & 15, q = lane >> 4;
    f32x4 v[16];
    if (gw < nitems) { const int kb = gw / nblk, nb = gw - kb * nblk; const float* src = W + (size_t)(64 * kb + 16 * q) * ldw + 64 * nb + 4 * c;
#pragma unroll
        for (int j = 0; j < 16; ++j) v[j] = __builtin_nontemporal_load((const f32x4*)(src + (size_t)j * ldw)); }
    for (int item = gw; item < nitems; item += ngw) {
        const int kb = item / nblk, nb = item - kb * nblk, k0 = 64 * kb, n0 = 64 * nb;
        u32x4 o[8];
#pragma unroll
        for (int i = 0; i < 4; ++i) {
            o[2 * i].x = pk2(v[0][i], v[1][i]); o[2 * i].y = pk2(v[2][i], v[3][i]); o[2 * i].z = pk2(v[4][i], v[5][i]); o[2 * i].w = pk2(v[6][i], v[7][i]);
            o[2 * i + 1].x = pk2(v[8][i], v[9][i]); o[2 * i + 1].y = pk2(v[10][i], v[11][i]); o[2 * i + 1].z = pk2(v[12][i], v[13][i]); o[2 * i + 1].w = pk2(v[14][i], v[15][i]);
        }
        const int nx = item + ngw;
        if (nx < nitems) { const int kb2 = nx / nblk, nb2 = nx - kb2 * nblk; const float* src = W + (size_t)(64 * kb2 + 16 * q) * ldw + 64 * nb2 + 4 * c;
#pragma unroll
            for (int j = 0; j < 16; ++j) v[j] = __builtin_nontemporal_load((const f32x4*)(src + (size_t)j * ldw)); }
        const int rb = conv_row(n0 + 4 * c, mode, rowoff);
#pragma unroll
        for (int i = 0; i < 4; ++i) {
            bf16_t* dst = WT + (size_t)(rb + i) * pitch + koff + k0 + 16 * q;
            *(u32x4*)dst = o[2 * i]; *(u32x4*)(dst + 8) = o[2 * i + 1];
        }
    }
}

__device__ __forceinline__ void convert_phase(PTab pt, int l, LAS unsigned char* lds, int tid, int wave, int lane, int bid, int G) {
    unsigned char* ws = (unsigned char*)ldptr(pt, 23);
    const int gw = bid * 8 + wave, ngw = G * 8;
    for (int s = 0; s < 2; ++s) {
        bf16_t* wgu = (bf16_t*)(ws + WS_WGU + (size_t)s * 44 * MiB);
        conv_mat(ldptr(pt, 4) + (size_t)(l * 2 + s) * D_ * FF_, FF_, D_, FF_, wgu, D_, 0, 1, 0, gw, ngw, lane);
        conv_mat(ldptr(pt, 5) + (size_t)(l * 2 + s) * D_ * FF_, FF_, D_, FF_, wgu, D_, 0, 2, 0, gw, ngw, lane);
        conv_mat(ldptr(pt, 6) + (size_t)(l * 2 + s) * D_ * FF_, D_, FF_, D_, (bf16_t*)(ws + WS_WD + (size_t)s * 22 * MiB), FF_, 0, 0, 0, gw, ngw, lane);
    }
    conv_mat(ldptr(pt, 7) + (size_t)l * D_ * NIN_, NIN_, D_, NZ_, (bf16_t*)(ws + WS_WIN), D_, 0, 0, 0, gw, ngw, lane);
    conv_mat(ldptr(pt, 7) + (size_t)l * D_ * NIN_ + NZ_, NIN_, D_, NGT_, (bf16_t*)(ws + WS_WIN), D_, 0, 3, NZ_, gw, ngw, lane);
    conv_mat(ldptr(pt, 15) + (size_t)l * 512 * D_, D_, 512, D_, (bf16_t*)(ws + WS_WBR), NO_, 0, 0, 0, gw, ngw, lane);
    conv_mat(ldptr(pt, 16) + (size_t)l * 512 * D_, D_, 512, D_, (bf16_t*)(ws + WS_WBR), NO_, 512, 0, 0, gw, ngw, lane);
    conv_mat(ldptr(pt, 17) + (size_t)l * 512 * D_, D_, 512, D_, (bf16_t*)(ws + WS_WBR), NO_, 1024, 0, 0, gw, ngw, lane);
    conv_mat(ldptr(pt, 18) + (size_t)l * 256 * D_, D_, 256, D_, (bf16_t*)(ws + WS_WBR), NO_, 1536, 0, 0, gw, ngw, lane);
    conv_mat(ldptr(pt, 19) + (size_t)l * D_ * D_, D_, D_, D_, (bf16_t*)(ws + WS_WOUT), D_, 0, 0, 0, gw, ngw, lane);
    conv_mat(ldptr(pt, 20) + (size_t)l * PLE_ * D_, D_, PLE_, D_, (bf16_t*)(ws + WS_WPP), PLE_, 0, 0, 0, gw, ngw, lane);
    conv_mat(ldptr(pt, 21) + (size_t)l * D_ * D_, D_, D_, D_, (bf16_t*)(ws + WS_WPG), D_, 0, 0, 0, gw, ngw, lane);
    if (l == 0) {
        const size_t gt = (size_t)bid * 512 + tid, nth = (size_t)G * 512;
        const f32x4* x4 = (const f32x4*)ldptr(pt, 0); u32x2* xb = (u32x2*)(ws + WS_XB);
        for (size_t i = gt; i < (size_t)T_ * D_ / 4; i += nth) { const f32x4 v = x4[i]; u32x2 w; w.x = pk2(v[0], v[1]); w.y = pk2(v[2], v[3]); xb[i] = w; }
        const f32x4* p4 = (const f32x4*)ldptr(pt, 1); u32x2* pb = (u32x2*)(ws + WS_PB);
        for (size_t i = gt; i < (size_t)2 * T_ * PLE_ / 4; i += nth) { const f32x4 v = p4[i]; u32x2 w; w.x = pk2(v[0], v[1]); w.y = pk2(v[2], v[3]); pb[i] = w; }
    }
}

__device__ __forceinline__ void ln_phase(float* X, bf16_t* XB, const float* g, const float* b, bool final_, int first, int rstep, int bstep, int nb, int lane) {
    const int ngw = rstep;
    for (int bi = 0, row0 = first; bi < nb; ++bi, row0 += bstep) {
        f32x4 v[4][8];
#pragma unroll
        for (int r = 0; r < 4; ++r) { const int row = min(row0 + r * ngw, T_ - 1); const f32x4* xr = (const f32x4*)(X + (size_t)row * D_) + lane;
#pragma unroll
            for (int j = 0; j < 8; ++j) v[r][j] = xr[64 * j]; }
        float mean[4], rstd[4];
#pragma unroll
        for (int r = 0; r < 4; ++r) { float s = 0.f;
#pragma unroll
            for (int j = 0; j < 8; ++j) s += (v[r][j][0] + v[r][j][1]) + (v[r][j][2] + v[r][j][3]);
            mean[r] = s; }
#pragma unroll
        for (int o = 1; o < 64; o <<= 1) {
#pragma unroll
            for (int r = 0; r < 4; ++r) mean[r] += __shfl_xor(mean[r], o); }
#pragma unroll
        for (int r = 0; r < 4; ++r) { mean[r] *= (1.f / D_); float s2 = 0.f;
#pragma unroll
            for (int j = 0; j < 8; ++j) { v[r][j] = v[r][j] - mean[r]; s2 += (v[r][j][0] * v[r][j][0] + v[r][j][1] * v[r][j][1]) + (v[r][j][2] * v[r][j][2] + v[r][j][3] * v[r][j][3]); }
            rstd[r] = s2; }
#pragma unroll
        for (int o = 1; o < 64; o <<= 1) {
#pragma unroll
            for (int r = 0; r < 4; ++r) rstd[r] += __shfl_xor(rstd[r], o); }
#pragma unroll
        for (int r = 0; r < 4; ++r) rstd[r] = 1.f / sqrtf(rstd[r] * (1.f / D_) + LN_EPS);
#pragma unroll
        for (int j = 0; j < 8; ++j) {
            const f32x4 gg = ((const f32x4*)g)[lane + 64 * j], bb = ((const f32x4*)b)[lane + 64 * j];
#pragma unroll
            for (int r = 0; r < 4; ++r) { const int row = row0 + r * ngw;
                if (row < T_) { const f32x4 y = v[r][j] * rstd[r] * gg + bb;
                    if (final_) ((f32x4*)(X + (size_t)row * D_))[lane + 64 * j] = y;
                    else { u32x2 w; w.x = pk2(y[0], y[1]); w.y = pk2(y[2], y[3]); ((u32x2*)(XB + (size_t)row * D_))[lane + 64 * j] = w; } } }
        }
    }
}

__device__ __forceinline__ void attn_unit(LAS unsigned char* L, const bf16_t* Z, int unit, const float* sinks, bf16_t* O, float* DPO, float* DLSE, int tid, int wave, int lane) {
    int qcol, kcol, vcol, base, blk, dil, max_dist, grp = 0, hh = 0; float slope_u, sink = 0.f; bool isA;
    if (unit < 1024) {
        isA = true; blk = unit & 31; const int head = (unit >> 5) & 7, b = unit >> 8, kvh = head >> 2;
        qcol = ZQA + head * 64; kcol = ZKA + kvh * 64; vcol = ZVA + kvh * 64; base = b * SEQ_; dil = 1; max_dist = 127;
        slope_u = __builtin_amdgcn_exp2f(-8.0f * (float)(head + 1) / 20.0f); sink = sinks[head]; hh = head;
    } else {
        isA = false; const int u2 = unit - 1024; grp = u2 >> 9; const int u3 = u2 & 511;
        dil = (grp == 0) ? 1 : (grp == 1 ? 4 : 16); const int nbk = 32 / dil;
        blk = u3 % nbk; const int r = (u3 / nbk) % dil; hh = (u3 / 32) & 3; const int b = u3 >> 7;
        qcol = ZQD + grp * 256 + hh * 64; kcol = ZKD + grp * 256 + hh * 64; vcol = ZVD + grp * 256 + hh * 64; base = b * SEQ_ + r; max_dist = 128;
        slope_u = __builtin_amdgcn_exp2f(-8.0f * (float)(8 + 4 * grp + hh + 1) / 20.0f) * (float)dil;
    }
    LAS bf16_t* Qs = (LAS bf16_t*)L;
    LAS bf16_t* Ks = Qs + 128 * 72;
    LAS bf16_t* Vs = Ks + 272 * 72;
    for (int i = tid; i < 1024; i += 512) { const int r = i >> 3, c = i & 7; const size_t tok = (size_t)(base + (blk * 128 + r) * dil);
        *(LAS u32x4*)(Qs + r * 72 + c * 8) = *(const u32x4*)(Z + tok * NZ_ + qcol + c * 8); }
    {
        u32x4 kv[5], vv[5];
#pragma unroll
        for (int it = 0; it < 5; ++it) { const int i = tid + it * 512; const int r = i >> 3, c = i & 7; const int sub = blk * 128 - 128 + r; const bool ok = (i < 2176) && (r < 256) && (sub >= 0);
            kv[it] = (u32x4){0u, 0u, 0u, 0u}; vv[it] = (u32x4){0u, 0u, 0u, 0u};
            if (ok) { const size_t tok = (size_t)(base + sub * dil); kv[it] = *(const u32x4*)(Z + tok * NZ_ + kcol + c * 8); vv[it] = *(const u32x4*)(Z + tok * NZ_ + vcol + c * 8); } }
#pragma unroll
        for (int it = 0; it < 5; ++it) { const int i = tid + it * 512; const int r = i >> 3, c = i & 7;
            if (i < 2176) {
                *(LAS u32x4*)(Ks + r * 72 + c * 8) = kv[it];
                *(LAS u32x4*)(Vs + r * 72 + c * 8) = vv[it]; } }
    }
    __syncthreads();
    const int q0 = wave * 16, qi = lane & 15, g = lane >> 4;
    bf16x8 bq[2];
#pragma unroll
    for (int ks = 0; ks < 2; ++ks) bq[ks] = *(const LAS bf16x8*)(Qs + (q0 + qi) * 72 + ks * 32 + g * 8);
    f32x4 st[10];
#pragma unroll
    for (int i = 0; i < 10; ++i) { f32x4 acc = {0.f, 0.f, 0.f, 0.f};
#pragma unroll
        for (int ks = 0; ks < 2; ++ks) { const bf16x8 ak = *(const LAS bf16x8*)(Ks + ((wave + i) * 16 + qi) * 72 + ks * 32 + g * 8); acc = mfma16(ak, bq[ks], acc); }
        st[i] = acc; }
    float mx = -3.0e38f;
    const int q = q0 + qi;
#pragma unroll
    for (int i = 0; i < 10; ++i)
#pragma unroll
        for (int j = 0; j < 4; ++j) { const int kk = (wave + i) * 16 + 4 * g + j; const int dist = q + 128 - kk;
            const bool valid = (dist >= 0) && (dist <= max_dist) && (blk > 0 || kk >= 128);
            const float s = valid ? (st[i][j] * 0.125f - slope_u * (float)dist) : -1.0e30f; st[i][j] = s; mx = fmaxf(mx, s); }
    mx = fmaxf(mx, __shfl_xor(mx, 16)); mx = fmaxf(mx, __shfl_xor(mx, 32));
    if (isA) mx = fmaxf(mx, sink);
    float den = 0.f;
#pragma unroll
    for (int i = 0; i < 10; ++i)
#pragma unroll
        for (int j = 0; j < 4; ++j) { const float p = __builtin_amdgcn_exp2f((st[i][j] - mx) * LOG2E); st[i][j] = p; den += p; }
    den += __shfl_xor(den, 16); den += __shfl_xor(den, 32);
    if (isA) den += __builtin_amdgcn_exp2f((sink - mx) * LOG2E);
    f32x4 o[4];
#pragma unroll
    for (int ht = 0; ht < 4; ++ht) o[ht] = (f32x4){0.f, 0.f, 0.f, 0.f};
    const LAS bf16_t* vbase = Vs + (wave * 16 + 4 * g + (qi >> 2)) * 72 + 4 * (qi & 3);
#pragma unroll
    for (int i = 0; i < 5; ++i) {
        u32x4 pw; pw.x = pk2(st[2 * i][0], st[2 * i][1]); pw.y = pk2(st[2 * i][2], st[2 * i][3]); pw.z = pk2(st[2 * i + 1][0], st[2 * i + 1][1]); pw.w = pk2(st[2 * i + 1][2], st[2 * i + 1][3]);
        const bf16x8 bp = __builtin_bit_cast(bf16x8, pw);
#pragma unroll
        for (int ht = 0; ht < 4; ++ht) { const LAS bf16_t* vr = vbase + (2 * i * 16) * 72 + ht * 16;
            const u32x2 va = tr16(vr), vb = tr16(vr + 16 * 72);
            o[ht] = mfma16(mk8(va, vb), bp, o[ht]); } }
    const float inv = 1.0f / den;
    const size_t tok = (size_t)(base + (blk * 128 + q) * dil);
    if (isA) {
#pragma unroll
        for (int ht = 0; ht < 4; ++ht) { u32x2 w; w.x = pk2(o[ht][0] * inv, o[ht][1] * inv); w.y = pk2(o[ht][2] * inv, o[ht][3] * inv);
            *(u32x2*)(O + tok * NO_ + hh * 64 + ht * 16 + 4 * g) = w; }
    } else {
#pragma unroll
        for (int ht = 0; ht < 4; ++ht) *(f32x4*)(DPO + ((size_t)grp * T_ + tok) * 256 + hh * 64 + ht * 16 + 4 * g) = o[ht] * inv;
        if (g == 0) DLSE[((size_t)grp * T_ + tok) * 4 + hh] = mx + logf(den);
    }
    __syncthreads();
}

__device__ __forceinline__ void gmlp_unit(LAS unsigned char* L, const bf16_t* Z, int unit, const float* lng, const float* lnb, const float* ws_, const float* bs, bf16_t* O, int tid, int wave, int lane) {
    const int n = unit >> 2, grp = unit & 3, tok0 = n * 128;
    LAS float* stats = (LAS float*)L;
    LAS bf16_t* vnt = (LAS bf16_t*)(L + 1024);
    LAS bf16_t* Wc = vnt + 128 * 136;
    {
        u32x4 raw[16];
#pragma unroll
        for (int r = 0; r < 16; ++r) raw[r] = *(const u32x4*)(Z + (size_t)(tok0 + 16 * wave + r) * NZ_ + ZVB + lane * 8);
        float s[16], ss[16];
#pragma unroll
        for (int r = 0; r < 16; ++r) { const float x0 = bflo(raw[r].x), x1 = bfhi(raw[r].x), x2 = bflo(raw[r].y), x3 = bfhi(raw[r].y), x4 = bflo(raw[r].z), x5 = bfhi(raw[r].z), x6 = bflo(raw[r].w), x7 = bfhi(raw[r].w);
            s[r] = ((x0 + x1) + (x2 + x3)) + ((x4 + x5) + (x6 + x7)); ss[r] = ((x0 * x0 + x1 * x1) + (x2 * x2 + x3 * x3)) + ((x4 * x4 + x5 * x5) + (x6 * x6 + x7 * x7)); }
#pragma unroll
        for (int o = 1; o < 64; o <<= 1) {
#pragma unroll
            for (int r = 0; r < 16; ++r) { s[r] += __shfl_xor(s[r], o); ss[r] += __shfl_xor(ss[r], o); } }
        if (lane < 16) { float m = 0.f, q = 0.f;
#pragma unroll
            for (int r = 0; r < 16; ++r) if (lane == r) { m = s[r]; q = ss[r]; }
            m *= (1.f / 512.f); const float var = fmaxf(q * (1.f / 512.f) - m * m, 0.f);
            stats[(16 * wave + lane) * 2] = m; stats[(16 * wave + lane) * 2 + 1] = 1.f / sqrtf(var + LN_EPS); }
    }
#pragma unroll
    for (int it = 0; it < 8; ++it) { const int i = tid + it * 512; const int t = i >> 5, s4 = (i & 31) * 4;
        f32x4 w = *(const f32x4*)(ws_ + (size_t)(grp * 128 + t) * 128 + s4);
#pragma unroll
        for (int e = 0; e < 4; ++e) if (s4 + e > t) w[e] = 0.f;
        u32x2 p; p.x = pk2(w[0], w[1]); p.y = pk2(w[2], w[3]); *(LAS u32x2*)(Wc + t * 136 + s4) = p; }
    u32x4 vraw[4];
#pragma unroll
    for (int it = 0; it < 4; ++it) { const int i = tid + it * 512; const int s = i >> 4, c8 = (i & 15) * 8;
        vraw[it] = *(const u32x4*)(Z + (size_t)(tok0 + s) * NZ_ + ZVB + grp * 128 + c8); }
    __syncthreads();
#pragma unroll
    for (int it = 0; it < 4; ++it) { const int i = tid + it * 512; const int s = i >> 4, c8 = (i & 15) * 8;
        const u32x4 raw = vraw[it];
        const float mean = stats[s * 2], rstd = stats[s * 2 + 1];
        float x[8]; x[0] = bflo(raw.x); x[1] = bfhi(raw.x); x[2] = bflo(raw.y); x[3] = bfhi(raw.y); x[4] = bflo(raw.z); x[5] = bfhi(raw.z); x[6] = bflo(raw.w); x[7] = bfhi(raw.w);
        const f32x4 g0 = *(const f32x4*)(lng + grp * 128 + c8), g1 = *(const f32x4*)(lng + grp * 128 + c8 + 4), b0 = *(const f32x4*)(lnb + grp * 128 + c8), b1 = *(const f32x4*)(lnb + grp * 128 + c8 + 4);
        float y[8];
#pragma unroll
        for (int e = 0; e < 8; ++e) y[e] = (x[e] - mean) * rstd * (e < 4 ? g0[e & 3] : g1[e & 3]) + (e < 4 ? b0[e & 3] : b1[e & 3]);
        u32x4 w; w.x = pk2(y[0], y[1]); w.y = pk2(y[2], y[3]); w.z = pk2(y[4], y[5]); w.w = pk2(y[6], y[7]);
        *(LAS u32x4*)(vnt + s * 136 + c8) = w; }
    __syncthreads();
    const int qi = lane & 15, g = lane >> 4;
    const int t = 16 * wave + qi; const float bias = bs[grp * 128 + t];
    const size_t tok = (size_t)(tok0 + t);
    u32x2 ur[8];
#pragma unroll
    for (int ct = 0; ct < 8; ++ct) ur[ct] = *(const u32x2*)(Z + tok * NZ_ + ZUB + grp * 128 + 16 * ct + 4 * g);
    f32x4 acc[8];
#pragma unroll
    for (int ct = 0; ct < 8; ++ct) acc[ct] = (f32x4){0.f, 0.f, 0.f, 0.f};
#pragma unroll
    for (int ks = 0; ks < 4; ++ks) { const bf16x8 bw = *(const LAS bf16x8*)(Wc + (16 * wave + qi) * 136 + ks * 32 + g * 8);
#pragma unroll
        for (int ct = 0; ct < 8; ++ct) { const LAS bf16_t* vr = vnt + (ks * 32 + 8 * g + (qi >> 2)) * 136 + 16 * ct + 4 * (qi & 3);
            acc[ct] = mfma16(mk8(tr16(vr), tr16(vr + 4 * 136)), bw, acc[ct]); } }
#pragma unroll
    for (int ct = 0; ct < 8; ++ct) { const int c = 16 * ct + 4 * g;
        u32x2 w; w.x = pk2(bflo(ur[ct].x) * (acc[ct][0] + bias), bfhi(ur[ct].x) * (acc[ct][1] + bias));
        w.y = pk2(bflo(ur[ct].y) * (acc[ct][2] + bias), bfhi(ur[ct].y) * (acc[ct][3] + bias));
        *(u32x2*)(O + tok * NO_ + 512 + grp * 128 + c) = w; }
    __syncthreads();
}

__device__ __forceinline__ float hgrn_lb(const float* lbl, int layer, int c) { return layer == 0 ? 0.0f : 1.0f / (1.0f + expf(lbl[c] - lbl[512 + c])); }

__device__ __forceinline__ void hgrn_c1_unit(LAS unsigned char* L, const bf16_t* Z, int unit, const float* lbl, int layer, float* DS, float* DEC, int tid, int wave, int lane) {
    const int h = unit & 3, cg_ = unit >> 2, tok0 = cg_ * 64;
    const int k = tid & 127, qtr = tid >> 7;
    LAS float* qsum = (LAS float*)L;
    LAS bf16_t* kt = (LAS bf16_t*)(L + 2048);
    LAS bf16_t* vt = kt + 128 * 72;
    const float lb = hgrn_lb(lbl, layer, h * 128 + k);
    float G[16], kk[16]; float run = 0.f;
    unsigned vraw[16];
#pragma unroll
    for (int i = 0; i < 16; ++i) { const size_t tok = (size_t)(tok0 + 16 * qtr + i);
        const float zf = bf2f(Z[tok * NZ_ + ZFC + h * 128 + k]);
        vraw[i] = Z[tok * NZ_ + ZIC + h * 128 + k];
        const float e = fexp(-zf), sg = frcp(1.0f + e);
        const float f = lb + (1.0f - lb) * sg;
        run += logf(fmaxf(f, 1e-6f)); G[i] = run; kk[i] = (1.0f - lb) * e * sg; }
    qsum[qtr * 128 + k] = run;
    __syncthreads();
    float off = 0.f, tot = 0.f;
#pragma unroll
    for (int qq = 0; qq < 4; ++qq) { const float v = qsum[qq * 128 + k]; tot += v; if (qq < qtr) off += v; }
    unsigned kw[8], vw[8];
#pragma unroll
    for (int i = 0; i < 8; ++i) { const float a0 = kk[2 * i] * fexp(tot - (G[2 * i] + off)), a1 = kk[2 * i + 1] * fexp(tot - (G[2 * i + 1] + off));
        kw[i] = pk2(a0, a1); vw[i] = vraw[2 * i] | (vraw[2 * i + 1] << 16); }
    *(LAS u32x4*)(kt + k * 72 + 16 * qtr) = (u32x4){kw[0], kw[1], kw[2], kw[3]}; *(LAS u32x4*)(kt + k * 72 + 16 * qtr + 8) = (u32x4){kw[4], kw[5], kw[6], kw[7]};
    *(LAS u32x4*)(vt + k * 72 + 16 * qtr) = (u32x4){vw[0], vw[1], vw[2], vw[3]}; *(LAS u32x4*)(vt + k * 72 + 16 * qtr + 8) = (u32x4){vw[4], vw[5], vw[6], vw[7]};
    if (qtr == 0) DEC[(size_t)unit * 128 + k] = fexp(tot);
    __syncthreads();
    const int qi = lane & 15, g = lane >> 4;
    bf16x8 av[2];
#pragma unroll
    for (int ks = 0; ks < 2; ++ks) av[ks] = *(const LAS bf16x8*)(vt + (16 * wave + qi) * 72 + ks * 32 + g * 8);
    float* dst = DS + (size_t)unit * 16384;
#pragma unroll
    for (int ktile = 0; ktile < 8; ++ktile) { f32x4 acc = {0.f, 0.f, 0.f, 0.f};
#pragma unroll
        for (int ks = 0; ks < 2; ++ks) { const bf16x8 bk = *(const LAS bf16x8*)(kt + (16 * ktile + qi) * 72 + ks * 32 + g * 8); acc = mfma16(av[ks], bk, acc); }
#pragma unroll
        for (int j = 0; j < 4; ++j) dst[(16 * wave + 4 * g + j) * 128 + 16 * ktile + qi] = acc[j]; }
    __syncthreads();
}

__device__ __forceinline__ void hgrn_scan_phase(const float* DS, const float* DEC, bf16_t* HS, int tid, int bid, int G) {
    const int nth = G * 512;
    for (int p = bid * 512 + tid; p < 16 * 8192; p += nth) {
        const int bh = p >> 13, idx = (p & 8191) * 2, k = idx & 127, b = bh >> 2, h = bh & 3;
        f32x2 S = {0.f, 0.f};
#pragma unroll 16
        for (int c = 0; c < 64; ++c) { const size_t u = (size_t)(((b * 64 + c) << 2) | h);
            *(unsigned*)(HS + u * 16384 + idx) = pk2(S[0], S[1]);
            const f32x2 d = *(const f32x2*)(DEC + u * 128 + k), ds = *(const f32x2*)(DS + u * 16384 + idx);
            S = d * S + ds; }
    }
}

__device__ __forceinline__ void hgrn_c3_unit(LAS unsigned char* L, const bf16_t* Z, int unit, const float* lbl, int layer, const bf16_t* HS, const float* ng, bf16_t* O, int tid, int wave, int lane) {
    const int h = unit & 3, cg_ = unit >> 2, tok0 = cg_ * 64;
    const int k = tid & 127, qtr = tid >> 7;
    LAS float* qsum = (LAS float*)L;
    LAS bf16_t* kT = (LAS bf16_t*)(L + 2048);
    LAS bf16_t* qT = kT + 128 * 72;
    LAS bf16_t* qC = qT + 128 * 72;
    LAS bf16_t* vt = qC + 128 * 72;
    LAS float* oL = (LAS float*)(L + 2048 + 4 * 128 * 72 * 2);
    const float lb = hgrn_lb(lbl, layer, h * 128 + k);
    float G[16], kk[16], qv[16]; float run = 0.f;
    unsigned vraw[16];
#pragma unroll
    for (int i = 0; i < 16; ++i) { const size_t tok = (size_t)(tok0 + 16 * qtr + i);
        const float zf = bf2f(Z[tok * NZ_ + ZFC + h * 128 + k]);
        qv[i] = bf2f(Z[tok * NZ_ + ZQC + h * 128 + k]);
        vraw[i] = Z[tok * NZ_ + ZIC + h * 128 + k];
        const float e = fexp(-zf), sg = frcp(1.0f + e);
        const float f = lb + (1.0f - lb) * sg;
        run += logf(fmaxf(f, 1e-6f)); G[i] = run; kk[i] = (1.0f - lb) * e * sg; }
    qsum[qtr * 128 + k] = run;
    __syncthreads();
    float off = 0.f;
#pragma unroll
    for (int qq = 0; qq < 4; ++qq) { const float v = qsum[qq * 128 + k]; if (qq < qtr) off += v; }
    const float Gm = qsum[k] + qsum[128 + k];
    {
        unsigned kw[8], qw[8], cw[8];
#pragma unroll
        for (int i = 0; i < 8; ++i) { float a[2], b[2], c[2];
#pragma unroll
            for (int e = 0; e < 2; ++e) { const float Gi = G[2 * i + e] + off; const float d = fminf(fmaxf(Gi - Gm, -80.f), 80.f);
                a[e] = kk[2 * i + e] * fexp(-d); b[e] = qv[2 * i + e] * fexp(d); c[e] = qv[2 * i + e] * fexp(Gi); }
            kw[i] = pk2(a[0], a[1]); qw[i] = pk2(b[0], b[1]); cw[i] = pk2(c[0], c[1]); }
        *(LAS u32x4*)(kT + k * 72 + 16 * qtr) = (u32x4){kw[0], kw[1], kw[2], kw[3]}; *(LAS u32x4*)(kT + k * 72 + 16 * qtr + 8) = (u32x4){kw[4], kw[5], kw[6], kw[7]};
        *(LAS u32x4*)(qT + k * 72 + 16 * qtr) = (u32x4){qw[0], qw[1], qw[2], qw[3]}; *(LAS u32x4*)(qT + k * 72 + 16 * qtr + 8) = (u32x4){qw[4], qw[5], qw[6], qw[7]};
        *(LAS u32x4*)(qC + k * 72 + 16 * qtr) = (u32x4){cw[0], cw[1], cw[2], cw[3]}; *(LAS u32x4*)(qC + k * 72 + 16 * qtr + 8) = (u32x4){cw[4], cw[5], cw[6], cw[7]};
    }
    {
        unsigned vw[8];
#pragma unroll
        for (int i = 0; i < 8; ++i) vw[i] = vraw[2 * i] | (vraw[2 * i + 1] << 16);
        *(LAS u32x4*)(vt + k * 72 + 16 * qtr) = (u32x4){vw[0], vw[1], vw[2], vw[3]}; *(LAS u32x4*)(vt + k * 72 + 16 * qtr + 8) = (u32x4){vw[4], vw[5], vw[6], vw[7]};
    }
    __syncthreads();
    const int qi = lane & 15, g = lane >> 4, tt = wave & 3, vh = wave >> 2;
    const bf16_t* hs = HS + (size_t)unit * 16384;
    bf16x8 ahs[4][4];
#pragma unroll
    for (int ks = 0; ks < 4; ++ks)
#pragma unroll
        for (int v_ = 0; v_ < 4; ++v_) ahs[ks][v_] = *(const bf16x8*)(hs + (16 * (4 * vh + v_) + qi) * 128 + ks * 32 + g * 8);
    unsigned graw[8][2];
#pragma unroll
    for (int r = 0; r < 8; ++r) { const size_t tok = (size_t)(tok0 + 8 * wave + r); graw[r][0] = Z[tok * NZ_ + ZGC + h * 128 + lane]; graw[r][1] = Z[tok * NZ_ + ZGC + h * 128 + 64 + lane]; }
    f32x4 sc[4];
#pragma unroll
    for (int st = 0; st < 4; ++st) { sc[st] = (f32x4){0.f, 0.f, 0.f, 0.f};
        if (st <= tt) {
#pragma unroll
            for (int ks = 0; ks < 4; ++ks) { const int ro = (ks * 32 + 8 * g + (qi >> 2)) * 72 + 4 * (qi & 3);
                const bf16x8 a = mk8(tr16(kT + ro + 16 * st), tr16(kT + ro + 4 * 72 + 16 * st)), b = mk8(tr16(qT + ro + 16 * tt), tr16(qT + ro + 4 * 72 + 16 * tt));
                sc[st] = mfma16(a, b, sc[st]); }
#pragma unroll
            for (int j = 0; j < 4; ++j) if (16 * st + 4 * g + j > 16 * tt + qi) sc[st][j] = 0.f;
        } }
    f32x4 o[4];
#pragma unroll
    for (int v_ = 0; v_ < 4; ++v_) o[v_] = (f32x4){0.f, 0.f, 0.f, 0.f};
#pragma unroll
    for (int i = 0; i < 2; ++i) {
        u32x4 pw; pw.x = pk2(sc[2 * i][0], sc[2 * i][1]); pw.y = pk2(sc[2 * i][2], sc[2 * i][3]); pw.z = pk2(sc[2 * i + 1][0], sc[2 * i + 1][1]); pw.w = pk2(sc[2 * i + 1][2], sc[2 * i + 1][3]);
        const bf16x8 bp = __builtin_bit_cast(bf16x8, pw);
#pragma unroll
        for (int v_ = 0; v_ < 4; ++v_) { const LAS bf16_t* vr = vt + (16 * (4 * vh + v_) + qi) * 72 + 4 * g;
            const u32x2 va = *(const LAS u32x2*)(vr + (2 * i) * 16), vb = *(const LAS u32x2*)(vr + (2 * i + 1) * 16);
            o[v_] = mfma16(mk8(va, vb), bp, o[v_]); } }
#pragma unroll
    for (int ks = 0; ks < 4; ++ks) { const int ro = (ks * 32 + 8 * g + (qi >> 2)) * 72 + 4 * (qi & 3) + 16 * tt; const bf16x8 b = mk8(tr16(qC + ro), tr16(qC + ro + 4 * 72));
#pragma unroll
        for (int v_ = 0; v_ < 4; ++v_) o[v_] = mfma16(ahs[ks][v_], b, o[v_]); }
#pragma unroll
    for (int v_ = 0; v_ < 4; ++v_) *(LAS f32x4*)(oL + (16 * tt + qi) * 132 + 16 * (4 * vh + v_) + 4 * g) = o[v_];
    __syncthreads();
    const float ng0 = ng[h * 128 + lane], ng1 = ng[h * 128 + 64 + lane];
#pragma unroll
    for (int r = 0; r < 8; ++r) { const int t = 8 * wave + r;
        const float x0 = oL[t * 132 + lane], x1 = oL[t * 132 + 64 + lane];
        const float ss = wave_sum(x0 * x0 + x1 * x1);
        const float rs = 1.0f / sqrtf(ss * (1.f / 128.f) + LN_EPS);
        const size_t tok = (size_t)(tok0 + t);
        const float g0 = bf2f(graw[r][0]), g1 = bf2f(graw[r][1]);
        const float y0 = x0 * rs * ng0 * fsigmoid(g0), y1 = x1 * rs * ng1 * fsigmoid(g1);
        O[tok * NO_ + 1024 + h * 128 + lane] = (bf16_t)(pk2(y0, 0.f) & 0xffffu);
        O[tok * NO_ + 1024 + h * 128 + 64 + lane] = (bf16_t)(pk2(y1, 0.f) & 0xffffu); }
    __syncthreads();
}

__device__ __forceinline__ void dcomb_phase(const float* DPO, const float* DLSE, bf16_t* O, int tid, int bid, int G) {
    const int nth = G * 512;
#pragma unroll 4
    for (int i = bid * 512 + tid; i < T_ * 64; i += nth) { const int t = i >> 6, c4 = (i & 63) * 4, h = c4 >> 6;
        const float l0 = DLSE[((size_t)0 * T_ + t) * 4 + h], l1 = DLSE[((size_t)1 * T_ + t) * 4 + h], l2 = DLSE[((size_t)2 * T_ + t) * 4 + h];
        const float m = fmaxf(l0, fmaxf(l1, l2));
        float w0 = fexp(l0 - m), w1 = fexp(l1 - m), w2 = fexp(l2 - m); const float inv = 1.0f / (w0 + w1 + w2); w0 *= inv; w1 *= inv; w2 *= inv;
        const f32x4 a = *(const f32x4*)(DPO + ((size_t)0 * T_ + t) * 256 + c4), b = *(const f32x4*)(DPO + ((size_t)1 * T_ + t) * 256 + c4), c = *(const f32x4*)(DPO + ((size_t)2 * T_ + t) * 256 + c4);
        const f32x4 r = w0 * a + w1 * b + w2 * c;
        u32x2 w; w.x = pk2(r[0], r[1]); w.y = pk2(r[2], r[3]);
        *(u32x2*)(O + (size_t)t * NO_ + 1536 + c4) = w; }
}

constexpr int NPH_LAYER = 14, NPH = 2 * NPH_LAYER;
__global__ void __launch_bounds__(512, 2) hybrid_fwd(Args a) {
    extern __shared__ __attribute__((aligned(16))) unsigned char lds_raw[];
    LAS unsigned char* lds = (LAS unsigned char*)lds_raw;
    PTab pt = (PTab)(lds + 131072);
    if (threadIdx.x == 0) {
#pragma unroll
        for (int i = 0; i < 22; ++i) pt[i] = (unsigned long long)a.in[i];
        pt[22] = (unsigned long long)a.out; pt[23] = (unsigned long long)a.ws;
    }
    if (threadIdx.x < 8) ((LAS unsigned*)(lds + 131072 + 512))[threadIdx.x] = 0u;
    __syncthreads();
    const int ph_lo = a.ph_lo, ph_hi = a.ph_hi;
    unsigned pepoch = 0u; bool fast = false;
    if (threadIdx.x == 0 && blockIdx.x < 8) __hip_atomic_store((unsigned*)(a.ws + WS_CTL + WS_BAR + 15400) + blockIdx.x, xb_xcc_id(), __ATOMIC_RELAXED, __HIP_MEMORY_SCOPE_AGENT);
    XcdBarrier bar = xcd_barrier_post((unsigned*)(a.ws + WS_CTL + WS_BAR), (volatile LAS unsigned*)(lds + 131072 + 512));
    for (int ph = ph_lo; ph < ph_hi; ++ph) {
        const int l = ph / NPH_LAYER, p = ph - l * NPH_LAYER;
        pg8::StaticOrder S;
        int tid = threadIdx.x; asm volatile("" : "+v"(tid));
        int bid = blockIdx.x, G = gridDim.x; asm volatile("" : "+s"(bid), "+s"(G));
        const int lane = tid & 63, wave = __builtin_amdgcn_readfirstlane(tid >> 6);
        unsigned char* ws = (unsigned char*)ldptr(pt, 23);
#define P_X ((float*)ldptr(pt, 22))
#define P_XB ((bf16_t*)(ws + WS_XB))
#define P_ZH ((bf16_t*)(ws + WS_ZH))
#define P_GATE ((bf16_t*)(ws + WS_GATE))
#define P_O ((bf16_t*)(ws + WS_O))
#define P_DS ((float*)(ws + WS_DS))
#define P_DEC ((float*)(ws + WS_CTL))
#define P_HS ((bf16_t*)(ws + WS_HS))
#define P_DPO ((float*)(ws + WS_DPO))
#define P_DLSE ((float*)(ws + WS_DLSE))
        switch (p) {
        case 0: if (l == 0) convert_phase(pt, 0, lds, tid, wave, lane, bid, G); break;
        case 1: case 11: {
            const int s = (p == 1) ? 0 : 1; const int n_ = (p == 1) ? 2 * FF_ : 2 * FF_ + D_;
            pg8::Gemm g{P_XB, (const bf16_t*)(ws + WS_WGU + (size_t)s * 44 * MiB), T_, n_, D_}; S.init(T_, n_, G, bid);
            pg8::EpiSwiGLU E{P_ZH, P_GATE}; pg8::gemm_phase(lds, g, S, E);
        } break;
        case 2: {
            pg8::Gemm g{P_ZH, (const bf16_t*)(ws + WS_WD), T_, D_, FF_}; S.init(T_, D_, G, bid);
            pg8::EpiResidT<false> E{P_X, P_XB, nullptr, ALPHA, 0.5f}; pg8::gemm_phase<pg8::EpiResidT<false>, true>(lds, g, S, E);
        } break;
        case 3: case 10: case 13: {
            const int which = (p == 3) ? 0 : (p == 10 ? 1 : 2);
            if (fast) ln_phase(P_X, P_XB, ldptr(pt, 2) + (size_t)(l * 3 + which) * D_, ldptr(pt, 3) + (size_t)(l * 3 + which) * D_, (l == 1 && p == 13), (8 * (bid & 7) + ((bid >> 3) & 7)) * 256 + (bid >> 6) * 64 + wave * 8, 1, 4, 2, lane);
            else ln_phase(P_X, P_XB, ldptr(pt, 2) + (size_t)(l * 3 + which) * D_, ldptr(pt, 3) + (size_t)(l * 3 + which) * D_, (l == 1 && p == 13), bid * 8 + wave, G * 8, 32 * G, (T_ + 32 * G - 1) / (32 * G), lane);
            if (p == 13 && l == 0) convert_phase(pt, 1, lds, tid, wave, lane, bid, G);
            if (p == 10) { int kp = PLE_; asm volatile("" : "+s"(kp)); pg8::Gemm g2{(const bf16_t*)(ws + WS_PB) + (size_t)l * T_ * PLE_, (const bf16_t*)(ws + WS_WPP), T_, D_, kp}; S.init(T_, D_, G, bid);
                pg8::EpiBf16 E2{P_GATE, D_}; pg8::gemm_phase(lds, g2, S, E2); }
        } break;
        case 4: {
            pg8::Gemm g{P_XB, (const bf16_t*)(ws + WS_WIN), T_, NIN_, D_}; S.init(T_, NIN_, G, bid);
            pg8::EpiZ E{P_ZH, P_GATE}; pg8::gemm_phase(lds, g, S, E);
        } break;
        case 5: {
            for (int u = bid; u < 2560; u += G) attn_unit(lds, P_ZH, u, ldptr(pt, 8) + l * 8, P_O, P_DPO, P_DLSE, tid, wave, lane);
            for (int u = bid; u < 512; u += G) gmlp_unit(lds, P_ZH, u, ldptr(pt, 9) + l * 512, ldptr(pt, 10) + l * 512, ldptr(pt, 11) + (size_t)l * 65536, ldptr(pt, 12) + l * 512, P_O, tid, wave, lane);
            for (int u = bid; u < 1024; u += G) hgrn_c1_unit(lds, P_ZH, u, ldptr(pt, 13), l, P_DS, P_DEC, tid, wave, lane);
        } break;
        case 6: hgrn_scan_phase(P_DS, P_DEC, P_HS, tid, bid, G); break;
        case 7: {
            for (int u = bid; u < 1024; u += G) hgrn_c3_unit(lds, P_ZH, u, ldptr(pt, 13), l, P_HS, ldptr(pt, 14) + l * 512, P_O, tid, wave, lane);
            dcomb_phase(P_DPO, P_DLSE, P_O, tid, bid, G);
        } break;
        case 8: {
            pg8::Gemm g{P_O, (const bf16_t*)(ws + WS_WBR), T_, D_, NO_}; S.init(T_, D_, G, bid);
            pg8::EpiBR E{P_ZH, P_GATE}; pg8::gemm_phase(lds, g, S, E);
        } break;
        case 9: {
            pg8::Gemm g{P_ZH, (const bf16_t*)(ws + WS_WOUT), T_, D_, D_}; S.init(T_, D_, G, bid);
            pg8::EpiResidT<false> E{P_X, P_XB, nullptr, ALPHA, 1.0f}; pg8::gemm_phase(lds, g, S, E);
        } break;
        case 12: {
            pg8::Gemm g{P_ZH, (const bf16_t*)(ws + WS_WD + (size_t)22 * MiB), T_, D_, FF_}; S.init(T_, D_, G, bid);
            pg8::EpiResidT<true> E{P_X, P_XB, P_GATE, ALPHA, 0.5f}; pg8::gemm_phase<pg8::EpiResidT<true>, true>(lds, g, S, E);
        } break;
        default: break;
        }
        if (ph + 1 < ph_hi) {
            if (ph_hi > 1000) { __threadfence(); cg::this_grid().sync(); }
            else if (fast && (p == 2 || p == 8 || p == 9 || p == 11))
                panel_barrier((unsigned*)(ws + WS_CTL + WS_BAR + 16384) + 64 * (8 * (bid & 7) + ((bid >> 3) & 7)), pepoch);
            else xcd_barrier(bar);
            if (ph == 0) { if (threadIdx.x == 0 && xb_xcc_id() != xb_ld((unsigned*)(ws + WS_CTL + WS_BAR + 15400) + (blockIdx.x & 7))) (void)xb_add((unsigned*)(ws + WS_CTL + WS_BAR + 15360), 1u); }
            if (ph == 1) fast = (G == 256) && (__builtin_amdgcn_readfirstlane(xb_ld((unsigned*)(ws + WS_CTL + WS_BAR + 15360))) == 0u);
        }
    }
}

extern "C" void kernel_launch(void* const* d_in, const int* in_sizes, int n_in, void* d_out, int out_size, void* d_ws, size_t ws_size, hipStream_t stream) {
    static int grid = 0;
    if (grid == 0) {
        if (n_in != 22 || out_size != T_ * D_ || ws_size < WS_END) { fprintf(stderr, "kernel_launch: unexpected shapes (n_in %d out %d ws %zu need %zu)\n", n_in, out_size, ws_size, (size_t)WS_END); grid = -1; return; }
        int dev = 0, cus = 0, per_cu = 0;
        hipGetDevice(&dev); hipDeviceGetAttribute(&cus, hipDeviceAttributeMultiprocessorCount, dev);
        if (hipFuncSetAttribute((const void*)hybrid_fwd, hipFuncAttributeMaxDynamicSharedMemorySize, LDS_BYTES) != hipSuccess) { fprintf(stderr, "kernel_launch: hipFuncSetAttribute failed\n"); grid = -1; return; }
        hipOccupancyMaxActiveBlocksPerMultiprocessor(&per_cu, (const void*)hybrid_fwd, 512, LDS_BYTES);
        (void)hipGetLastError();
        if (per_cu < 1) per_cu = 1;
        grid = cus * 1;
    }
    if (grid < 0) return;
    if (hipMemsetAsync((char*)d_ws + WS_CTL + WS_BAR, 0, BAR_BYTES, stream) != hipSuccess) { fprintf(stderr, "kernel_launch: memset failed\n"); return; }
    Args a{};
    for (int i = 0; i < 22; ++i) a.in[i] = (const float*)d_in[i];
    a.out = (float*)d_out; a.ws = (unsigned char*)d_ws; a.ph_lo = 0; a.ph_hi = NPH;
    void* args[] = {&a};
    hipError_t e = hipLaunchCooperativeKernel((const void*)hybrid_fwd, dim3(grid), dim3(512), args, LDS_BYTES, stream);
    if (e != hipSuccess) fprintf(stderr, "cooperative launch failed: %s (grid %d)\n", hipGetErrorString(e), grid);
}
```

```cpp
#include <hip/hip_runtime.h>
#include <hip/hip_cooperative_groups.h>
#include <cstdio>
#include <cstdint>
namespace cg = cooperative_groups;

#define LAS __attribute__((address_space(3)))
typedef unsigned short bf16_t;
typedef short bf16x8 __attribute__((ext_vector_type(8)));
typedef float f32x4 __attribute__((ext_vector_type(4)));
typedef float f32x2 __attribute__((ext_vector_type(2)));
typedef unsigned u32x4 __attribute__((ext_vector_type(4)));
typedef unsigned u32x2 __attribute__((ext_vector_type(2)));

constexpr int T_ = 16384, SEQ_ = 4096, D_ = 2048, FF_ = 5632, NIN_ = 14336, NZ_ = 6144, NGT_ = 8192, NO_ = 1792, PLE_ = 256;
constexpr int ZQA = 0, ZKA = 512, ZVA = 640, ZUB = 768, ZVB = 1280, ZQC = 1792, ZFC = 2304, ZIC = 2816, ZGC = 3328, ZQD = 3840, ZKD = 4608, ZVD = 5376;
constexpr float LN_EPS = 1e-5f;
constexpr float ALPHA = 1.41421356237f;
constexpr float LOG2E = 1.44269504089f;

constexpr size_t MiB = 1u << 20;
constexpr size_t WS_CTL = 0;
constexpr size_t WS_BAR = 768 * 1024, BAR_BYTES = 32768;
constexpr size_t WS_WGU = 1 * MiB;
constexpr size_t WS_WPG = WS_WGU + 88 * MiB;
constexpr size_t WS_WD = WS_WPG + 8 * MiB;
constexpr size_t WS_WIN = WS_WD + 44 * MiB;
constexpr size_t WS_WBR = WS_WIN + 56 * MiB;
constexpr size_t WS_WOUT = WS_WBR + 7 * MiB;
constexpr size_t WS_WPP = WS_WOUT + 8 * MiB;
constexpr size_t WS_PB = WS_WPP + 1 * MiB;
constexpr size_t WS_XB = WS_PB + 16 * MiB;
constexpr size_t WS_ZH = WS_XB + 64 * MiB;
constexpr size_t WS_GATE = WS_ZH + 192 * MiB;
constexpr size_t WS_O = WS_GATE + 256 * MiB;
constexpr size_t WS_HS = WS_O + 56 * MiB;
constexpr size_t WS_DPO = WS_HS + 32 * MiB;
constexpr size_t WS_DLSE = WS_DPO + 48 * MiB;
constexpr size_t WS_DS = WS_DLSE + 1 * MiB;
constexpr size_t WS_END = WS_DS + 64 * MiB;

constexpr int LDS_BYTES = 147456;

__device__ __forceinline__ float bf2f(unsigned b) { return __uint_as_float(b << 16); }
__device__ __forceinline__ float bflo(unsigned w) { return __uint_as_float(w << 16); }
__device__ __forceinline__ float bfhi(unsigned w) { return __uint_as_float(w & 0xffff0000u); }
__device__ __forceinline__ unsigned pk2(float lo, float hi) { unsigned r; asm("v_cvt_pk_bf16_f32 %0, %1, %2" : "=v"(r) : "v"(lo), "v"(hi)); return r; }
__device__ __forceinline__ float fexp(float x) { return __builtin_amdgcn_exp2f(x * LOG2E); }
__device__ __forceinline__ float frcp(float x) { return __builtin_amdgcn_rcpf(x); }
__device__ __forceinline__ float fsigmoid(float x) { return frcp(1.0f + fexp(-x)); }
__device__ __forceinline__ float gelu_erf(float x) { return 0.5f * x * (1.0f + erff(x * 0.70710678118f)); }
__device__ __forceinline__ float gelu_fast(float v) {
    const float av = fabsf(v), t = frcp(av * 0.2316418882f + 1.0f);
    float q = t * 0.5307027145f + (-0.7265760135f); q = q * t + 0.7107068705f; q = q * t + (-0.142248368f); q = q * t + 0.127414796f; q = q * t;
    const float e = __builtin_amdgcn_exp2f((v * v) * (-0.72134752044f));
    const float m = v * (q * e);
    return v < 0.f ? m : v - m;
}
__device__ __forceinline__ float wave_sum(float v) {
#pragma unroll
    for (int o = 1; o < 64; o <<= 1) v += __shfl_xor(v, o);
    return v;
}
__device__ __forceinline__ f32x4 mfma16(bf16x8 a, bf16x8 b, f32x4 c) { return __builtin_amdgcn_mfma_f32_16x16x32_bf16(a, b, c, 0, 0, 0); }
typedef short s16x4 __attribute__((ext_vector_type(4)));
__device__ __forceinline__ u32x2 tr16(const LAS bf16_t* p) { const s16x4 r = __builtin_amdgcn_ds_read_tr16_b64_v4i16((LAS s16x4*)p); return __builtin_bit_cast(u32x2, r); }
__device__ __forceinline__ bf16x8 mk8(u32x2 a, u32x2 b) { u32x4 t = {a.x, a.y, b.x, b.y}; return __builtin_bit_cast(bf16x8, t); }

namespace pg8 {
constexpr int BM = 256, BK = 64, HALF = 128, HTB = HALF * BK * 2, STAGE_BYTES = 8 * HTB, NXCD = 8, WGM = 8;
__device__ __forceinline__ int lds_byte(int r, int c) { const int st = (r >> 4) * 2 + (c >> 5), rr = r & 15, cc = c & 31, ob = rr * 64 + cc * 2; return st * 1024 + (ob ^ (((ob >> 9) & 1) << 5)); }
__device__ __forceinline__ void stage_rc(int b, int& R, int& C) { const int st = b / 1024, sb = b % 1024, swz = sb ^ (((sb >> 9) & 1) << 5); R = (st >> 1) * 16 + swz / 64; C = (st & 1) * 32 + (swz % 64) / 2; }
__device__ __forceinline__ int perm32(int rho) { const int n = rho >> 4, i = rho & 15; return 8 * (i >> 2) + 4 * n + (i & 3); }
struct Unit { int pm, pn; };
struct Gemm { const bf16_t* A; const bf16_t* Bt; int M, N, K; };
struct StaticOrder {
    int nM, nN, nwg, G, c;
    __device__ void init(int M, int N, int G_, int c_) { nM = M / BM; nN = N / BM; nwg = nM * nN; G = G_; c = c_; }
    __device__ bool next(int i, Unit& u) const {
        const long L = (long)i * G + c; if (L >= nwg) return false;
        int wgid = (int)L; { const int q = nwg / NXCD, r = nwg % NXCD, xcd = wgid % NXCD, off = wgid / NXCD; wgid = (xcd < r ? xcd * (q + 1) : r * (q + 1) + (xcd - r) * q) + off; }
        const int nig = WGM * nN, gid = wgid / nig, fm = gid * WGM, gsz = (nM - fm) < WGM ? (nM - fm) : WGM;
        u.pm = fm + ((wgid % nig) % gsz); u.pn = (wgid % nig) / gsz; return true;
    }
};

struct EpiSwiGLU {
    static constexpr bool PERM = true, HAS_MID = false;
    bf16_t* H; bf16_t* PP;
    __device__ __forceinline__ void mid(int, f32x4 (&)[2][2][4][2], const Unit&, int, int, int, int) const {}
    __device__ __forceinline__ void operator()(const f32x4 (&acc)[2][2][4][2], const Unit& u, int wr, int wc, int fr, int fq) const {
        const int row0 = u.pm * BM + wr * 64 + fr;
        if (u.pn < 44) {
            const int col0 = u.pn * 128 + wc * 32 + 8 * fq;
#pragma unroll
            for (int ai = 0; ai < 2; ++ai)
#pragma unroll
                for (int m = 0; m < 4; ++m) {
                    bf16_t* rowp = H + (size_t)(row0 + ai * HALF + m * 16) * FF_ + col0;
                    float h[8];
#pragma unroll
                    for (int n = 0; n < 2; ++n)
#pragma unroll
                        for (int j = 0; j < 4; ++j) { const float g = acc[ai][0][m][n][j], up = acc[ai][1][m][n][j]; h[n * 4 + j] = g * fsigmoid(g) * up; }
                    u32x4 w; w.x = pk2(h[0], h[1]); w.y = pk2(h[2], h[3]); w.z = pk2(h[4], h[5]); w.w = pk2(h[6], h[7]);
                    *(u32x4*)rowp = w;
                    asm volatile("" ::: "memory"); __builtin_amdgcn_sched_barrier(0);
                }
        } else {
            const int col0 = (u.pn - 44) * BM + wc * 32 + 8 * fq;
#pragma unroll
            for (int am = 0; am < 4; ++am) { const int ai = am >> 1, mb = (am & 1) * 2;
                u32x4 pv[2][2];
#pragma unroll
                for (int mm = 0; mm < 2; ++mm)
#pragma unroll
                    for (int bj = 0; bj < 2; ++bj) pv[mm][bj] = *(const u32x4*)(PP + (size_t)(row0 + ai * HALF + (mb + mm) * 16) * D_ + col0 + bj * HALF);
#pragma unroll
                for (int mm = 0; mm < 2; ++mm) { const int m = mb + mm;
                    bf16_t* rowp = PP + (size_t)(row0 + ai * HALF + m * 16) * D_ + col0;
#pragma unroll
                    for (int bj = 0; bj < 2; ++bj) {
                        const u32x4 p = pv[mm][bj];
                        const f32x4 a0 = acc[ai][bj][m][0], a1 = acc[ai][bj][m][1];
                        u32x4 w;
                        w.x = pk2(fsigmoid(a0[0]) * bflo(p.x), fsigmoid(a0[1]) * bfhi(p.x)); w.y = pk2(fsigmoid(a0[2]) * bflo(p.y), fsigmoid(a0[3]) * bfhi(p.y));
                        w.z = pk2(fsigmoid(a1[0]) * bflo(p.z), fsigmoid(a1[1]) * bfhi(p.z)); w.w = pk2(fsigmoid(a1[2]) * bflo(p.w), fsigmoid(a1[3]) * bfhi(p.w));
                        *(u32x4*)(rowp + bj * HALF) = w;
                    }
                }
                asm volatile("" ::: "memory"); __builtin_amdgcn_sched_barrier(0);
            }
        }
    }
};
template <bool ADD> struct EpiResidT {
    static constexpr bool PERM = false, HAS_MID = false;
    float* Y; const bf16_t* XB; const bf16_t* PP; float a, b;
    __device__ __forceinline__ void mid(int, f32x4 (&)[2][2][4][2], const Unit&, int, int, int, int) const {}
    __device__ __forceinline__ void operator()(const f32x4 (&acc)[2][2][4][2], const Unit& u, int wr, int wc, int fr, int fq) const {
        const int row0 = u.pm * BM + wr * 64 + fr, col0 = u.pn * BM + wc * 32 + 4 * fq;
        constexpr int GM = ADD ? 2 : 4;
#pragma unroll
        for (int ai = 0; ai < 2; ++ai)
#pragma unroll
            for (int m0 = 0; m0 < 4; m0 += GM) {
                u32x2 xb[GM][2][2], pp[GM][2][2];
#pragma unroll
                for (int mm = 0; mm < GM; ++mm) { const size_t off = (size_t)(row0 + ai * HALF + (m0 + mm) * 16) * D_ + col0;
#pragma unroll
                    for (int bj = 0; bj < 2; ++bj)
#pragma unroll
                        for (int n = 0; n < 2; ++n) { xb[mm][bj][n] = *(const u32x2*)(XB + off + bj * HALF + n * 16); if (ADD) pp[mm][bj][n] = *(const u32x2*)(PP + off + bj * HALF + n * 16); } }
#pragma unroll
                for (int mm = 0; mm < GM; ++mm) { const int m = m0 + mm; const size_t off = (size_t)(row0 + ai * HALF + m * 16) * D_ + col0;
#pragma unroll
                    for (int bj = 0; bj < 2; ++bj)
#pragma unroll
                        for (int n = 0; n < 2; ++n) { const u32x2 x = xb[mm][bj][n]; const f32x4 s = acc[ai][bj][m][n];
                            f32x4 y; y[0] = a * bflo(x.x) + b * s[0]; y[1] = a * bfhi(x.x) + b * s[1]; y[2] = a * bflo(x.y) + b * s[2]; y[3] = a * bfhi(x.y) + b * s[3];
                            if (ADD) { const u32x2 q = pp[mm][bj][n]; y[0] += bflo(q.x); y[1] += bfhi(q.x); y[2] += bflo(q.y); y[3] += bfhi(q.y); }
                            *(f32x4*)(Y + off + bj * HALF + n * 16) = y; } }
                asm volatile("" ::: "memory"); __builtin_amdgcn_sched_barrier(0);
            }
    }
};
struct EpiZ {
    static constexpr bool PERM = true, HAS_MID = false;
    bf16_t* Z; bf16_t* GATE;
    __device__ __forceinline__ void mid(int, f32x4 (&)[2][2][4][2], const Unit&, int, int, int, int) const {}
    __device__ __forceinline__ void operator()(const f32x4 (&acc)[2][2][4][2], const Unit& u, int wr, int wc, int fr, int fq) const {
        const int row0 = u.pm * BM + wr * 64 + fr;
        if (u.pn < 24) {
            const bool isgelu = (u.pn >= 3) && (u.pn <= 6);
            const int col0 = u.pn * BM + wc * 32 + 8 * fq;
#pragma unroll
            for (int ai = 0; ai < 2; ++ai)
#pragma unroll
                for (int m = 0; m < 4; ++m) {
                    bf16_t* rowp = Z + (size_t)(row0 + ai * HALF + m * 16) * NZ_ + col0;
#pragma unroll
                    for (int bj = 0; bj < 2; ++bj) {
                        f32x4 v0 = acc[ai][bj][m][0], v1 = acc[ai][bj][m][1];
                        if (isgelu) {
#pragma unroll
                            for (int j = 0; j < 4; ++j) { v0[j] = gelu_fast(v0[j]); v1[j] = gelu_fast(v1[j]); }
                        }
                        u32x4 w; w.x = pk2(v0[0], v0[1]); w.y = pk2(v0[2], v0[3]); w.z = pk2(v1[0], v1[1]); w.w = pk2(v1[2], v1[3]);
                        *(u32x4*)(rowp + bj * HALF) = w;
                    }
                    asm volatile("" ::: "memory"); __builtin_amdgcn_sched_barrier(0);
                }
        } else {
            const int mc0 = (u.pn - 24) * 64 + wc * 16 + 4 * fq;
#pragma unroll
            for (int ai = 0; ai < 2; ++ai)
#pragma unroll
                for (int m = 0; m < 4; ++m) {
                    bf16_t* rowp = GATE + (size_t)(row0 + ai * HALF + m * 16) * D_ + mc0;
                    f32x4 e[4];
#pragma unroll
                    for (int br = 0; br < 4; ++br)
#pragma unroll
                        for (int j = 0; j < 4; ++j) e[br][j] = fminf(1.0f + fexp(-acc[ai][br >> 1][m][br & 1][j]), 1e30f);
                    f32x4 i0, i1, i2, i3;
#pragma unroll
                    for (int j = 0; j < 4; ++j) { i0[j] = frcp(e[0][j]); i1[j] = frcp(e[1][j]); i2[j] = frcp(e[2][j]); i3[j] = frcp(e[3][j]); }
                    const f32x4 r0 = e[1] * i0, r1 = e[2] * i1, r2 = e[3] * i2;
                    u32x2 w;
                    w.x = pk2(r0[0], r0[1]); w.y = pk2(r0[2], r0[3]); *(u32x2*)(rowp) = w;
                    w.x = pk2(r1[0], r1[1]); w.y = pk2(r1[2], r1[3]); *(u32x2*)(rowp + (size_t)T_ * D_) = w;
                    w.x = pk2(r2[0], r2[1]); w.y = pk2(r2[2], r2[3]); *(u32x2*)(rowp + (size_t)2 * T_ * D_) = w;
                    w.x = pk2(i3[0], i3[1]); w.y = pk2(i3[2], i3[3]); *(u32x2*)(rowp + (size_t)3 * T_ * D_) = w;
                    asm volatile("" ::: "memory"); __builtin_amdgcn_sched_barrier(0);
                }
        }
    }
};
struct EpiBf16 {
    static constexpr bool PERM = true, HAS_MID = false;
    bf16_t* O; int ldc;
    __device__ __forceinline__ void mid(int, f32x4 (&)[2][2][4][2], const Unit&, int, int, int, int) const {}
    __device__ __forceinline__ void operator()(const f32x4 (&acc)[2][2][4][2], const Unit& u, int wr, int wc, int fr, int fq) const {
        const int row0 = u.pm * BM + wr * 64 + fr, col0 = u.pn * BM + wc * 32 + 8 * fq;
#pragma unroll
        for (int ai = 0; ai < 2; ++ai)
#pragma unroll
            for (int m = 0; m < 4; ++m) {
                bf16_t* rowp = O + (size_t)(row0 + ai * HALF + m * 16) * ldc + col0;
#pragma unroll
                for (int bj = 0; bj < 2; ++bj) {
                    const f32x4 v0 = acc[ai][bj][m][0], v1 = acc[ai][bj][m][1];
                    u32x4 w; w.x = pk2(v0[0], v0[1]); w.y = pk2(v0[2], v0[3]); w.z = pk2(v1[0], v1[1]); w.w = pk2(v1[2], v1[3]);
                    *(u32x4*)(rowp + bj * HALF) = w;
                }
                asm volatile("" ::: "memory"); __builtin_amdgcn_sched_barrier(0);
            }
    }
};
struct EpiBR {
    static constexpr bool PERM = true, HAS_MID = true;
    bf16_t* O; const bf16_t* GATE;
    __device__ __forceinline__ void scale(const bf16_t* plane, f32x4 (&acc)[2][2][4][2], const Unit& u, int wr, int wc, int fr, int fq) const {
        const int row0 = u.pm * BM + wr * 64 + fr, col0 = u.pn * BM + wc * 32 + 8 * fq;
        u32x4 r[2][4][2];
#pragma unroll
        for (int ai = 0; ai < 2; ++ai)
#pragma unroll
            for (int m = 0; m < 4; ++m)
#pragma unroll
                for (int bj = 0; bj < 2; ++bj) r[ai][m][bj] = *(const u32x4*)(plane + (size_t)(row0 + ai * HALF + m * 16) * D_ + col0 + bj * HALF);
#pragma unroll
        for (int ai = 0; ai < 2; ++ai)
#pragma unroll
            for (int m = 0; m < 4; ++m)
#pragma unroll
                for (int bj = 0; bj < 2; ++bj) { const u32x4 e = r[ai][m][bj];
                    acc[ai][bj][m][0] *= (f32x4){bflo(e.x), bfhi(e.x), bflo(e.y), bfhi(e.y)}; acc[ai][bj][m][1] *= (f32x4){bflo(e.z), bfhi(e.z), bflo(e.w), bfhi(e.w)}; }
    }
    __device__ __forceinline__ void mid(int t, f32x4 (&acc)[2][2][4][2], const Unit& u, int wr, int wc, int fr, int fq) const {
        if (t != 8 && t != 16 && t != 24) return;
        asm volatile("" : "+v"(fr), "+v"(fq));
        scale(GATE + (size_t)((t >> 3) - 1) * T_ * D_, acc, u, wr, wc, fr, fq);
    }
    __device__ __forceinline__ void operator()(f32x4 (&acc)[2][2][4][2], const Unit& u, int wr, int wc, int fr, int fq) const {
        scale(GATE + (size_t)3 * T_ * D_, acc, u, wr, wc, fr, fq);
        const int row0 = u.pm * BM + wr * 64 + fr, col0 = u.pn * BM + wc * 32 + 8 * fq;
#pragma unroll
        for (int ai = 0; ai < 2; ++ai)
#pragma unroll
            for (int m = 0; m < 4; ++m) {
                bf16_t* rowp = O + (size_t)(row0 + ai * HALF + m * 16) * D_ + col0;
#pragma unroll
                for (int bj = 0; bj < 2; ++bj) {
                    const f32x4 a0 = acc[ai][bj][m][0], a1 = acc[ai][bj][m][1];
                    u32x4 w; w.x = pk2(a0[0], a0[1]); w.y = pk2(a0[2], a0[3]); w.z = pk2(a1[0], a1[1]); w.w = pk2(a1[2], a1[3]);
                    *(u32x4*)(rowp + bj * HALF) = w;
                }
            }
    }
};

template <class Epi, bool KREV = false>
__device__ __forceinline__ void gemm_phase(LAS unsigned char* lds, const Gemm g, const StaticOrder& S, const Epi& E) {
    int tid = threadIdx.x; asm volatile("" : "+v"(tid));
    const int wid = __builtin_amdgcn_readfirstlane(tid >> 6), lane = tid & 63, wr = wid >> 2, wc = wid & 3, fr = lane & 15, fq = lane >> 4;
    const int K = g.K, nt = K / BK;
    unsigned voffA[2], voffB[2];
#pragma unroll
    for (int i = 0; i < 2; ++i) { int R, C; stage_rc(tid * 16 + i * 8192, R, C); const int Rb = Epi::PERM ? ((R & ~31) + perm32(R & 31)) : R;
        voffA[i] = (unsigned)(R * K + C) * 2u; voffB[i] = (unsigned)(Rb * K + C) * 2u; }
    const long kstep = KREV ? -(long)(BK * 2) : (long)(BK * 2);
    const size_t kbase = KREV ? (size_t)(nt - 1) * (BK * 2) : 0;
    const size_t hstep = (size_t)HALF * K * 2;
    const size_t tstep = 2 * hstep;
    const unsigned ldsw = (unsigned)wid * 1024u;
    const int aoff = lds_byte(wr * 64 + fr, fq * 8), boff = lds_byte(wc * 32 + fr, fq * 8);
#define PG8_SA(b, h) (((b) * 2 + (h)) * HTB)
#define PG8_SB(b, h) ((4 + (b) * 2 + (h)) * HTB)
#define PG8_STAGE(bufoff, gbase, voff) do { _Pragma("unroll") for (int _i = 0; _i < 2; ++_i) \
        __builtin_amdgcn_global_load_lds((const unsigned*)((const char*)(gbase) + (voff)[_i]), (LAS unsigned*)(lds + (bufoff) + ldsw + _i * 8192), 16, 0, 0); } while (0)
#define PG8_LDA(dst, b, h) do { _Pragma("unroll") for (int m = 0; m < 4; ++m) _Pragma("unroll") for (int k = 0; k < 2; ++k) dst[m][k] = *(const LAS bf16x8*)(lds + PG8_SA(b, h) + aoff + m * 2048 + k * 1024); } while (0)
#define PG8_LDB(dst, b, h) do { _Pragma("unroll") for (int n = 0; n < 2; ++n) _Pragma("unroll") for (int k = 0; k < 2; ++k) dst[n][k] = *(const LAS bf16x8*)(lds + PG8_SB(b, h) + boff + n * 2048 + k * 1024); } while (0)
#define PG8_MMA(ai, bj, At, Bt) do { __builtin_amdgcn_s_setprio(1); _Pragma("unroll") for (int m = 0; m < 4; ++m) _Pragma("unroll") for (int n = 0; n < 2; ++n) _Pragma("unroll") for (int k = 0; k < 2; ++k) \
        acc[ai][bj][m][n] = __builtin_amdgcn_mfma_f32_16x16x32_bf16(Bt[n][k], At[m][k], acc[ai][bj][m][n], 0, 0, 0); __builtin_amdgcn_s_setprio(0); } while (0)
#define PG8_WAIT_V(n) asm volatile("s_waitcnt vmcnt(" #n ")" ::: "memory")
#define PG8_WAIT_L(n) asm volatile("s_waitcnt lgkmcnt(" #n ")" ::: "memory")
#define PG8_BAR __builtin_amdgcn_s_barrier()
#define PG8_SCHED __builtin_amdgcn_sched_barrier(0)
    Unit cur, nxt; int ui = 0;
    if (!S.next(0, cur)) return;
    f32x4 acc[2][2][4][2];
#pragma unroll
    for (int a = 0; a < 2; ++a)
#pragma unroll
        for (int b = 0; b < 2; ++b)
#pragma unroll
            for (int m = 0; m < 4; ++m)
#pragma unroll
                for (int n = 0; n < 2; ++n) acc[a][b][m][n] = (f32x4){0.f, 0.f, 0.f, 0.f};
    bf16x8 At[4][2], B0[2][2], B1[2][2];
    const char* cA = (const char*)g.A + (size_t)cur.pm * tstep + kbase; const char* cB = (const char*)g.Bt + (size_t)cur.pn * tstep + kbase;
    PG8_STAGE(PG8_SB(0, 0), cB, voffB); PG8_STAGE(PG8_SB(0, 1), cB + hstep, voffB); PG8_STAGE(PG8_SA(0, 0), cA, voffA); PG8_STAGE(PG8_SA(0, 1), cA + hstep, voffA);
    if (wr == 1) PG8_BAR;
    PG8_WAIT_V(2); PG8_BAR;
    PG8_STAGE(PG8_SB(1, 0), cB + kstep, voffB); PG8_STAGE(PG8_SA(1, 0), cA + kstep, voffA); PG8_STAGE(PG8_SB(1, 1), cB + hstep + kstep, voffB);
    PG8_WAIT_V(6); PG8_BAR;
    for (;;) {
        const bool has_next = S.next(ui + 1, nxt);
        const char* nA = has_next ? (const char*)g.A + (size_t)nxt.pm * tstep + kbase : cA; const char* nB = has_next ? (const char*)g.Bt + (size_t)nxt.pn * tstep + kbase : cB;
        for (int t = 0; t < nt; t += 2) {
            const bool last = (t == nt - 2);
            const char* a1 = cA + (long)(t + 1) * kstep;
            const char* a2 = last ? nA : cA + (long)(t + 2) * kstep; const char* b2 = last ? nB : cB + (long)(t + 2) * kstep;
            const char* a3 = a2 + kstep; const char* b3 = b2 + kstep;
            if constexpr (Epi::HAS_MID) E.mid(t, acc, cur, wr, wc, fr, fq);
            PG8_LDB(B0, 0, 0); PG8_LDB(B1, 0, 1); PG8_SCHED; PG8_LDA(At, 0, 0); PG8_STAGE(PG8_SA(1, 1), a1 + hstep, voffA);
            PG8_WAIT_V(8); PG8_WAIT_L(0); PG8_BAR; PG8_MMA(0, 0, At, B0); PG8_MMA(0, 1, At, B1); PG8_BAR; PG8_SCHED;
            PG8_LDA(At, 0, 1); PG8_STAGE(PG8_SB(0, 0), b2, voffB); PG8_STAGE(PG8_SB(0, 1), b2 + hstep, voffB); PG8_STAGE(PG8_SA(0, 0), a2, voffA);
            PG8_WAIT_V(8); PG8_WAIT_L(0); PG8_BAR; PG8_MMA(1, 0, At, B0); PG8_MMA(1, 1, At, B1); PG8_BAR; PG8_SCHED;
            PG8_LDB(B0, 1, 0); PG8_LDB(B1, 1, 1); PG8_SCHED; PG8_LDA(At, 1, 0); PG8_STAGE(PG8_SA(0, 1), a2 + hstep, voffA);
            PG8_WAIT_V(8); PG8_WAIT_L(0); PG8_BAR; PG8_MMA(0, 0, At, B0); PG8_MMA(0, 1, At, B1); PG8_BAR; PG8_SCHED;
            PG8_LDA(At, 1, 1); PG8_STAGE(PG8_SB(1, 0), b3, voffB); PG8_STAGE(PG8_SB(1, 1), b3 + hstep, voffB); PG8_STAGE(PG8_SA(1, 0), a3, voffA);
            PG8_WAIT_V(8); PG8_WAIT_L(0); PG8_BAR; PG8_MMA(1, 0, At, B0); PG8_MMA(1, 1, At, B1); PG8_BAR; PG8_SCHED;
        }
        if (wr == 0) PG8_BAR;
#pragma unroll
        for (int a = 0; a < 2; ++a)
#pragma unroll
            for (int b = 0; b < 2; ++b)
#pragma unroll
                for (int m = 0; m < 4; ++m)
#pragma unroll
                    for (int n = 0; n < 2; ++n) asm volatile("" : "+v"(acc[a][b][m][n]));
        E(acc, cur, wr, wc, fr, fq);
        if (!has_next) break;
#pragma unroll
        for (int a = 0; a < 2; ++a)
#pragma unroll
            for (int b = 0; b < 2; ++b)
#pragma unroll
                for (int m = 0; m < 4; ++m)
#pragma unroll
                    for (int n = 0; n < 2; ++n) acc[a][b][m][n] = (f32x4){0.f, 0.f, 0.f, 0.f};
        cur = nxt; cA = nA; cB = nB; ++ui;
        if (wr == 1) PG8_BAR;
    }
    PG8_WAIT_V(0);
    PG8_BAR;
#undef PG8_SA
#undef PG8_SB
#undef PG8_STAGE
#undef PG8_LDA
#undef PG8_LDB
#undef PG8_MMA
#undef PG8_WAIT_V
#undef PG8_WAIT_L
#undef PG8_BAR
#undef PG8_SCHED
}
}

typedef __attribute__((address_space(1))) unsigned gu32;
#define XB_TMO      128
#define XB_XCNT(j)  (256  + 64 * (j))
#define XB_XSUB(j)  (1280 + 64 * (j))
#define XB_XGEN(j)  (2304 + 64 * (j))
#define XB_TOP      3328
#define XB_TOPGEN   3392
#define XCD_BAR_WORDS 3456
#define XB_SPIN_CAP (1u << 18)

__device__ __forceinline__ unsigned xb_ld(unsigned* p)              { return __hip_atomic_load(p, __ATOMIC_RELAXED, __HIP_MEMORY_SCOPE_AGENT); }
__device__ __forceinline__ unsigned xb_add(unsigned* p, unsigned v) { return __hip_atomic_fetch_add(p, v, __ATOMIC_RELAXED, __HIP_MEMORY_SCOPE_AGENT); }
__device__ __forceinline__ unsigned xb_xcc_id() { return (unsigned)__builtin_amdgcn_s_getreg((3 << 11) | 20) & 0xFu; }
#define XB_SPIN(cond, bar) do { unsigned _sp = 0; while (cond) { __builtin_amdgcn_s_sleep(1); \
    if ((++_sp & 255u) == 0u) { if (xb_ld(&(bar)[XB_TMO])) break; if (_sp > XB_SPIN_CAP) { atomicAdd(&(bar)[XB_TMO], 1u); break; } } } } while (0)

struct XcdBarrier {
    unsigned* bar; unsigned x;
    volatile LAS unsigned* st;
};

__device__ __forceinline__ XcdBarrier xcd_barrier_post(unsigned* bar, volatile LAS unsigned* st) {
    XcdBarrier b; b.bar = bar; b.x = xb_xcc_id(); b.st = st;
    if (threadIdx.x == 0) (void)xb_add(&bar[XB_XCNT(b.x)], 1u);
    return b;
}
__device__ __forceinline__ void xcd_barrier_complete(unsigned* bar, unsigned x, unsigned& nloc, unsigned& nx) {
    const unsigned G = gridDim.x * gridDim.y * gridDim.z;
    unsigned sum, cnt, mine, sp = 0u;
    for (;;) {
        sum = 0u; cnt = 0u; mine = 0u;
#pragma unroll
        for (unsigned j = 0; j < 16; ++j) { const unsigned c = xb_ld(&bar[XB_XCNT(j)]); sum += c; cnt += (c > 0u) ? 1u : 0u; mine = (j == x) ? c : mine; }
        if (sum == G) break;
        __builtin_amdgcn_s_sleep(1);
        if ((++sp & 255u) == 0u) { if (xb_ld(&bar[XB_TMO])) break; if (sp > XB_SPIN_CAP) { atomicAdd(&bar[XB_TMO], 1u); break; } }
    }
    nloc = mine > 0u ? mine : 1u; nx = cnt > 0u ? cnt : 1u;
}

__device__ __forceinline__ void xcd_barrier(const XcdBarrier& b) {
    asm volatile("s_waitcnt vmcnt(0)" ::: "memory");
    __syncthreads();
    if (threadIdx.x == 0) {
        unsigned* bar = b.bar;
        __builtin_amdgcn_s_waitcnt(0);
        unsigned nloc = b.st[0], nx = b.st[1];
        if (nloc == 0u) { xcd_barrier_complete(bar, b.x, nloc, nx); b.st[0] = nloc; b.st[1] = nx; }
        const unsigned old = xb_add(&bar[XB_XSUB(b.x)], 1u);
        const unsigned gen = old / nloc;
        if (old + 1u == (gen + 1u) * nloc) {
            __builtin_amdgcn_fence(__ATOMIC_RELEASE, "agent");
            asm volatile("s_waitcnt vmcnt(0)" ::: "memory");
            const unsigned og = xb_add(&bar[XB_TOP], 1u);
            const unsigned tg = og / nx;
            if (og + 1u == (tg + 1u) * nx) xb_add(&bar[XB_TOPGEN], 1u);
            else XB_SPIN(xb_ld(&bar[XB_TOPGEN]) == tg, bar);
            __builtin_amdgcn_fence(__ATOMIC_ACQUIRE, "agent");
            xb_add(&bar[XB_XGEN(b.x)], 1u);
            asm volatile("s_waitcnt vmcnt(0)" ::: "memory");
        } else {
            XB_SPIN(xb_ld(&bar[XB_XGEN(b.x)]) == gen, bar);
            __builtin_amdgcn_fence(__ATOMIC_ACQUIRE, "agent");
            asm volatile("s_waitcnt vmcnt(0)" ::: "memory");
        }
    }
    __syncthreads();
}


__device__ __forceinline__ void panel_barrier(unsigned* cnt, unsigned& epoch) {
    asm volatile("s_waitcnt vmcnt(0)" ::: "memory");
    __syncthreads();
    ++epoch;
    if (threadIdx.x == 0) {
        (void)xb_add(cnt, 1u);
        unsigned sp = 0u;
        while (xb_ld(cnt) < 4u * epoch) { __builtin_amdgcn_s_sleep(1); if (++sp > (1u << 22)) break; }
        __builtin_amdgcn_fence(__ATOMIC_ACQUIRE, "agent");
        asm volatile("s_waitcnt vmcnt(0)" ::: "memory");
    }
    __syncthreads();
}

struct Args { const float* in[22]; float* out; unsigned char* ws; int ph_lo, ph_hi; };

typedef LAS unsigned long long* PTab;
__device__ __forceinline__ const float* ldptr(PTab pt, int k) {
    const unsigned long long v = pt[k];
    const unsigned lo = __builtin_amdgcn_readfirstlane((unsigned)v), hi = __builtin_amdgcn_readfirstlane((unsigned)(v >> 32));
    return (const float*)(__attribute__((address_space(1))) const float*)(((unsigned long long)hi << 32) | lo);
}

__device__ __forceinline__ int conv_row(int n, int mode, int rowoff) {
    if (mode == 0) return rowoff + n;
    if (mode == 3) { const int br = n >> 11, mc = n & 2047, q = mc >> 6, mcl = mc & 63; return rowoff + 256 * q + 128 * (br >> 1) + 32 * (mcl >> 4) + 8 * ((mcl >> 2) & 3) + 4 * (br & 1) + (mcl & 3); }
    return (n >> 7) * 256 + (n & 127) + (mode == 2 ? 128 : 0);
}
__device__ __forceinline__ void conv_mat(const float* W, int ldw, int K, int N, bf16_t* WT, int pitch, int koff, int mode, int rowoff, int gw, int ngw, int lane) {
    const int nblk = N / 64, nitems = (K / 64) * nblk;
    const int c = lane & 15, q = lane >> 4;
    f32x4 v[16];
    if (gw < nitems) { const int kb = gw / nblk, nb = gw - kb * nblk; const float* src = W + (size_t)(64 * kb + 16 * q) * ldw + 64 * nb + 4 * c;
#pragma unroll
        for (int j = 0; j < 16; ++j) v[j] = __builtin_nontemporal_load((const f32x4*)(src + (size_t)j * ldw)); }
    for (int item = gw; item < nitems; item += ngw) {
        const int kb = item / nblk, nb = item - kb * nblk, k0 = 64 * kb, n0 = 64 * nb;
        u32x4 o[8];
#pragma unroll
        for (int i = 0; i < 4; ++i) {
            o[2 * i].x = pk2(v[0][i], v[1][i]); o[2 * i].y = pk2(v[2][i], v[3][i]); o[2 * i].z = pk2(v[4][i], v[5][i]); o[2 * i].w = pk2(v[6][i], v[7][i]);
            o[2 * i + 1].x = pk2(v[8][i], v[9][i]); o[2 * i + 1].y = pk2(v[10][i], v[11][i]); o[2 * i + 1].z = pk2(v[12][i], v[13][i]); o[2 * i + 1].w = pk2(v[14][i], v[15][i]);
        }
        const int nx = item + ngw;
        if (nx < nitems) { const int kb2 = nx / nblk, nb2 = nx - kb2 * nblk; const float* src = W + (size_t)(64 * kb2 + 16 * q) * ldw + 64 * nb2 + 4 * c;
#pragma unroll
            for (int j = 0; j < 16; ++j) v[j] = __builtin_nontemporal_load((const f32x4*)(src + (size_t)j * ldw)); }
        const int rb = conv_row(n0 + 4 * c, mode, rowoff);
#pragma unroll
        for (int i = 0; i < 4; ++i) {
            bf16_t* dst = WT + (size_t)(rb + i) * pitch + koff + k0 + 16 * q;
            *(u32x4*)dst = o[2 * i]; *(u32x4*)(dst + 8) = o[2 * i + 1];
        }
    }
}

__device__ __forceinline__ void convert_phase(PTab pt, int l, LAS unsigned char* lds, int tid, int wave, int lane, int bid, int G) {
    unsigned char* ws = (unsigned char*)ldptr(pt, 23);
    const int gw = bid * 8 + wave, ngw = G * 8;
    for (int s = 0; s < 2; ++s) {
        bf16_t* wgu = (bf16_t*)(ws + WS_WGU + (size_t)s * 44 * MiB);
        conv_mat(ldptr(pt, 4) + (size_t)(l * 2 + s) * D_ * FF_, FF_, D_, FF_, wgu, D_, 0, 1, 0, gw, ngw, lane);
        conv_mat(ldptr(pt, 5) + (size_t)(l * 2 + s) * D_ * FF_, FF_, D_, FF_, wgu, D_, 0, 2, 0, gw, ngw, lane);
        conv_mat(ldptr(pt, 6) + (size_t)(l * 2 + s) * D_ * FF_, D_, FF_, D_, (bf16_t*)(ws + WS_WD + (size_t)s * 22 * MiB), FF_, 0, 0, 0, gw, ngw, lane);
    }
    conv_mat(ldptr(pt, 7) + (size_t)l * D_ * NIN_, NIN_, D_, NZ_, (bf16_t*)(ws + WS_WIN), D_, 0, 0, 0, gw, ngw, lane);
    conv_mat(ldptr(pt, 7) + (size_t)l * D_ * NIN_ + NZ_, NIN_, D_, NGT_, (bf16_t*)(ws + WS_WIN), D_, 0, 3, NZ_, gw, ngw, lane);
    conv_mat(ldptr(pt, 15) + (size_t)l * 512 * D_, D_, 512, D_, (bf16_t*)(ws + WS_WBR), NO_, 0, 0, 0, gw, ngw, lane);
    conv_mat(ldptr(pt, 16) + (size_t)l * 512 * D_, D_, 512, D_, (bf16_t*)(ws + WS_WBR), NO_, 512, 0, 0, gw, ngw, lane);
    conv_mat(ldptr(pt, 17) + (size_t)l * 512 * D_, D_, 512, D_, (bf16_t*)(ws + WS_WBR), NO_, 1024, 0, 0, gw, ngw, lane);
    conv_mat(ldptr(pt, 18) + (size_t)l * 256 * D_, D_, 256, D_, (bf16_t*)(ws + WS_WBR), NO_, 1536, 0, 0, gw, ngw, lane);
    conv_mat(ldptr(pt, 19) + (size_t)l * D_ * D_, D_, D_, D_, (bf16_t*)(ws + WS_WOUT), D_, 0, 0, 0, gw, ngw, lane);
    conv_mat(ldptr(pt, 20) + (size_t)l * PLE_ * D_, D_, PLE_, D_, (bf16_t*)(ws + WS_WPP), PLE_, 0, 0, 0, gw, ngw, lane);
    conv_mat(ldptr(pt, 21) + (size_t)l * D_ * D_, D_, D_, D_, (bf16_t*)(ws + WS_WPG), D_, 0, 0, 0, gw, ngw, lane);
    if (l == 0) {
        const size_t gt = (size_t)bid * 512 + tid, nth = (size_t)G * 512;
        const f32x4* x4 = (const f32x4*)ldptr(pt, 0); u32x2* xb = (u32x2*)(ws + WS_XB);
        for (size_t i = gt; i < (size_t)T_ * D_ / 4; i += nth) { const f32x4 v = x4[i]; u32x2 w; w.x = pk2(v[0], v[1]); w.y = pk2(v[2], v[3]); xb[i] = w; }
        const f32x4* p4 = (const f32x4*)ldptr(pt, 1); u32x2* pb = (u32x2*)(ws + WS_PB);
        for (size_t i = gt; i < (size_t)2 * T_ * PLE_ / 4; i += nth) { const f32x4 v = p4[i]; u32x2 w; w.x = pk2(v[0], v[1]); w.y = pk2(v[2], v[3]); pb[i] = w; }
    }
}

__device__ __forceinline__ void ln_phase(float* X, bf16_t* XB, const float* g, const float* b, bool final_, int first, int rstep, int bstep, int nb, int lane) {
    const int ngw = rstep;
    for (int bi = 0, row0 = first; bi < nb; ++bi, row0 += bstep) {
        f32x4 v[4][8];
#pragma unroll
        for (int r = 0; r < 4; ++r) { const int row = min(row0 + r * ngw, T_ - 1); const f32x4* xr = (const f32x4*)(X + (size_t)row * D_) + lane;
#pragma unroll
            for (int j = 0; j < 8; ++j) v[r][j] = xr[64 * j]; }
        float mean[4], rstd[4];
#pragma unroll
        for (int r = 0; r < 4; ++r) { float s = 0.f;
#pragma unroll
            for (int j = 0; j < 8; ++j) s += (v[r][j][0] + v[r][j][1]) + (v[r][j][2] + v[r][j][3]);
            mean[r] = s; }
#pragma unroll
        for (int o = 1; o < 64; o <<= 1) {
#pragma unroll
            for (int r = 0; r < 4; ++r) mean[r] += __shfl_xor(mean[r], o); }
#pragma unroll
        for (int r = 0; r < 4; ++r) { mean[r] *= (1.f / D_); float s2 = 0.f;
#pragma unroll
            for (int j = 0; j < 8; ++j) { v[r][j] = v[r][j] - mean[r]; s2 += (v[r][j][0] * v[r][j][0] + v[r][j][1] * v[r][j][1]) + (v[r][j][2] * v[r][j][2] + v[r][j][3] * v[r][j][3]); }
            rstd[r] = s2; }
#pragma unroll
        for (int o = 1; o < 64; o <<= 1) {
#pragma unroll
            for (int r = 0; r < 4; ++r) rstd[r] += __shfl_xor(rstd[r], o); }
#pragma unroll
        for (int r = 0; r < 4; ++r) rstd[r] = 1.f / sqrtf(rstd[r] * (1.f / D_) + LN_EPS);
#pragma unroll
        for (int j = 0; j < 8; ++j) {
            const f32x4 gg = ((const f32x4*)g)[lane + 64 * j], bb = ((const f32x4*)b)[lane + 64 * j];
#pragma unroll
            for (int r = 0; r < 4; ++r) { const int row = row0 + r * ngw;
                if (row < T_) { const f32x4 y = v[r][j] * rstd[r] * gg + bb;
                    if (final_) ((f32x4*)(X + (size_t)row * D_))[lane + 64 * j] = y;
                    else { u32x2 w; w.x = pk2(y[0], y[1]); w.y = pk2(y[2], y[3]); ((u32x2*)(XB + (size_t)row * D_))[lane + 64 * j] = w; } } }
        }
    }
}

__device__ __forceinline__ void attn_unit(LAS unsigned char* L, const bf16_t* Z, int unit, const float* sinks, bf16_t* O, float* DPO, float* DLSE, int tid, int wave, int lane) {
    int qcol, kcol, vcol, base, blk, dil, max_dist, grp = 0, hh = 0; float slope_u, sink = 0.f; bool isA;
    if (unit < 1024) {
        isA = true; blk = unit & 31; const int head = (unit >> 5) & 7, b = unit >> 8, kvh = head >> 2;
        qcol = ZQA + head * 64; kcol = ZKA + kvh * 64; vcol = ZVA + kvh * 64; base = b * SEQ_; dil = 1; max_dist = 127;
        slope_u = __builtin_amdgcn_exp2f(-8.0f * (float)(head + 1) / 20.0f); sink = sinks[head]; hh = head;
    } else {
        isA = false; const int u2 = unit - 1024; grp = u2 >> 9; const int u3 = u2 & 511;
        dil = (grp == 0) ? 1 : (grp == 1 ? 4 : 16); const int nbk = 32 / dil;
        blk = u3 % nbk; const int r = (u3 / nbk) % dil; hh = (u3 / 32) & 3; const int b = u3 >> 7;
        qcol = ZQD + grp * 256 + hh * 64; kcol = ZKD + grp * 256 + hh * 64; vcol = ZVD + grp * 256 + hh * 64; base = b * SEQ_ + r; max_dist = 128;
        slope_u = __builtin_amdgcn_exp2f(-8.0f * (float)(8 + 4 * grp + hh + 1) / 20.0f) * (float)dil;
    }
    LAS bf16_t* Qs = (LAS bf16_t*)L;
    LAS bf16_t* Ks = Qs + 128 * 72;
    LAS bf16_t* Vs = Ks + 272 * 72;
    for (int i = tid; i < 1024; i += 512) { const int r = i >> 3, c = i & 7; const size_t tok = (size_t)(base + (blk * 128 + r) * dil);
        *(LAS u32x4*)(Qs + r * 72 + c * 8) = *(const u32x4*)(Z + tok * NZ_ + qcol + c * 8); }
    {
        u32x4 kv[5], vv[5];
#pragma unroll
        for (int it = 0; it < 5; ++it) { const int i = tid + it * 512; const int r = i >> 3, c = i & 7; const int sub = blk * 128 - 128 + r; const bool ok = (i < 2176) && (r < 256) && (sub >= 0);
            kv[it] = (u32x4){0u, 0u, 0u, 0u}; vv[it] = (u32x4){0u, 0u, 0u, 0u};
            if (ok) { const size_t tok = (size_t)(base + sub * dil); kv[it] = *(const u32x4*)(Z + tok * NZ_ + kcol + c * 8); vv[it] = *(const u32x4*)(Z + tok * NZ_ + vcol + c * 8); } }
#pragma unroll
        for (int it = 0; it < 5; ++it) { const int i = tid + it * 512; const int r = i >> 3, c = i & 7;
            if (i < 2176) {
                *(LAS u32x4*)(Ks + r * 72 + c * 8) = kv[it];
                *(LAS u32x4*)(Vs + r * 72 + c * 8) = vv[it]; } }
    }
    __syncthreads();
    const int q0 = wave * 16, qi = lane & 15, g = lane >> 4;
    bf16x8 bq[2];
#pragma unroll
    for (int ks = 0; ks < 2; ++ks) bq[ks] = *(const LAS bf16x8*)(Qs + (q0 + qi) * 72 + ks * 32 + g * 8);
    f32x4 st[10];
#pragma unroll
    for (int i = 0; i < 10; ++i) { f32x4 acc = {0.f, 0.f, 0.f, 0.f};
#pragma unroll
        for (int ks = 0; ks < 2; ++ks) { const bf16x8 ak = *(const LAS bf16x8*)(Ks + ((wave + i) * 16 + qi) * 72 + ks * 32 + g * 8); acc = mfma16(ak, bq[ks], acc); }
        st[i] = acc; }
    float mx = -3.0e38f;
    const int q = q0 + qi;
#pragma unroll
    for (int i = 0; i < 10; ++i)
#pragma unroll
        for (int j = 0; j < 4; ++j) { const int kk = (wave + i) * 16 + 4 * g + j; const int dist = q + 128 - kk;
            const bool valid = (dist >= 0) && (dist <= max_dist) && (blk > 0 || kk >= 128);
            const float s = valid ? (st[i][j] * 0.125f - slope_u * (float)dist) : -1.0e30f; st[i][j] = s; mx = fmaxf(mx, s); }
    mx = fmaxf(mx, __shfl_xor(mx, 16)); mx = fmaxf(mx, __shfl_xor(mx, 32));
    if (isA) mx = fmaxf(mx, sink);
    float den = 0.f;
#pragma unroll
    for (int i = 0; i < 10; ++i)
#pragma unroll
        for (int j = 0; j < 4; ++j) { const float p = __builtin_amdgcn_exp2f((st[i][j] - mx) * LOG2E); st[i][j] = p; den += p; }
    den += __shfl_xor(den, 16); den += __shfl_xor(den, 32);
    if (isA) den += __builtin_amdgcn_exp2f((sink - mx) * LOG2E);
    f32x4 o[4];
#pragma unroll
    for (int ht = 0; ht < 4; ++ht) o[ht] = (f32x4){0.f, 0.f, 0.f, 0.f};
    const LAS bf16_t* vbase = Vs + (wave * 16 + 4 * g + (qi >> 2)) * 72 + 4 * (qi & 3);
#pragma unroll
    for (int i = 0; i < 5; ++i) {
        u32x4 pw; pw.x = pk2(st[2 * i][0], st[2 * i][1]); pw.y = pk2(st[2 * i][2], st[2 * i][3]); pw.z = pk2(st[2 * i + 1][0], st[2 * i + 1][1]); pw.w = pk2(st[2 * i + 1][2], st[2 * i + 1][3]);
        const bf16x8 bp = __builtin_bit_cast(bf16x8, pw);
#pragma unroll
        for (int ht = 0; ht < 4; ++ht) { const LAS bf16_t* vr = vbase + (2 * i * 16) * 72 + ht * 16;
            const u32x2 va = tr16(vr), vb = tr16(vr + 16 * 72);
            o[ht] = mfma16(mk8(va, vb), bp, o[ht]); } }
    const float inv = 1.0f / den;
    const size_t tok = (size_t)(base + (blk * 128 + q) * dil);
    if (isA) {
#pragma unroll
        for (int ht = 0; ht < 4; ++ht) { u32x2 w; w.x = pk2(o[ht][0] * inv, o[ht][1] * inv); w.y = pk2(o[ht][2] * inv, o[ht][3] * inv);
            *(u32x2*)(O + tok * NO_ + hh * 64 + ht * 16 + 4 * g) = w; }
    } else {
#pragma unroll
        for (int ht = 0; ht < 4; ++ht) *(f32x4*)(DPO + ((size_t)grp * T_ + tok) * 256 + hh * 64 + ht * 16 + 4 * g) = o[ht] * inv;
        if (g == 0) DLSE[((size_t)grp * T_ + tok) * 4 + hh] = mx + logf(den);
    }
    __syncthreads();
}

__device__ __forceinline__ void gmlp_unit(LAS unsigned char* L, const bf16_t* Z, int unit, const float* lng, const float* lnb, const float* ws_, const float* bs, bf16_t* O, int tid, int wave, int lane) {
    const int n = unit >> 2, grp = unit & 3, tok0 = n * 128;
    LAS float* stats = (LAS float*)L;
    LAS bf16_t* vnt = (LAS bf16_t*)(L + 1024);
    LAS bf16_t* Wc = vnt + 128 * 136;
    {
        u32x4 raw[16];
#pragma unroll
        for (int r = 0; r < 16; ++r) raw[r] = *(const u32x4*)(Z + (size_t)(tok0 + 16 * wave + r) * NZ_ + ZVB + lane * 8);
        float s[16], ss[16];
#pragma unroll
        for (int r = 0; r < 16; ++r) { const float x0 = bflo(raw[r].x), x1 = bfhi(raw[r].x), x2 = bflo(raw[r].y), x3 = bfhi(raw[r].y), x4 = bflo(raw[r].z), x5 = bfhi(raw[r].z), x6 = bflo(raw[r].w), x7 = bfhi(raw[r].w);
            s[r] = ((x0 + x1) + (x2 + x3)) + ((x4 + x5) + (x6 + x7)); ss[r] = ((x0 * x0 + x1 * x1) + (x2 * x2 + x3 * x3)) + ((x4 * x4 + x5 * x5) + (x6 * x6 + x7 * x7)); }
#pragma unroll
        for (int o = 1; o < 64; o <<= 1) {
#pragma unroll
            for (int r = 0; r < 16; ++r) { s[r] += __shfl_xor(s[r], o); ss[r] += __shfl_xor(ss[r], o); } }
        if (lane < 16) { float m = 0.f, q = 0.f;
#pragma unroll
            for (int r = 0; r < 16; ++r) if (lane == r) { m = s[r]; q = ss[r]; }
            m *= (1.f / 512.f); const float var = fmaxf(q * (1.f / 512.f) - m * m, 0.f);
            stats[(16 * wave + lane) * 2] = m; stats[(16 * wave + lane) * 2 + 1] = 1.f / sqrtf(var + LN_EPS); }
    }
#pragma unroll
    for (int it = 0; it < 8; ++it) { const int i = tid + it * 512; const int t = i >> 5, s4 = (i & 31) * 4;
        f32x4 w = *(const f32x4*)(ws_ + (size_t)(grp * 128 + t) * 128 + s4);
#pragma unroll
        for (int e = 0; e < 4; ++e) if (s4 + e > t) w[e] = 0.f;
        u32x2 p; p.x = pk2(w[0], w[1]); p.y = pk2(w[2], w[3]); *(LAS u32x2*)(Wc + t * 136 + s4) = p; }
    u32x4 vraw[4];
#pragma unroll
    for (int it = 0; it < 4; ++it) { const int i = tid + it * 512; const int s = i >> 4, c8 = (i & 15) * 8;
        vraw[it] = *(const u32x4*)(Z + (size_t)(tok0 + s) * NZ_ + ZVB + grp * 128 + c8); }
    __syncthreads();
#pragma unroll
    for (int it = 0; it < 4; ++it) { const int i = tid + it * 512; const int s = i >> 4, c8 = (i & 15) * 8;
        const u32x4 raw = vraw[it];
        const float mean = stats[s * 2], rstd = stats[s * 2 + 1];
        float x[8]; x[0] = bflo(raw.x); x[1] = bfhi(raw.x); x[2] = bflo(raw.y); x[3] = bfhi(raw.y); x[4] = bflo(raw.z); x[5] = bfhi(raw.z); x[6] = bflo(raw.w); x[7] = bfhi(raw.w);
        const f32x4 g0 = *(const f32x4*)(lng + grp * 128 + c8), g1 = *(const f32x4*)(lng + grp * 128 + c8 + 4), b0 = *(const f32x4*)(lnb + grp * 128 + c8), b1 = *(const f32x4*)(lnb + grp * 128 + c8 + 4);
        float y[8];
#pragma unroll
        for (int e = 0; e < 8; ++e) y[e] = (x[e] - mean) * rstd * (e < 4 ? g0[e & 3] : g1[e & 3]) + (e < 4 ? b0[e & 3] : b1[e & 3]);
        u32x4 w; w.x = pk2(y[0], y[1]); w.y = pk2(y[2], y[3]); w.z = pk2(y[4], y[5]); w.w = pk2(y[6], y[7]);
        *(LAS u32x4*)(vnt + s * 136 + c8) = w; }
    __syncthreads();
    const int qi = lane & 15, g = lane >> 4;
    const int t = 16 * wave + qi; const float bias = bs[grp * 128 + t];
    const size_t tok = (size_t)(tok0 + t);
    u32x2 ur[8];
#pragma unroll
    for (int ct = 0; ct < 8; ++ct) ur[ct] = *(const u32x2*)(Z + tok * NZ_ + ZUB + grp * 128 + 16 * ct + 4 * g);
    f32x4 acc[8];
#pragma unroll
    for (int ct = 0; ct < 8; ++ct) acc[ct] = (f32x4){0.f, 0.f, 0.f, 0.f};
#pragma unroll
    for (int ks = 0; ks < 4; ++ks) { const bf16x8 bw = *(const LAS bf16x8*)(Wc + (16 * wave + qi) * 136 + ks * 32 + g * 8);
#pragma unroll
        for (int ct = 0; ct < 8; ++ct) { const LAS bf16_t* vr = vnt + (ks * 32 + 8 * g + (qi >> 2)) * 136 + 16 * ct + 4 * (qi & 3);
            acc[ct] = mfma16(mk8(tr16(vr), tr16(vr + 4 * 136)), bw, acc[ct]); } }
#pragma unroll
    for (int ct = 0; ct < 8; ++ct) { const int c = 16 * ct + 4 * g;
        u32x2 w; w.x = pk2(bflo(ur[ct].x) * (acc[ct][0] + bias), bfhi(ur[ct].x) * (acc[ct][1] + bias));
        w.y = pk2(bflo(ur[ct].y) * (acc[ct][2] + bias), bfhi(ur[ct].y) * (acc[ct][3] + bias));
        *(u32x2*)(O + tok * NO_ + 512 + grp * 128 + c) = w; }
    __syncthreads();
}

__device__ __forceinline__ float hgrn_lb(const float* lbl, int layer, int c) { return layer == 0 ? 0.0f : 1.0f / (1.0f + expf(lbl[c] - lbl[512 + c])); }

__device__ __forceinline__ void hgrn_c1_unit(LAS unsigned char* L, const bf16_t* Z, int unit, const float* lbl, int layer, float* DS, float* DEC, int tid, int wave, int lane) {
    const int h = unit & 3, cg_ = unit >> 2, tok0 = cg_ * 64;
    const int k = tid & 127, qtr = tid >> 7;
    LAS float* qsum = (LAS float*)L;
    LAS bf16_t* kt = (LAS bf16_t*)(L + 2048);
    LAS bf16_t* vt = kt + 128 * 72;
    const float lb = hgrn_lb(lbl, layer, h * 128 + k);
    float G[16], kk[16]; float run = 0.f;
    unsigned vraw[16];
#pragma unroll
    for (int i = 0; i < 16; ++i) { const size_t tok = (size_t)(tok0 + 16 * qtr + i);
        const float zf = bf2f(Z[tok * NZ_ + ZFC + h * 128 + k]);
        vraw[i] = Z[tok * NZ_ + ZIC + h * 128 + k];
        const float e = fexp(-zf), sg = frcp(1.0f + e);
        const float f = lb + (1.0f - lb) * sg;
        run += logf(fmaxf(f, 1e-6f)); G[i] = run; kk[i] = (1.0f - lb) * e * sg; }
    qsum[qtr * 128 + k] = run;
    __syncthreads();
    float off = 0.f, tot = 0.f;
#pragma unroll
    for (int qq = 0; qq < 4; ++qq) { const float v = qsum[qq * 128 + k]; tot += v; if (qq < qtr) off += v; }
    unsigned kw[8], vw[8];
#pragma unroll
    for (int i = 0; i < 8; ++i) { const float a0 = kk[2 * i] * fexp(tot - (G[2 * i] + off)), a1 = kk[2 * i + 1] * fexp(tot - (G[2 * i + 1] + off));
        kw[i] = pk2(a0, a1); vw[i] = vraw[2 * i] | (vraw[2 * i + 1] << 16); }
    *(LAS u32x4*)(kt + k * 72 + 16 * qtr) = (u32x4){kw[0], kw[1], kw[2], kw[3]}; *(LAS u32x4*)(kt + k * 72 + 16 * qtr + 8) = (u32x4){kw[4], kw[5], kw[6], kw[7]};
    *(LAS u32x4*)(vt + k * 72 + 16 * qtr) = (u32x4){vw[0], vw[1], vw[2], vw[3]}; *(LAS u32x4*)(vt + k * 72 + 16 * qtr + 8) = (u32x4){vw[4], vw[5], vw[6], vw[7]};
    if (qtr == 0) DEC[(size_t)unit * 128 + k] = fexp(tot);
    __syncthreads();
    const int qi = lane & 15, g = lane >> 4;
    bf16x8 av[2];
#pragma unroll
    for (int ks = 0; ks < 2; ++ks) av[ks] = *(const LAS bf16x8*)(vt + (16 * wave + qi) * 72 + ks * 32 + g * 8);
    float* dst = DS + (size_t)unit * 16384;
#pragma unroll
    for (int ktile = 0; ktile < 8; ++ktile) { f32x4 acc = {0.f, 0.f, 0.f, 0.f};
#pragma unroll
        for (int ks = 0; ks < 2; ++ks) { const bf16x8 bk = *(const LAS bf16x8*)(kt + (16 * ktile + qi) * 72 + ks * 32 + g * 8); acc = mfma16(av[ks], bk, acc); }
#pragma unroll
        for (int j = 0; j < 4; ++j) dst[(16 * wave + 4 * g + j) * 128 + 16 * ktile + qi] = acc[j]; }
    __syncthreads();
}

__device__ __forceinline__ void hgrn_scan_phase(const float* DS, const float* DEC, bf16_t* HS, int tid, int bid, int G) {
    const int nth = G * 512;
    for (int p = bid * 512 + tid; p < 16 * 8192; p += nth) {
        const int bh = p >> 13, idx = (p & 8191) * 2, k = idx & 127, b = bh >> 2, h = bh & 3;
        f32x2 S = {0.f, 0.f};
#pragma unroll 16
        for (int c = 0; c < 64; ++c) { const size_t u = (size_t)(((b * 64 + c) << 2) | h);
            *(unsigned*)(HS + u * 16384 + idx) = pk2(S[0], S[1]);
            const f32x2 d = *(const f32x2*)(DEC + u * 128 + k), ds = *(const f32x2*)(DS + u * 16384 + idx);
            S = d * S + ds; }
    }
}

__device__ __forceinline__ void hgrn_c3_unit(LAS unsigned char* L, const bf16_t* Z, int unit, const float* lbl, int layer, const bf16_t* HS, const float* ng, bf16_t* O, int tid, int wave, int lane) {
    const int h = unit & 3, cg_ = unit >> 2, tok0 = cg_ * 64;
    const int k = tid & 127, qtr = tid >> 7;
    LAS float* qsum = (LAS float*)L;
    LAS bf16_t* kT = (LAS bf16_t*)(L + 2048);
    LAS bf16_t* qT = kT + 128 * 72;
    LAS bf16_t* qC = qT + 128 * 72;
    LAS bf16_t* vt = qC + 128 * 72;
    LAS float* oL = (LAS float*)(L + 2048 + 4 * 128 * 72 * 2);
    const float lb = hgrn_lb(lbl, layer, h * 128 + k);
    float G[16], kk[16], qv[16]; float run = 0.f;
    unsigned vraw[16];
#pragma unroll
    for (int i = 0; i < 16; ++i) { const size_t tok = (size_t)(tok0 + 16 * qtr + i);
        const float zf = bf2f(Z[tok * NZ_ + ZFC + h * 128 + k]);
        qv[i] = bf2f(Z[tok * NZ_ + ZQC + h * 128 + k]);
        vraw[i] = Z[tok * NZ_ + ZIC + h * 128 + k];
        const float e = fexp(-zf), sg = frcp(1.0f + e);
        const float f = lb + (1.0f - lb) * sg;
        run += logf(fmaxf(f, 1e-6f)); G[i] = run; kk[i] = (1.0f - lb) * e * sg; }
    qsum[qtr * 128 + k] = run;
    __syncthreads();
    float off = 0.f;
#pragma unroll
    for (int qq = 0; qq < 4; ++qq) { const float v = qsum[qq * 128 + k]; if (qq < qtr) off += v; }
    const float Gm = qsum[k] + qsum[128 + k];
    {
        unsigned kw[8], qw[8], cw[8];
#pragma unroll
        for (int i = 0; i < 8; ++i) { float a[2], b[2], c[2];
#pragma unroll
            for (int e = 0; e < 2; ++e) { const float Gi = G[2 * i + e] + off; const float d = fminf(fmaxf(Gi - Gm, -80.f), 80.f);
                a[e] = kk[2 * i + e] * fexp(-d); b[e] = qv[2 * i + e] * fexp(d); c[e] = qv[2 * i + e] * fexp(Gi); }
            kw[i] = pk2(a[0], a[1]); qw[i] = pk2(b[0], b[1]); cw[i] = pk2(c[0], c[1]); }
        *(LAS u32x4*)(kT + k * 72 + 16 * qtr) = (u32x4){kw[0], kw[1], kw[2], kw[3]}; *(LAS u32x4*)(kT + k * 72 + 16 * qtr + 8) = (u32x4){kw[4], kw[5], kw[6], kw[7]};
        *(LAS u32x4*)(qT + k * 72 + 16 * qtr) = (u32x4){qw[0], qw[1], qw[2], qw[3]}; *(LAS u32x4*)(qT + k * 72 + 16 * qtr + 8) = (u32x4){qw[4], qw[5], qw[6], qw[7]};
        *(LAS u32x4*)(qC + k * 72 + 16 * qtr) = (u32x4){cw[0], cw[1], cw[2], cw[3]}; *(LAS u32x4*)(qC + k * 72 + 16 * qtr + 8) = (u32x4){cw[4], cw[5], cw[6], cw[7]};
    }
    {
        unsigned vw[8];
#pragma unroll
        for (int i = 0; i < 8; ++i) vw[i] = vraw[2 * i] | (vraw[2 * i + 1] << 16);
        *(LAS u32x4*)(vt + k * 72 + 16 * qtr) = (u32x4){vw[0], vw[1], vw[2], vw[3]}; *(LAS u32x4*)(vt + k * 72 + 16 * qtr + 8) = (u32x4){vw[4], vw[5], vw[6], vw[7]};
    }
    __syncthreads();
    const int qi = lane & 15, g = lane >> 4, tt = wave & 3, vh = wave >> 2;
    const bf16_t* hs = HS + (size_t)unit * 16384;
    bf16x8 ahs[4][4];
#pragma unroll
    for (int ks = 0; ks < 4; ++ks)
#pragma unroll
        for (int v_ = 0; v_ < 4; ++v_) ahs[ks][v_] = *(const bf16x8*)(hs + (16 * (4 * vh + v_) + qi) * 128 + ks * 32 + g * 8);
    unsigned graw[8][2];
#pragma unroll
    for (int r = 0; r < 8; ++r) { const size_t tok = (size_t)(tok0 + 8 * wave + r); graw[r][0] = Z[tok * NZ_ + ZGC + h * 128 + lane]; graw[r][1] = Z[tok * NZ_ + ZGC + h * 128 + 64 + lane]; }
    f32x4 sc[4];
#pragma unroll
    for (int st = 0; st < 4; ++st) { sc[st] = (f32x4){0.f, 0.f, 0.f, 0.f};
        if (st <= tt) {
#pragma unroll
            for (int ks = 0; ks < 4; ++ks) { const int ro = (ks * 32 + 8 * g + (qi >> 2)) * 72 + 4 * (qi & 3);
                const bf16x8 a = mk8(tr16(kT + ro + 16 * st), tr16(kT + ro + 4 * 72 + 16 * st)), b = mk8(tr16(qT + ro + 16 * tt), tr16(qT + ro + 4 * 72 + 16 * tt));
                sc[st] = mfma16(a, b, sc[st]); }
#pragma unroll
            for (int j = 0; j < 4; ++j) if (16 * st + 4 * g + j > 16 * tt + qi) sc[st][j] = 0.f;
        } }
    f32x4 o[4];
#pragma unroll
    for (int v_ = 0; v_ < 4; ++v_) o[v_] = (f32x4){0.f, 0.f, 0.f, 0.f};
#pragma unroll
    for (int i = 0; i < 2; ++i) {
        u32x4 pw; pw.x = pk2(sc[2 * i][0], sc[2 * i][1]); pw.y = pk2(sc[2 * i][2], sc[2 * i][3]); pw.z = pk2(sc[2 * i + 1][0], sc[2 * i + 1][1]); pw.w = pk2(sc[2 * i + 1][2], sc[2 * i + 1][3]);
        const bf16x8 bp = __builtin_bit_cast(bf16x8, pw);
#pragma unroll
        for (int v_ = 0; v_ < 4; ++v_) { const LAS bf16_t* vr = vt + (16 * (4 * vh + v_) + qi) * 72 + 4 * g;
            const u32x2 va = *(const LAS u32x2*)(vr + (2 * i) * 16), vb = *(const LAS u32x2*)(vr + (2 * i + 1) * 16);
            o[v_] = mfma16(mk8(va, vb), bp, o[v_]); } }
#pragma unroll
    for (int ks = 0; ks < 4; ++ks) { const int ro = (ks * 32 + 8 * g + (qi >> 2)) * 72 + 4 * (qi & 3) + 16 * tt; const bf16x8 b = mk8(tr16(qC + ro), tr16(qC + ro + 4 * 72));
#pragma unroll
        for (int v_ = 0; v_ < 4; ++v_) o[v_] = mfma16(ahs[ks][v_], b, o[v_]); }
#pragma unroll
    for (int v_ = 0; v_ < 4; ++v_) *(LAS f32x4*)(oL + (16 * tt + qi) * 132 + 16 * (4 * vh + v_) + 4 * g) = o[v_];
    __syncthreads();
    const float ng0 = ng[h * 128 + lane], ng1 = ng[h * 128 + 64 + lane];
#pragma unroll
    for (int r = 0; r < 8; ++r) { const int t = 8 * wave + r;
        const float x0 = oL[t * 132 + lane], x1 = oL[t * 132 + 64 + lane];
        const float ss = wave_sum(x0 * x0 + x1 * x1);
        const float rs = 1.0f / sqrtf(ss * (1.f / 128.f) + LN_EPS);
        const size_t tok = (size_t)(tok0 + t);
        const float g0 = bf2f(graw[r][0]), g1 = bf2f(graw[r][1]);
        const float y0 = x0 * rs * ng0 * fsigmoid(g0), y1 = x1 * rs * ng1 * fsigmoid(g1);
        O[tok * NO_ + 1024 + h * 128 + lane] = (bf16_t)(pk2(y0, 0.f) & 0xffffu);
        O[tok * NO_ + 1024 + h * 128 + 64 + lane] = (bf16_t)(pk2(y1, 0.f) & 0xffffu); }
    __syncthreads();
}

__device__ __forceinline__ void dcomb_phase(const float* DPO, const float* DLSE, bf16_t* O, int tid, int bid, int G) {
    const int nth = G * 512;
#pragma unroll 4
    for (int i = bid * 512 + tid; i < T_ * 64; i += nth) { const int t = i >> 6, c4 = (i & 63) * 4, h = c4 >> 6;
        const float l0 = DLSE[((size_t)0 * T_ + t) * 4 + h], l1 = DLSE[((size_t)1 * T_ + t) * 4 + h], l2 = DLSE[((size_t)2 * T_ + t) * 4 + h];
        const float m = fmaxf(l0, fmaxf(l1, l2));
        float w0 = fexp(l0 - m), w1 = fexp(l1 - m), w2 = fexp(l2 - m); const float inv = 1.0f / (w0 + w1 + w2); w0 *= inv; w1 *= inv; w2 *= inv;
        const f32x4 a = *(const f32x4*)(DPO + ((size_t)0 * T_ + t) * 256 + c4), b = *(const f32x4*)(DPO + ((size_t)1 * T_ + t) * 256 + c4), c = *(const f32x4*)(DPO + ((size_t)2 * T_ + t) * 256 + c4);
        const f32x4 r = w0 * a + w1 * b + w2 * c;
        u32x2 w; w.x = pk2(r[0], r[1]); w.y = pk2(r[2], r[3]);
        *(u32x2*)(O + (size_t)t * NO_ + 1536 + c4) = w; }
}

constexpr int NPH_LAYER = 14, NPH = 2 * NPH_LAYER;
__global__ void __launch_bounds__(512, 2) hybrid_fwd(Args a) {
    extern __shared__ __attribute__((aligned(16))) unsigned char lds_raw[];
    LAS unsigned char* lds = (LAS unsigned char*)lds_raw;
    PTab pt = (PTab)(lds + 131072);
    if (threadIdx.x == 0) {
#pragma unroll
        for (int i = 0; i < 22; ++i) pt[i] = (unsigned long long)a.in[i];
        pt[22] = (unsigned long long)a.out; pt[23] = (unsigned long long)a.ws;
    }
    if (threadIdx.x < 8) ((LAS unsigned*)(lds + 131072 + 512))[threadIdx.x] = 0u;
    __syncthreads();
    const int ph_lo = a.ph_lo, ph_hi = a.ph_hi;
    unsigned pepoch = 0u; bool fast = false;
    if (threadIdx.x == 0 && blockIdx.x < 8) __hip_atomic_store((unsigned*)(a.ws + WS_CTL + WS_BAR + 15400) + blockIdx.x, xb_xcc_id(), __ATOMIC_RELAXED, __HIP_MEMORY_SCOPE_AGENT);
    XcdBarrier bar = xcd_barrier_post((unsigned*)(a.ws + WS_CTL + WS_BAR), (volatile LAS unsigned*)(lds + 131072 + 512));
    for (int ph = ph_lo; ph < ph_hi; ++ph) {
        const int l = ph / NPH_LAYER, p = ph - l * NPH_LAYER;
        pg8::StaticOrder S;
        int tid = threadIdx.x; asm volatile("" : "+v"(tid));
        int bid = blockIdx.x, G = gridDim.x; asm volatile("" : "+s"(bid), "+s"(G));
        const int lane = tid & 63, wave = __builtin_amdgcn_readfirstlane(tid >> 6);
        unsigned char* ws = (unsigned char*)ldptr(pt, 23);
#define P_X ((float*)ldptr(pt, 22))
#define P_XB ((bf16_t*)(ws + WS_XB))
#define P_ZH ((bf16_t*)(ws + WS_ZH))
#define P_GATE ((bf16_t*)(ws + WS_GATE))
#define P_O ((bf16_t*)(ws + WS_O))
#define P_DS ((float*)(ws + WS_DS))
#define P_DEC ((float*)(ws + WS_CTL))
#define P_HS ((bf16_t*)(ws + WS_HS))
#define P_DPO ((float*)(ws + WS_DPO))
#define P_DLSE ((float*)(ws + WS_DLSE))
        switch (p) {
        case 0: if (l == 0) convert_phase(pt, 0, lds, tid, wave, lane, bid, G); break;
        case 1: case 11: {
            const int s = (p == 1) ? 0 : 1; const int n_ = (p == 1) ? 2 * FF_ : 2 * FF_ + D_;
            pg8::Gemm g{P_XB, (const bf16_t*)(ws + WS_WGU + (size_t)s * 44 * MiB), T_, n_, D_}; S.init(T_, n_, G, bid);
            pg8::EpiSwiGLU E{P_ZH, P_GATE}; pg8::gemm_phase(lds, g, S, E);
        } break;
        case 2: {
            pg8::Gemm g{P_ZH, (const bf16_t*)(ws + WS_WD), T_, D_, FF_}; S.init(T_, D_, G, bid);
            pg8::EpiResidT<false> E{P_X, P_XB, nullptr, ALPHA, 0.5f}; pg8::gemm_phase<pg8::EpiResidT<false>, true>(lds, g, S, E);
        } break;
        case 3: case 10: case 13: {
            const int which = (p == 3) ? 0 : (p == 10 ? 1 : 2);
            if (fast) ln_phase(P_X, P_XB, ldptr(pt, 2) + (size_t)(l * 3 + which) * D_, ldptr(pt, 3) + (size_t)(l * 3 + which) * D_, (l == 1 && p == 13), (8 * (bid & 7) + ((bid >> 3) & 7)) * 256 + (bid >> 6) * 64 + wave * 8, 1, 4, 2, lane);
            else ln_phase(P_X, P_XB, ldptr(pt, 2) + (size_t)(l * 3 + which) * D_, ldptr(pt, 3) + (size_t)(l * 3 + which) * D_, (l == 1 && p == 13), bid * 8 + wave, G * 8, 32 * G, (T_ + 32 * G - 1) / (32 * G), lane);
            if (p == 13 && l == 0) convert_phase(pt, 1, lds, tid, wave, lane, bid, G);
            if (p == 10) { int kp = PLE_; asm volatile("" : "+s"(kp)); pg8::Gemm g2{(const bf16_t*)(ws + WS_PB) + (size_t)l * T_ * PLE_, (const bf16_t*)(ws + WS_WPP), T_, D_, kp}; S.init(T_, D_, G, bid);
                pg8::EpiBf16 E2{P_GATE, D_}; pg8::gemm_phase(lds, g2, S, E2); }
        } break;
        case 4: {
            pg8::Gemm g{P_XB, (const bf16_t*)(ws + WS_WIN), T_, NIN_, D_}; S.init(T_, NIN_, G, bid);
            pg8::EpiZ E{P_ZH, P_GATE}; pg8::gemm_phase(lds, g, S, E);
        } break;
        case 5: {
            for (int u = bid; u < 2560; u += G) attn_unit(lds, P_ZH, u, ldptr(pt, 8) + l * 8, P_O, P_DPO, P_DLSE, tid, wave, lane);
            for (int u = bid; u < 512; u += G) gmlp_unit(lds, P_ZH, u, ldptr(pt, 9) + l * 512, ldptr(pt, 10) + l * 512, ldptr(pt, 11) + (size_t)l * 65536, ldptr(pt, 12) + l * 512, P_O, tid, wave, lane);
            for (int u = bid; u < 1024; u += G) hgrn_c1_unit(lds, P_ZH, u, ldptr(pt, 13), l, P_DS, P_DEC, tid, wave, lane);
        } break;
        case 6: hgrn_scan_phase(P_DS, P_DEC, P_HS, tid, bid, G); break;
        case 7: {
            for (int u = bid; u < 1024; u += G) hgrn_c3_unit(lds, P_ZH, u, ldptr(pt, 13), l, P_HS, ldptr(pt, 14) + l * 512, P_O, tid, wave, lane);
            dcomb_phase(P_DPO, P_DLSE, P_O, tid, bid, G);
        } break;
        case 8: {
            pg8::Gemm g{P_O, (const bf16_t*)(ws + WS_WBR), T_, D_, NO_}; S.init(T_, D_, G, bid);
            pg8::EpiBR E{(bf16_t*)P_DS, P_GATE}; pg8::gemm_phase(lds, g, S, E);
        } break;
        case 9: {
            pg8::Gemm g{(const bf16_t*)P_DS, (const bf16_t*)(ws + WS_WOUT), T_, D_, D_}; S.init(T_, D_, G, bid);
            pg8::EpiResidT<false> E{P_X, P_XB, nullptr, ALPHA, 1.0f}; pg8::gemm_phase(lds, g, S, E);
        } break;
        case 12: {
            pg8::Gemm g{P_ZH, (const bf16_t*)(ws + WS_WD + (size_t)22 * MiB), T_, D_, FF_}; S.init(T_, D_, G, bid);
            pg8::EpiResidT<true> E{P_X, P_XB, P_GATE, ALPHA, 0.5f}; pg8::gemm_phase<pg8::EpiResidT<true>, true>(lds, g, S, E);
        } break;
        default: break;
        }
        if (ph + 1 < ph_hi) {
            if (ph_hi > 1000) { __threadfence(); cg::this_grid().sync(); }
            else if (fast && (p == 2 || p == 8 || p == 9 || p == 10 || p == 11 || (l == 1 && (p == 1 || p == 12))))
                panel_barrier((unsigned*)(ws + WS_CTL + WS_BAR + 16384) + 64 * (8 * (bid & 7) + ((bid >> 3) & 7)), pepoch);
            else xcd_barrier(bar);
            if (ph == 0) { if (threadIdx.x == 0 && xb_xcc_id() != xb_ld((unsigned*)(ws + WS_CTL + WS_BAR + 15400) + (blockIdx.x & 7))) (void)xb_add((unsigned*)(ws + WS_CTL + WS_BAR + 15360), 1u); }
            if (ph == 1) fast = (G == 256) && (__builtin_amdgcn_readfirstlane(xb_ld((unsigned*)(ws + WS_CTL + WS_BAR + 15360))) == 0u);
        }
    }
}

extern "C" void kernel_launch(void* const* d_in, const int* in_sizes, int n_in, void* d_out, int out_size, void* d_ws, size_t ws_size, hipStream_t stream) {
    static int grid = 0;
    if (grid == 0) {
        if (n_in != 22 || out_size != T_ * D_ || ws_size < WS_END) { fprintf(stderr, "kernel_launch: unexpected shapes (n_in %d out %d ws %zu need %zu)\n", n_in, out_size, ws_size, (size_t)WS_END); grid = -1; return; }
        int dev = 0, cus = 0, per_cu = 0;
        hipGetDevice(&dev); hipDeviceGetAttribute(&cus, hipDeviceAttributeMultiprocessorCount, dev);
        if (hipFuncSetAttribute((const void*)hybrid_fwd, hipFuncAttributeMaxDynamicSharedMemorySize, LDS_BYTES) != hipSuccess) { fprintf(stderr, "kernel_launch: hipFuncSetAttribute failed\n"); grid = -1; return; }
        hipOccupancyMaxActiveBlocksPerMultiprocessor(&per_cu, (const void*)hybrid_fwd, 512, LDS_BYTES);
        (void)hipGetLastError();
        if (per_cu < 1) per_cu = 1;
        grid = cus * 1;
    }
    if (grid < 0) return;
    if (hipMemsetAsync((char*)d_ws + WS_CTL + WS_BAR, 0, BAR_BYTES, stream) != hipSuccess) { fprintf(stderr, "kernel_launch: memset failed\n"); return; }
    Args a{};
    for (int i = 0; i < 22; ++i) a.in[i] = (const float*)d_in[i];
    a.out = (float*)d_out; a.ws = (unsigned char*)d_ws; a.ph_lo = 0; a.ph_hi = NPH;
    void* args[] = {&a};
    hipError_t e = hipLaunchCooperativeKernel((const void*)hybrid_fwd, dim3(grid), dim3(512), args, LDS_BYTES, stream);
    if (e != hipSuccess) fprintf(stderr, "cooperative launch failed: %s (grid %d)\n", hipGetErrorString(e), grid);
}
```

```cpp
#include <hip/hip_runtime.h>
#include <hip/hip_cooperative_groups.h>
#include <cstdio>
#include <cstdint>
namespace cg = cooperative_groups;

#define LAS __attribute__((address_space(3)))
typedef unsigned short bf16_t;
typedef short bf16x8 __attribute__((ext_vector_type(8)));
typedef float f32x4 __attribute__((ext_vector_type(4)));
typedef float f32x2 __attribute__((ext_vector_type(2)));
typedef unsigned u32x4 __attribute__((ext_vector_type(4)));
typedef unsigned u32x2 __attribute__((ext_vector_type(2)));

constexpr int T_ = 16384, SEQ_ = 4096, D_ = 2048, FF_ = 5632, NIN_ = 14336, NZ_ = 6144, NGT_ = 8192, NO_ = 1792, PLE_ = 256;
constexpr int ZQA = 0, ZKA = 512, ZVA = 640, ZUB = 768, ZVB = 1280, ZQC = 1792, ZFC = 2304, ZIC = 2816, ZGC = 3328, ZQD = 3840, ZKD = 4608, ZVD = 5376;
constexpr float LN_EPS = 1e-5f;
constexpr float ALPHA = 1.41421356237f;
constexpr float LOG2E = 1.44269504089f;

constexpr size_t MiB = 1u << 20;
constexpr size_t WS_CTL = 0;
constexpr size_t WS_BAR = 768 * 1024, BAR_BYTES = 32768;
constexpr size_t WS_WGU = 1 * MiB;
constexpr size_t WS_WPG = WS_WGU + 88 * MiB;
constexpr size_t WS_WD = WS_WPG + 8 * MiB;
constexpr size_t WS_WIN = WS_WD + 44 * MiB;
constexpr size_t WS_WBR = WS_WIN + 56 * MiB;
constexpr size_t WS_WOUT = WS_WBR + 7 * MiB;
constexpr size_t WS_WPP = WS_WOUT + 8 * MiB;
constexpr size_t WS_PB = WS_WPP + 1 * MiB;
constexpr size_t WS_XB = WS_PB + 16 * MiB;
constexpr size_t WS_ZH = WS_XB + 64 * MiB;
constexpr size_t WS_GATE = WS_ZH + 192 * MiB;
constexpr size_t WS_O = WS_GATE + 256 * MiB;
constexpr size_t WS_HS = WS_O + 56 * MiB;
constexpr size_t WS_DPO = WS_HS + 32 * MiB;
constexpr size_t WS_DLSE = WS_DPO + 48 * MiB;
constexpr size_t WS_DS = WS_DLSE + 1 * MiB;
constexpr size_t WS_END = WS_DS + 64 * MiB;
static_assert(WS_HS == WS_O + 56 * MiB && WS_DPO == WS_HS + 32 * MiB && WS_DLSE == WS_DPO + 48 * MiB && WS_DS == WS_DLSE + 1 * MiB && WS_END - WS_O >= 176 * MiB, "FFN1's H [T][5632] bf16 (176 MiB) overlays the contiguous O | HS | DPO | DLSE | dS span");

constexpr int LDS_BYTES = 147456;

__device__ __forceinline__ float bf2f(unsigned b) { return __uint_as_float(b << 16); }
__device__ __forceinline__ float bflo(unsigned w) { return __uint_as_float(w << 16); }
__device__ __forceinline__ float bfhi(unsigned w) { return __uint_as_float(w & 0xffff0000u); }
__device__ __forceinline__ unsigned pk2(float lo, float hi) { unsigned r; asm("v_cvt_pk_bf16_f32 %0, %1, %2" : "=v"(r) : "v"(lo), "v"(hi)); return r; }
__device__ __forceinline__ float fexp(float x) { return __builtin_amdgcn_exp2f(x * LOG2E); }
__device__ __forceinline__ float frcp(float x) { return __builtin_amdgcn_rcpf(x); }
__device__ __forceinline__ float fsigmoid(float x) { return frcp(1.0f + fexp(-x)); }
__device__ __forceinline__ float gelu_erf(float x) { return 0.5f * x * (1.0f + erff(x * 0.70710678118f)); }
__device__ __forceinline__ float gelu_fast(float v) {
    const float av = fabsf(v), t = frcp(av * 0.2316418882f + 1.0f);
    float q = t * 0.5307027145f + (-0.7265760135f); q = q * t + 0.7107068705f; q = q * t + (-0.142248368f); q = q * t + 0.127414796f; q = q * t;
    const float e = __builtin_amdgcn_exp2f((v * v) * (-0.72134752044f));
    const float m = v * (q * e);
    return v < 0.f ? m : v - m;
}
__device__ __forceinline__ float wave_sum(float v) {
#pragma unroll
    for (int o = 1; o < 64; o <<= 1) v += __shfl_xor(v, o);
    return v;
}
__device__ __forceinline__ f32x4 mfma16(bf16x8 a, bf16x8 b, f32x4 c) { return __builtin_amdgcn_mfma_f32_16x16x32_bf16(a, b, c, 0, 0, 0); }
typedef short s16x4 __attribute__((ext_vector_type(4)));
__device__ __forceinline__ u32x2 tr16(const LAS bf16_t* p) { const s16x4 r = __builtin_amdgcn_ds_read_tr16_b64_v4i16((LAS s16x4*)p); return __builtin_bit_cast(u32x2, r); }
__device__ __forceinline__ bf16x8 mk8(u32x2 a, u32x2 b) { u32x4 t = {a.x, a.y, b.x, b.y}; return __builtin_bit_cast(bf16x8, t); }

namespace pg8 {
constexpr int BM = 256, BK = 64, HALF = 128, HTB = HALF * BK * 2, STAGE_BYTES = 8 * HTB, NXCD = 8, WGM = 8;
__device__ __forceinline__ int lds_byte(int r, int c) { const int st = (r >> 4) * 2 + (c >> 5), rr = r & 15, cc = c & 31, ob = rr * 64 + cc * 2; return st * 1024 + (ob ^ (((ob >> 9) & 1) << 5)); }
__device__ __forceinline__ void stage_rc(int b, int& R, int& C) { const int st = b / 1024, sb = b % 1024, swz = sb ^ (((sb >> 9) & 1) << 5); R = (st >> 1) * 16 + swz / 64; C = (st & 1) * 32 + (swz % 64) / 2; }
__device__ __forceinline__ int perm32(int rho) { const int n = rho >> 4, i = rho & 15; return 8 * (i >> 2) + 4 * n + (i & 3); }
struct Unit { int pm, pn; };
struct Gemm { const bf16_t* A; const bf16_t* Bt; int M, N, K; };
struct StaticOrder {
    int nM, nN, nwg, G, c;
    __device__ void init(int M, int N, int G_, int c_) { nM = M / BM; nN = N / BM; nwg = nM * nN; G = G_; c = c_; }
    __device__ bool next(int i, Unit& u) const {
        const long L = (long)i * G + c; if (L >= nwg) return false;
        int wgid = (int)L; { const int q = nwg / NXCD, r = nwg % NXCD, xcd = wgid % NXCD, off = wgid / NXCD; wgid = (xcd < r ? xcd * (q + 1) : r * (q + 1) + (xcd - r) * q) + off; }
        const int nig = WGM * nN, gid = wgid / nig, fm = gid * WGM, gsz = (nM - fm) < WGM ? (nM - fm) : WGM;
        u.pm = fm + ((wgid % nig) % gsz); u.pn = (wgid % nig) / gsz; return true;
    }
};

struct EpiSwiGLU {
    static constexpr bool PERM = true, HAS_MID = false;
    bf16_t* H; bf16_t* PP;
    __device__ __forceinline__ void mid(int, f32x4 (&)[2][2][4][2], const Unit&, int, int, int, int) const {}
    __device__ __forceinline__ void operator()(const f32x4 (&acc)[2][2][4][2], const Unit& u, int wr, int wc, int fr, int fq) const {
        const int row0 = u.pm * BM + wr * 64 + fr;
        if (u.pn < 44) {
            const int col0 = u.pn * 128 + wc * 32 + 8 * fq;
#pragma unroll
            for (int ai = 0; ai < 2; ++ai)
#pragma unroll
                for (int m = 0; m < 4; ++m) {
                    bf16_t* rowp = H + (size_t)(row0 + ai * HALF + m * 16) * FF_ + col0;
                    float h[8];
#pragma unroll
                    for (int n = 0; n < 2; ++n)
#pragma unroll
                        for (int j = 0; j < 4; ++j) { const float g = acc[ai][0][m][n][j], up = acc[ai][1][m][n][j]; h[n * 4 + j] = g * fsigmoid(g) * up; }
                    u32x4 w; w.x = pk2(h[0], h[1]); w.y = pk2(h[2], h[3]); w.z = pk2(h[4], h[5]); w.w = pk2(h[6], h[7]);
                    *(u32x4*)rowp = w;
                    asm volatile("" ::: "memory"); __builtin_amdgcn_sched_barrier(0);
                }
        } else {
            const int col0 = (u.pn - 44) * BM + wc * 32 + 8 * fq;
#pragma unroll
            for (int am = 0; am < 4; ++am) { const int ai = am >> 1, mb = (am & 1) * 2;
                u32x4 pv[2][2];
#pragma unroll
                for (int mm = 0; mm < 2; ++mm)
#pragma unroll
                    for (int bj = 0; bj < 2; ++bj) pv[mm][bj] = *(const u32x4*)(PP + (size_t)(row0 + ai * HALF + (mb + mm) * 16) * D_ + col0 + bj * HALF);
#pragma unroll
                for (int mm = 0; mm < 2; ++mm) { const int m = mb + mm;
                    bf16_t* rowp = PP + (size_t)(row0 + ai * HALF + m * 16) * D_ + col0;
#pragma unroll
                    for (int bj = 0; bj < 2; ++bj) {
                        const u32x4 p = pv[mm][bj];
                        const f32x4 a0 = acc[ai][bj][m][0], a1 = acc[ai][bj][m][1];
                        u32x4 w;
                        w.x = pk2(fsigmoid(a0[0]) * bflo(p.x), fsigmoid(a0[1]) * bfhi(p.x)); w.y = pk2(fsigmoid(a0[2]) * bflo(p.y), fsigmoid(a0[3]) * bfhi(p.y));
                        w.z = pk2(fsigmoid(a1[0]) * bflo(p.z), fsigmoid(a1[1]) * bfhi(p.z)); w.w = pk2(fsigmoid(a1[2]) * bflo(p.w), fsigmoid(a1[3]) * bfhi(p.w));
                        *(u32x4*)(rowp + bj * HALF) = w;
                    }
                }
                asm volatile("" ::: "memory"); __builtin_amdgcn_sched_barrier(0);
            }
        }
    }
};
template <bool ADD> struct EpiResidT {
    static constexpr bool PERM = false, HAS_MID = false;
    float* Y; const bf16_t* XB; const bf16_t* PP; float a, b;
    __device__ __forceinline__ void mid(int, f32x4 (&)[2][2][4][2], const Unit&, int, int, int, int) const {}
    __device__ __forceinline__ void operator()(const f32x4 (&acc)[2][2][4][2], const Unit& u, int wr, int wc, int fr, int fq) const {
        const int row0 = u.pm * BM + wr * 64 + fr, col0 = u.pn * BM + wc * 32 + 4 * fq;
        constexpr int GM = ADD ? 2 : 4;
#pragma unroll
        for (int ai = 0; ai < 2; ++ai)
#pragma unroll
            for (int m0 = 0; m0 < 4; m0 += GM) {
                u32x2 xb[GM][2][2], pp[GM][2][2];
#pragma unroll
                for (int mm = 0; mm < GM; ++mm) { const size_t off = (size_t)(row0 + ai * HALF + (m0 + mm) * 16) * D_ + col0;
#pragma unroll
                    for (int bj = 0; bj < 2; ++bj)
#pragma unroll
                        for (int n = 0; n < 2; ++n) { xb[mm][bj][n] = *(const u32x2*)(XB + off + bj * HALF + n * 16); if (ADD) pp[mm][bj][n] = *(const u32x2*)(PP + off + bj * HALF + n * 16); } }
#pragma unroll
                for (int mm = 0; mm < GM; ++mm) { const int m = m0 + mm; const size_t off = (size_t)(row0 + ai * HALF + m * 16) * D_ + col0;
#pragma unroll
                    for (int bj = 0; bj < 2; ++bj)
#pragma unroll
                        for (int n = 0; n < 2; ++n) { const u32x2 x = xb[mm][bj][n]; const f32x4 s = acc[ai][bj][m][n];
                            f32x4 y; y[0] = a * bflo(x.x) + b * s[0]; y[1] = a * bfhi(x.x) + b * s[1]; y[2] = a * bflo(x.y) + b * s[2]; y[3] = a * bfhi(x.y) + b * s[3];
                            if (ADD) { const u32x2 q = pp[mm][bj][n]; y[0] += bflo(q.x); y[1] += bfhi(q.x); y[2] += bflo(q.y); y[3] += bfhi(q.y); }
                            *(f32x4*)(Y + off + bj * HALF + n * 16) = y; } }
                asm volatile("" ::: "memory"); __builtin_amdgcn_sched_barrier(0);
            }
    }
};
struct EpiZ {
    static constexpr bool PERM = true, HAS_MID = false;
    bf16_t* Z; bf16_t* GATE;
    __device__ __forceinline__ void mid(int, f32x4 (&)[2][2][4][2], const Unit&, int, int, int, int) const {}
    __device__ __forceinline__ void operator()(const f32x4 (&acc)[2][2][4][2], const Unit& u, int wr, int wc, int fr, int fq) const {
        const int row0 = u.pm * BM + wr * 64 + fr;
        if (u.pn < 24) {
            const bool isgelu = (u.pn >= 3) && (u.pn <= 6);
            const int col0 = u.pn * BM + wc * 32 + 8 * fq;
#pragma unroll
            for (int ai = 0; ai < 2; ++ai)
#pragma unroll
                for (int m = 0; m < 4; ++m) {
                    bf16_t* rowp = Z + (size_t)(row0 + ai * HALF + m * 16) * NZ_ + col0;
#pragma unroll
                    for (int bj = 0; bj < 2; ++bj) {
                        f32x4 v0 = acc[ai][bj][m][0], v1 = acc[ai][bj][m][1];
                        if (isgelu) {
#pragma unroll
                            for (int j = 0; j < 4; ++j) { v0[j] = gelu_fast(v0[j]); v1[j] = gelu_fast(v1[j]); }
                        }
                        u32x4 w; w.x = pk2(v0[0], v0[1]); w.y = pk2(v0[2], v0[3]); w.z = pk2(v1[0], v1[1]); w.w = pk2(v1[2], v1[3]);
                        *(u32x4*)(rowp + bj * HALF) = w;
                    }
                    asm volatile("" ::: "memory"); __builtin_amdgcn_sched_barrier(0);
                }
        } else {
            const int mc0 = (u.pn - 24) * 64 + wc * 16 + 4 * fq;
#pragma unroll
            for (int ai = 0; ai < 2; ++ai)
#pragma unroll
                for (int m = 0; m < 4; ++m) {
                    bf16_t* rowp = GATE + (size_t)(row0 + ai * HALF + m * 16) * D_ + mc0;
                    f32x4 e[4];
#pragma unroll
                    for (int br = 0; br < 4; ++br)
#pragma unroll
                        for (int j = 0; j < 4; ++j) e[br][j] = fminf(1.0f + fexp(-acc[ai][br >> 1][m][br & 1][j]), 1e30f);
                    f32x4 i0, i1, i2, i3;
#pragma unroll
                    for (int j = 0; j < 4; ++j) { i0[j] = frcp(e[0][j]); i1[j] = frcp(e[1][j]); i2[j] = frcp(e[2][j]); i3[j] = frcp(e[3][j]); }
                    const f32x4 r0 = e[1] * i0, r1 = e[2] * i1, r2 = e[3] * i2;
                    u32x2 w;
                    w.x = pk2(r0[0], r0[1]); w.y = pk2(r0[2], r0[3]); *(u32x2*)(rowp) = w;
                    w.x = pk2(r1[0], r1[1]); w.y = pk2(r1[2], r1[3]); *(u32x2*)(rowp + (size_t)T_ * D_) = w;
                    w.x = pk2(r2[0], r2[1]); w.y = pk2(r2[2], r2[3]); *(u32x2*)(rowp + (size_t)2 * T_ * D_) = w;
                    w.x = pk2(i3[0], i3[1]); w.y = pk2(i3[2], i3[3]); *(u32x2*)(rowp + (size_t)3 * T_ * D_) = w;
                    asm volatile("" ::: "memory"); __builtin_amdgcn_sched_barrier(0);
                }
        }
    }
};
struct EpiBf16 {
    static constexpr bool PERM = true, HAS_MID = false;
    bf16_t* O; int ldc;
    __device__ __forceinline__ void mid(int, f32x4 (&)[2][2][4][2], const Unit&, int, int, int, int) const {}
    __device__ __forceinline__ void operator()(const f32x4 (&acc)[2][2][4][2], const Unit& u, int wr, int wc, int fr, int fq) const {
        const int row0 = u.pm * BM + wr * 64 + fr, col0 = u.pn * BM + wc * 32 + 8 * fq;
#pragma unroll
        for (int ai = 0; ai < 2; ++ai)
#pragma unroll
            for (int m = 0; m < 4; ++m) {
                bf16_t* rowp = O + (size_t)(row0 + ai * HALF + m * 16) * ldc + col0;
#pragma unroll
                for (int bj = 0; bj < 2; ++bj) {
                    const f32x4 v0 = acc[ai][bj][m][0], v1 = acc[ai][bj][m][1];
                    u32x4 w; w.x = pk2(v0[0], v0[1]); w.y = pk2(v0[2], v0[3]); w.z = pk2(v1[0], v1[1]); w.w = pk2(v1[2], v1[3]);
                    *(u32x4*)(rowp + bj * HALF) = w;
                }
                asm volatile("" ::: "memory"); __builtin_amdgcn_sched_barrier(0);
            }
    }
};
struct EpiBR {
    static constexpr bool PERM = true, HAS_MID = true;
    bf16_t* O; const bf16_t* GATE;
    __device__ __forceinline__ void scale(const bf16_t* plane, f32x4 (&acc)[2][2][4][2], const Unit& u, int wr, int wc, int fr, int fq) const {
        const int row0 = u.pm * BM + wr * 64 + fr, col0 = u.pn * BM + wc * 32 + 8 * fq;
        u32x4 r[2][4][2];
#pragma unroll
        for (int ai = 0; ai < 2; ++ai)
#pragma unroll
            for (int m = 0; m < 4; ++m)
#pragma unroll
                for (int bj = 0; bj < 2; ++bj) r[ai][m][bj] = *(const u32x4*)(plane + (size_t)(row0 + ai * HALF + m * 16) * D_ + col0 + bj * HALF);
#pragma unroll
        for (int ai = 0; ai < 2; ++ai)
#pragma unroll
            for (int m = 0; m < 4; ++m)
#pragma unroll
                for (int bj = 0; bj < 2; ++bj) { const u32x4 e = r[ai][m][bj];
                    acc[ai][bj][m][0] *= (f32x4){bflo(e.x), bfhi(e.x), bflo(e.y), bfhi(e.y)}; acc[ai][bj][m][1] *= (f32x4){bflo(e.z), bfhi(e.z), bflo(e.w), bfhi(e.w)}; }
    }
    __device__ __forceinline__ void mid(int t, f32x4 (&acc)[2][2][4][2], const Unit& u, int wr, int wc, int fr, int fq) const {
        if (t != 8 && t != 16 && t != 24) return;
        asm volatile("" : "+v"(fr), "+v"(fq));
        scale(GATE + (size_t)((t >> 3) - 1) * T_ * D_, acc, u, wr, wc, fr, fq);
    }
    __device__ __forceinline__ void operator()(f32x4 (&acc)[2][2][4][2], const Unit& u, int wr, int wc, int fr, int fq) const {
        scale(GATE + (size_t)3 * T_ * D_, acc, u, wr, wc, fr, fq);
        const int row0 = u.pm * BM + wr * 64 + fr, col0 = u.pn * BM + wc * 32 + 8 * fq;
#pragma unroll
        for (int ai = 0; ai < 2; ++ai)
#pragma unroll
            for (int m = 0; m < 4; ++m) {
                bf16_t* rowp = O + (size_t)(row0 + ai * HALF + m * 16) * D_ + col0;
#pragma unroll
                for (int bj = 0; bj < 2; ++bj) {
                    const f32x4 a0 = acc[ai][bj][m][0], a1 = acc[ai][bj][m][1];
                    u32x4 w; w.x = pk2(a0[0], a0[1]); w.y = pk2(a0[2], a0[3]); w.z = pk2(a1[0], a1[1]); w.w = pk2(a1[2], a1[3]);
                    *(u32x4*)(rowp + bj * HALF) = w;
                }
            }
    }
};

template <class Epi, bool KREV = false>
__device__ __forceinline__ void gemm_phase(LAS unsigned char* lds, const Gemm g, const StaticOrder& S, const Epi& E) {
    int tid = threadIdx.x; asm volatile("" : "+v"(tid));
    const int wid = __builtin_amdgcn_readfirstlane(tid >> 6), lane = tid & 63, wr = wid >> 2, wc = wid & 3, fr = lane & 15, fq = lane >> 4;
    const int K = g.K, nt = K / BK;
    unsigned voffA[2], voffB[2];
#pragma unroll
    for (int i = 0; i < 2; ++i) { int R, C; stage_rc(tid * 16 + i * 8192, R, C); const int Rb = Epi::PERM ? ((R & ~31) + perm32(R & 31)) : R;
        voffA[i] = (unsigned)(R * K + C) * 2u; voffB[i] = (unsigned)(Rb * K + C) * 2u; }
    const long kstep = KREV ? -(long)(BK * 2) : (long)(BK * 2);
    const size_t kbase = KREV ? (size_t)(nt - 1) * (BK * 2) : 0;
    const size_t hstep = (size_t)HALF * K * 2;
    const size_t tstep = 2 * hstep;
    const unsigned ldsw = (unsigned)wid * 1024u;
    const int aoff = lds_byte(wr * 64 + fr, fq * 8), boff = lds_byte(wc * 32 + fr, fq * 8);
#define PG8_SA(b, h) (((b) * 2 + (h)) * HTB)
#define PG8_SB(b, h) ((4 + (b) * 2 + (h)) * HTB)
#define PG8_STAGE(bufoff, gbase, voff) do { _Pragma("unroll") for (int _i = 0; _i < 2; ++_i) \
        __builtin_amdgcn_global_load_lds((const unsigned*)((const char*)(gbase) + (voff)[_i]), (LAS unsigned*)(lds + (bufoff) + ldsw + _i * 8192), 16, 0, 0); } while (0)
#define PG8_LDA(dst, b, h) do { _Pragma("unroll") for (int m = 0; m < 4; ++m) _Pragma("unroll") for (int k = 0; k < 2; ++k) dst[m][k] = *(const LAS bf16x8*)(lds + PG8_SA(b, h) + aoff + m * 2048 + k * 1024); } while (0)
#define PG8_LDB(dst, b, h) do { _Pragma("unroll") for (int n = 0; n < 2; ++n) _Pragma("unroll") for (int k = 0; k < 2; ++k) dst[n][k] = *(const LAS bf16x8*)(lds + PG8_SB(b, h) + boff + n * 2048 + k * 1024); } while (0)
#define PG8_MMA(ai, bj, At, Bt) do { __builtin_amdgcn_s_setprio(1); _Pragma("unroll") for (int m = 0; m < 4; ++m) _Pragma("unroll") for (int n = 0; n < 2; ++n) _Pragma("unroll") for (int k = 0; k < 2; ++k) \
        acc[ai][bj][m][n] = __builtin_amdgcn_mfma_f32_16x16x32_bf16(Bt[n][k], At[m][k], acc[ai][bj][m][n], 0, 0, 0); __builtin_amdgcn_s_setprio(0); } while (0)
#define PG8_WAIT_V(n) asm volatile("s_waitcnt vmcnt(" #n ")" ::: "memory")
#define PG8_WAIT_L(n) asm volatile("s_waitcnt lgkmcnt(" #n ")" ::: "memory")
#define PG8_BAR __builtin_amdgcn_s_barrier()
#define PG8_SCHED __builtin_amdgcn_sched_barrier(0)
    Unit cur, nxt; int ui = 0;
    if (!S.next(0, cur)) return;
    f32x4 acc[2][2][4][2];
#pragma unroll
    for (int a = 0; a < 2; ++a)
#pragma unroll
        for (int b = 0; b < 2; ++b)
#pragma unroll
            for (int m = 0; m < 4; ++m)
#pragma unroll
                for (int n = 0; n < 2; ++n) acc[a][b][m][n] = (f32x4){0.f, 0.f, 0.f, 0.f};
    bf16x8 At[4][2], B0[2][2], B1[2][2];
    const char* cA = (const char*)g.A + (size_t)cur.pm * tstep + kbase; const char* cB = (const char*)g.Bt + (size_t)cur.pn * tstep + kbase;
    PG8_STAGE(PG8_SB(0, 0), cB, voffB); PG8_STAGE(PG8_SB(0, 1), cB + hstep, voffB); PG8_STAGE(PG8_SA(0, 0), cA, voffA); PG8_STAGE(PG8_SA(0, 1), cA + hstep, voffA);
    if (wr == 1) PG8_BAR;
    PG8_WAIT_V(2); PG8_BAR;
    PG8_STAGE(PG8_SB(1, 0), cB + kstep, voffB); PG8_STAGE(PG8_SA(1, 0), cA + kstep, voffA); PG8_STAGE(PG8_SB(1, 1), cB + hstep + kstep, voffB);
    PG8_WAIT_V(6); PG8_BAR;
    for (;;) {
        const bool has_next = S.next(ui + 1, nxt);
        const char* nA = has_next ? (const char*)g.A + (size_t)nxt.pm * tstep + kbase : cA; const char* nB = has_next ? (const char*)g.Bt + (size_t)nxt.pn * tstep + kbase : cB;
        for (int t = 0; t < nt; t += 2) {
            const bool last = (t == nt - 2);
            const char* a1 = cA + (long)(t + 1) * kstep;
            const char* a2 = last ? nA : cA + (long)(t + 2) * kstep; const char* b2 = last ? nB : cB + (long)(t + 2) * kstep;
            const char* a3 = a2 + kstep; const char* b3 = b2 + kstep;
            if constexpr (Epi::HAS_MID) E.mid(t, acc, cur, wr, wc, fr, fq);
            PG8_LDB(B0, 0, 0); PG8_LDB(B1, 0, 1); PG8_SCHED; PG8_LDA(At, 0, 0); PG8_STAGE(PG8_SA(1, 1), a1 + hstep, voffA);
            PG8_WAIT_V(8); PG8_WAIT_L(0); PG8_BAR; PG8_MMA(0, 0, At, B0); PG8_MMA(0, 1, At, B1); PG8_BAR; PG8_SCHED;
            PG8_LDA(At, 0, 1); PG8_STAGE(PG8_SB(0, 0), b2, voffB); PG8_STAGE(PG8_SB(0, 1), b2 + hstep, voffB); PG8_STAGE(PG8_SA(0, 0), a2, voffA);
            PG8_WAIT_V(8); PG8_WAIT_L(0); PG8_BAR; PG8_MMA(1, 0, At, B0); PG8_MMA(1, 1, At, B1); PG8_BAR; PG8_SCHED;
            PG8_LDB(B0, 1, 0); PG8_LDB(B1, 1, 1); PG8_SCHED; PG8_LDA(At, 1, 0); PG8_STAGE(PG8_SA(0, 1), a2 + hstep, voffA);
            PG8_WAIT_V(8); PG8_WAIT_L(0); PG8_BAR; PG8_MMA(0, 0, At, B0); PG8_MMA(0, 1, At, B1); PG8_BAR; PG8_SCHED;
            PG8_LDA(At, 1, 1); PG8_STAGE(PG8_SB(1, 0), b3, voffB); PG8_STAGE(PG8_SB(1, 1), b3 + hstep, voffB); PG8_STAGE(PG8_SA(1, 0), a3, voffA);
            PG8_WAIT_V(8); PG8_WAIT_L(0); PG8_BAR; PG8_MMA(1, 0, At, B0); PG8_MMA(1, 1, At, B1); PG8_BAR; PG8_SCHED;
        }
        if (wr == 0) PG8_BAR;
#pragma unroll
        for (int a = 0; a < 2; ++a)
#pragma unroll
            for (int b = 0; b < 2; ++b)
#pragma unroll
                for (int m = 0; m < 4; ++m)
#pragma unroll
                    for (int n = 0; n < 2; ++n) asm volatile("" : "+v"(acc[a][b][m][n]));
        E(acc, cur, wr, wc, fr, fq);
        if (!has_next) break;
#pragma unroll
        for (int a = 0; a < 2; ++a)
#pragma unroll
            for (int b = 0; b < 2; ++b)
#pragma unroll
                for (int m = 0; m < 4; ++m)
#pragma unroll
                    for (int n = 0; n < 2; ++n) acc[a][b][m][n] = (f32x4){0.f, 0.f, 0.f, 0.f};
        cur = nxt; cA = nA; cB = nB; ++ui;
        if (wr == 1) PG8_BAR;
    }
    PG8_WAIT_V(0);
    PG8_BAR;
#undef PG8_SA
#undef PG8_SB
#undef PG8_STAGE
#undef PG8_LDA
#undef PG8_LDB
#undef PG8_MMA
#undef PG8_WAIT_V
#undef PG8_WAIT_L
#undef PG8_BAR
#undef PG8_SCHED
}
}

typedef __attribute__((address_space(1))) unsigned gu32;
#define XB_TMO      128
#define XB_XCNT(j)  (256  + 64 * (j))
#define XB_XSUB(j)  (1280 + 64 * (j))
#define XB_XGEN(j)  (2304 + 64 * (j))
#define XB_TOP      3328
#define XB_TOPGEN   3392
#define XCD_BAR_WORDS 3456
#define XB_SPIN_CAP (1u << 18)

__device__ __forceinline__ unsigned xb_ld(unsigned* p)              { return __hip_atomic_load(p, __ATOMIC_RELAXED, __HIP_MEMORY_SCOPE_AGENT); }
__device__ __forceinline__ unsigned xb_add(unsigned* p, unsigned v) { return __hip_atomic_fetch_add(p, v, __ATOMIC_RELAXED, __HIP_MEMORY_SCOPE_AGENT); }
__device__ __forceinline__ unsigned xb_xcc_id() { return (unsigned)__builtin_amdgcn_s_getreg((3 << 11) | 20) & 0xFu; }
#define XB_SPIN(cond, bar) do { unsigned _sp = 0; while (cond) { __builtin_amdgcn_s_sleep(1); \
    if ((++_sp & 255u) == 0u) { if (xb_ld(&(bar)[XB_TMO])) break; if (_sp > XB_SPIN_CAP) { atomicAdd(&(bar)[XB_TMO], 1u); break; } } } } while (0)

struct XcdBarrier {
    unsigned* bar; unsigned x;
    volatile LAS unsigned* st;
};

__device__ __forceinline__ XcdBarrier xcd_barrier_post(unsigned* bar, volatile LAS unsigned* st) {
    XcdBarrier b; b.bar = bar; b.x = xb_xcc_id(); b.st = st;
    if (threadIdx.x == 0) (void)xb_add(&bar[XB_XCNT(b.x)], 1u);
    return b;
}
__device__ __forceinline__ void xcd_barrier_complete(unsigned* bar, unsigned x, unsigned& nloc, unsigned& nx) {
    const unsigned G = gridDim.x * gridDim.y * gridDim.z;
    unsigned sum, cnt, mine, sp = 0u;
    for (;;) {
        sum = 0u; cnt = 0u; mine = 0u;
#pragma unroll
        for (unsigned j = 0; j < 16; ++j) { const unsigned c = xb_ld(&bar[XB_XCNT(j)]); sum += c; cnt += (c > 0u) ? 1u : 0u; mine = (j == x) ? c : mine; }
        if (sum == G) break;
        __builtin_amdgcn_s_sleep(1);
        if ((++sp & 255u) == 0u) { if (xb_ld(&bar[XB_TMO])) break; if (sp > XB_SPIN_CAP) { atomicAdd(&bar[XB_TMO], 1u); break; } }
    }
    nloc = mine > 0u ? mine : 1u; nx = cnt > 0u ? cnt : 1u;
}

__device__ __forceinline__ void xcd_barrier(const XcdBarrier& b) {
    asm volatile("s_waitcnt vmcnt(0)" ::: "memory");
    __syncthreads();
    if (threadIdx.x == 0) {
        unsigned* bar = b.bar;
        __builtin_amdgcn_s_waitcnt(0);
        unsigned nloc = b.st[0], nx = b.st[1];
        if (nloc == 0u) { xcd_barrier_complete(bar, b.x, nloc, nx); b.st[0] = nloc; b.st[1] = nx; }
        const unsigned old = xb_add(&bar[XB_XSUB(b.x)], 1u);
        const unsigned gen = old / nloc;
        if (old + 1u == (gen + 1u) * nloc) {
            __builtin_amdgcn_fence(__ATOMIC_RELEASE, "agent");
            asm volatile("s_waitcnt vmcnt(0)" ::: "memory");
            const unsigned og = xb_add(&bar[XB_TOP], 1u);
            const unsigned tg = og / nx;
            if (og + 1u == (tg + 1u) * nx) xb_add(&bar[XB_TOPGEN], 1u);
            else XB_SPIN(xb_ld(&bar[XB_TOPGEN]) == tg, bar);
            __builtin_amdgcn_fence(__ATOMIC_ACQUIRE, "agent");
            xb_add(&bar[XB_XGEN(b.x)], 1u);
            asm volatile("s_waitcnt vmcnt(0)" ::: "memory");
        } else {
            XB_SPIN(xb_ld(&bar[XB_XGEN(b.x)]) == gen, bar);
            __builtin_amdgcn_fence(__ATOMIC_ACQUIRE, "agent");
            asm volatile("s_waitcnt vmcnt(0)" ::: "memory");
        }
    }
    __syncthreads();
}


__device__ __forceinline__ void panel_barrier(unsigned* cnt, unsigned& epoch) {
    asm volatile("s_waitcnt vmcnt(0)" ::: "memory");
    __syncthreads();
    ++epoch;
    if (threadIdx.x == 0) {
        (void)xb_add(cnt, 1u);
        unsigned sp = 0u;
        while (xb_ld(cnt) < 4u * epoch) { __builtin_amdgcn_s_sleep(1); if (++sp > (1u << 22)) break; }
        __builtin_amdgcn_fence(__ATOMIC_ACQUIRE, "agent");
        asm volatile("s_waitcnt vmcnt(0)" ::: "memory");
    }
    __syncthreads();
}

struct Args { const float* in[22]; float* out; unsigned char* ws; int ph_lo, ph_hi; };

typedef LAS unsigned long long* PTab;
__device__ __forceinline__ const float* ldptr(PTab pt, int k) {
    const unsigned long long v = pt[k];
    const unsigned lo = __builtin_amdgcn_readfirstlane((unsigned)v), hi = __builtin_amdgcn_readfirstlane((unsigned)(v >> 32));
    return (const float*)(__attribute__((address_space(1))) const float*)(((unsigned long long)hi << 32) | lo);
}

__device__ __forceinline__ int conv_row(int n, int mode, int rowoff) {
    if (mode == 0) return rowoff + n;
    if (mode == 3) { const int br = n >> 11, mc = n & 2047, q = mc >> 6, mcl = mc & 63; return rowoff + 256 * q + 128 * (br >> 1) + 32 * (mcl >> 4) + 8 * ((mcl >> 2) & 3) + 4 * (br & 1) + (mcl & 3); }
    return (n >> 7) * 256 + (n & 127) + (mode == 2 ? 128 : 0);
}
__device__ __forceinline__ void conv_mat(const float* W, int ldw, int K, int N, bf16_t* WT, int pitch, int koff, int mode, int rowoff, int gw, int ngw, int lane) {
    const int nblk = N / 64, nitems = (K / 64) * nblk;
    const int c = lane & 15, q = lane >> 4;
    f32x4 v[16];
    if (gw < nitems) { const int kb = gw / nblk, nb = gw - kb * nblk; const float* src = W + (size_t)(64 * kb + 16 * q) * ldw + 64 * nb + 4 * c;
#pragma unroll
        for (int j = 0; j < 16; ++j) v[j] = __builtin_nontemporal_load((const f32x4*)(src + (size_t)j * ldw)); }
    for (int item = gw; item < nitems; item += ngw) {
        const int kb = item / nblk, nb = item - kb * nblk, k0 = 64 * kb, n0 = 64 * nb;
        u32x4 o[8];
#pragma unroll
        for (int i = 0; i < 4; ++i) {
            o[2 * i].x = pk2(v[0][i], v[1][i]); o[2 * i].y = pk2(v[2][i], v[3][i]); o[2 * i].z = pk2(v[4][i], v[5][i]); o[2 * i].w = pk2(v[6][i], v[7][i]);
            o[2 * i + 1].x = pk2(v[8][i], v[9][i]); o[2 * i + 1].y = pk2(v[10][i], v[11][i]); o[2 * i + 1].z = pk2(v[12][i], v[13][i]); o[2 * i + 1].w = pk2(v[14][i], v[15][i]);
        }
        const int nx = item + ngw;
        if (nx < nitems) { const int kb2 = nx / nblk, nb2 = nx - kb2 * nblk; const float* src = W + (size_t)(64 * kb2 + 16 * q) * ldw + 64 * nb2 + 4 * c;
#pragma unroll
            for (int j = 0; j < 16; ++j) v[j] = __builtin_nontemporal_load((const f32x4*)(src + (size_t)j * ldw)); }
        const int rb = conv_row(n0 + 4 * c, mode, rowoff);
#pragma unroll
        for (int i = 0; i < 4; ++i) {
            bf16_t* dst = WT + (size_t)(rb + i) * pitch + koff + k0 + 16 * q;
            *(u32x4*)dst = o[2 * i]; *(u32x4*)(dst + 8) = o[2 * i + 1];
        }
    }
}

__device__ __forceinline__ void convert_phase(PTab pt, int l, LAS unsigned char* lds, int tid, int wave, int lane, int bid, int G) {
    unsigned char* ws = (unsigned char*)ldptr(pt, 23);
    const int gw = bid * 8 + wave, ngw = G * 8;
    for (int s = 0; s < 2; ++s) {
        bf16_t* wgu = (bf16_t*)(ws + WS_WGU + (size_t)s * 44 * MiB);
        conv_mat(ldptr(pt, 4) + (size_t)(l * 2 + s) * D_ * FF_, FF_, D_, FF_, wgu, D_, 0, 1, 0, gw, ngw, lane);
        conv_mat(ldptr(pt, 5) + (size_t)(l * 2 + s) * D_ * FF_, FF_, D_, FF_, wgu, D_, 0, 2, 0, gw, ngw, lane);
        conv_mat(ldptr(pt, 6) + (size_t)(l * 2 + s) * D_ * FF_, D_, FF_, D_, (bf16_t*)(ws + WS_WD + (size_t)s * 22 * MiB), FF_, 0, 0, 0, gw, ngw, lane);
    }
    conv_mat(ldptr(pt, 7) + (size_t)l * D_ * NIN_, NIN_, D_, NZ_, (bf16_t*)(ws + WS_WIN), D_, 0, 0, 0, gw, ngw, lane);
    conv_mat(ldptr(pt, 7) + (size_t)l * D_ * NIN_ + NZ_, NIN_, D_, NGT_, (bf16_t*)(ws + WS_WIN), D_, 0, 3, NZ_, gw, ngw, lane);
    conv_mat(ldptr(pt, 15) + (size_t)l * 512 * D_, D_, 512, D_, (bf16_t*)(ws + WS_WBR), NO_, 0, 0, 0, gw, ngw, lane);
    conv_mat(ldptr(pt, 16) + (size_t)l * 512 * D_, D_, 512, D_, (bf16_t*)(ws + WS_WBR), NO_, 512, 0, 0, gw, ngw, lane);
    conv_mat(ldptr(pt, 17) + (size_t)l * 512 * D_, D_, 512, D_, (bf16_t*)(ws + WS_WBR), NO_, 1024, 0, 0, gw, ngw, lane);
    conv_mat(ldptr(pt, 18) + (size_t)l * 256 * D_, D_, 256, D_, (bf16_t*)(ws + WS_WBR), NO_, 1536, 0, 0, gw, ngw, lane);
    conv_mat(ldptr(pt, 19) + (size_t)l * D_ * D_, D_, D_, D_, (bf16_t*)(ws + WS_WOUT), D_, 0, 0, 0, gw, ngw, lane);
    conv_mat(ldptr(pt, 20) + (size_t)l * PLE_ * D_, D_, PLE_, D_, (bf16_t*)(ws + WS_WPP), PLE_, 0, 0, 0, gw, ngw, lane);
    conv_mat(ldptr(pt, 21) + (size_t)l * D_ * D_, D_, D_, D_, (bf16_t*)(ws + WS_WPG), D_, 0, 0, 0, gw, ngw, lane);
    if (l == 0) {
        const size_t gt = (size_t)bid * 512 + tid, nth = (size_t)G * 512;
        const f32x4* x4 = (const f32x4*)ldptr(pt, 0); u32x2* xb = (u32x2*)(ws + WS_XB);
        for (size_t i = gt; i < (size_t)T_ * D_ / 4; i += nth) { const f32x4 v = x4[i]; u32x2 w; w.x = pk2(v[0], v[1]); w.y = pk2(v[2], v[3]); xb[i] = w; }
        const f32x4* p4 = (const f32x4*)ldptr(pt, 1); u32x2* pb = (u32x2*)(ws + WS_PB);
        for (size_t i = gt; i < (size_t)2 * T_ * PLE_ / 4; i += nth) { const f32x4 v = p4[i]; u32x2 w; w.x = pk2(v[0], v[1]); w.y = pk2(v[2], v[3]); pb[i] = w; }
    }
}

__device__ __forceinline__ void ln_phase(float* X, bf16_t* XB, const float* g, const float* b, bool final_, int first, int rstep, int bstep, int nb, int lane) {
    const int ngw = rstep;
    for (int bi = 0, row0 = first; bi < nb; ++bi, row0 += bstep) {
        f32x4 v[4][8];
#pragma unroll
        for (int r = 0; r < 4; ++r) { const int row = min(row0 + r * ngw, T_ - 1); const f32x4* xr = (const f32x4*)(X + (size_t)row * D_) + lane;
#pragma unroll
            for (int j = 0; j < 8; ++j) v[r][j] = xr[64 * j]; }
        float mean[4], rstd[4];
#pragma unroll
        for (int r = 0; r < 4; ++r) { float s = 0.f;
#pragma unroll
            for (int j = 0; j < 8; ++j) s += (v[r][j][0] + v[r][j][1]) + (v[r][j][2] + v[r][j][3]);
            mean[r] = s; }
#pragma unroll
        for (int o = 1; o < 64; o <<= 1) {
#pragma unroll
            for (int r = 0; r < 4; ++r) mean[r] += __shfl_xor(mean[r], o); }
#pragma unroll
        for (int r = 0; r < 4; ++r) { mean[r] *= (1.f / D_); float s2 = 0.f;
#pragma unroll
            for (int j = 0; j < 8; ++j) { v[r][j] = v[r][j] - mean[r]; s2 += (v[r][j][0] * v[r][j][0] + v[r][j][1] * v[r][j][1]) + (v[r][j][2] * v[r][j][2] + v[r][j][3] * v[r][j][3]); }
            rstd[r] = s2; }
#pragma unroll
        for (int o = 1; o < 64; o <<= 1) {
#pragma unroll
            for (int r = 0; r < 4; ++r) rstd[r] += __shfl_xor(rstd[r], o); }
#pragma unroll
        for (int r = 0; r < 4; ++r) rstd[r] = 1.f / sqrtf(rstd[r] * (1.f / D_) + LN_EPS);
#pragma unroll
        for (int j = 0; j < 8; ++j) {
            const f32x4 gg = ((const f32x4*)g)[lane + 64 * j], bb = ((const f32x4*)b)[lane + 64 * j];
#pragma unroll
            for (int r = 0; r < 4; ++r) { const int row = row0 + r * ngw;
                if (row < T_) { const f32x4 y = v[r][j] * rstd[r] * gg + bb;
                    if (final_) ((f32x4*)(X + (size_t)row * D_))[lane + 64 * j] = y;
                    else { u32x2 w; w.x = pk2(y[0], y[1]); w.y = pk2(y[2], y[3]); ((u32x2*)(XB + (size_t)row * D_))[lane + 64 * j] = w; } } }
        }
    }
}

__device__ __forceinline__ void attn_unit(LAS unsigned char* L, const bf16_t* Z, int unit, const float* sinks, bf16_t* O, float* DPO, float* DLSE, int tid, int wave, int lane) {
    int qcol, kcol, vcol, base, blk, dil, max_dist, grp = 0, hh = 0; float slope_u, sink = 0.f; bool isA;
    if (unit < 1024) {
        isA = true; blk = unit & 31; const int head = (unit >> 5) & 7, b = unit >> 8, kvh = head >> 2;
        qcol = ZQA + head * 64; kcol = ZKA + kvh * 64; vcol = ZVA + kvh * 64; base = b * SEQ_; dil = 1; max_dist = 127;
        slope_u = __builtin_amdgcn_exp2f(-8.0f * (float)(head + 1) / 20.0f); sink = sinks[head]; hh = head;
    } else {
        isA = false; const int u2 = unit - 1024; grp = u2 >> 9; const int u3 = u2 & 511;
        dil = (grp == 0) ? 1 : (grp == 1 ? 4 : 16); const int nbk = 32 / dil;
        blk = u3 % nbk; const int r = (u3 / nbk) % dil; hh = (u3 / 32) & 3; const int b = u3 >> 7;
        qcol = ZQD + grp * 256 + hh * 64; kcol = ZKD + grp * 256 + hh * 64; vcol = ZVD + grp * 256 + hh * 64; base = b * SEQ_ + r; max_dist = 128;
        slope_u = __builtin_amdgcn_exp2f(-8.0f * (float)(8 + 4 * grp + hh + 1) / 20.0f) * (float)dil;
    }
    LAS bf16_t* Qs = (LAS bf16_t*)L;
    LAS bf16_t* Ks = Qs + 128 * 72;
    LAS bf16_t* Vs = Ks + 272 * 72;
    for (int i = tid; i < 1024; i += 512) { const int r = i >> 3, c = i & 7; const size_t tok = (size_t)(base + (blk * 128 + r) * dil);
        *(LAS u32x4*)(Qs + r * 72 + c * 8) = *(const u32x4*)(Z + tok * NZ_ + qcol + c * 8); }
    {
        u32x4 kv[5], vv[5];
#pragma unroll
        for (int it = 0; it < 5; ++it) { const int i = tid + it * 512; const int r = i >> 3, c = i & 7; const int sub = blk * 128 - 128 + r; const bool ok = (i < 2176) && (r < 256) && (sub >= 0);
            kv[it] = (u32x4){0u, 0u, 0u, 0u}; vv[it] = (u32x4){0u, 0u, 0u, 0u};
            if (ok) { const size_t tok = (size_t)(base + sub * dil); kv[it] = *(const u32x4*)(Z + tok * NZ_ + kcol + c * 8); vv[it] = *(const u32x4*)(Z + tok * NZ_ + vcol + c * 8); } }
#pragma unroll
        for (int it = 0; it < 5; ++it) { const int i = tid + it * 512; const int r = i >> 3, c = i & 7;
            if (i < 2176) {
                *(LAS u32x4*)(Ks + r * 72 + c * 8) = kv[it];
                *(LAS u32x4*)(Vs + r * 72 + c * 8) = vv[it]; } }
    }
    __syncthreads();
    const int q0 = wave * 16, qi = lane & 15, g = lane >> 4;
    bf16x8 bq[2];
#pragma unroll
    for (int ks = 0; ks < 2; ++ks) bq[ks] = *(const LAS bf16x8*)(Qs + (q0 + qi) * 72 + ks * 32 + g * 8);
    f32x4 st[10];
#pragma unroll
    for (int i = 0; i < 10; ++i) { f32x4 acc = {0.f, 0.f, 0.f, 0.f};
#pragma unroll
        for (int ks = 0; ks < 2; ++ks) { const bf16x8 ak = *(const LAS bf16x8*)(Ks + ((wave + i) * 16 + qi) * 72 + ks * 32 + g * 8); acc = mfma16(ak, bq[ks], acc); }
        st[i] = acc; }
    float mx = -3.0e38f;
    const int q = q0 + qi;
#pragma unroll
    for (int i = 0; i < 10; ++i)
#pragma unroll
        for (int j = 0; j < 4; ++j) { const int kk = (wave + i) * 16 + 4 * g + j; const int dist = q + 128 - kk;
            const bool valid = (dist >= 0) && (dist <= max_dist) && (blk > 0 || kk >= 128);
            const float s = valid ? (st[i][j] * 0.125f - slope_u * (float)dist) : -1.0e30f; st[i][j] = s; mx = fmaxf(mx, s); }
    mx = fmaxf(mx, __shfl_xor(mx, 16)); mx = fmaxf(mx, __shfl_xor(mx, 32));
    if (isA) mx = fmaxf(mx, sink);
    float den = 0.f;
#pragma unroll
    for (int i = 0; i < 10; ++i)
#pragma unroll
        for (int j = 0; j < 4; ++j) { const float p = __builtin_amdgcn_exp2f((st[i][j] - mx) * LOG2E); st[i][j] = p; den += p; }
    den += __shfl_xor(den, 16); den += __shfl_xor(den, 32);
    if (isA) den += __builtin_amdgcn_exp2f((sink - mx) * LOG2E);
    f32x4 o[4];
#pragma unroll
    for (int ht = 0; ht < 4; ++ht) o[ht] = (f32x4){0.f, 0.f, 0.f, 0.f};
    const LAS bf16_t* vbase = Vs + (wave * 16 + 4 * g + (qi >> 2)) * 72 + 4 * (qi & 3);
#pragma unroll
    for (int i = 0; i < 5; ++i) {
        u32x4 pw; pw.x = pk2(st[2 * i][0], st[2 * i][1]); pw.y = pk2(st[2 * i][2], st[2 * i][3]); pw.z = pk2(st[2 * i + 1][0], st[2 * i + 1][1]); pw.w = pk2(st[2 * i + 1][2], st[2 * i + 1][3]);
        const bf16x8 bp = __builtin_bit_cast(bf16x8, pw);
#pragma unroll
        for (int ht = 0; ht < 4; ++ht) { const LAS bf16_t* vr = vbase + (2 * i * 16) * 72 + ht * 16;
            const u32x2 va = tr16(vr), vb = tr16(vr + 16 * 72);
            o[ht] = mfma16(mk8(va, vb), bp, o[ht]); } }
    const float inv = 1.0f / den;
    const size_t tok = (size_t)(base + (blk * 128 + q) * dil);
    if (isA) {
#pragma unroll
        for (int ht = 0; ht < 4; ++ht) { u32x2 w; w.x = pk2(o[ht][0] * inv, o[ht][1] * inv); w.y = pk2(o[ht][2] * inv, o[ht][3] * inv);
            *(u32x2*)(O + tok * NO_ + hh * 64 + ht * 16 + 4 * g) = w; }
    } else {
#pragma unroll
        for (int ht = 0; ht < 4; ++ht) *(f32x4*)(DPO + ((size_t)grp * T_ + tok) * 256 + hh * 64 + ht * 16 + 4 * g) = o[ht] * inv;
        if (g == 0) DLSE[((size_t)grp * T_ + tok) * 4 + hh] = mx + logf(den);
    }
    __syncthreads();
}

__device__ __forceinline__ void gmlp_unit(LAS unsigned char* L, const bf16_t* Z, int unit, const float* lng, const float* lnb, const float* ws_, const float* bs, bf16_t* O, int tid, int wave, int lane) {
    const int n = unit >> 2, grp = unit & 3, tok0 = n * 128;
    LAS float* stats = (LAS float*)L;
    LAS bf16_t* vnt = (LAS bf16_t*)(L + 1024);
    LAS bf16_t* Wc = vnt + 128 * 136;
    {
        u32x4 raw[16];
#pragma unroll
        for (int r = 0; r < 16; ++r) raw[r] = *(const u32x4*)(Z + (size_t)(tok0 + 16 * wave + r) * NZ_ + ZVB + lane * 8);
        float s[16], ss[16];
#pragma unroll
        for (int r = 0; r < 16; ++r) { const float x0 = bflo(raw[r].x), x1 = bfhi(raw[r].x), x2 = bflo(raw[r].y), x3 = bfhi(raw[r].y), x4 = bflo(raw[r].z), x5 = bfhi(raw[r].z), x6 = bflo(raw[r].w), x7 = bfhi(raw[r].w);
            s[r] = ((x0 + x1) + (x2 + x3)) + ((x4 + x5) + (x6 + x7)); ss[r] = ((x0 * x0 + x1 * x1) + (x2 * x2 + x3 * x3)) + ((x4 * x4 + x5 * x5) + (x6 * x6 + x7 * x7)); }
#pragma unroll
        for (int o = 1; o < 64; o <<= 1) {
#pragma unroll
            for (int r = 0; r < 16; ++r) { s[r] += __shfl_xor(s[r], o); ss[r] += __shfl_xor(ss[r], o); } }
        if (lane < 16) { float m = 0.f, q = 0.f;
#pragma unroll
            for (int r = 0; r < 16; ++r) if (lane == r) { m = s[r]; q = ss[r]; }
            m *= (1.f / 512.f); const float var = fmaxf(q * (1.f / 512.f) - m * m, 0.f);
            stats[(16 * wave + lane) * 2] = m; stats[(16 * wave + lane) * 2 + 1] = 1.f / sqrtf(var + LN_EPS); }
    }
#pragma unroll
    for (int it = 0; it < 8; ++it) { const int i = tid + it * 512; const int t = i >> 5, s4 = (i & 31) * 4;
        f32x4 w = *(const f32x4*)(ws_ + (size_t)(grp * 128 + t) * 128 + s4);
#pragma unroll
        for (int e = 0; e < 4; ++e) if (s4 + e > t) w[e] = 0.f;
        u32x2 p; p.x = pk2(w[0], w[1]); p.y = pk2(w[2], w[3]); *(LAS u32x2*)(Wc + t * 136 + s4) = p; }
    u32x4 vraw[4];
#pragma unroll
    for (int it = 0; it < 4; ++it) { const int i = tid + it * 512; const int s = i >> 4, c8 = (i & 15) * 8;
        vraw[it] = *(const u32x4*)(Z + (size_t)(tok0 + s) * NZ_ + ZVB + grp * 128 + c8); }
    __syncthreads();
#pragma unroll
    for (int it = 0; it < 4; ++it) { const int i = tid + it * 512; const int s = i >> 4, c8 = (i & 15) * 8;
        const u32x4 raw = vraw[it];
        const float mean = stats[s * 2], rstd = stats[s * 2 + 1];
        float x[8]; x[0] = bflo(raw.x); x[1] = bfhi(raw.x); x[2] = bflo(raw.y); x[3] = bfhi(raw.y); x[4] = bflo(raw.z); x[5] = bfhi(raw.z); x[6] = bflo(raw.w); x[7] = bfhi(raw.w);
        const f32x4 g0 = *(const f32x4*)(lng + grp * 128 + c8), g1 = *(const f32x4*)(lng + grp * 128 + c8 + 4), b0 = *(const f32x4*)(lnb + grp * 128 + c8), b1 = *(const f32x4*)(lnb + grp * 128 + c8 + 4);
        float y[8];
#pragma unroll
        for (int e = 0; e < 8; ++e) y[e] = (x[e] - mean) * rstd * (e < 4 ? g0[e & 3] : g1[e & 3]) + (e < 4 ? b0[e & 3] : b1[e & 3]);
        u32x4 w; w.x = pk2(y[0], y[1]); w.y = pk2(y[2], y[3]); w.z = pk2(y[4], y[5]); w.w = pk2(y[6], y[7]);
        *(LAS u32x4*)(vnt + s * 136 + c8) = w; }
    __syncthreads();
    const int qi = lane & 15, g = lane >> 4;
    const int t = 16 * wave + qi; const float bias = bs[grp * 128 + t];
    const size_t tok = (size_t)(tok0 + t);
    u32x2 ur[8];
#pragma unroll
    for (int ct = 0; ct < 8; ++ct) ur[ct] = *(const u32x2*)(Z + tok * NZ_ + ZUB + grp * 128 + 16 * ct + 4 * g);
    f32x4 acc[8];
#pragma unroll
    for (int ct = 0; ct < 8; ++ct) acc[ct] = (f32x4){0.f, 0.f, 0.f, 0.f};
#pragma unroll
    for (int ks = 0; ks < 4; ++ks) { const bf16x8 bw = *(const LAS bf16x8*)(Wc + (16 * wave + qi) * 136 + ks * 32 + g * 8);
#pragma unroll
        for (int ct = 0; ct < 8; ++ct) { const LAS bf16_t* vr = vnt + (ks * 32 + 8 * g + (qi >> 2)) * 136 + 16 * ct + 4 * (qi & 3);
            acc[ct] = mfma16(mk8(tr16(vr), tr16(vr + 4 * 136)), bw, acc[ct]); } }
#pragma unroll
    for (int ct = 0; ct < 8; ++ct) { const int c = 16 * ct + 4 * g;
        u32x2 w; w.x = pk2(bflo(ur[ct].x) * (acc[ct][0] + bias), bfhi(ur[ct].x) * (acc[ct][1] + bias));
        w.y = pk2(bflo(ur[ct].y) * (acc[ct][2] + bias), bfhi(ur[ct].y) * (acc[ct][3] + bias));
        *(u32x2*)(O + tok * NO_ + 512 + grp * 128 + c) = w; }
    __syncthreads();
}

__device__ __forceinline__ float hgrn_lb(const float* lbl, int layer, int c) { return layer == 0 ? 0.0f : 1.0f / (1.0f + expf(lbl[c] - lbl[512 + c])); }

__device__ __forceinline__ void hgrn_c1_unit(LAS unsigned char* L, const bf16_t* Z, int unit, const float* lbl, int layer, float* DS, float* DEC, int tid, int wave, int lane) {
    const int h = unit & 3, cg_ = unit >> 2, tok0 = cg_ * 64;
    const int k = tid & 127, qtr = tid >> 7;
    LAS float* qsum = (LAS float*)L;
    LAS bf16_t* kt = (LAS bf16_t*)(L + 2048);
    LAS bf16_t* vt = kt + 128 * 72;
    const float lb = hgrn_lb(lbl, layer, h * 128 + k);
    float G[16], kk[16]; float run = 0.f;
    unsigned vraw[16];
#pragma unroll
    for (int i = 0; i < 16; ++i) { const size_t tok = (size_t)(tok0 + 16 * qtr + i);
        const float zf = bf2f(Z[tok * NZ_ + ZFC + h * 128 + k]);
        vraw[i] = Z[tok * NZ_ + ZIC + h * 128 + k];
        const float e = fexp(-zf), sg = frcp(1.0f + e);
        const float f = lb + (1.0f - lb) * sg;
        run += logf(fmaxf(f, 1e-6f)); G[i] = run; kk[i] = (1.0f - lb) * e * sg; }
    qsum[qtr * 128 + k] = run;
    __syncthreads();
    float off = 0.f, tot = 0.f;
#pragma unroll
    for (int qq = 0; qq < 4; ++qq) { const float v = qsum[qq * 128 + k]; tot += v; if (qq < qtr) off += v; }
    unsigned kw[8], vw[8];
#pragma unroll
    for (int i = 0; i < 8; ++i) { const float a0 = kk[2 * i] * fexp(tot - (G[2 * i] + off)), a1 = kk[2 * i + 1] * fexp(tot - (G[2 * i + 1] + off));
        kw[i] = pk2(a0, a1); vw[i] = vraw[2 * i] | (vraw[2 * i + 1] << 16); }
    *(LAS u32x4*)(kt + k * 72 + 16 * qtr) = (u32x4){kw[0], kw[1], kw[2], kw[3]}; *(LAS u32x4*)(kt + k * 72 + 16 * qtr + 8) = (u32x4){kw[4], kw[5], kw[6], kw[7]};
    *(LAS u32x4*)(vt + k * 72 + 16 * qtr) = (u32x4){vw[0], vw[1], vw[2], vw[3]}; *(LAS u32x4*)(vt + k * 72 + 16 * qtr + 8) = (u32x4){vw[4], vw[5], vw[6], vw[7]};
    if (qtr == 0) DEC[(size_t)unit * 128 + k] = fexp(tot);
    __syncthreads();
    const int qi = lane & 15, g = lane >> 4;
    bf16x8 av[2];
#pragma unroll
    for (int ks = 0; ks < 2; ++ks) av[ks] = *(const LAS bf16x8*)(vt + (16 * wave + qi) * 72 + ks * 32 + g * 8);
    float* dst = DS + (size_t)unit * 16384;
#pragma unroll
    for (int ktile = 0; ktile < 8; ++ktile) { f32x4 acc = {0.f, 0.f, 0.f, 0.f};
#pragma unroll
        for (int ks = 0; ks < 2; ++ks) { const bf16x8 bk = *(const LAS bf16x8*)(kt + (16 * ktile + qi) * 72 + ks * 32 + g * 8); acc = mfma16(av[ks], bk, acc); }
#pragma unroll
        for (int j = 0; j < 4; ++j) dst[(16 * wave + 4 * g + j) * 128 + 16 * ktile + qi] = acc[j]; }
    __syncthreads();
}

__device__ __forceinline__ void hgrn_scan_phase(const float* DS, const float* DEC, bf16_t* HS, int tid, int bid, int G) {
    const int nth = G * 512;
    for (int p = bid * 512 + tid; p < 16 * 8192; p += nth) {
        const int bh = p >> 13, idx = (p & 8191) * 2, k = idx & 127, b = bh >> 2, h = bh & 3;
        f32x2 S = {0.f, 0.f};
#pragma unroll 16
        for (int c = 0; c < 64; ++c) { const size_t u = (size_t)(((b * 64 + c) << 2) | h);
            *(unsigned*)(HS + u * 16384 + idx) = pk2(S[0], S[1]);
            const f32x2 d = *(const f32x2*)(DEC + u * 128 + k), ds = *(const f32x2*)(DS + u * 16384 + idx);
            S = d * S + ds; }
    }
}

__device__ __forceinline__ void hgrn_c3_unit(LAS unsigned char* L, const bf16_t* Z, int unit, const float* lbl, int layer, const bf16_t* HS, const float* ng, bf16_t* O, int tid, int wave, int lane) {
    const int h = unit & 3, cg_ = unit >> 2, tok0 = cg_ * 64;
    const int k = tid & 127, qtr = tid >> 7;
    LAS float* qsum = (LAS float*)L;
    LAS bf16_t* kT = (LAS bf16_t*)(L + 2048);
    LAS bf16_t* qT = kT + 128 * 72;
    LAS bf16_t* qC = qT + 128 * 72;
    LAS bf16_t* vt = qC + 128 * 72;
    LAS float* oL = (LAS float*)(L + 2048 + 4 * 128 * 72 * 2);
    const float lb = hgrn_lb(lbl, layer, h * 128 + k);
    float G[16], kk[16], qv[16]; float run = 0.f;
    unsigned vraw[16];
#pragma unroll
    for (int i = 0; i < 16; ++i) { const size_t tok = (size_t)(tok0 + 16 * qtr + i);
        const float zf = bf2f(Z[tok * NZ_ + ZFC + h * 128 + k]);
        qv[i] = bf2f(Z[tok * NZ_ + ZQC + h * 128 + k]);
        vraw[i] = Z[tok * NZ_ + ZIC + h * 128 + k];
        const float e = fexp(-zf), sg = frcp(1.0f + e);
        const float f = lb + (1.0f - lb) * sg;
        run += logf(fmaxf(f, 1e-6f)); G[i] = run; kk[i] = (1.0f - lb) * e * sg; }
    qsum[qtr * 128 + k] = run;
    __syncthreads();
    float off = 0.f;
#pragma unroll
    for (int qq = 0; qq < 4; ++qq) { const float v = qsum[qq * 128 + k]; if (qq < qtr) off += v; }
    const float Gm = qsum[k] + qsum[128 + k];
    {
        unsigned kw[8], qw[8], cw[8];
#pragma unroll
        for (int i = 0; i < 8; ++i) { float a[2], b[2], c[2];
#pragma unroll
            for (int e = 0; e < 2; ++e) { const float Gi = G[2 * i + e] + off; const float d = fminf(fmaxf(Gi - Gm, -80.f), 80.f);
                a[e] = kk[2 * i + e] * fexp(-d); b[e] = qv[2 * i + e] * fexp(d); c[e] = qv[2 * i + e] * fexp(Gi); }
            kw[i] = pk2(a[0], a[1]); qw[i] = pk2(b[0], b[1]); cw[i] = pk2(c[0], c[1]); }
        *(LAS u32x4*)(kT + k * 72 + 16 * qtr) = (u32x4){kw[0], kw[1], kw[2], kw[3]}; *(LAS u32x4*)(kT + k * 72 + 16 * qtr + 8) = (u32x4){kw[4], kw[5], kw[6], kw[7]};
        *(LAS u32x4*)(qT + k * 72 + 16 * qtr) = (u32x4){qw[0], qw[1], qw[2], qw[3]}; *(LAS u32x4*)(qT + k * 72 + 16 * qtr + 8) = (u32x4){qw[4], qw[5], qw[6], qw[7]};
        *(LAS u32x4*)(qC + k * 72 + 16 * qtr) = (u32x4){cw[0], cw[1], cw[2], cw[3]}; *(LAS u32x4*)(qC + k * 72 + 16 * qtr + 8) = (u32x4){cw[4], cw[5], cw[6], cw[7]};
    }
    {
        unsigned vw[8];
#pragma unroll
        for (int i = 0; i < 8; ++i) vw[i] = vraw[2 * i] | (vraw[2 * i + 1] << 16);
        *(LAS u32x4*)(vt + k * 72 + 16 * qtr) = (u32x4){vw[0], vw[1], vw[2], vw[3]}; *(LAS u32x4*)(vt + k * 72 + 16 * qtr + 8) = (u32x4){vw[4], vw[5], vw[6], vw[7]};
    }
    __syncthreads();
    const int qi = lane & 15, g = lane >> 4, tt = wave & 3, vh = wave >> 2;
    const bf16_t* hs = HS + (size_t)unit * 16384;
    bf16x8 ahs[4][4];
#pragma unroll
    for (int ks = 0; ks < 4; ++ks)
#pragma unroll
        for (int v_ = 0; v_ < 4; ++v_) ahs[ks][v_] = *(const bf16x8*)(hs + (16 * (4 * vh + v_) + qi) * 128 + ks * 32 + g * 8);
    unsigned graw[8][2];
#pragma unroll
    for (int r = 0; r < 8; ++r) { const size_t tok = (size_t)(tok0 + 8 * wave + r); graw[r][0] = Z[tok * NZ_ + ZGC + h * 128 + lane]; graw[r][1] = Z[tok * NZ_ + ZGC + h * 128 + 64 + lane]; }
    f32x4 sc[4];
#pragma unroll
    for (int st = 0; st < 4; ++st) { sc[st] = (f32x4){0.f, 0.f, 0.f, 0.f};
        if (st <= tt) {
#pragma unroll
            for (int ks = 0; ks < 4; ++ks) { const int ro = (ks * 32 + 8 * g + (qi >> 2)) * 72 + 4 * (qi & 3);
                const bf16x8 a = mk8(tr16(kT + ro + 16 * st), tr16(kT + ro + 4 * 72 + 16 * st)), b = mk8(tr16(qT + ro + 16 * tt), tr16(qT + ro + 4 * 72 + 16 * tt));
                sc[st] = mfma16(a, b, sc[st]); }
#pragma unroll
            for (int j = 0; j < 4; ++j) if (16 * st + 4 * g + j > 16 * tt + qi) sc[st][j] = 0.f;
        } }
    f32x4 o[4];
#pragma unroll
    for (int v_ = 0; v_ < 4; ++v_) o[v_] = (f32x4){0.f, 0.f, 0.f, 0.f};
#pragma unroll
    for (int i = 0; i < 2; ++i) {
        u32x4 pw; pw.x = pk2(sc[2 * i][0], sc[2 * i][1]); pw.y = pk2(sc[2 * i][2], sc[2 * i][3]); pw.z = pk2(sc[2 * i + 1][0], sc[2 * i + 1][1]); pw.w = pk2(sc[2 * i + 1][2], sc[2 * i + 1][3]);
        const bf16x8 bp = __builtin_bit_cast(bf16x8, pw);
#pragma unroll
        for (int v_ = 0; v_ < 4; ++v_) { const LAS bf16_t* vr = vt + (16 * (4 * vh + v_) + qi) * 72 + 4 * g;
            const u32x2 va = *(const LAS u32x2*)(vr + (2 * i) * 16), vb = *(const LAS u32x2*)(vr + (2 * i + 1) * 16);
            o[v_] = mfma16(mk8(va, vb), bp, o[v_]); } }
#pragma unroll
    for (int ks = 0; ks < 4; ++ks) { const int ro = (ks * 32 + 8 * g + (qi >> 2)) * 72 + 4 * (qi & 3) + 16 * tt; const bf16x8 b = mk8(tr16(qC + ro), tr16(qC + ro + 4 * 72));
#pragma unroll
        for (int v_ = 0; v_ < 4; ++v_) o[v_] = mfma16(ahs[ks][v_], b, o[v_]); }
#pragma unroll
    for (int v_ = 0; v_ < 4; ++v_) *(LAS f32x4*)(oL + (16 * tt + qi) * 132 + 16 * (4 * vh + v_) + 4 * g) = o[v_];
    __syncthreads();
    const float ng0 = ng[h * 128 + lane], ng1 = ng[h * 128 + 64 + lane];
#pragma unroll
    for (int r = 0; r < 8; ++r) { const int t = 8 * wave + r;
        const float x0 = oL[t * 132 + lane], x1 = oL[t * 132 + 64 + lane];
        const float ss = wave_sum(x0 * x0 + x1 * x1);
        const float rs = 1.0f / sqrtf(ss * (1.f / 128.f) + LN_EPS);
        const size_t tok = (size_t)(tok0 + t);
        const float g0 = bf2f(graw[r][0]), g1 = bf2f(graw[r][1]);
        const float y0 = x0 * rs * ng0 * fsigmoid(g0), y1 = x1 * rs * ng1 * fsigmoid(g1);
        O[tok * NO_ + 1024 + h * 128 + lane] = (bf16_t)(pk2(y0, 0.f) & 0xffffu);
        O[tok * NO_ + 1024 + h * 128 + 64 + lane] = (bf16_t)(pk2(y1, 0.f) & 0xffffu); }
    __syncthreads();
}

__device__ __forceinline__ void dcomb_phase(const float* DPO, const float* DLSE, bf16_t* O, int tid, int bid, int G) {
    const int nth = G * 512;
#pragma unroll 4
    for (int i = bid * 512 + tid; i < T_ * 64; i += nth) { const int t = i >> 6, c4 = (i & 63) * 4, h = c4 >> 6;
        const float l0 = DLSE[((size_t)0 * T_ + t) * 4 + h], l1 = DLSE[((size_t)1 * T_ + t) * 4 + h], l2 = DLSE[((size_t)2 * T_ + t) * 4 + h];
        const float m = fmaxf(l0, fmaxf(l1, l2));
        float w0 = fexp(l0 - m), w1 = fexp(l1 - m), w2 = fexp(l2 - m); const float inv = 1.0f / (w0 + w1 + w2); w0 *= inv; w1 *= inv; w2 *= inv;
        const f32x4 a = *(const f32x4*)(DPO + ((size_t)0 * T_ + t) * 256 + c4), b = *(const f32x4*)(DPO + ((size_t)1 * T_ + t) * 256 + c4), c = *(const f32x4*)(DPO + ((size_t)2 * T_ + t) * 256 + c4);
        const f32x4 r = w0 * a + w1 * b + w2 * c;
        u32x2 w; w.x = pk2(r[0], r[1]); w.y = pk2(r[2], r[3]);
        *(u32x2*)(O + (size_t)t * NO_ + 1536 + c4) = w; }
}

constexpr int NPH_LAYER = 14, NPH = 2 * NPH_LAYER;
__global__ void __launch_bounds__(512, 2) hybrid_fwd(Args a) {
    extern __shared__ __attribute__((aligned(16))) unsigned char lds_raw[];
    LAS unsigned char* lds = (LAS unsigned char*)lds_raw;
    PTab pt = (PTab)(lds + 131072);
    if (threadIdx.x == 0) {
#pragma unroll
        for (int i = 0; i < 22; ++i) pt[i] = (unsigned long long)a.in[i];
        pt[22] = (unsigned long long)a.out; pt[23] = (unsigned long long)a.ws;
    }
    if (threadIdx.x < 8) ((LAS unsigned*)(lds + 131072 + 512))[threadIdx.x] = 0u;
    __syncthreads();
    const int ph_lo = a.ph_lo, ph_hi = a.ph_hi;
    unsigned pepoch = 0u; bool fast = false;
    if (threadIdx.x == 0 && blockIdx.x < 8) __hip_atomic_store((unsigned*)(a.ws + WS_CTL + WS_BAR + 15400) + blockIdx.x, xb_xcc_id(), __ATOMIC_RELAXED, __HIP_MEMORY_SCOPE_AGENT);
    XcdBarrier bar = xcd_barrier_post((unsigned*)(a.ws + WS_CTL + WS_BAR), (volatile LAS unsigned*)(lds + 131072 + 512));
    for (int ph = ph_lo; ph < ph_hi; ++ph) {
        const int l = ph / NPH_LAYER, p = ph - l * NPH_LAYER;
        pg8::StaticOrder S;
        int tid = threadIdx.x; asm volatile("" : "+v"(tid));
        int bid = blockIdx.x, G = gridDim.x; asm volatile("" : "+s"(bid), "+s"(G));
        const int lane = tid & 63, wave = __builtin_amdgcn_readfirstlane(tid >> 6);
        unsigned char* ws = (unsigned char*)ldptr(pt, 23);
#define P_X ((float*)ldptr(pt, 22))
#define P_XB ((bf16_t*)(ws + WS_XB))
#define P_ZH ((bf16_t*)(ws + WS_ZH))
#define P_GATE ((bf16_t*)(ws + WS_GATE))
#define P_O ((bf16_t*)(ws + WS_O))
#define P_DS ((float*)(ws + WS_DS))
#define P_DEC ((float*)(ws + WS_CTL))
#define P_HS ((bf16_t*)(ws + WS_HS))
#define P_DPO ((float*)(ws + WS_DPO))
#define P_DLSE ((float*)(ws + WS_DLSE))
        switch (p) {
        case 0: if (l == 0) convert_phase(pt, 0, lds, tid, wave, lane, bid, G); break;
        case 1: case 11: {
            const int s = (p == 1) ? 0 : 1; const int n_ = (p == 1) ? 2 * FF_ : 2 * FF_ + D_;
            pg8::Gemm g{P_XB, (const bf16_t*)(ws + WS_WGU + (size_t)s * 44 * MiB), T_, n_, D_}; S.init(T_, n_, G, bid);
            pg8::EpiSwiGLU E{p == 1 ? P_O : P_ZH, P_GATE}; pg8::gemm_phase(lds, g, S, E);
        } break;
        case 2: {
            pg8::Gemm g{P_O, (const bf16_t*)(ws + WS_WD), T_, D_, FF_}; S.init(T_, D_, G, bid);
            pg8::EpiResidT<false> E{P_X, P_XB, nullptr, ALPHA, 0.5f}; pg8::gemm_phase<pg8::EpiResidT<false>, true>(lds, g, S, E);
        } break;
        case 3: case 10: case 13: {
            const int which = (p == 3) ? 0 : (p == 10 ? 1 : 2);
            if (fast) ln_phase(P_X, P_XB, ldptr(pt, 2) + (size_t)(l * 3 + which) * D_, ldptr(pt, 3) + (size_t)(l * 3 + which) * D_, (l == 1 && p == 13), (8 * (bid & 7) + ((bid >> 3) & 7)) * 256 + (bid >> 6) * 64 + wave * 8, 1, 4, 2, lane);
            else ln_phase(P_X, P_XB, ldptr(pt, 2) + (size_t)(l * 3 + which) * D_, ldptr(pt, 3) + (size_t)(l * 3 + which) * D_, (l == 1 && p == 13), bid * 8 + wave, G * 8, 32 * G, (T_ + 32 * G - 1) / (32 * G), lane);
            if (p == 13 && l == 0) convert_phase(pt, 1, lds, tid, wave, lane, bid, G);
            if (p == 10) { int kp = PLE_; asm volatile("" : "+s"(kp)); pg8::Gemm g2{(const bf16_t*)(ws + WS_PB) + (size_t)l * T_ * PLE_, (const bf16_t*)(ws + WS_WPP), T_, D_, kp}; S.init(T_, D_, G, bid);
                pg8::EpiBf16 E2{P_GATE, D_}; pg8::gemm_phase(lds, g2, S, E2); }
        } break;
        case 4: {
            pg8::Gemm g{P_XB, (const bf16_t*)(ws + WS_WIN), T_, NIN_, D_}; S.init(T_, NIN_, G, bid);
            pg8::EpiZ E{P_ZH, P_GATE}; pg8::gemm_phase(lds, g, S, E);
        } break;
        case 5: {
            for (int u = bid; u < 2560; u += G) attn_unit(lds, P_ZH, u, ldptr(pt, 8) + l * 8, P_O, P_DPO, P_DLSE, tid, wave, lane);
            for (int u = bid; u < 512; u += G) gmlp_unit(lds, P_ZH, u, ldptr(pt, 9) + l * 512, ldptr(pt, 10) + l * 512, ldptr(pt, 11) + (size_t)l * 65536, ldptr(pt, 12) + l * 512, P_O, tid, wave, lane);
            for (int u = bid; u < 1024; u += G) hgrn_c1_unit(lds, P_ZH, u, ldptr(pt, 13), l, P_DS, P_DEC, tid, wave, lane);
        } break;
        case 6: hgrn_scan_phase(P_DS, P_DEC, P_HS, tid, bid, G); break;
        case 7: {
            for (int u = bid; u < 1024; u += G) hgrn_c3_unit(lds, P_ZH, u, ldptr(pt, 13), l, P_HS, ldptr(pt, 14) + l * 512, P_O, tid, wave, lane);
            dcomb_phase(P_DPO, P_DLSE, P_O, tid, bid, G);
        } break;
        case 8: {
            pg8::Gemm g{P_O, (const bf16_t*)(ws + WS_WBR), T_, D_, NO_}; S.init(T_, D_, G, bid);
            pg8::EpiBR E{(bf16_t*)P_DS, P_GATE}; pg8::gemm_phase(lds, g, S, E);
        } break;
        case 9: {
            pg8::Gemm g{(const bf16_t*)P_DS, (const bf16_t*)(ws + WS_WOUT), T_, D_, D_}; S.init(T_, D_, G, bid);
            pg8::EpiResidT<false> E{P_X, P_XB, nullptr, ALPHA, 1.0f}; pg8::gemm_phase(lds, g, S, E);
        } break;
        case 12: {
            pg8::Gemm g{P_ZH, (const bf16_t*)(ws + WS_WD + (size_t)22 * MiB), T_, D_, FF_}; S.init(T_, D_, G, bid);
            pg8::EpiResidT<true> E{P_X, P_XB, P_GATE, ALPHA, 0.5f}; pg8::gemm_phase<pg8::EpiResidT<true>, true>(lds, g, S, E);
        } break;
        default: break;
        }
        if (ph + 1 < ph_hi) {
            if (ph_hi > 1000) { __threadfence(); cg::this_grid().sync(); }
            else if (fast && (p == 2 || p == 3 || p == 8 || p == 9 || p == 10 || p == 11 || (l == 1 && (p == 1 || p == 12))))
                panel_barrier((unsigned*)(ws + WS_CTL + WS_BAR + 16384) + 64 * (8 * (bid & 7) + ((bid >> 3) & 7)), pepoch);
            else xcd_barrier(bar);
            if (ph == 0) { if (threadIdx.x == 0 && xb_xcc_id() != xb_ld((unsigned*)(ws + WS_CTL + WS_BAR + 15400) + (blockIdx.x & 7))) (void)xb_add((unsigned*)(ws + WS_CTL + WS_BAR + 15360), 1u); }
            if (ph == 1) fast = (G == 256) && (__builtin_amdgcn_readfirstlane(xb_ld((unsigned*)(ws + WS_CTL + WS_BAR + 15360))) == 0u);
        }
    }
}

extern "C" void kernel_launch(void* const* d_in, const int* in_sizes, int n_in, void* d_out, int out_size, void* d_ws, size_t ws_size, hipStream_t stream) {
    static int grid = 0;
    if (grid == 0) {
        if (n_in != 22 || out_size != T_ * D_ || ws_size < WS_END) { fprintf(stderr, "kernel_launch: unexpected shapes (n_in %d out %d ws %zu need %zu)\n", n_in, out_size, ws_size, (size_t)WS_END); grid = -1; return; }
        int dev = 0, cus = 0, per_cu = 0;
        hipGetDevice(&dev); hipDeviceGetAttribute(&cus, hipDeviceAttributeMultiprocessorCount, dev);
        if (hipFuncSetAttribute((const void*)hybrid_fwd, hipFuncAttributeMaxDynamicSharedMemorySize, LDS_BYTES) != hipSuccess) { fprintf(stderr, "kernel_launch: hipFuncSetAttribute failed\n"); grid = -1; return; }
        hipOccupancyMaxActiveBlocksPerMultiprocessor(&per_cu, (const void*)hybrid_fwd, 512, LDS_BYTES);
        (void)hipGetLastError();
        if (per_cu < 1) per_cu = 1;
        grid = cus * 1;
    }
    if (grid < 0) return;
    if (hipMemsetAsync((char*)d_ws + WS_CTL + WS_BAR, 0, BAR_BYTES, stream) != hipSuccess) { fprintf(stderr, "kernel_launch: memset failed\n"); return; }
    Args a{};
    for (int i = 0; i < 22; ++i) a.in[i] = (const float*)d_in[i];
    a.out = (float*)d_out; a.ws = (unsigned char*)d_ws; a.ph_lo = 0; a.ph_hi = NPH;
    void* args[] = {&a};
    hipError_t e = hipLaunchCooperativeKernel((const void*)hybrid_fwd, dim3(grid), dim3(512), args, LDS_BYTES, stream);
    if (e != hipSuccess) fprintf(stderr, "cooperative launch failed: %s (grid %d)\n", hipGetErrorString(e), grid);
}
```

```cpp
#include <hip/hip_runtime.h>
#include <hip/hip_cooperative_groups.h>
#include <cstdio>
#include <cstdint>
namespace cg = cooperative_groups;

#define LAS __attribute__((address_space(3)))
typedef unsigned short bf16_t;
typedef short bf16x8 __attribute__((ext_vector_type(8)));
typedef float f32x4 __attribute__((ext_vector_type(4)));
typedef float f32x2 __attribute__((ext_vector_type(2)));
typedef unsigned u32x4 __attribute__((ext_vector_type(4)));
typedef unsigned u32x2 __attribute__((ext_vector_type(2)));

constexpr int T_ = 16384, SEQ_ = 4096, D_ = 2048, FF_ = 5632, NIN_ = 14336, NZ_ = 6144, NGT_ = 8192, NO_ = 1792, PLE_ = 256;
constexpr int ZQA = 0, ZKA = 512, ZVA = 640, ZUB = 768, ZVB = 1280, ZQC = 1792, ZFC = 2304, ZIC = 2816, ZGC = 3328, ZQD = 3840, ZKD = 4608, ZVD = 5376;
constexpr float LN_EPS = 1e-5f;
constexpr float ALPHA = 1.41421356237f;
constexpr float LOG2E = 1.44269504089f;

constexpr size_t MiB = 1u << 20;
constexpr size_t WS_CTL = 0;
constexpr size_t WS_BAR = 768 * 1024, BAR_BYTES = 32768;
constexpr size_t WS_WGU = 1 * MiB;
constexpr size_t WS_WPG = WS_WGU + 88 * MiB;
constexpr size_t WS_WD = WS_WPG + 8 * MiB;
constexpr size_t WS_WIN = WS_WD + 44 * MiB;
constexpr size_t WS_WBR = WS_WIN + 56 * MiB;
constexpr size_t WS_WOUT = WS_WBR + 7 * MiB;
constexpr size_t WS_WPP = WS_WOUT + 8 * MiB;
constexpr size_t WS_PB = WS_WPP + 1 * MiB;
constexpr size_t WS_XB = WS_PB + 16 * MiB;
constexpr size_t WS_ZH = WS_XB + 64 * MiB;
constexpr size_t WS_GATE = WS_ZH + 192 * MiB;
constexpr size_t WS_O = WS_GATE + 256 * MiB;
constexpr size_t WS_HS = WS_O + 56 * MiB;
constexpr size_t WS_DPO = WS_HS + 32 * MiB;
constexpr size_t WS_DLSE = WS_DPO + 48 * MiB;
constexpr size_t WS_DS = WS_DLSE + 1 * MiB;
constexpr size_t WS_END = WS_DS + 64 * MiB;
static_assert(WS_HS == WS_O + 56 * MiB && WS_DPO == WS_HS + 32 * MiB && WS_DLSE == WS_DPO + 48 * MiB && WS_DS == WS_DLSE + 1 * MiB && WS_END - WS_O >= 176 * MiB, "FFN1's H [T][5632] bf16 (176 MiB) overlays the contiguous O | HS | DPO | DLSE | dS span");

constexpr int LDS_BYTES = 147456;

__device__ __forceinline__ float bf2f(unsigned b) { return __uint_as_float(b << 16); }
__device__ __forceinline__ float bflo(unsigned w) { return __uint_as_float(w << 16); }
__device__ __forceinline__ float bfhi(unsigned w) { return __uint_as_float(w & 0xffff0000u); }
__device__ __forceinline__ unsigned pk2(float lo, float hi) { unsigned r; asm("v_cvt_pk_bf16_f32 %0, %1, %2" : "=v"(r) : "v"(lo), "v"(hi)); return r; }
__device__ __forceinline__ float fexp(float x) { return __builtin_amdgcn_exp2f(x * LOG2E); }
__device__ __forceinline__ float frcp(float x) { return __builtin_amdgcn_rcpf(x); }
__device__ __forceinline__ float fsigmoid(float x) { return frcp(1.0f + fexp(-x)); }
__device__ __forceinline__ float gelu_erf(float x) { return 0.5f * x * (1.0f + erff(x * 0.70710678118f)); }
__device__ __forceinline__ float gelu_fast(float v) {
    const float av = fabsf(v), t = frcp(av * 0.2316418882f + 1.0f);
    float q = t * 0.5307027145f + (-0.7265760135f); q = q * t + 0.7107068705f; q = q * t + (-0.142248368f); q = q * t + 0.127414796f; q = q * t;
    const float e = __builtin_amdgcn_exp2f((v * v) * (-0.72134752044f));
    const float m = v * (q * e);
    return v < 0.f ? m : v - m;
}
__device__ __forceinline__ float wave_sum(float v) {
#pragma unroll
    for (int o = 1; o < 64; o <<= 1) v += __shfl_xor(v, o);
    return v;
}
__device__ __forceinline__ f32x4 mfma16(bf16x8 a, bf16x8 b, f32x4 c) { return __builtin_amdgcn_mfma_f32_16x16x32_bf16(a, b, c, 0, 0, 0); }
typedef short s16x4 __attribute__((ext_vector_type(4)));
__device__ __forceinline__ u32x2 tr16(const LAS bf16_t* p) { const s16x4 r = __builtin_amdgcn_ds_read_tr16_b64_v4i16((LAS s16x4*)p); return __builtin_bit_cast(u32x2, r); }
__device__ __forceinline__ bf16x8 mk8(u32x2 a, u32x2 b) { u32x4 t = {a.x, a.y, b.x, b.y}; return __builtin_bit_cast(bf16x8, t); }

namespace pg8 {
constexpr int BM = 256, BK = 64, HALF = 128, HTB = HALF * BK * 2, STAGE_BYTES = 8 * HTB, NXCD = 8, WGM = 8;
__device__ __forceinline__ int lds_byte(int r, int c) { const int st = (r >> 4) * 2 + (c >> 5), rr = r & 15, cc = c & 31, ob = rr * 64 + cc * 2; return st * 1024 + (ob ^ (((ob >> 9) & 1) << 5)); }
__device__ __forceinline__ void stage_rc(int b, int& R, int& C) { const int st = b / 1024, sb = b % 1024, swz = sb ^ (((sb >> 9) & 1) << 5); R = (st >> 1) * 16 + swz / 64; C = (st & 1) * 32 + (swz % 64) / 2; }
__device__ __forceinline__ int perm32(int rho) { const int n = rho >> 4, i = rho & 15; return 8 * (i >> 2) + 4 * n + (i & 3); }
struct Unit { int pm, pn; };
struct Gemm { const bf16_t* A; const bf16_t* Bt; int M, N, K; };
struct StaticOrder {
    int nM, nN, nwg, G, c;
    __device__ void init(int M, int N, int G_, int c_) { nM = M / BM; nN = N / BM; nwg = nM * nN; G = G_; c = c_; }
    __device__ bool next(int i, Unit& u) const {
        const long L = (long)i * G + c; if (L >= nwg) return false;
        int wgid = (int)L; { const int q = nwg / NXCD, r = nwg % NXCD, xcd = wgid % NXCD, off = wgid / NXCD; wgid = (xcd < r ? xcd * (q + 1) : r * (q + 1) + (xcd - r) * q) + off; }
        const int nig = WGM * nN, gid = wgid / nig, fm = gid * WGM, gsz = (nM - fm) < WGM ? (nM - fm) : WGM;
        u.pm = fm + ((wgid % nig) % gsz); u.pn = (wgid % nig) / gsz; return true;
    }
};

struct EpiSwiGLU {
    static constexpr bool PERM = true, HAS_MID = false;
    bf16_t* H; bf16_t* PP;
    __device__ __forceinline__ void mid(int, f32x4 (&)[2][2][4][2], const Unit&, int, int, int, int) const {}
    __device__ __forceinline__ void operator()(const f32x4 (&acc)[2][2][4][2], const Unit& u, int wr, int wc, int fr, int fq) const {
        const int row0 = u.pm * BM + wr * 64 + fr;
        if (u.pn < 44) {
            const int col0 = u.pn * 128 + wc * 32 + 8 * fq;
#pragma unroll
            for (int ai = 0; ai < 2; ++ai)
#pragma unroll
                for (int m = 0; m < 4; ++m) {
                    bf16_t* rowp = H + (size_t)(row0 + ai * HALF + m * 16) * FF_ + col0;
                    float h[8];
#pragma unroll
                    for (int n = 0; n < 2; ++n)
#pragma unroll
                        for (int j = 0; j < 4; ++j) { const float g = acc[ai][0][m][n][j], up = acc[ai][1][m][n][j]; h[n * 4 + j] = g * fsigmoid(g) * up; }
                    u32x4 w; w.x = pk2(h[0], h[1]); w.y = pk2(h[2], h[3]); w.z = pk2(h[4], h[5]); w.w = pk2(h[6], h[7]);
                    *(u32x4*)rowp = w;
                    asm volatile("" ::: "memory"); __builtin_amdgcn_sched_barrier(0);
                }
        } else {
            const int col0 = (u.pn - 44) * BM + wc * 32 + 8 * fq;
#pragma unroll
            for (int am = 0; am < 4; ++am) { const int ai = am >> 1, mb = (am & 1) * 2;
                u32x4 pv[2][2];
#pragma unroll
                for (int mm = 0; mm < 2; ++mm)
#pragma unroll
                    for (int bj = 0; bj < 2; ++bj) pv[mm][bj] = *(const u32x4*)(PP + (size_t)(row0 + ai * HALF + (mb + mm) * 16) * D_ + col0 + bj * HALF);
#pragma unroll
                for (int mm = 0; mm < 2; ++mm) { const int m = mb + mm;
                    bf16_t* rowp = PP + (size_t)(row0 + ai * HALF + m * 16) * D_ + col0;
#pragma unroll
                    for (int bj = 0; bj < 2; ++bj) {
                        const u32x4 p = pv[mm][bj];
                        const f32x4 a0 = acc[ai][bj][m][0], a1 = acc[ai][bj][m][1];
                        u32x4 w;
                        w.x = pk2(fsigmoid(a0[0]) * bflo(p.x), fsigmoid(a0[1]) * bfhi(p.x)); w.y = pk2(fsigmoid(a0[2]) * bflo(p.y), fsigmoid(a0[3]) * bfhi(p.y));
                        w.z = pk2(fsigmoid(a1[0]) * bflo(p.z), fsigmoid(a1[1]) * bfhi(p.z)); w.w = pk2(fsigmoid(a1[2]) * bflo(p.w), fsigmoid(a1[3]) * bfhi(p.w));
                        *(u32x4*)(rowp + bj * HALF) = w;
                    }
                }
                asm volatile("" ::: "memory"); __builtin_amdgcn_sched_barrier(0);
            }
        }
    }
};
template <bool ADD> struct EpiResidT {
    static constexpr bool PERM = false, HAS_MID = false;
    float* Y; const bf16_t* XB; const bf16_t* PP; float a, b;
    __device__ __forceinline__ void mid(int, f32x4 (&)[2][2][4][2], const Unit&, int, int, int, int) const {}
    __device__ __forceinline__ void operator()(const f32x4 (&acc)[2][2][4][2], const Unit& u, int wr, int wc, int fr, int fq) const {
        const int row0 = u.pm * BM + wr * 64 + fr, col0 = u.pn * BM + wc * 32 + 4 * fq;
        constexpr int GM = ADD ? 2 : 4;
#pragma unroll
        for (int ai = 0; ai < 2; ++ai)
#pragma unroll
            for (int m0 = 0; m0 < 4; m0 += GM) {
                u32x2 xb[GM][2][2], pp[GM][2][2];
#pragma unroll
                for (int mm = 0; mm < GM; ++mm) { const size_t off = (size_t)(row0 + ai * HALF + (m0 + mm) * 16) * D_ + col0;
#pragma unroll
                    for (int bj = 0; bj < 2; ++bj)
#pragma unroll
                        for (int n = 0; n < 2; ++n) { xb[mm][bj][n] = *(const u32x2*)(XB + off + bj * HALF + n * 16); if (ADD) pp[mm][bj][n] = *(const u32x2*)(PP + off + bj * HALF + n * 16); } }
#pragma unroll
                for (int mm = 0; mm < GM; ++mm) { const int m = m0 + mm; const size_t off = (size_t)(row0 + ai * HALF + m * 16) * D_ + col0;
#pragma unroll
                    for (int bj = 0; bj < 2; ++bj)
#pragma unroll
                        for (int n = 0; n < 2; ++n) { const u32x2 x = xb[mm][bj][n]; const f32x4 s = acc[ai][bj][m][n];
                            f32x4 y; y[0] = a * bflo(x.x) + b * s[0]; y[1] = a * bfhi(x.x) + b * s[1]; y[2] = a * bflo(x.y) + b * s[2]; y[3] = a * bfhi(x.y) + b * s[3];
                            if (ADD) { const u32x2 q = pp[mm][bj][n]; y[0] += bflo(q.x); y[1] += bfhi(q.x); y[2] += bflo(q.y); y[3] += bfhi(q.y); }
                            *(f32x4*)(Y + off + bj * HALF + n * 16) = y; } }
                asm volatile("" ::: "memory"); __builtin_amdgcn_sched_barrier(0);
            }
    }
};
struct EpiZ {
    static constexpr bool PERM = true, HAS_MID = false;
    bf16_t* Z; bf16_t* GATE; int pn_off;
    __device__ __forceinline__ void mid(int, f32x4 (&)[2][2][4][2], const Unit&, int, int, int, int) const {}
    __device__ __forceinline__ void operator()(const f32x4 (&acc)[2][2][4][2], const Unit& u0, int wr, int wc, int fr, int fq) const {
        Unit u; u.pm = u0.pm; u.pn = u0.pn + pn_off;
        const int row0 = u.pm * BM + wr * 64 + fr;
        if (u.pn < 24) {
            const bool isgelu = (u.pn >= 3) && (u.pn <= 6);
            const int col0 = u.pn * BM + wc * 32 + 8 * fq;
#pragma unroll
            for (int ai = 0; ai < 2; ++ai)
#pragma unroll
                for (int m = 0; m < 4; ++m) {
                    bf16_t* rowp = Z + (size_t)(row0 + ai * HALF + m * 16) * NZ_ + col0;
#pragma unroll
                    for (int bj = 0; bj < 2; ++bj) {
                        f32x4 v0 = acc[ai][bj][m][0], v1 = acc[ai][bj][m][1];
                        if (isgelu) {
#pragma unroll
                            for (int j = 0; j < 4; ++j) { v0[j] = gelu_fast(v0[j]); v1[j] = gelu_fast(v1[j]); }
                        }
                        u32x4 w; w.x = pk2(v0[0], v0[1]); w.y = pk2(v0[2], v0[3]); w.z = pk2(v1[0], v1[1]); w.w = pk2(v1[2], v1[3]);
                        *(u32x4*)(rowp + bj * HALF) = w;
                    }
                    asm volatile("" ::: "memory"); __builtin_amdgcn_sched_barrier(0);
                }
        } else {
            const int mc0 = (u.pn - 24) * 64 + wc * 16 + 4 * fq;
#pragma unroll
            for (int ai = 0; ai < 2; ++ai)
#pragma unroll
                for (int m = 0; m < 4; ++m) {
                    bf16_t* rowp = GATE + (size_t)(row0 + ai * HALF + m * 16) * D_ + mc0;
                    f32x4 e[4];
#pragma unroll
                    for (int br = 0; br < 4; ++br)
#pragma unroll
                        for (int j = 0; j < 4; ++j) e[br][j] = fminf(1.0f + fexp(-acc[ai][br >> 1][m][br & 1][j]), 1e30f);
                    f32x4 i0, i1, i2, i3;
#pragma unroll
                    for (int j = 0; j < 4; ++j) { i0[j] = frcp(e[0][j]); i1[j] = frcp(e[1][j]); i2[j] = frcp(e[2][j]); i3[j] = frcp(e[3][j]); }
                    const f32x4 r0 = e[1] * i0, r1 = e[2] * i1, r2 = e[3] * i2;
                    u32x2 w;
                    w.x = pk2(r0[0], r0[1]); w.y = pk2(r0[2], r0[3]); *(u32x2*)(rowp) = w;
                    w.x = pk2(r1[0], r1[1]); w.y = pk2(r1[2], r1[3]); *(u32x2*)(rowp + (size_t)T_ * D_) = w;
                    w.x = pk2(r2[0], r2[1]); w.y = pk2(r2[2], r2[3]); *(u32x2*)(rowp + (size_t)2 * T_ * D_) = w;
                    w.x = pk2(i3[0], i3[1]); w.y = pk2(i3[2], i3[3]); *(u32x2*)(rowp + (size_t)3 * T_ * D_) = w;
                    asm volatile("" ::: "memory"); __builtin_amdgcn_sched_barrier(0);
                }
        }
    }
};
struct EpiBf16 {
    static constexpr bool PERM = true, HAS_MID = false;
    bf16_t* O; int ldc;
    __device__ __forceinline__ void mid(int, f32x4 (&)[2][2][4][2], const Unit&, int, int, int, int) const {}
    __device__ __forceinline__ void operator()(const f32x4 (&acc)[2][2][4][2], const Unit& u, int wr, int wc, int fr, int fq) const {
        const int row0 = u.pm * BM + wr * 64 + fr, col0 = u.pn * BM + wc * 32 + 8 * fq;
#pragma unroll
        for (int ai = 0; ai < 2; ++ai)
#pragma unroll
            for (int m = 0; m < 4; ++m) {
                bf16_t* rowp = O + (size_t)(row0 + ai * HALF + m * 16) * ldc + col0;
#pragma unroll
                for (int bj = 0; bj < 2; ++bj) {
                    const f32x4 v0 = acc[ai][bj][m][0], v1 = acc[ai][bj][m][1];
                    u32x4 w; w.x = pk2(v0[0], v0[1]); w.y = pk2(v0[2], v0[3]); w.z = pk2(v1[0], v1[1]); w.w = pk2(v1[2], v1[3]);
                    *(u32x4*)(rowp + bj * HALF) = w;
                }
                asm volatile("" ::: "memory"); __builtin_amdgcn_sched_barrier(0);
            }
    }
};
struct EpiBR {
    static constexpr bool PERM = true, HAS_MID = true;
    bf16_t* O; const bf16_t* GATE;
    __device__ __forceinline__ void scale(const bf16_t* plane, f32x4 (&acc)[2][2][4][2], const Unit& u, int wr, int wc, int fr, int fq) const {
        const int row0 = u.pm * BM + wr * 64 + fr, col0 = u.pn * BM + wc * 32 + 8 * fq;
        u32x4 r[2][4][2];
#pragma unroll
        for (int ai = 0; ai < 2; ++ai)
#pragma unroll
            for (int m = 0; m < 4; ++m)
#pragma unroll
                for (int bj = 0; bj < 2; ++bj) r[ai][m][bj] = *(const u32x4*)(plane + (size_t)(row0 + ai * HALF + m * 16) * D_ + col0 + bj * HALF);
#pragma unroll
        for (int ai = 0; ai < 2; ++ai)
#pragma unroll
            for (int m = 0; m < 4; ++m)
#pragma unroll
                for (int bj = 0; bj < 2; ++bj) { const u32x4 e = r[ai][m][bj];
                    acc[ai][bj][m][0] *= (f32x4){bflo(e.x), bfhi(e.x), bflo(e.y), bfhi(e.y)}; acc[ai][bj][m][1] *= (f32x4){bflo(e.z), bfhi(e.z), bflo(e.w), bfhi(e.w)}; }
    }
    __device__ __forceinline__ void mid(int t, f32x4 (&acc)[2][2][4][2], const Unit& u, int wr, int wc, int fr, int fq) const {
        if (t != 8 && t != 16 && t != 24) return;
        asm volatile("" : "+v"(fr), "+v"(fq));
        scale(GATE + (size_t)((t >> 3) - 1) * T_ * D_, acc, u, wr, wc, fr, fq);
    }
    __device__ __forceinline__ void operator()(f32x4 (&acc)[2][2][4][2], const Unit& u, int wr, int wc, int fr, int fq) const {
        scale(GATE + (size_t)3 * T_ * D_, acc, u, wr, wc, fr, fq);
        const int row0 = u.pm * BM + wr * 64 + fr, col0 = u.pn * BM + wc * 32 + 8 * fq;
#pragma unroll
        for (int ai = 0; ai < 2; ++ai)
#pragma unroll
            for (int m = 0; m < 4; ++m) {
                bf16_t* rowp = O + (size_t)(row0 + ai * HALF + m * 16) * D_ + col0;
#pragma unroll
                for (int bj = 0; bj < 2; ++bj) {
                    const f32x4 a0 = acc[ai][bj][m][0], a1 = acc[ai][bj][m][1];
                    u32x4 w; w.x = pk2(a0[0], a0[1]); w.y = pk2(a0[2], a0[3]); w.z = pk2(a1[0], a1[1]); w.w = pk2(a1[2], a1[3]);
                    *(u32x4*)(rowp + bj * HALF) = w;
                }
            }
    }
};

template <class Epi, bool KREV = false>
__device__ __forceinline__ void gemm_phase(LAS unsigned char* lds, const Gemm g, const StaticOrder& S, const Epi& E) {
    int tid = threadIdx.x; asm volatile("" : "+v"(tid));
    const int wid = __builtin_amdgcn_readfirstlane(tid >> 6), lane = tid & 63, wr = wid >> 2, wc = wid & 3, fr = lane & 15, fq = lane >> 4;
    const int K = g.K, nt = K / BK;
    unsigned voffA[2], voffB[2];
#pragma unroll
    for (int i = 0; i < 2; ++i) { int R, C; stage_rc(tid * 16 + i * 8192, R, C); const int Rb = Epi::PERM ? ((R & ~31) + perm32(R & 31)) : R;
        voffA[i] = (unsigned)(R * K + C) * 2u; voffB[i] = (unsigned)(Rb * K + C) * 2u; }
    const long kstep = KREV ? -(long)(BK * 2) : (long)(BK * 2);
    const size_t kbase = KREV ? (size_t)(nt - 1) * (BK * 2) : 0;
    const size_t hstep = (size_t)HALF * K * 2;
    const size_t tstep = 2 * hstep;
    const unsigned ldsw = (unsigned)wid * 1024u;
    const int aoff = lds_byte(wr * 64 + fr, fq * 8), boff = lds_byte(wc * 32 + fr, fq * 8);
#define PG8_SA(b, h) (((b) * 2 + (h)) * HTB)
#define PG8_SB(b, h) ((4 + (b) * 2 + (h)) * HTB)
#define PG8_STAGE(bufoff, gbase, voff) do { _Pragma("unroll") for (int _i = 0; _i < 2; ++_i) \
        __builtin_amdgcn_global_load_lds((const unsigned*)((const char*)(gbase) + (voff)[_i]), (LAS unsigned*)(lds + (bufoff) + ldsw + _i * 8192), 16, 0, 0); } while (0)
#define PG8_LDA(dst, b, h) do { _Pragma("unroll") for (int m = 0; m < 4; ++m) _Pragma("unroll") for (int k = 0; k < 2; ++k) dst[m][k] = *(const LAS bf16x8*)(lds + PG8_SA(b, h) + aoff + m * 2048 + k * 1024); } while (0)
#define PG8_LDB(dst, b, h) do { _Pragma("unroll") for (int n = 0; n < 2; ++n) _Pragma("unroll") for (int k = 0; k < 2; ++k) dst[n][k] = *(const LAS bf16x8*)(lds + PG8_SB(b, h) + boff + n * 2048 + k * 1024); } while (0)
#define PG8_MMA(ai, bj, At, Bt) do { __builtin_amdgcn_s_setprio(1); _Pragma("unroll") for (int m = 0; m < 4; ++m) _Pragma("unroll") for (int n = 0; n < 2; ++n) _Pragma("unroll") for (int k = 0; k < 2; ++k) \
        acc[ai][bj][m][n] = __builtin_amdgcn_mfma_f32_16x16x32_bf16(Bt[n][k], At[m][k], acc[ai][bj][m][n], 0, 0, 0); __builtin_amdgcn_s_setprio(0); } while (0)
#define PG8_WAIT_V(n) asm volatile("s_waitcnt vmcnt(" #n ")" ::: "memory")
#define PG8_WAIT_L(n) asm volatile("s_waitcnt lgkmcnt(" #n ")" ::: "memory")
#define PG8_BAR __builtin_amdgcn_s_barrier()
#define PG8_SCHED __builtin_amdgcn_sched_barrier(0)
    Unit cur, nxt; int ui = 0;
    if (!S.next(0, cur)) return;
    f32x4 acc[2][2][4][2];
#pragma unroll
    for (int a = 0; a < 2; ++a)
#pragma unroll
        for (int b = 0; b < 2; ++b)
#pragma unroll
            for (int m = 0; m < 4; ++m)
#pragma unroll
                for (int n = 0; n < 2; ++n) acc[a][b][m][n] = (f32x4){0.f, 0.f, 0.f, 0.f};
    bf16x8 At[4][2], B0[2][2], B1[2][2];
    const char* cA = (const char*)g.A + (size_t)cur.pm * tstep + kbase; const char* cB = (const char*)g.Bt + (size_t)cur.pn * tstep + kbase;
    PG8_STAGE(PG8_SB(0, 0), cB, voffB); PG8_STAGE(PG8_SB(0, 1), cB + hstep, voffB); PG8_STAGE(PG8_SA(0, 0), cA, voffA); PG8_STAGE(PG8_SA(0, 1), cA + hstep, voffA);
    if (wr == 1) PG8_BAR;
    PG8_WAIT_V(2); PG8_BAR;
    PG8_STAGE(PG8_SB(1, 0), cB + kstep, voffB); PG8_STAGE(PG8_SA(1, 0), cA + kstep, voffA); PG8_STAGE(PG8_SB(1, 1), cB + hstep + kstep, voffB);
    PG8_WAIT_V(6); PG8_BAR;
    for (;;) {
        const bool has_next = S.next(ui + 1, nxt);
        const char* nA = has_next ? (const char*)g.A + (size_t)nxt.pm * tstep + kbase : cA; const char* nB = has_next ? (const char*)g.Bt + (size_t)nxt.pn * tstep + kbase : cB;
        for (int t = 0; t < nt; t += 2) {
            const bool last = (t == nt - 2);
            const char* a1 = cA + (long)(t + 1) * kstep;
            const char* a2 = last ? nA : cA + (long)(t + 2) * kstep; const char* b2 = last ? nB : cB + (long)(t + 2) * kstep;
            const char* a3 = a2 + kstep; const char* b3 = b2 + kstep;
            if constexpr (Epi::HAS_MID) E.mid(t, acc, cur, wr, wc, fr, fq);
            PG8_LDB(B0, 0, 0); PG8_LDB(B1, 0, 1); PG8_SCHED; PG8_LDA(At, 0, 0); PG8_STAGE(PG8_SA(1, 1), a1 + hstep, voffA);
            PG8_WAIT_V(8); PG8_WAIT_L(0); PG8_BAR; PG8_MMA(0, 0, At, B0); PG8_MMA(0, 1, At, B1); PG8_BAR; PG8_SCHED;
            PG8_LDA(At, 0, 1); PG8_STAGE(PG8_SB(0, 0), b2, voffB); PG8_STAGE(PG8_SB(0, 1), b2 + hstep, voffB); PG8_STAGE(PG8_SA(0, 0), a2, voffA);
            PG8_WAIT_V(8); PG8_WAIT_L(0); PG8_BAR; PG8_MMA(1, 0, At, B0); PG8_MMA(1, 1, At, B1); PG8_BAR; PG8_SCHED;
            PG8_LDB(B0, 1, 0); PG8_LDB(B1, 1, 1); PG8_SCHED; PG8_LDA(At, 1, 0); PG8_STAGE(PG8_SA(0, 1), a2 + hstep, voffA);
            PG8_WAIT_V(8); PG8_WAIT_L(0); PG8_BAR; PG8_MMA(0, 0, At, B0); PG8_MMA(0, 1, At, B1); PG8_BAR; PG8_SCHED;
            PG8_LDA(At, 1, 1); PG8_STAGE(PG8_SB(1, 0), b3, voffB); PG8_STAGE(PG8_SB(1, 1), b3 + hstep, voffB); PG8_STAGE(PG8_SA(1, 0), a3, voffA);
            PG8_WAIT_V(8); PG8_WAIT_L(0); PG8_BAR; PG8_MMA(1, 0, At, B0); PG8_MMA(1, 1, At, B1); PG8_BAR; PG8_SCHED;
        }
        if (wr == 0) PG8_BAR;
#pragma unroll
        for (int a = 0; a < 2; ++a)
#pragma unroll
            for (int b = 0; b < 2; ++b)
#pragma unroll
                for (int m = 0; m < 4; ++m)
#pragma unroll
                    for (int n = 0; n < 2; ++n) asm volatile("" : "+v"(acc[a][b][m][n]));
        E(acc, cur, wr, wc, fr, fq);
        if (!has_next) break;
#pragma unroll
        for (int a = 0; a < 2; ++a)
#pragma unroll
            for (int b = 0; b < 2; ++b)
#pragma unroll
                for (int m = 0; m < 4; ++m)
#pragma unroll
                    for (int n = 0; n < 2; ++n) acc[a][b][m][n] = (f32x4){0.f, 0.f, 0.f, 0.f};
        cur = nxt; cA = nA; cB = nB; ++ui;
        if (wr == 1) PG8_BAR;
    }
    PG8_WAIT_V(0);
    PG8_BAR;
#undef PG8_SA
#undef PG8_SB
#undef PG8_STAGE
#undef PG8_LDA
#undef PG8_LDB
#undef PG8_MMA
#undef PG8_WAIT_V
#undef PG8_WAIT_L
#undef PG8_BAR
#undef PG8_SCHED
}
}

typedef __attribute__((address_space(1))) unsigned gu32;
#define XB_TMO      128
#define XB_XCNT(j)  (256  + 64 * (j))
#define XB_XSUB(j)  (1280 + 64 * (j))
#define XB_XGEN(j)  (2304 + 64 * (j))
#define XB_TOP      3328
#define XB_TOPGEN   3392
#define XCD_BAR_WORDS 3456
#define XB_SPIN_CAP (1u << 18)

__device__ __forceinline__ unsigned xb_ld(unsigned* p)              { return __hip_atomic_load(p, __ATOMIC_RELAXED, __HIP_MEMORY_SCOPE_AGENT); }
__device__ __forceinline__ unsigned xb_add(unsigned* p, unsigned v) { return __hip_atomic_fetch_add(p, v, __ATOMIC_RELAXED, __HIP_MEMORY_SCOPE_AGENT); }
__device__ __forceinline__ unsigned xb_xcc_id() { return (unsigned)__builtin_amdgcn_s_getreg((3 << 11) | 20) & 0xFu; }
#define XB_SPIN(cond, bar) do { unsigned _sp = 0; while (cond) { __builtin_amdgcn_s_sleep(1); \
    if ((++_sp & 255u) == 0u) { if (xb_ld(&(bar)[XB_TMO])) break; if (_sp > XB_SPIN_CAP) { atomicAdd(&(bar)[XB_TMO], 1u); break; } } } } while (0)

struct XcdBarrier {
    unsigned* bar; unsigned x;
    volatile LAS unsigned* st;
};

__device__ __forceinline__ XcdBarrier xcd_barrier_post(unsigned* bar, volatile LAS unsigned* st) {
    XcdBarrier b; b.bar = bar; b.x = xb_xcc_id(); b.st = st;
    if (threadIdx.x == 0) (void)xb_add(&bar[XB_XCNT(b.x)], 1u);
    return b;
}
__device__ __forceinline__ void xcd_barrier_complete(unsigned* bar, unsigned x, unsigned& nloc, unsigned& nx) {
    const unsigned G = gridDim.x * gridDim.y * gridDim.z;
    unsigned sum, cnt, mine, sp = 0u;
    for (;;) {
        sum = 0u; cnt = 0u; mine = 0u;
#pragma unroll
        for (unsigned j = 0; j < 16; ++j) { const unsigned c = xb_ld(&bar[XB_XCNT(j)]); sum += c; cnt += (c > 0u) ? 1u : 0u; mine = (j == x) ? c : mine; }
        if (sum == G) break;
        __builtin_amdgcn_s_sleep(1);
        if ((++sp & 255u) == 0u) { if (xb_ld(&bar[XB_TMO])) break; if (sp > XB_SPIN_CAP) { atomicAdd(&bar[XB_TMO], 1u); break; } }
    }
    nloc = mine > 0u ? mine : 1u; nx = cnt > 0u ? cnt : 1u;
}

__device__ __forceinline__ void xcd_barrier(const XcdBarrier& b) {
    asm volatile("s_waitcnt vmcnt(0)" ::: "memory");
    __syncthreads();
    if (threadIdx.x == 0) {
        unsigned* bar = b.bar;
        __builtin_amdgcn_s_waitcnt(0);
        unsigned nloc = b.st[0], nx = b.st[1];
        if (nloc == 0u) { xcd_barrier_complete(bar, b.x, nloc, nx); b.st[0] = nloc; b.st[1] = nx; }
        const unsigned old = xb_add(&bar[XB_XSUB(b.x)], 1u);
        const unsigned gen = old / nloc;
        if (old + 1u == (gen + 1u) * nloc) {
            __builtin_amdgcn_fence(__ATOMIC_RELEASE, "agent");
            asm volatile("s_waitcnt vmcnt(0)" ::: "memory");
            const unsigned og = xb_add(&bar[XB_TOP], 1u);
            const unsigned tg = og / nx;
            if (og + 1u == (tg + 1u) * nx) xb_add(&bar[XB_TOPGEN], 1u);
            else XB_SPIN(xb_ld(&bar[XB_TOPGEN]) == tg, bar);
            __builtin_amdgcn_fence(__ATOMIC_ACQUIRE, "agent");
            xb_add(&bar[XB_XGEN(b.x)], 1u);
            asm volatile("s_waitcnt vmcnt(0)" ::: "memory");
        } else {
            XB_SPIN(xb_ld(&bar[XB_XGEN(b.x)]) == gen, bar);
            __builtin_amdgcn_fence(__ATOMIC_ACQUIRE, "agent");
            asm volatile("s_waitcnt vmcnt(0)" ::: "memory");
        }
    }
    __syncthreads();
}


__device__ __forceinline__ void panel_barrier(unsigned* cnt, unsigned& epoch) {
    asm volatile("s_waitcnt vmcnt(0)" ::: "memory");
    __syncthreads();
    ++epoch;
    if (threadIdx.x == 0) {
        (void)xb_add(cnt, 1u);
        unsigned sp = 0u;
        while (xb_ld(cnt) < 4u * epoch) { __builtin_amdgcn_s_sleep(1); if (++sp > (1u << 22)) break; }
        __builtin_amdgcn_fence(__ATOMIC_ACQUIRE, "agent");
        asm volatile("s_waitcnt vmcnt(0)" ::: "memory");
    }
    __syncthreads();
}

struct Args { const float* in[22]; float* out; unsigned char* ws; int ph_lo, ph_hi; };

typedef LAS unsigned long long* PTab;
__device__ __forceinline__ const float* ldptr(PTab pt, int k) {
    const unsigned long long v = pt[k];
    const unsigned lo = __builtin_amdgcn_readfirstlane((unsigned)v), hi = __builtin_amdgcn_readfirstlane((unsigned)(v >> 32));
    return (const float*)(__attribute__((address_space(1))) const float*)(((unsigned long long)hi << 32) | lo);
}

__device__ __forceinline__ int conv_row(int n, int mode, int rowoff) {
    if (mode == 0) return rowoff + n;
    if (mode == 3) { const int br = n >> 11, mc = n & 2047, q = mc >> 6, mcl = mc & 63; return rowoff + 256 * q + 128 * (br >> 1) + 32 * (mcl >> 4) + 8 * ((mcl >> 2) & 3) + 4 * (br & 1) + (mcl & 3); }
    return (n >> 7) * 256 + (n & 127) + (mode == 2 ? 128 : 0);
}
__device__ __forceinline__ void conv_mat(const float* W, int ldw, int K, int N, bf16_t* WT, int pitch, int koff, int mode, int rowoff, int gw, int ngw, int lane) {
    const int nblk = N / 64, nitems = (K / 64) * nblk;
    const int c = lane & 15, q = lane >> 4;
    f32x4 v[16];
    if (gw < nitems) { const int kb = gw / nblk, nb = gw - kb * nblk; const float* src = W + (size_t)(64 * kb + 16 * q) * ldw + 64 * nb + 4 * c;
#pragma unroll
        for (int j = 0; j < 16; ++j) v[j] = __builtin_nontemporal_load((const f32x4*)(src + (size_t)j * ldw)); }
    for (int item = gw; item < nitems; item += ngw) {
        const int kb = item / nblk, nb = item - kb * nblk, k0 = 64 * kb, n0 = 64 * nb;
        u32x4 o[8];
#pragma unroll
        for (int i = 0; i < 4; ++i) {
            o[2 * i].x = pk2(v[0][i], v[1][i]); o[2 * i].y = pk2(v[2][i], v[3][i]); o[2 * i].z = pk2(v[4][i], v[5][i]); o[2 * i].w = pk2(v[6][i], v[7][i]);
            o[2 * i + 1].x = pk2(v[8][i], v[9][i]); o[2 * i + 1].y = pk2(v[10][i], v[11][i]); o[2 * i + 1].z = pk2(v[12][i], v[13][i]); o[2 * i + 1].w = pk2(v[14][i], v[15][i]);
        }
        const int nx = item + ngw;
        if (nx < nitems) { const int kb2 = nx / nblk, nb2 = nx - kb2 * nblk; const float* src = W + (size_t)(64 * kb2 + 16 * q) * ldw + 64 * nb2 + 4 * c;
#pragma unroll
            for (int j = 0; j < 16; ++j) v[j] = __builtin_nontemporal_load((const f32x4*)(src + (size_t)j * ldw)); }
        const int rb = conv_row(n0 + 4 * c, mode, rowoff);
#pragma unroll
        for (int i = 0; i < 4; ++i) {
            bf16_t* dst = WT + (size_t)(rb + i) * pitch + koff + k0 + 16 * q;
            *(u32x4*)dst = o[2 * i]; *(u32x4*)(dst + 8) = o[2 * i + 1];
        }
    }
}

__device__ __forceinline__ void convert_phase(PTab pt, int l, LAS unsigned char* lds, int tid, int wave, int lane, int bid, int G) {
    unsigned char* ws = (unsigned char*)ldptr(pt, 23);
    const int gw = bid * 8 + wave, ngw = G * 8;
    for (int s = 0; s < 2; ++s) {
        bf16_t* wgu = (bf16_t*)(ws + WS_WGU + (size_t)s * 44 * MiB);
        conv_mat(ldptr(pt, 4) + (size_t)(l * 2 + s) * D_ * FF_, FF_, D_, FF_, wgu, D_, 0, 1, 0, gw, ngw, lane);
        conv_mat(ldptr(pt, 5) + (size_t)(l * 2 + s) * D_ * FF_, FF_, D_, FF_, wgu, D_, 0, 2, 0, gw, ngw, lane);
        conv_mat(ldptr(pt, 6) + (size_t)(l * 2 + s) * D_ * FF_, D_, FF_, D_, (bf16_t*)(ws + WS_WD + (size_t)s * 22 * MiB), FF_, 0, 0, 0, gw, ngw, lane);
    }
    conv_mat(ldptr(pt, 7) + (size_t)l * D_ * NIN_, NIN_, D_, NZ_, (bf16_t*)(ws + WS_WIN), D_, 0, 0, 0, gw, ngw, lane);
    conv_mat(ldptr(pt, 7) + (size_t)l * D_ * NIN_ + NZ_, NIN_, D_, NGT_, (bf16_t*)(ws + WS_WIN), D_, 0, 3, NZ_, gw, ngw, lane);
    conv_mat(ldptr(pt, 15) + (size_t)l * 512 * D_, D_, 512, D_, (bf16_t*)(ws + WS_WBR), NO_, 0, 0, 0, gw, ngw, lane);
    conv_mat(ldptr(pt, 16) + (size_t)l * 512 * D_, D_, 512, D_, (bf16_t*)(ws + WS_WBR), NO_, 512, 0, 0, gw, ngw, lane);
    conv_mat(ldptr(pt, 17) + (size_t)l * 512 * D_, D_, 512, D_, (bf16_t*)(ws + WS_WBR), NO_, 1024, 0, 0, gw, ngw, lane);
    conv_mat(ldptr(pt, 18) + (size_t)l * 256 * D_, D_, 256, D_, (bf16_t*)(ws + WS_WBR), NO_, 1536, 0, 0, gw, ngw, lane);
    conv_mat(ldptr(pt, 19) + (size_t)l * D_ * D_, D_, D_, D_, (bf16_t*)(ws + WS_WOUT), D_, 0, 0, 0, gw, ngw, lane);
    conv_mat(ldptr(pt, 20) + (size_t)l * PLE_ * D_, D_, PLE_, D_, (bf16_t*)(ws + WS_WPP), PLE_, 0, 0, 0, gw, ngw, lane);
    conv_mat(ldptr(pt, 21) + (size_t)l * D_ * D_, D_, D_, D_, (bf16_t*)(ws + WS_WPG), D_, 0, 0, 0, gw, ngw, lane);
    if (l == 0) {
        const size_t gt = (size_t)bid * 512 + tid, nth = (size_t)G * 512;
        const f32x4* x4 = (const f32x4*)ldptr(pt, 0); u32x2* xb = (u32x2*)(ws + WS_XB);
        for (size_t i = gt; i < (size_t)T_ * D_ / 4; i += nth) { const f32x4 v = x4[i]; u32x2 w; w.x = pk2(v[0], v[1]); w.y = pk2(v[2], v[3]); xb[i] = w; }
        const f32x4* p4 = (const f32x4*)ldptr(pt, 1); u32x2* pb = (u32x2*)(ws + WS_PB);
        for (size_t i = gt; i < (size_t)2 * T_ * PLE_ / 4; i += nth) { const f32x4 v = p4[i]; u32x2 w; w.x = pk2(v[0], v[1]); w.y = pk2(v[2], v[3]); pb[i] = w; }
    }
}

__device__ __forceinline__ void ln_phase(float* X, bf16_t* XB, const float* g, const float* b, bool final_, int first, int rstep, int bstep, int nb, int lane) {
    const int ngw = rstep;
    for (int bi = 0, row0 = first; bi < nb; ++bi, row0 += bstep) {
        f32x4 v[4][8];
#pragma unroll
        for (int r = 0; r < 4; ++r) { const int row = min(row0 + r * ngw, T_ - 1); const f32x4* xr = (const f32x4*)(X + (size_t)row * D_) + lane;
#pragma unroll
            for (int j = 0; j < 8; ++j) v[r][j] = xr[64 * j]; }
        float mean[4], rstd[4];
#pragma unroll
        for (int r = 0; r < 4; ++r) { float s = 0.f;
#pragma unroll
            for (int j = 0; j < 8; ++j) s += (v[r][j][0] + v[r][j][1]) + (v[r][j][2] + v[r][j][3]);
            mean[r] = s; }
#pragma unroll
        for (int o = 1; o < 64; o <<= 1) {
#pragma unroll
            for (int r = 0; r < 4; ++r) mean[r] += __shfl_xor(mean[r], o); }
#pragma unroll
        for (int r = 0; r < 4; ++r) { mean[r] *= (1.f / D_); float s2 = 0.f;
#pragma unroll
            for (int j = 0; j < 8; ++j) { v[r][j] = v[r][j] - mean[r]; s2 += (v[r][j][0] * v[r][j][0] + v[r][j][1] * v[r][j][1]) + (v[r][j][2] * v[r][j][2] + v[r][j][3] * v[r][j][3]); }
            rstd[r] = s2; }
#pragma unroll
        for (int o = 1; o < 64; o <<= 1) {
#pragma unroll
            for (int r = 0; r < 4; ++r) rstd[r] += __shfl_xor(rstd[r], o); }
#pragma unroll
        for (int r = 0; r < 4; ++r) rstd[r] = 1.f / sqrtf(rstd[r] * (1.f / D_) + LN_EPS);
#pragma unroll
        for (int j = 0; j < 8; ++j) {
            const f32x4 gg = ((const f32x4*)g)[lane + 64 * j], bb = ((const f32x4*)b)[lane + 64 * j];
#pragma unroll
            for (int r = 0; r < 4; ++r) { const int row = row0 + r * ngw;
                if (row < T_) { const f32x4 y = v[r][j] * rstd[r] * gg + bb;
                    if (final_) ((f32x4*)(X + (size_t)row * D_))[lane + 64 * j] = y;
                    else { u32x2 w; w.x = pk2(y[0], y[1]); w.y = pk2(y[2], y[3]); ((u32x2*)(XB + (size_t)row * D_))[lane + 64 * j] = w; } } }
        }
    }
}

__device__ __forceinline__ void attn_unit(LAS unsigned char* L, const bf16_t* Z, int unit, const float* sinks, bf16_t* O, float* DPO, float* DLSE, int tid, int wave, int lane) {
    int qcol, kcol, vcol, base, blk, dil, max_dist, grp = 0, hh = 0; float slope_u, sink = 0.f; bool isA;
    if (unit < 1024) {
        isA = true; blk = unit & 31; const int head = (unit >> 5) & 7, b = unit >> 8, kvh = head >> 2;
        qcol = ZQA + head * 64; kcol = ZKA + kvh * 64; vcol = ZVA + kvh * 64; base = b * SEQ_; dil = 1; max_dist = 127;
        slope_u = __builtin_amdgcn_exp2f(-8.0f * (float)(head + 1) / 20.0f); sink = sinks[head]; hh = head;
    } else {
        isA = false; const int u2 = unit - 1024; grp = u2 >> 9; const int u3 = u2 & 511;
        dil = (grp == 0) ? 1 : (grp == 1 ? 4 : 16); const int nbk = 32 / dil;
        blk = u3 % nbk; const int r = (u3 / nbk) % dil; hh = (u3 / 32) & 3; const int b = u3 >> 7;
        qcol = ZQD + grp * 256 + hh * 64; kcol = ZKD + grp * 256 + hh * 64; vcol = ZVD + grp * 256 + hh * 64; base = b * SEQ_ + r; max_dist = 128;
        slope_u = __builtin_amdgcn_exp2f(-8.0f * (float)(8 + 4 * grp + hh + 1) / 20.0f) * (float)dil;
    }
    LAS bf16_t* Qs = (LAS bf16_t*)L;
    LAS bf16_t* Ks = Qs + 128 * 72;
    LAS bf16_t* Vs = Ks + 272 * 72;
    for (int i = tid; i < 1024; i += 512) { const int r = i >> 3, c = i & 7; const size_t tok = (size_t)(base + (blk * 128 + r) * dil);
        *(LAS u32x4*)(Qs + r * 72 + c * 8) = *(const u32x4*)(Z + tok * NZ_ + qcol + c * 8); }
    {
        u32x4 kv[5], vv[5];
#pragma unroll
        for (int it = 0; it < 5; ++it) { const int i = tid + it * 512; const int r = i >> 3, c = i & 7; const int sub = blk * 128 - 128 + r; const bool ok = (i < 2176) && (r < 256) && (sub >= 0);
            kv[it] = (u32x4){0u, 0u, 0u, 0u}; vv[it] = (u32x4){0u, 0u, 0u, 0u};
            if (ok) { const size_t tok = (size_t)(base + sub * dil); kv[it] = *(const u32x4*)(Z + tok * NZ_ + kcol + c * 8); vv[it] = *(const u32x4*)(Z + tok * NZ_ + vcol + c * 8); } }
#pragma unroll
        for (int it = 0; it < 5; ++it) { const int i = tid + it * 512; const int r = i >> 3, c = i & 7;
            if (i < 2176) {
                *(LAS u32x4*)(Ks + r * 72 + c * 8) = kv[it];
                *(LAS u32x4*)(Vs + r * 72 + c * 8) = vv[it]; } }
    }
    __syncthreads();
    const int q0 = wave * 16, qi = lane & 15, g = lane >> 4;
    bf16x8 bq[2];
#pragma unroll
    for (int ks = 0; ks < 2; ++ks) bq[ks] = *(const LAS bf16x8*)(Qs + (q0 + qi) * 72 + ks * 32 + g * 8);
    f32x4 st[10];
#pragma unroll
    for (int i = 0; i < 10; ++i) { f32x4 acc = {0.f, 0.f, 0.f, 0.f};
#pragma unroll
        for (int ks = 0; ks < 2; ++ks) { const bf16x8 ak = *(const LAS bf16x8*)(Ks + ((wave + i) * 16 + qi) * 72 + ks * 32 + g * 8); acc = mfma16(ak, bq[ks], acc); }
        st[i] = acc; }
    float mx = -3.0e38f;
    const int q = q0 + qi;
#pragma unroll
    for (int i = 0; i < 10; ++i)
#pragma unroll
        for (int j = 0; j < 4; ++j) { const int kk = (wave + i) * 16 + 4 * g + j; const int dist = q + 128 - kk;
            const bool valid = (dist >= 0) && (dist <= max_dist) && (blk > 0 || kk >= 128);
            const float s = valid ? (st[i][j] * 0.125f - slope_u * (float)dist) : -1.0e30f; st[i][j] = s; mx = fmaxf(mx, s); }
    mx = fmaxf(mx, __shfl_xor(mx, 16)); mx = fmaxf(mx, __shfl_xor(mx, 32));
    if (isA) mx = fmaxf(mx, sink);
    float den = 0.f;
#pragma unroll
    for (int i = 0; i < 10; ++i)
#pragma unroll
        for (int j = 0; j < 4; ++j) { const float p = __builtin_amdgcn_exp2f((st[i][j] - mx) * LOG2E); st[i][j] = p; den += p; }
    den += __shfl_xor(den, 16); den += __shfl_xor(den, 32);
    if (isA) den += __builtin_amdgcn_exp2f((sink - mx) * LOG2E);
    f32x4 o[4];
#pragma unroll
    for (int ht = 0; ht < 4; ++ht) o[ht] = (f32x4){0.f, 0.f, 0.f, 0.f};
    const LAS bf16_t* vbase = Vs + (wave * 16 + 4 * g + (qi >> 2)) * 72 + 4 * (qi & 3);
#pragma unroll
    for (int i = 0; i < 5; ++i) {
        u32x4 pw; pw.x = pk2(st[2 * i][0], st[2 * i][1]); pw.y = pk2(st[2 * i][2], st[2 * i][3]); pw.z = pk2(st[2 * i + 1][0], st[2 * i + 1][1]); pw.w = pk2(st[2 * i + 1][2], st[2 * i + 1][3]);
        const bf16x8 bp = __builtin_bit_cast(bf16x8, pw);
#pragma unroll
        for (int ht = 0; ht < 4; ++ht) { const LAS bf16_t* vr = vbase + (2 * i * 16) * 72 + ht * 16;
            const u32x2 va = tr16(vr), vb = tr16(vr + 16 * 72);
            o[ht] = mfma16(mk8(va, vb), bp, o[ht]); } }
    const float inv = 1.0f / den;
    const size_t tok = (size_t)(base + (blk * 128 + q) * dil);
    if (isA) {
#pragma unroll
        for (int ht = 0; ht < 4; ++ht) { u32x2 w; w.x = pk2(o[ht][0] * inv, o[ht][1] * inv); w.y = pk2(o[ht][2] * inv, o[ht][3] * inv);
            *(u32x2*)(O + tok * NO_ + hh * 64 + ht * 16 + 4 * g) = w; }
    } else {
#pragma unroll
        for (int ht = 0; ht < 4; ++ht) *(f32x4*)(DPO + ((size_t)grp * T_ + tok) * 256 + hh * 64 + ht * 16 + 4 * g) = o[ht] * inv;
        if (g == 0) DLSE[((size_t)grp * T_ + tok) * 4 + hh] = mx + logf(den);
    }
    __syncthreads();
}

__device__ __forceinline__ void gmlp_unit(LAS unsigned char* L, const bf16_t* Z, int unit, const float* lng, const float* lnb, const float* ws_, const float* bs, bf16_t* O, int tid, int wave, int lane) {
    const int n = unit >> 2, grp = unit & 3, tok0 = n * 128;
    LAS float* stats = (LAS float*)L;
    LAS bf16_t* vnt = (LAS bf16_t*)(L + 1024);
    LAS bf16_t* Wc = vnt + 128 * 136;
    {
        u32x4 raw[16];
#pragma unroll
        for (int r = 0; r < 16; ++r) raw[r] = *(const u32x4*)(Z + (size_t)(tok0 + 16 * wave + r) * NZ_ + ZVB + lane * 8);
        float s[16], ss[16];
#pragma unroll
        for (int r = 0; r < 16; ++r) { const float x0 = bflo(raw[r].x), x1 = bfhi(raw[r].x), x2 = bflo(raw[r].y), x3 = bfhi(raw[r].y), x4 = bflo(raw[r].z), x5 = bfhi(raw[r].z), x6 = bflo(raw[r].w), x7 = bfhi(raw[r].w);
            s[r] = ((x0 + x1) + (x2 + x3)) + ((x4 + x5) + (x6 + x7)); ss[r] = ((x0 * x0 + x1 * x1) + (x2 * x2 + x3 * x3)) + ((x4 * x4 + x5 * x5) + (x6 * x6 + x7 * x7)); }
#pragma unroll
        for (int o = 1; o < 64; o <<= 1) {
#pragma unroll
            for (int r = 0; r < 16; ++r) { s[r] += __shfl_xor(s[r], o); ss[r] += __shfl_xor(ss[r], o); } }
        if (lane < 16) { float m = 0.f, q = 0.f;
#pragma unroll
            for (int r = 0; r < 16; ++r) if (lane == r) { m = s[r]; q = ss[r]; }
            m *= (1.f / 512.f); const float var = fmaxf(q * (1.f / 512.f) - m * m, 0.f);
            stats[(16 * wave + lane) * 2] = m; stats[(16 * wave + lane) * 2 + 1] = 1.f / sqrtf(var + LN_EPS); }
    }
#pragma unroll
    for (int it = 0; it < 8; ++it) { const int i = tid + it * 512; const int t = i >> 5, s4 = (i & 31) * 4;
        f32x4 w = *(const f32x4*)(ws_ + (size_t)(grp * 128 + t) * 128 + s4);
#pragma unroll
        for (int e = 0; e < 4; ++e) if (s4 + e > t) w[e] = 0.f;
        u32x2 p; p.x = pk2(w[0], w[1]); p.y = pk2(w[2], w[3]); *(LAS u32x2*)(Wc + t * 136 + s4) = p; }
    u32x4 vraw[4];
#pragma unroll
    for (int it = 0; it < 4; ++it) { const int i = tid + it * 512; const int s = i >> 4, c8 = (i & 15) * 8;
        vraw[it] = *(const u32x4*)(Z + (size_t)(tok0 + s) * NZ_ + ZVB + grp * 128 + c8); }
    __syncthreads();
#pragma unroll
    for (int it = 0; it < 4; ++it) { const int i = tid + it * 512; const int s = i >> 4, c8 = (i & 15) * 8;
        const u32x4 raw = vraw[it];
        const float mean = stats[s * 2], rstd = stats[s * 2 + 1];
        float x[8]; x[0] = bflo(raw.x); x[1] = bfhi(raw.x); x[2] = bflo(raw.y); x[3] = bfhi(raw.y); x[4] = bflo(raw.z); x[5] = bfhi(raw.z); x[6] = bflo(raw.w); x[7] = bfhi(raw.w);
        const f32x4 g0 = *(const f32x4*)(lng + grp * 128 + c8), g1 = *(const f32x4*)(lng + grp * 128 + c8 + 4), b0 = *(const f32x4*)(lnb + grp * 128 + c8), b1 = *(const f32x4*)(lnb + grp * 128 + c8 + 4);
        float y[8];
#pragma unroll
        for (int e = 0; e < 8; ++e) y[e] = (x[e] - mean) * rstd * (e < 4 ? g0[e & 3] : g1[e & 3]) + (e < 4 ? b0[e & 3] : b1[e & 3]);
        u32x4 w; w.x = pk2(y[0], y[1]); w.y = pk2(y[2], y[3]); w.z = pk2(y[4], y[5]); w.w = pk2(y[6], y[7]);
        *(LAS u32x4*)(vnt + s * 136 + c8) = w; }
    __syncthreads();
    const int qi = lane & 15, g = lane >> 4;
    const int t = 16 * wave + qi; const float bias = bs[grp * 128 + t];
    const size_t tok = (size_t)(tok0 + t);
    u32x2 ur[8];
#pragma unroll
    for (int ct = 0; ct < 8; ++ct) ur[ct] = *(const u32x2*)(Z + tok * NZ_ + ZUB + grp * 128 + 16 * ct + 4 * g);
    f32x4 acc[8];
#pragma unroll
    for (int ct = 0; ct < 8; ++ct) acc[ct] = (f32x4){0.f, 0.f, 0.f, 0.f};
#pragma unroll
    for (int ks = 0; ks < 4; ++ks) { const bf16x8 bw = *(const LAS bf16x8*)(Wc + (16 * wave + qi) * 136 + ks * 32 + g * 8);
#pragma unroll
        for (int ct = 0; ct < 8; ++ct) { const LAS bf16_t* vr = vnt + (ks * 32 + 8 * g + (qi >> 2)) * 136 + 16 * ct + 4 * (qi & 3);
            acc[ct] = mfma16(mk8(tr16(vr), tr16(vr + 4 * 136)), bw, acc[ct]); } }
#pragma unroll
    for (int ct = 0; ct < 8; ++ct) { const int c = 16 * ct + 4 * g;
        u32x2 w; w.x = pk2(bflo(ur[ct].x) * (acc[ct][0] + bias), bfhi(ur[ct].x) * (acc[ct][1] + bias));
        w.y = pk2(bflo(ur[ct].y) * (acc[ct][2] + bias), bfhi(ur[ct].y) * (acc[ct][3] + bias));
        *(u32x2*)(O + tok * NO_ + 512 + grp * 128 + c) = w; }
    __syncthreads();
}

__device__ __forceinline__ float hgrn_lb(const float* lbl, int layer, int c) { return layer == 0 ? 0.0f : 1.0f / (1.0f + expf(lbl[c] - lbl[512 + c])); }

__device__ __forceinline__ void hgrn_c1_unit(LAS unsigned char* L, const bf16_t* Z, int unit, const float* lbl, int layer, float* DS, float* DEC, int tid, int wave, int lane) {
    const int h = unit & 3, cg_ = unit >> 2, tok0 = cg_ * 64;
    const int k = tid & 127, qtr = tid >> 7;
    LAS float* qsum = (LAS float*)L;
    LAS bf16_t* kt = (LAS bf16_t*)(L + 2048);
    LAS bf16_t* vt = kt + 128 * 72;
    const float lb = hgrn_lb(lbl, layer, h * 128 + k);
    float G[16], kk[16]; float run = 0.f;
    unsigned vraw[16];
#pragma unroll
    for (int i = 0; i < 16; ++i) { const size_t tok = (size_t)(tok0 + 16 * qtr + i);
        const float zf = bf2f(Z[tok * NZ_ + ZFC + h * 128 + k]);
        vraw[i] = Z[tok * NZ_ + ZIC + h * 128 + k];
        const float e = fexp(-zf), sg = frcp(1.0f + e);
        const float f = lb + (1.0f - lb) * sg;
        run += logf(fmaxf(f, 1e-6f)); G[i] = run; kk[i] = (1.0f - lb) * e * sg; }
    qsum[qtr * 128 + k] = run;
    __syncthreads();
    float off = 0.f, tot = 0.f;
#pragma unroll
    for (int qq = 0; qq < 4; ++qq) { const float v = qsum[qq * 128 + k]; tot += v; if (qq < qtr) off += v; }
    unsigned kw[8], vw[8];
#pragma unroll
    for (int i = 0; i < 8; ++i) { const float a0 = kk[2 * i] * fexp(tot - (G[2 * i] + off)), a1 = kk[2 * i + 1] * fexp(tot - (G[2 * i + 1] + off));
        kw[i] = pk2(a0, a1); vw[i] = vraw[2 * i] | (vraw[2 * i + 1] << 16); }
    *(LAS u32x4*)(kt + k * 72 + 16 * qtr) = (u32x4){kw[0], kw[1], kw[2], kw[3]}; *(LAS u32x4*)(kt + k * 72 + 16 * qtr + 8) = (u32x4){kw[4], kw[5], kw[6], kw[7]};
    *(LAS u32x4*)(vt + k * 72 + 16 * qtr) = (u32x4){vw[0], vw[1], vw[2], vw[3]}; *(LAS u32x4*)(vt + k * 72 + 16 * qtr + 8) = (u32x4){vw[4], vw[5], vw[6], vw[7]};
    if (qtr == 0) DEC[(size_t)unit * 128 + k] = fexp(tot);
    __syncthreads();
    const int qi = lane & 15, g = lane >> 4;
    bf16x8 av[2];
#pragma unroll
    for (int ks = 0; ks < 2; ++ks) av[ks] = *(const LAS bf16x8*)(vt + (16 * wave + qi) * 72 + ks * 32 + g * 8);
    float* dst = DS + (size_t)unit * 16384;
#pragma unroll
    for (int ktile = 0; ktile < 8; ++ktile) { f32x4 acc = {0.f, 0.f, 0.f, 0.f};
#pragma unroll
        for (int ks = 0; ks < 2; ++ks) { const bf16x8 bk = *(const LAS bf16x8*)(kt + (16 * ktile + qi) * 72 + ks * 32 + g * 8); acc = mfma16(av[ks], bk, acc); }
#pragma unroll
        for (int j = 0; j < 4; ++j) dst[(16 * wave + 4 * g + j) * 128 + 16 * ktile + qi] = acc[j]; }
    __syncthreads();
}

__device__ __forceinline__ void hgrn_scan_phase(const float* DS, const float* DEC, bf16_t* HS, int tid, int bid, int G) {
    const int nth = G * 512;
    for (int p = bid * 512 + tid; p < 16 * 8192; p += nth) {
        const int bh = p >> 13, idx = (p & 8191) * 2, k = idx & 127, b = bh >> 2, h = bh & 3;
        f32x2 S = {0.f, 0.f};
#pragma unroll 16
        for (int c = 0; c < 64; ++c) { const size_t u = (size_t)(((b * 64 + c) << 2) | h);
            *(unsigned*)(HS + u * 16384 + idx) = pk2(S[0], S[1]);
            const f32x2 d = *(const f32x2*)(DEC + u * 128 + k), ds = *(const f32x2*)(DS + u * 16384 + idx);
            S = d * S + ds; }
    }
}

__device__ __forceinline__ void hgrn_c3_unit(LAS unsigned char* L, const bf16_t* Z, int unit, const float* lbl, int layer, const bf16_t* HS, const float* ng, bf16_t* O, int tid, int wave, int lane) {
    const int h = unit & 3, cg_ = unit >> 2, tok0 = cg_ * 64;
    const int k = tid & 127, qtr = tid >> 7;
    LAS float* qsum = (LAS float*)L;
    LAS bf16_t* kT = (LAS bf16_t*)(L + 2048);
    LAS bf16_t* qT = kT + 128 * 72;
    LAS bf16_t* qC = qT + 128 * 72;
    LAS bf16_t* vt = qC + 128 * 72;
    LAS float* oL = (LAS float*)(L + 2048 + 4 * 128 * 72 * 2);
    const float lb = hgrn_lb(lbl, layer, h * 128 + k);
    float G[16], kk[16], qv[16]; float run = 0.f;
    unsigned vraw[16];
#pragma unroll
    for (int i = 0; i < 16; ++i) { const size_t tok = (size_t)(tok0 + 16 * qtr + i);
        const float zf = bf2f(Z[tok * NZ_ + ZFC + h * 128 + k]);
        qv[i] = bf2f(Z[tok * NZ_ + ZQC + h * 128 + k]);
        vraw[i] = Z[tok * NZ_ + ZIC + h * 128 + k];
        const float e = fexp(-zf), sg = frcp(1.0f + e);
        const float f = lb + (1.0f - lb) * sg;
        run += logf(fmaxf(f, 1e-6f)); G[i] = run; kk[i] = (1.0f - lb) * e * sg; }
    qsum[qtr * 128 + k] = run;
    __syncthreads();
    float off = 0.f;
#pragma unroll
    for (int qq = 0; qq < 4; ++qq) { const float v = qsum[qq * 128 + k]; if (qq < qtr) off += v; }
    const float Gm = qsum[k] + qsum[128 + k];
    {
        unsigned kw[8], qw[8], cw[8];
#pragma unroll
        for (int i = 0; i < 8; ++i) { float a[2], b[2], c[2];
#pragma unroll
            for (int e = 0; e < 2; ++e) { const float Gi = G[2 * i + e] + off; const float d = fminf(fmaxf(Gi - Gm, -80.f), 80.f);
                a[e] = kk[2 * i + e] * fexp(-d); b[e] = qv[2 * i + e] * fexp(d); c[e] = qv[2 * i + e] * fexp(Gi); }
            kw[i] = pk2(a[0], a[1]); qw[i] = pk2(b[0], b[1]); cw[i] = pk2(c[0], c[1]); }
        *(LAS u32x4*)(kT + k * 72 + 16 * qtr) = (u32x4){kw[0], kw[1], kw[2], kw[3]}; *(LAS u32x4*)(kT + k * 72 + 16 * qtr + 8) = (u32x4){kw[4], kw[5], kw[6], kw[7]};
        *(LAS u32x4*)(qT + k * 72 + 16 * qtr) = (u32x4){qw[0], qw[1], qw[2], qw[3]}; *(LAS u32x4*)(qT + k * 72 + 16 * qtr + 8) = (u32x4){qw[4], qw[5], qw[6], qw[7]};
        *(LAS u32x4*)(qC + k * 72 + 16 * qtr) = (u32x4){cw[0], cw[1], cw[2], cw[3]}; *(LAS u32x4*)(qC + k * 72 + 16 * qtr + 8) = (u32x4){cw[4], cw[5], cw[6], cw[7]};
    }
    {
        unsigned vw[8];
#pragma unroll
        for (int i = 0; i < 8; ++i) vw[i] = vraw[2 * i] | (vraw[2 * i + 1] << 16);
        *(LAS u32x4*)(vt + k * 72 + 16 * qtr) = (u32x4){vw[0], vw[1], vw[2], vw[3]}; *(LAS u32x4*)(vt + k * 72 + 16 * qtr + 8) = (u32x4){vw[4], vw[5], vw[6], vw[7]};
    }
    __syncthreads();
    const int qi = lane & 15, g = lane >> 4, tt = wave & 3, vh = wave >> 2;
    const bf16_t* hs = HS + (size_t)unit * 16384;
    bf16x8 ahs[4][4];
#pragma unroll
    for (int ks = 0; ks < 4; ++ks)
#pragma unroll
        for (int v_ = 0; v_ < 4; ++v_) ahs[ks][v_] = *(const bf16x8*)(hs + (16 * (4 * vh + v_) + qi) * 128 + ks * 32 + g * 8);
    unsigned graw[8][2];
#pragma unroll
    for (int r = 0; r < 8; ++r) { const size_t tok = (size_t)(tok0 + 8 * wave + r); graw[r][0] = Z[tok * NZ_ + ZGC + h * 128 + lane]; graw[r][1] = Z[tok * NZ_ + ZGC + h * 128 + 64 + lane]; }
    f32x4 sc[4];
#pragma unroll
    for (int st = 0; st < 4; ++st) { sc[st] = (f32x4){0.f, 0.f, 0.f, 0.f};
        if (st <= tt) {
#pragma unroll
            for (int ks = 0; ks < 4; ++ks) { const int ro = (ks * 32 + 8 * g + (qi >> 2)) * 72 + 4 * (qi & 3);
                const bf16x8 a = mk8(tr16(kT + ro + 16 * st), tr16(kT + ro + 4 * 72 + 16 * st)), b = mk8(tr16(qT + ro + 16 * tt), tr16(qT + ro + 4 * 72 + 16 * tt));
                sc[st] = mfma16(a, b, sc[st]); }
#pragma unroll
            for (int j = 0; j < 4; ++j) if (16 * st + 4 * g + j > 16 * tt + qi) sc[st][j] = 0.f;
        } }
    f32x4 o[4];
#pragma unroll
    for (int v_ = 0; v_ < 4; ++v_) o[v_] = (f32x4){0.f, 0.f, 0.f, 0.f};
#pragma unroll
    for (int i = 0; i < 2; ++i) {
        u32x4 pw; pw.x = pk2(sc[2 * i][0], sc[2 * i][1]); pw.y = pk2(sc[2 * i][2], sc[2 * i][3]); pw.z = pk2(sc[2 * i + 1][0], sc[2 * i + 1][1]); pw.w = pk2(sc[2 * i + 1][2], sc[2 * i + 1][3]);
        const bf16x8 bp = __builtin_bit_cast(bf16x8, pw);
#pragma unroll
        for (int v_ = 0; v_ < 4; ++v_) { const LAS bf16_t* vr = vt + (16 * (4 * vh + v_) + qi) * 72 + 4 * g;
            const u32x2 va = *(const LAS u32x2*)(vr + (2 * i) * 16), vb = *(const LAS u32x2*)(vr + (2 * i + 1) * 16);
            o[v_] = mfma16(mk8(va, vb), bp, o[v_]); } }
#pragma unroll
    for (int ks = 0; ks < 4; ++ks) { const int ro = (ks * 32 + 8 * g + (qi >> 2)) * 72 + 4 * (qi & 3) + 16 * tt; const bf16x8 b = mk8(tr16(qC + ro), tr16(qC + ro + 4 * 72));
#pragma unroll
        for (int v_ = 0; v_ < 4; ++v_) o[v_] = mfma16(ahs[ks][v_], b, o[v_]); }
#pragma unroll
    for (int v_ = 0; v_ < 4; ++v_) *(LAS f32x4*)(oL + (16 * tt + qi) * 132 + 16 * (4 * vh + v_) + 4 * g) = o[v_];
    __syncthreads();
    const float ng0 = ng[h * 128 + lane], ng1 = ng[h * 128 + 64 + lane];
#pragma unroll
    for (int r = 0; r < 8; ++r) { const int t = 8 * wave + r;
        const float x0 = oL[t * 132 + lane], x1 = oL[t * 132 + 64 + lane];
        const float ss = wave_sum(x0 * x0 + x1 * x1);
        const float rs = 1.0f / sqrtf(ss * (1.f / 128.f) + LN_EPS);
        const size_t tok = (size_t)(tok0 + t);
        const float g0 = bf2f(graw[r][0]), g1 = bf2f(graw[r][1]);
        const float y0 = x0 * rs * ng0 * fsigmoid(g0), y1 = x1 * rs * ng1 * fsigmoid(g1);
        O[tok * NO_ + 1024 + h * 128 + lane] = (bf16_t)(pk2(y0, 0.f) & 0xffffu);
        O[tok * NO_ + 1024 + h * 128 + 64 + lane] = (bf16_t)(pk2(y1, 0.f) & 0xffffu); }
    __syncthreads();
}

__device__ __forceinline__ void dcomb_phase(const float* DPO, const float* DLSE, bf16_t* O, int tid, int bid, int G) {
    const int nth = G * 512;
#pragma unroll 4
    for (int i = bid * 512 + tid; i < T_ * 64; i += nth) { const int t = i >> 6, c4 = (i & 63) * 4, h = c4 >> 6;
        const float l0 = DLSE[((size_t)0 * T_ + t) * 4 + h], l1 = DLSE[((size_t)1 * T_ + t) * 4 + h], l2 = DLSE[((size_t)2 * T_ + t) * 4 + h];
        const float m = fmaxf(l0, fmaxf(l1, l2));
        float w0 = fexp(l0 - m), w1 = fexp(l1 - m), w2 = fexp(l2 - m); const float inv = 1.0f / (w0 + w1 + w2); w0 *= inv; w1 *= inv; w2 *= inv;
        const f32x4 a = *(const f32x4*)(DPO + ((size_t)0 * T_ + t) * 256 + c4), b = *(const f32x4*)(DPO + ((size_t)1 * T_ + t) * 256 + c4), c = *(const f32x4*)(DPO + ((size_t)2 * T_ + t) * 256 + c4);
        const f32x4 r = w0 * a + w1 * b + w2 * c;
        u32x2 w; w.x = pk2(r[0], r[1]); w.y = pk2(r[2], r[3]);
        *(u32x2*)(O + (size_t)t * NO_ + 1536 + c4) = w; }
}

constexpr int NPH_LAYER = 14, NPH = 2 * NPH_LAYER;
__global__ void __launch_bounds__(512, 2) hybrid_fwd(Args a) {
    extern __shared__ __attribute__((aligned(16))) unsigned char lds_raw[];
    LAS unsigned char* lds = (LAS unsigned char*)lds_raw;
    PTab pt = (PTab)(lds + 131072);
    if (threadIdx.x == 0) {
#pragma unroll
        for (int i = 0; i < 22; ++i) pt[i] = (unsigned long long)a.in[i];
        pt[22] = (unsigned long long)a.out; pt[23] = (unsigned long long)a.ws;
    }
    if (threadIdx.x < 8) ((LAS unsigned*)(lds + 131072 + 512))[threadIdx.x] = 0u;
    __syncthreads();
    const int ph_lo = a.ph_lo, ph_hi = a.ph_hi;
    unsigned pepoch = 0u; bool fast = false;
    if (threadIdx.x == 0 && blockIdx.x < 8) __hip_atomic_store((unsigned*)(a.ws + WS_CTL + WS_BAR + 15400) + blockIdx.x, xb_xcc_id(), __ATOMIC_RELAXED, __HIP_MEMORY_SCOPE_AGENT);
    XcdBarrier bar = xcd_barrier_post((unsigned*)(a.ws + WS_CTL + WS_BAR), (volatile LAS unsigned*)(lds + 131072 + 512));
    for (int ph = ph_lo; ph < ph_hi; ++ph) {
        const int l = ph / NPH_LAYER, p = ph - l * NPH_LAYER;
        pg8::StaticOrder S;
        int tid = threadIdx.x; asm volatile("" : "+v"(tid));
        int bid = blockIdx.x, G = gridDim.x; asm volatile("" : "+s"(bid), "+s"(G));
        const int lane = tid & 63, wave = __builtin_amdgcn_readfirstlane(tid >> 6);
        unsigned char* ws = (unsigned char*)ldptr(pt, 23);
#define P_X ((float*)ldptr(pt, 22))
#define P_XB ((bf16_t*)(ws + WS_XB))
#define P_ZH ((bf16_t*)(ws + WS_ZH))
#define P_GATE ((bf16_t*)(ws + WS_GATE))
#define P_O ((bf16_t*)(ws + WS_O))
#define P_DS ((float*)(ws + WS_DS))
#define P_DEC ((float*)(ws + WS_CTL))
#define P_HS ((bf16_t*)(ws + WS_HS))
#define P_DPO ((float*)(ws + WS_DPO))
#define P_DLSE ((float*)(ws + WS_DLSE))
        switch (p) {
        case 0: if (l == 0) convert_phase(pt, 0, lds, tid, wave, lane, bid, G); break;
        case 1: case 11: {
            const int s = (p == 1) ? 0 : 1; const int n_ = (p == 1) ? 2 * FF_ : 2 * FF_ + D_;
            pg8::Gemm g{P_XB, (const bf16_t*)(ws + WS_WGU + (size_t)s * 44 * MiB), T_, n_, D_}; S.init(T_, n_, G, bid);
            pg8::EpiSwiGLU E{p == 1 ? P_O : P_ZH, P_GATE}; pg8::gemm_phase(lds, g, S, E);
        } break;
        case 2: {
            pg8::Gemm g{P_O, (const bf16_t*)(ws + WS_WD), T_, D_, FF_}; S.init(T_, D_, G, bid);
            pg8::EpiResidT<false> E{P_X, P_XB, nullptr, ALPHA, 0.5f}; pg8::gemm_phase<pg8::EpiResidT<false>, true>(lds, g, S, E);
        } break;
        case 3: case 10: case 13: {
            const int which = (p == 3) ? 0 : (p == 10 ? 1 : 2);
            if (fast) ln_phase(P_X, P_XB, ldptr(pt, 2) + (size_t)(l * 3 + which) * D_, ldptr(pt, 3) + (size_t)(l * 3 + which) * D_, (l == 1 && p == 13), (8 * (bid & 7) + ((bid >> 3) & 7)) * 256 + (bid >> 6) * 64 + wave * 8, 1, 4, 2, lane);
            else ln_phase(P_X, P_XB, ldptr(pt, 2) + (size_t)(l * 3 + which) * D_, ldptr(pt, 3) + (size_t)(l * 3 + which) * D_, (l == 1 && p == 13), bid * 8 + wave, G * 8, 32 * G, (T_ + 32 * G - 1) / (32 * G), lane);
            if (p == 13 && l == 0) convert_phase(pt, 1, lds, tid, wave, lane, bid, G);
            if (p == 10) { int kp = PLE_; asm volatile("" : "+s"(kp)); pg8::Gemm g2{(const bf16_t*)(ws + WS_PB) + (size_t)l * T_ * PLE_, (const bf16_t*)(ws + WS_WPP), T_, D_, kp}; S.init(T_, D_, G, bid);
                pg8::EpiBf16 E2{P_GATE, D_}; pg8::gemm_phase(lds, g2, S, E2); }
        } break;
        case 4: {
            pg8::Gemm g{P_XB, (const bf16_t*)(ws + WS_WIN), T_, NZ_, D_}; S.init(T_, NZ_, G, bid);
            pg8::EpiZ E{P_ZH, P_GATE, 0}; pg8::gemm_phase(lds, g, S, E);
        } break;
        case 5: {
            for (int u = bid; u < 2560; u += G) attn_unit(lds, P_ZH, u, ldptr(pt, 8) + l * 8, P_O, P_DPO, P_DLSE, tid, wave, lane);
            for (int u = bid; u < 512; u += G) gmlp_unit(lds, P_ZH, u, ldptr(pt, 9) + l * 512, ldptr(pt, 10) + l * 512, ldptr(pt, 11) + (size_t)l * 65536, ldptr(pt, 12) + l * 512, P_O, tid, wave, lane);
            for (int u = bid; u < 1024; u += G) hgrn_c1_unit(lds, P_ZH, u, ldptr(pt, 13), l, P_DS, P_DEC, tid, wave, lane);
        } break;
        case 6: hgrn_scan_phase(P_DS, P_DEC, P_HS, tid, bid, G); break;
        case 7: {
            for (int u = bid; u < 1024; u += G) hgrn_c3_unit(lds, P_ZH, u, ldptr(pt, 13), l, P_HS, ldptr(pt, 14) + l * 512, P_O, tid, wave, lane);
            dcomb_phase(P_DPO, P_DLSE, P_O, tid, bid, G);
        } break;
        case 8: {
            { pg8::Gemm gg{P_XB, (const bf16_t*)(ws + WS_WIN) + (size_t)NZ_ * D_, T_, NGT_, D_}; S.init(T_, NGT_, G, bid);
              pg8::EpiZ Eg{P_ZH, P_GATE, 24}; pg8::gemm_phase(lds, gg, S, Eg); }
            if (fast) panel_barrier((unsigned*)(ws + WS_CTL + WS_BAR + 16384) + 64 * (8 * (bid & 7) + ((bid >> 3) & 7)), pepoch); else xcd_barrier(bar);
            pg8::Gemm g{P_O, (const bf16_t*)(ws + WS_WBR), T_, D_, NO_}; S.init(T_, D_, G, bid);
            pg8::EpiBR E{(bf16_t*)P_DS, P_GATE}; pg8::gemm_phase(lds, g, S, E);
        } break;
        case 9: {
            pg8::Gemm g{(const bf16_t*)P_DS, (const bf16_t*)(ws + WS_WOUT), T_, D_, D_}; S.init(T_, D_, G, bid);
            pg8::EpiResidT<false> E{P_X, P_XB, nullptr, ALPHA, 1.0f}; pg8::gemm_phase(lds, g, S, E);
        } break;
        case 12: {
            pg8::Gemm g{P_ZH, (const bf16_t*)(ws + WS_WD + (size_t)22 * MiB), T_, D_, FF_}; S.init(T_, D_, G, bid);
            pg8::EpiResidT<true> E{P_X, P_XB, P_GATE, ALPHA, 0.5f}; pg8::gemm_phase<pg8::EpiResidT<true>, true>(lds, g, S, E);
        } break;
        default: break;
        }
        if (ph + 1 < ph_hi) {
            if (ph_hi > 1000) { __threadfence(); cg::this_grid().sync(); }
            else if (fast && (p == 2 || p == 3 || p == 8 || p == 9 || p == 10 || p == 11 || (l == 1 && (p == 1 || p == 12))))
                panel_barrier((unsigned*)(ws + WS_CTL + WS_BAR + 16384) + 64 * (8 * (bid & 7) + ((bid >> 3) & 7)), pepoch);
            else xcd_barrier(bar);
            if (ph == 0) { if (threadIdx.x == 0 && xb_xcc_id() != xb_ld((unsigned*)(ws + WS_CTL + WS_BAR + 15400) + (blockIdx.x & 7))) (void)xb_add((unsigned*)(ws + WS_CTL + WS_BAR + 15360), 1u); }
            if (ph == 1) fast = (G == 256) && (__builtin_amdgcn_readfirstlane(xb_ld((unsigned*)(ws + WS_CTL + WS_BAR + 15360))) == 0u);
        }
    }
}

extern "C" void kernel_launch(void* const* d_in, const int* in_sizes, int n_in, void* d_out, int out_size, void* d_ws, size_t ws_size, hipStream_t stream) {
    static int grid = 0;
    if (grid == 0) {
        if (n_in != 22 || out_size != T_ * D_ || ws_size < WS_END) { fprintf(stderr, "kernel_launch: unexpected shapes (n_in %d out %d ws %zu need %zu)\n", n_in, out_size, ws_size, (size_t)WS_END); grid = -1; return; }
        int dev = 0, cus = 0, per_cu = 0;
        hipGetDevice(&dev); hipDeviceGetAttribute(&cus, hipDeviceAttributeMultiprocessorCount, dev);
        if (hipFuncSetAttribute((const void*)hybrid_fwd, hipFuncAttributeMaxDynamicSharedMemorySize, LDS_BYTES) != hipSuccess) { fprintf(stderr, "kernel_launch: hipFuncSetAttribute failed\n"); grid = -1; return; }
        hipOccupancyMaxActiveBlocksPerMultiprocessor(&per_cu, (const void*)hybrid_fwd, 512, LDS_BYTES);
        (void)hipGetLastError();
        if (per_cu < 1) per_cu = 1;
        grid = cus * 1;
    }
    if (grid < 0) return;
    if (hipMemsetAsync((char*)d_ws + WS_CTL + WS_BAR, 0, BAR_BYTES, stream) != hipSuccess) { fprintf(stderr, "kernel_launch: memset failed\n"); return; }
    Args a{};
    for (int i = 0; i < 22; ++i) a.in[i] = (const float*)d_in[i];
    a.out = (float*)d_out; a.ws = (unsigned char*)d_ws; a.ph_lo = 0; a.ph_hi = NPH;
    void* args[] = {&a};
    hipError_t e = hipLaunchCooperativeKernel((const void*)hybrid_fwd, dim3(grid), dim3(512), args, LDS_BYTES, stream);
    if (e != hipSuccess) fprintf(stderr, "cooperative launch failed: %s (grid %d)\n", hipGetErrorString(e), grid);
}
```

```cpp
#include <hip/hip_runtime.h>
#include <hip/hip_cooperative_groups.h>
#include <cstdio>
#include <cstdint>
namespace cg = cooperative_groups;

#define LAS __attribute__((address_space(3)))
typedef unsigned short bf16_t;
typedef short bf16x8 __attribute__((ext_vector_type(8)));
typedef float f32x4 __attribute__((ext_vector_type(4)));
typedef float f32x2 __attribute__((ext_vector_type(2)));
typedef unsigned u32x4 __attribute__((ext_vector_type(4)));
typedef unsigned u32x2 __attribute__((ext_vector_type(2)));

constexpr int T_ = 16384, SEQ_ = 4096, D_ = 2048, FF_ = 5632, NIN_ = 14336, NZ_ = 6144, NGT_ = 8192, NO_ = 1792, PLE_ = 256;
constexpr int ZQA = 0, ZKA = 512, ZVA = 640, ZUB = 768, ZVB = 1280, ZQC = 1792, ZFC = 2304, ZIC = 2816, ZGC = 3328, ZQD = 3840, ZKD = 4608, ZVD = 5376;
constexpr float LN_EPS = 1e-5f;
constexpr float ALPHA = 1.41421356237f;
constexpr float LOG2E = 1.44269504089f;

constexpr size_t MiB = 1u << 20;
constexpr size_t WS_CTL = 0;
constexpr size_t WS_BAR = 768 * 1024, BAR_BYTES = 32768;
constexpr size_t WS_WGU = 1 * MiB;
constexpr size_t WS_WPG = WS_WGU + 88 * MiB;
constexpr size_t WS_WD = WS_WPG + 8 * MiB;
constexpr size_t WS_WIN = WS_WD + 44 * MiB;
constexpr size_t WS_WBR = WS_WIN + 56 * MiB;
constexpr size_t WS_WOUT = WS_WBR + 7 * MiB;
constexpr size_t WS_WPP = WS_WOUT + 8 * MiB;
constexpr size_t WS_PB = WS_WPP + 1 * MiB;
constexpr size_t WS_XB = WS_PB + 16 * MiB;
constexpr size_t WS_ZH = WS_XB + 64 * MiB;
constexpr size_t WS_GATE = WS_ZH + 192 * MiB;
constexpr size_t WS_O = WS_GATE + 256 * MiB;
constexpr size_t WS_HS = WS_O + 56 * MiB;
constexpr size_t WS_DPO = WS_HS + 32 * MiB;
constexpr size_t WS_DLSE = WS_DPO + 48 * MiB;
constexpr size_t WS_DS = WS_DLSE + 1 * MiB;
constexpr size_t WS_END = WS_DS + 64 * MiB;
static_assert(WS_HS == WS_O + 56 * MiB && WS_DPO == WS_HS + 32 * MiB && WS_DLSE == WS_DPO + 48 * MiB && WS_DS == WS_DLSE + 1 * MiB && WS_END - WS_O >= 176 * MiB, "FFN1's H [T][5632] bf16 (176 MiB) overlays the contiguous O | HS | DPO | DLSE | dS span");

constexpr int LDS_BYTES = 147456;

__device__ __forceinline__ float bf2f(unsigned b) { return __uint_as_float(b << 16); }
__device__ __forceinline__ float bflo(unsigned w) { return __uint_as_float(w << 16); }
__device__ __forceinline__ float bfhi(unsigned w) { return __uint_as_float(w & 0xffff0000u); }
__device__ __forceinline__ unsigned pk2(float lo, float hi) { unsigned r; asm("v_cvt_pk_bf16_f32 %0, %1, %2" : "=v"(r) : "v"(lo), "v"(hi)); return r; }
__device__ __forceinline__ float fexp(float x) { return __builtin_amdgcn_exp2f(x * LOG2E); }
__device__ __forceinline__ float frcp(float x) { return __builtin_amdgcn_rcpf(x); }
__device__ __forceinline__ float fsigmoid(float x) { return frcp(1.0f + fexp(-x)); }
__device__ __forceinline__ float gelu_erf(float x) { return 0.5f * x * (1.0f + erff(x * 0.70710678118f)); }
__device__ __forceinline__ float gelu_fast(float v) {
    const float av = fabsf(v), t = frcp(av * 0.2316418882f + 1.0f);
    float q = t * 0.5307027145f + (-0.7265760135f); q = q * t + 0.7107068705f; q = q * t + (-0.142248368f); q = q * t + 0.127414796f; q = q * t;
    const float e = __builtin_amdgcn_exp2f((v * v) * (-0.72134752044f));
    const float m = v * (q * e);
    return v < 0.f ? m : v - m;
}
__device__ __forceinline__ float wave_sum(float v) {
#pragma unroll
    for (int o = 1; o < 64; o <<= 1) v += __shfl_xor(v, o);
    return v;
}
__device__ __forceinline__ f32x4 mfma16(bf16x8 a, bf16x8 b, f32x4 c) { return __builtin_amdgcn_mfma_f32_16x16x32_bf16(a, b, c, 0, 0, 0); }
typedef short s16x4 __attribute__((ext_vector_type(4)));
__device__ __forceinline__ u32x2 tr16(const LAS bf16_t* p) { const s16x4 r = __builtin_amdgcn_ds_read_tr16_b64_v4i16((LAS s16x4*)p); return __builtin_bit_cast(u32x2, r); }
__device__ __forceinline__ bf16x8 mk8(u32x2 a, u32x2 b) { u32x4 t = {a.x, a.y, b.x, b.y}; return __builtin_bit_cast(bf16x8, t); }

namespace pg8 {
constexpr int BM = 256, BK = 64, HALF = 128, HTB = HALF * BK * 2, STAGE_BYTES = 8 * HTB, NXCD = 8, WGM = 8;
__device__ __forceinline__ int lds_byte(int r, int c) { const int st = (r >> 4) * 2 + (c >> 5), rr = r & 15, cc = c & 31, ob = rr * 64 + cc * 2; return st * 1024 + (ob ^ (((ob >> 9) & 1) << 5)); }
__device__ __forceinline__ void stage_rc(int b, int& R, int& C) { const int st = b / 1024, sb = b % 1024, swz = sb ^ (((sb >> 9) & 1) << 5); R = (st >> 1) * 16 + swz / 64; C = (st & 1) * 32 + (swz % 64) / 2; }
__device__ __forceinline__ int perm32(int rho) { const int n = rho >> 4, i = rho & 15; return 8 * (i >> 2) + 4 * n + (i & 3); }
struct Unit { int pm, pn; };
struct Gemm { const bf16_t* A; const bf16_t* Bt; int M, N, K; };
struct StaticOrder {
    int nM, nN, nwg, G, c;
    __device__ void init(int M, int N, int G_, int c_) { nM = M / BM; nN = N / BM; nwg = nM * nN; G = G_; c = c_; }
    __device__ bool next(int i, Unit& u) const {
        const long L = (long)i * G + c; if (L >= nwg) return false;
        int wgid = (int)L; { const int q = nwg / NXCD, r = nwg % NXCD, xcd = wgid % NXCD, off = wgid / NXCD; wgid = (xcd < r ? xcd * (q + 1) : r * (q + 1) + (xcd - r) * q) + off; }
        const int nig = WGM * nN, gid = wgid / nig, fm = gid * WGM, gsz = (nM - fm) < WGM ? (nM - fm) : WGM;
        u.pm = fm + ((wgid % nig) % gsz); u.pn = (wgid % nig) / gsz; return true;
    }
};

struct EpiSwiGLU {
    static constexpr bool PERM = true, HAS_MID = false;
    bf16_t* H; bf16_t* PP;
    __device__ __forceinline__ void mid(int, f32x4 (&)[2][2][4][2], const Unit&, int, int, int, int) const {}
    __device__ __forceinline__ void operator()(const f32x4 (&acc)[2][2][4][2], const Unit& u, int wr, int wc, int fr, int fq) const {
        const int row0 = u.pm * BM + wr * 64 + fr;
        if (u.pn < 44) {
            const int col0 = u.pn * 128 + wc * 32 + 8 * fq;
#pragma unroll
            for (int ai = 0; ai < 2; ++ai)
#pragma unroll
                for (int m = 0; m < 4; ++m) {
                    bf16_t* rowp = H + (size_t)(row0 + ai * HALF + m * 16) * FF_ + col0;
                    float h[8];
#pragma unroll
                    for (int n = 0; n < 2; ++n)
#pragma unroll
                        for (int j = 0; j < 4; ++j) { const float g = acc[ai][0][m][n][j], up = acc[ai][1][m][n][j]; h[n * 4 + j] = g * fsigmoid(g) * up; }
                    u32x4 w; w.x = pk2(h[0], h[1]); w.y = pk2(h[2], h[3]); w.z = pk2(h[4], h[5]); w.w = pk2(h[6], h[7]);
                    *(u32x4*)rowp = w;
                    asm volatile("" ::: "memory"); __builtin_amdgcn_sched_barrier(0);
                }
        } else {
            const int col0 = (u.pn - 44) * BM + wc * 32 + 8 * fq;
#pragma unroll
            for (int am = 0; am < 4; ++am) { const int ai = am >> 1, mb = (am & 1) * 2;
                u32x4 pv[2][2];
#pragma unroll
                for (int mm = 0; mm < 2; ++mm)
#pragma unroll
                    for (int bj = 0; bj < 2; ++bj) pv[mm][bj] = *(const u32x4*)(PP + (size_t)(row0 + ai * HALF + (mb + mm) * 16) * D_ + col0 + bj * HALF);
#pragma unroll
                for (int mm = 0; mm < 2; ++mm) { const int m = mb + mm;
                    bf16_t* rowp = PP + (size_t)(row0 + ai * HALF + m * 16) * D_ + col0;
#pragma unroll
                    for (int bj = 0; bj < 2; ++bj) {
                        const u32x4 p = pv[mm][bj];
                        const f32x4 a0 = acc[ai][bj][m][0], a1 = acc[ai][bj][m][1];
                        u32x4 w;
                        w.x = pk2(fsigmoid(a0[0]) * bflo(p.x), fsigmoid(a0[1]) * bfhi(p.x)); w.y = pk2(fsigmoid(a0[2]) * bflo(p.y), fsigmoid(a0[3]) * bfhi(p.y));
                        w.z = pk2(fsigmoid(a1[0]) * bflo(p.z), fsigmoid(a1[1]) * bfhi(p.z)); w.w = pk2(fsigmoid(a1[2]) * bflo(p.w), fsigmoid(a1[3]) * bfhi(p.w));
                        *(u32x4*)(rowp + bj * HALF) = w;
                    }
                }
                asm volatile("" ::: "memory"); __builtin_amdgcn_sched_barrier(0);
            }
        }
    }
};
template <bool ADD> struct EpiResidT {
    static constexpr bool PERM = false, HAS_MID = false;
    float* Y; const bf16_t* XB; const bf16_t* PP; float a, b;
    __device__ __forceinline__ void mid(int, f32x4 (&)[2][2][4][2], const Unit&, int, int, int, int) const {}
    __device__ __forceinline__ void operator()(const f32x4 (&acc)[2][2][4][2], const Unit& u, int wr, int wc, int fr, int fq) const {
        const int row0 = u.pm * BM + wr * 64 + fr, col0 = u.pn * BM + wc * 32 + 4 * fq;
        constexpr int GM = ADD ? 2 : 4;
#pragma unroll
        for (int ai = 0; ai < 2; ++ai)
#pragma unroll
            for (int m0 = 0; m0 < 4; m0 += GM) {
                u32x2 xb[GM][2][2], pp[GM][2][2];
#pragma unroll
                for (int mm = 0; mm < GM; ++mm) { const size_t off = (size_t)(row0 + ai * HALF + (m0 + mm) * 16) * D_ + col0;
#pragma unroll
                    for (int bj = 0; bj < 2; ++bj)
#pragma unroll
                        for (int n = 0; n < 2; ++n) { xb[mm][bj][n] = *(const u32x2*)(XB + off + bj * HALF + n * 16); if (ADD) pp[mm][bj][n] = *(const u32x2*)(PP + off + bj * HALF + n * 16); } }
#pragma unroll
                for (int mm = 0; mm < GM; ++mm) { const int m = m0 + mm; const size_t off = (size_t)(row0 + ai * HALF + m * 16) * D_ + col0;
#pragma unroll
                    for (int bj = 0; bj < 2; ++bj)
#pragma unroll
                        for (int n = 0; n < 2; ++n) { const u32x2 x = xb[mm][bj][n]; const f32x4 s = acc[ai][bj][m][n];
                            f32x4 y; y[0] = a * bflo(x.x) + b * s[0]; y[1] = a * bfhi(x.x) + b * s[1]; y[2] = a * bflo(x.y) + b * s[2]; y[3] = a * bfhi(x.y) + b * s[3];
                            if (ADD) { const u32x2 q = pp[mm][bj][n]; y[0] += bflo(q.x); y[1] += bfhi(q.x); y[2] += bflo(q.y); y[3] += bfhi(q.y); }
                            *(f32x4*)(Y + off + bj * HALF + n * 16) = y; } }
                asm volatile("" ::: "memory"); __builtin_amdgcn_sched_barrier(0);
            }
    }
};
struct EpiZ {
    static constexpr bool PERM = true, HAS_MID = false;
    bf16_t* Z; bf16_t* GATE; int pn_off;
    __device__ __forceinline__ void mid(int, f32x4 (&)[2][2][4][2], const Unit&, int, int, int, int) const {}
    __device__ __forceinline__ void operator()(const f32x4 (&acc)[2][2][4][2], const Unit& u0, int wr, int wc, int fr, int fq) const {
        Unit u; u.pm = u0.pm; u.pn = u0.pn + pn_off;
        const int row0 = u.pm * BM + wr * 64 + fr;
        if (u.pn < 24) {
            const bool isgelu = (u.pn >= 3) && (u.pn <= 6);
            const int col0 = u.pn * BM + wc * 32 + 8 * fq;
#pragma unroll
            for (int ai = 0; ai < 2; ++ai)
#pragma unroll
                for (int m = 0; m < 4; ++m) {
                    bf16_t* rowp = Z + (size_t)(row0 + ai * HALF + m * 16) * NZ_ + col0;
#pragma unroll
                    for (int bj = 0; bj < 2; ++bj) {
                        f32x4 v0 = acc[ai][bj][m][0], v1 = acc[ai][bj][m][1];
                        if (isgelu) {
#pragma unroll
                            for (int j = 0; j < 4; ++j) { v0[j] = gelu_fast(v0[j]); v1[j] = gelu_fast(v1[j]); }
                        }
                        u32x4 w; w.x = pk2(v0[0], v0[1]); w.y = pk2(v0[2], v0[3]); w.z = pk2(v1[0], v1[1]); w.w = pk2(v1[2], v1[3]);
                        *(u32x4*)(rowp + bj * HALF) = w;
                    }
                    asm volatile("" ::: "memory"); __builtin_amdgcn_sched_barrier(0);
                }
        } else {
            const int mc0 = (u.pn - 24) * 64 + wc * 16 + 4 * fq;
#pragma unroll
            for (int ai = 0; ai < 2; ++ai)
#pragma unroll
                for (int m = 0; m < 4; ++m) {
                    bf16_t* rowp = GATE + (size_t)(row0 + ai * HALF + m * 16) * D_ + mc0;
                    f32x4 e[4];
#pragma unroll
                    for (int br = 0; br < 4; ++br)
#pragma unroll
                        for (int j = 0; j < 4; ++j) e[br][j] = fminf(1.0f + fexp(-acc[ai][br >> 1][m][br & 1][j]), 1e30f);
                    f32x4 i0, i1, i2, i3;
#pragma unroll
                    for (int j = 0; j < 4; ++j) { i0[j] = frcp(e[0][j]); i1[j] = frcp(e[1][j]); i2[j] = frcp(e[2][j]); i3[j] = frcp(e[3][j]); }
                    const f32x4 r0 = e[1] * i0, r1 = e[2] * i1, r2 = e[3] * i2;
                    u32x2 w;
                    w.x = pk2(r0[0], r0[1]); w.y = pk2(r0[2], r0[3]); *(u32x2*)(rowp) = w;
                    w.x = pk2(r1[0], r1[1]); w.y = pk2(r1[2], r1[3]); *(u32x2*)(rowp + (size_t)T_ * D_) = w;
                    w.x = pk2(r2[0], r2[1]); w.y = pk2(r2[2], r2[3]); *(u32x2*)(rowp + (size_t)2 * T_ * D_) = w;
                    w.x = pk2(i3[0], i3[1]); w.y = pk2(i3[2], i3[3]); *(u32x2*)(rowp + (size_t)3 * T_ * D_) = w;
                    asm volatile("" ::: "memory"); __builtin_amdgcn_sched_barrier(0);
                }
        }
    }
};
struct EpiBf16 {
    static constexpr bool PERM = true, HAS_MID = false;
    bf16_t* O; int ldc;
    __device__ __forceinline__ void mid(int, f32x4 (&)[2][2][4][2], const Unit&, int, int, int, int) const {}
    __device__ __forceinline__ void operator()(const f32x4 (&acc)[2][2][4][2], const Unit& u, int wr, int wc, int fr, int fq) const {
        const int row0 = u.pm * BM + wr * 64 + fr, col0 = u.pn * BM + wc * 32 + 8 * fq;
#pragma unroll
        for (int ai = 0; ai < 2; ++ai)
#pragma unroll
            for (int m = 0; m < 4; ++m) {
                bf16_t* rowp = O + (size_t)(row0 + ai * HALF + m * 16) * ldc + col0;
#pragma unroll
                for (int bj = 0; bj < 2; ++bj) {
                    const f32x4 v0 = acc[ai][bj][m][0], v1 = acc[ai][bj][m][1];
                    u32x4 w; w.x = pk2(v0[0], v0[1]); w.y = pk2(v0[2], v0[3]); w.z = pk2(v1[0], v1[1]); w.w = pk2(v1[2], v1[3]);
                    *(u32x4*)(rowp + bj * HALF) = w;
                }
                asm volatile("" ::: "memory"); __builtin_amdgcn_sched_barrier(0);
            }
    }
};
struct EpiBR {
    static constexpr bool PERM = true, HAS_MID = true;
    bf16_t* O; const bf16_t* GATE;
    __device__ __forceinline__ void scale(const bf16_t* plane, f32x4 (&acc)[2][2][4][2], const Unit& u, int wr, int wc, int fr, int fq) const {
        const int row0 = u.pm * BM + wr * 64 + fr, col0 = u.pn * BM + wc * 32 + 8 * fq;
        u32x4 r[2][4][2];
#pragma unroll
        for (int ai = 0; ai < 2; ++ai)
#pragma unroll
            for (int m = 0; m < 4; ++m)
#pragma unroll
                for (int bj = 0; bj < 2; ++bj) r[ai][m][bj] = *(const u32x4*)(plane + (size_t)(row0 + ai * HALF + m * 16) * D_ + col0 + bj * HALF);
#pragma unroll
        for (int ai = 0; ai < 2; ++ai)
#pragma unroll
            for (int m = 0; m < 4; ++m)
#pragma unroll
                for (int bj = 0; bj < 2; ++bj) { const u32x4 e = r[ai][m][bj];
                    acc[ai][bj][m][0] *= (f32x4){bflo(e.x), bfhi(e.x), bflo(e.y), bfhi(e.y)}; acc[ai][bj][m][1] *= (f32x4){bflo(e.z), bfhi(e.z), bflo(e.w), bfhi(e.w)}; }
    }
    __device__ __forceinline__ void mid(int t, f32x4 (&acc)[2][2][4][2], const Unit& u, int wr, int wc, int fr, int fq) const {
        if (t != 8 && t != 16 && t != 24) return;
        asm volatile("" : "+v"(fr), "+v"(fq));
        scale(GATE + (size_t)((t >> 3) - 1) * T_ * D_, acc, u, wr, wc, fr, fq);
    }
    __device__ __forceinline__ void operator()(f32x4 (&acc)[2][2][4][2], const Unit& u, int wr, int wc, int fr, int fq) const {
        scale(GATE + (size_t)3 * T_ * D_, acc, u, wr, wc, fr, fq);
        const int row0 = u.pm * BM + wr * 64 + fr, col0 = u.pn * BM + wc * 32 + 8 * fq;
#pragma unroll
        for (int ai = 0; ai < 2; ++ai)
#pragma unroll
            for (int m = 0; m < 4; ++m) {
                bf16_t* rowp = O + (size_t)(row0 + ai * HALF + m * 16) * D_ + col0;
#pragma unroll
                for (int bj = 0; bj < 2; ++bj) {
                    const f32x4 a0 = acc[ai][bj][m][0], a1 = acc[ai][bj][m][1];
                    u32x4 w; w.x = pk2(a0[0], a0[1]); w.y = pk2(a0[2], a0[3]); w.z = pk2(a1[0], a1[1]); w.w = pk2(a1[2], a1[3]);
                    *(u32x4*)(rowp + bj * HALF) = w;
                }
            }
    }
};

template <class Epi, bool KREV = false>
__device__ __forceinline__ void gemm_phase(LAS unsigned char* lds, const Gemm g, const StaticOrder& S, const Epi& E) {
    int tid = threadIdx.x; asm volatile("" : "+v"(tid));
    const int wid = __builtin_amdgcn_readfirstlane(tid >> 6), lane = tid & 63, wr = wid >> 2, wc = wid & 3, fr = lane & 15, fq = lane >> 4;
    const int K = g.K, nt = K / BK;
    unsigned voffA[2], voffB[2];
#pragma unroll
    for (int i = 0; i < 2; ++i) { int R, C; stage_rc(tid * 16 + i * 8192, R, C); const int Rb = Epi::PERM ? ((R & ~31) + perm32(R & 31)) : R;
        voffA[i] = (unsigned)(R * K + C) * 2u; voffB[i] = (unsigned)(Rb * K + C) * 2u; }
    const long kstep = KREV ? -(long)(BK * 2) : (long)(BK * 2);
    const size_t kbase = KREV ? (size_t)(nt - 1) * (BK * 2) : 0;
    const size_t hstep = (size_t)HALF * K * 2;
    const size_t tstep = 2 * hstep;
    const unsigned ldsw = (unsigned)wid * 1024u;
    const int aoff = lds_byte(wr * 64 + fr, fq * 8), boff = lds_byte(wc * 32 + fr, fq * 8);
#define PG8_SA(b, h) (((b) * 2 + (h)) * HTB)
#define PG8_SB(b, h) ((4 + (b) * 2 + (h)) * HTB)
#define PG8_STAGE(bufoff, gbase, voff) do { _Pragma("unroll") for (int _i = 0; _i < 2; ++_i) \
        __builtin_amdgcn_global_load_lds((const unsigned*)((const char*)(gbase) + (voff)[_i]), (LAS unsigned*)(lds + (bufoff) + ldsw + _i * 8192), 16, 0, 0); } while (0)
#define PG8_LDA(dst, b, h) do { _Pragma("unroll") for (int m = 0; m < 4; ++m) _Pragma("unroll") for (int k = 0; k < 2; ++k) dst[m][k] = *(const LAS bf16x8*)(lds + PG8_SA(b, h) + aoff + m * 2048 + k * 1024); } while (0)
#define PG8_LDB(dst, b, h) do { _Pragma("unroll") for (int n = 0; n < 2; ++n) _Pragma("unroll") for (int k = 0; k < 2; ++k) dst[n][k] = *(const LAS bf16x8*)(lds + PG8_SB(b, h) + boff + n * 2048 + k * 1024); } while (0)
#define PG8_MMA(ai, bj, At, Bt) do { __builtin_amdgcn_s_setprio(1); _Pragma("unroll") for (int m = 0; m < 4; ++m) _Pragma("unroll") for (int n = 0; n < 2; ++n) _Pragma("unroll") for (int k = 0; k < 2; ++k) \
        acc[ai][bj][m][n] = __builtin_amdgcn_mfma_f32_16x16x32_bf16(Bt[n][k], At[m][k], acc[ai][bj][m][n], 0, 0, 0); __builtin_amdgcn_s_setprio(0); } while (0)
#define PG8_WAIT_V(n) asm volatile("s_waitcnt vmcnt(" #n ")" ::: "memory")
#define PG8_WAIT_L(n) asm volatile("s_waitcnt lgkmcnt(" #n ")" ::: "memory")
#define PG8_BAR __builtin_amdgcn_s_barrier()
#define PG8_SCHED __builtin_amdgcn_sched_barrier(0)
    Unit cur, nxt; int ui = 0;
    if (!S.next(0, cur)) return;
    f32x4 acc[2][2][4][2];
#pragma unroll
    for (int a = 0; a < 2; ++a)
#pragma unroll
        for (int b = 0; b < 2; ++b)
#pragma unroll
            for (int m = 0; m < 4; ++m)
#pragma unroll
                for (int n = 0; n < 2; ++n) acc[a][b][m][n] = (f32x4){0.f, 0.f, 0.f, 0.f};
    bf16x8 At[4][2], B0[2][2], B1[2][2];
    const char* cA = (const char*)g.A + (size_t)cur.pm * tstep + kbase; const char* cB = (const char*)g.Bt + (size_t)cur.pn * tstep + kbase;
    PG8_STAGE(PG8_SB(0, 0), cB, voffB); PG8_STAGE(PG8_SB(0, 1), cB + hstep, voffB); PG8_STAGE(PG8_SA(0, 0), cA, voffA); PG8_STAGE(PG8_SA(0, 1), cA + hstep, voffA);
    if (wr == 1) PG8_BAR;
    PG8_WAIT_V(2); PG8_BAR;
    PG8_STAGE(PG8_SB(1, 0), cB + kstep, voffB); PG8_STAGE(PG8_SA(1, 0), cA + kstep, voffA); PG8_STAGE(PG8_SB(1, 1), cB + hstep + kstep, voffB);
    PG8_WAIT_V(6); PG8_BAR;
    for (;;) {
        const bool has_next = S.next(ui + 1, nxt);
        const char* nA = has_next ? (const char*)g.A + (size_t)nxt.pm * tstep + kbase : cA; const char* nB = has_next ? (const char*)g.Bt + (size_t)nxt.pn * tstep + kbase : cB;
        for (int t = 0; t < nt; t += 2) {
            const bool last = (t == nt - 2);
            const char* a1 = cA + (long)(t + 1) * kstep;
            const char* a2 = last ? nA : cA + (long)(t + 2) * kstep; const char* b2 = last ? nB : cB + (long)(t + 2) * kstep;
            const char* a3 = a2 + kstep; const char* b3 = b2 + kstep;
            if constexpr (Epi::HAS_MID) E.mid(t, acc, cur, wr, wc, fr, fq);
            PG8_LDB(B0, 0, 0); PG8_LDB(B1, 0, 1); PG8_SCHED; PG8_LDA(At, 0, 0); PG8_STAGE(PG8_SA(1, 1), a1 + hstep, voffA);
            PG8_WAIT_V(8); PG8_WAIT_L(0); PG8_BAR; PG8_MMA(0, 0, At, B0); PG8_MMA(0, 1, At, B1); PG8_BAR; PG8_SCHED;
            PG8_LDA(At, 0, 1); PG8_STAGE(PG8_SB(0, 0), b2, voffB); PG8_STAGE(PG8_SB(0, 1), b2 + hstep, voffB); PG8_STAGE(PG8_SA(0, 0), a2, voffA);
            PG8_WAIT_V(8); PG8_WAIT_L(0); PG8_BAR; PG8_MMA(1, 0, At, B0); PG8_MMA(1, 1, At, B1); PG8_BAR; PG8_SCHED;
            PG8_LDB(B0, 1, 0); PG8_LDB(B1, 1, 1); PG8_SCHED; PG8_LDA(At, 1, 0); PG8_STAGE(PG8_SA(0, 1), a2 + hstep, voffA);
            PG8_WAIT_V(8); PG8_WAIT_L(0); PG8_BAR; PG8_MMA(0, 0, At, B0); PG8_MMA(0, 1, At, B1); PG8_BAR; PG8_SCHED;
            PG8_LDA(At, 1, 1); PG8_STAGE(PG8_SB(1, 0), b3, voffB); PG8_STAGE(PG8_SB(1, 1), b3 + hstep, voffB); PG8_STAGE(PG8_SA(1, 0), a3, voffA);
            PG8_WAIT_V(8); PG8_WAIT_L(0); PG8_BAR; PG8_MMA(1, 0, At, B0); PG8_MMA(1, 1, At, B1); PG8_BAR; PG8_SCHED;
        }
        if (wr == 0) PG8_BAR;
#pragma unroll
        for (int a = 0; a < 2; ++a)
#pragma unroll
            for (int b = 0; b < 2; ++b)
#pragma unroll
                for (int m = 0; m < 4; ++m)
#pragma unroll
                    for (int n = 0; n < 2; ++n) asm volatile("" : "+v"(acc[a][b][m][n]));
        E(acc, cur, wr, wc, fr, fq);
        if (!has_next) break;
#pragma unroll
        for (int a = 0; a < 2; ++a)
#pragma unroll
            for (int b = 0; b < 2; ++b)
#pragma unroll
                for (int m = 0; m < 4; ++m)
#pragma unroll
                    for (int n = 0; n < 2; ++n) acc[a][b][m][n] = (f32x4){0.f, 0.f, 0.f, 0.f};
        cur = nxt; cA = nA; cB = nB; ++ui;
        if (wr == 1) PG8_BAR;
    }
    PG8_WAIT_V(0);
    PG8_BAR;
#undef PG8_SA
#undef PG8_SB
#undef PG8_STAGE
#undef PG8_LDA
#undef PG8_LDB
#undef PG8_MMA
#undef PG8_WAIT_V
#undef PG8_WAIT_L
#undef PG8_BAR
#undef PG8_SCHED
}
}

typedef __attribute__((address_space(1))) unsigned gu32;
#define XB_TMO      128
#define XB_XCNT(j)  (256  + 64 * (j))
#define XB_XSUB(j)  (1280 + 64 * (j))
#define XB_XGEN(j)  (2304 + 64 * (j))
#define XB_TOP      3328
#define XB_TOPGEN   3392
#define XCD_BAR_WORDS 3456
#define XB_SPIN_CAP (1u << 18)

__device__ __forceinline__ unsigned xb_ld(unsigned* p)              { return __hip_atomic_load(p, __ATOMIC_RELAXED, __HIP_MEMORY_SCOPE_AGENT); }
__device__ __forceinline__ unsigned xb_add(unsigned* p, unsigned v) { return __hip_atomic_fetch_add(p, v, __ATOMIC_RELAXED, __HIP_MEMORY_SCOPE_AGENT); }
__device__ __forceinline__ unsigned xb_xcc_id() { return (unsigned)__builtin_amdgcn_s_getreg((3 << 11) | 20) & 0xFu; }
#define XB_SPIN(cond, bar) do { unsigned _sp = 0; while (cond) { __builtin_amdgcn_s_sleep(1); \
    if ((++_sp & 255u) == 0u) { if (xb_ld(&(bar)[XB_TMO])) break; if (_sp > XB_SPIN_CAP) { atomicAdd(&(bar)[XB_TMO], 1u); break; } } } } while (0)

struct XcdBarrier {
    unsigned* bar; unsigned x;
    volatile LAS unsigned* st;
};

__device__ __forceinline__ XcdBarrier xcd_barrier_post(unsigned* bar, volatile LAS unsigned* st) {
    XcdBarrier b; b.bar = bar; b.x = xb_xcc_id(); b.st = st;
    if (threadIdx.x == 0) (void)xb_add(&bar[XB_XCNT(b.x)], 1u);
    return b;
}
__device__ __forceinline__ void xcd_barrier_complete(unsigned* bar, unsigned x, unsigned& nloc, unsigned& nx) {
    const unsigned G = gridDim.x * gridDim.y * gridDim.z;
    unsigned sum, cnt, mine, sp = 0u;
    for (;;) {
        sum = 0u; cnt = 0u; mine = 0u;
#pragma unroll
        for (unsigned j = 0; j < 16; ++j) { const unsigned c = xb_ld(&bar[XB_XCNT(j)]); sum += c; cnt += (c > 0u) ? 1u : 0u; mine = (j == x) ? c : mine; }
        if (sum == G) break;
        __builtin_amdgcn_s_sleep(1);
        if ((++sp & 255u) == 0u) { if (xb_ld(&bar[XB_TMO])) break; if (sp > XB_SPIN_CAP) { atomicAdd(&bar[XB_TMO], 1u); break; } }
    }
    nloc = mine > 0u ? mine : 1u; nx = cnt > 0u ? cnt : 1u;
}

__device__ __forceinline__ void xcd_barrier(const XcdBarrier& b) {
    asm volatile("s_waitcnt vmcnt(0)" ::: "memory");
    __syncthreads();
    if (threadIdx.x == 0) {
        unsigned* bar = b.bar;
        __builtin_amdgcn_s_waitcnt(0);
        unsigned nloc = b.st[0], nx = b.st[1];
        if (nloc == 0u) { xcd_barrier_complete(bar, b.x, nloc, nx); b.st[0] = nloc; b.st[1] = nx; }
        const unsigned old = xb_add(&bar[XB_XSUB(b.x)], 1u);
        const unsigned gen = old / nloc;
        if (old + 1u == (gen + 1u) * nloc) {
            __builtin_amdgcn_fence(__ATOMIC_RELEASE, "agent");
            asm volatile("s_waitcnt vmcnt(0)" ::: "memory");
            const unsigned og = xb_add(&bar[XB_TOP], 1u);
            const unsigned tg = og / nx;
            if (og + 1u == (tg + 1u) * nx) xb_add(&bar[XB_TOPGEN], 1u);
            else XB_SPIN(xb_ld(&bar[XB_TOPGEN]) == tg, bar);
            __builtin_amdgcn_fence(__ATOMIC_ACQUIRE, "agent");
            xb_add(&bar[XB_XGEN(b.x)], 1u);
            asm volatile("s_waitcnt vmcnt(0)" ::: "memory");
        } else {
            XB_SPIN(xb_ld(&bar[XB_XGEN(b.x)]) == gen, bar);
            __builtin_amdgcn_fence(__ATOMIC_ACQUIRE, "agent");
            asm volatile("s_waitcnt vmcnt(0)" ::: "memory");
        }
    }
    __syncthreads();
}


__device__ __forceinline__ void panel_barrier(unsigned* cnt, unsigned& epoch) {
    asm volatile("s_waitcnt vmcnt(0)" ::: "memory");
    __syncthreads();
    ++epoch;
    if (threadIdx.x == 0) {
        (void)xb_add(cnt, 1u);
        unsigned sp = 0u;
        while (xb_ld(cnt) < 4u * epoch) { __builtin_amdgcn_s_sleep(1); if (++sp > (1u << 22)) break; }
        __builtin_amdgcn_fence(__ATOMIC_ACQUIRE, "agent");
        asm volatile("s_waitcnt vmcnt(0)" ::: "memory");
    }
    __syncthreads();
}

struct Args { const float* in[22]; float* out; unsigned char* ws; int ph_lo, ph_hi; };

typedef LAS unsigned long long* PTab;
__device__ __forceinline__ const float* ldptr(PTab pt, int k) {
    const unsigned long long v = pt[k];
    const unsigned lo = __builtin_amdgcn_readfirstlane((unsigned)v), hi = __builtin_amdgcn_readfirstlane((unsigned)(v >> 32));
    return (const float*)(__attribute__((address_space(1))) const float*)(((unsigned long long)hi << 32) | lo);
}

__device__ __forceinline__ int conv_row(int n, int mode, int rowoff) {
    if (mode == 0) return rowoff + n;
    if (mode == 3) { const int br = n >> 11, mc = n & 2047, q = mc >> 6, mcl = mc & 63; return rowoff + 256 * q + 128 * (br >> 1) + 32 * (mcl >> 4) + 8 * ((mcl >> 2) & 3) + 4 * (br & 1) + (mcl & 3); }
    return (n >> 7) * 256 + (n & 127) + (mode == 2 ? 128 : 0);
}
__device__ __forceinline__ void conv_mat(const float* W, int ldw, int K, int N, bf16_t* WT, int pitch, int koff, int mode, int rowoff, int gw, int ngw, int lane) {
    const int nblk = N / 64, nitems = (K / 64) * nblk;
    const int c = lane & 15, q = lane >> 4;
    f32x4 v[16];
    if (gw < nitems) { const int kb = gw / nblk, nb = gw - kb * nblk; const float* src = W + (size_t)(64 * kb + 16 * q) * ldw + 64 * nb + 4 * c;
#pragma unroll
        for (int j = 0; j < 16; ++j) v[j] = __builtin_nontemporal_load((const f32x4*)(src + (size_t)j * ldw)); }
    for (int item = gw; item < nitems; item += ngw) {
        const int kb = item / nblk, nb = item - kb * nblk, k0 = 64 * kb, n0 = 64 * nb;
        u32x4 o[8];
#pragma unroll
        for (int i = 0; i < 4; ++i) {
            o[2 * i].x = pk2(v[0][i], v[1][i]); o[2 * i].y = pk2(v[2][i], v[3][i]); o[2 * i].z = pk2(v[4][i], v[5][i]); o[2 * i].w = pk2(v[6][i], v[7][i]);
            o[2 * i + 1].x = pk2(v[8][i], v[9][i]); o[2 * i + 1].y = pk2(v[10][i], v[11][i]); o[2 * i + 1].z = pk2(v[12][i], v[13][i]); o[2 * i + 1].w = pk2(v[14][i], v[15][i]);
        }
        const int nx = item + ngw;
        if (nx < nitems) { const int kb2 = nx / nblk, nb2 = nx - kb2 * nblk; const float* src = W + (size_t)(64 * kb2 + 16 * q) * ldw + 64 * nb2 + 4 * c;
#pragma unroll
            for (int j = 0; j < 16; ++j) v[j] = __builtin_nontemporal_load((const f32x4*)(src + (size_t)j * ldw)); }
        const int rb = conv_row(n0 + 4 * c, mode, rowoff);
#pragma unroll
        for (int i = 0; i < 4; ++i) {
            bf16_t* dst = WT + (size_t)(rb + i) * pitch + koff + k0 + 16 * q;
            *(u32x4*)dst = o[2 * i]; *(u32x4*)(dst + 8) = o[2 * i + 1];
        }
    }
}

__device__ __forceinline__ void convert_phase(PTab pt, int l, LAS unsigned char* lds, int tid, int wave, int lane, int bid, int G) {
    unsigned char* ws = (unsigned char*)ldptr(pt, 23);
    const int gw = bid * 8 + wave, ngw = G * 8;
    for (int s = 0; s < 2; ++s) {
        bf16_t* wgu = (bf16_t*)(ws + WS_WGU + (size_t)s * 44 * MiB);
        conv_mat(ldptr(pt, 4) + (size_t)(l * 2 + s) * D_ * FF_, FF_, D_, FF_, wgu, D_, 0, 1, 0, gw, ngw, lane);
        conv_mat(ldptr(pt, 5) + (size_t)(l * 2 + s) * D_ * FF_, FF_, D_, FF_, wgu, D_, 0, 2, 0, gw, ngw, lane);
        conv_mat(ldptr(pt, 6) + (size_t)(l * 2 + s) * D_ * FF_, D_, FF_, D_, (bf16_t*)(ws + WS_WD + (size_t)s * 22 * MiB), FF_, 0, 0, 0, gw, ngw, lane);
    }
    conv_mat(ldptr(pt, 7) + (size_t)l * D_ * NIN_, NIN_, D_, NZ_, (bf16_t*)(ws + WS_WIN), D_, 0, 0, 0, gw, ngw, lane);
    conv_mat(ldptr(pt, 7) + (size_t)l * D_ * NIN_ + NZ_, NIN_, D_, NGT_, (bf16_t*)(ws + WS_WIN), D_, 0, 3, NZ_, gw, ngw, lane);
    conv_mat(ldptr(pt, 15) + (size_t)l * 512 * D_, D_, 512, D_, (bf16_t*)(ws + WS_WBR), NO_, 0, 0, 0, gw, ngw, lane);
    conv_mat(ldptr(pt, 16) + (size_t)l * 512 * D_, D_, 512, D_, (bf16_t*)(ws + WS_WBR), NO_, 512, 0, 0, gw, ngw, lane);
    conv_mat(ldptr(pt, 17) + (size_t)l * 512 * D_, D_, 512, D_, (bf16_t*)(ws + WS_WBR), NO_, 1024, 0, 0, gw, ngw, lane);
    conv_mat(ldptr(pt, 18) + (size_t)l * 256 * D_, D_, 256, D_, (bf16_t*)(ws + WS_WBR), NO_, 1536, 0, 0, gw, ngw, lane);
    conv_mat(ldptr(pt, 19) + (size_t)l * D_ * D_, D_, D_, D_, (bf16_t*)(ws + WS_WOUT), D_, 0, 0, 0, gw, ngw, lane);
    conv_mat(ldptr(pt, 20) + (size_t)l * PLE_ * D_, D_, PLE_, D_, (bf16_t*)(ws + WS_WPP), PLE_, 0, 0, 0, gw, ngw, lane);
    conv_mat(ldptr(pt, 21) + (size_t)l * D_ * D_, D_, D_, D_, (bf16_t*)(ws + WS_WPG), D_, 0, 0, 0, gw, ngw, lane);
    if (l == 0) {
        const size_t gt = (size_t)bid * 512 + tid, nth = (size_t)G * 512;
        const f32x4* x4 = (const f32x4*)ldptr(pt, 0); u32x2* xb = (u32x2*)(ws + WS_XB);
        for (size_t i = gt; i < (size_t)T_ * D_ / 4; i += nth) { const f32x4 v = x4[i]; u32x2 w; w.x = pk2(v[0], v[1]); w.y = pk2(v[2], v[3]); xb[i] = w; }
        const f32x4* p4 = (const f32x4*)ldptr(pt, 1); u32x2* pb = (u32x2*)(ws + WS_PB);
        for (size_t i = gt; i < (size_t)2 * T_ * PLE_ / 4; i += nth) { const f32x4 v = p4[i]; u32x2 w; w.x = pk2(v[0], v[1]); w.y = pk2(v[2], v[3]); pb[i] = w; }
    }
}

__device__ __forceinline__ void ln_phase(float* X, bf16_t* XB, const float* g, const float* b, bool final_, int first, int rstep, int bstep, int nb, int lane) {
    const int ngw = rstep;
    for (int bi = 0, row0 = first; bi < nb; ++bi, row0 += bstep) {
        f32x4 v[4][8];
#pragma unroll
        for (int r = 0; r < 4; ++r) { const int row = min(row0 + r * ngw, T_ - 1); const f32x4* xr = (const f32x4*)(X + (size_t)row * D_) + lane;
#pragma unroll
            for (int j = 0; j < 8; ++j) v[r][j] = xr[64 * j]; }
        float mean[4], rstd[4];
#pragma unroll
        for (int r = 0; r < 4; ++r) { float s = 0.f;
#pragma unroll
            for (int j = 0; j < 8; ++j) s += (v[r][j][0] + v[r][j][1]) + (v[r][j][2] + v[r][j][3]);
            mean[r] = s; }
#pragma unroll
        for (int o = 1; o < 64; o <<= 1) {
#pragma unroll
            for (int r = 0; r < 4; ++r) mean[r] += __shfl_xor(mean[r], o); }
#pragma unroll
        for (int r = 0; r < 4; ++r) { mean[r] *= (1.f / D_); float s2 = 0.f;
#pragma unroll
            for (int j = 0; j < 8; ++j) { v[r][j] = v[r][j] - mean[r]; s2 += (v[r][j][0] * v[r][j][0] + v[r][j][1] * v[r][j][1]) + (v[r][j][2] * v[r][j][2] + v[r][j][3] * v[r][j][3]); }
            rstd[r] = s2; }
#pragma unroll
        for (int o = 1; o < 64; o <<= 1) {
#pragma unroll
            for (int r = 0; r < 4; ++r) rstd[r] += __shfl_xor(rstd[r], o); }
#pragma unroll
        for (int r = 0; r < 4; ++r) rstd[r] = 1.f / sqrtf(rstd[r] * (1.f / D_) + LN_EPS);
#pragma unroll
        for (int j = 0; j < 8; ++j) {
            const f32x4 gg = ((const f32x4*)g)[lane + 64 * j], bb = ((const f32x4*)b)[lane + 64 * j];
#pragma unroll
            for (int r = 0; r < 4; ++r) { const int row = row0 + r * ngw;
                if (row < T_) { const f32x4 y = v[r][j] * rstd[r] * gg + bb;
                    if (final_) ((f32x4*)(X + (size_t)row * D_))[lane + 64 * j] = y;
                    else { u32x2 w; w.x = pk2(y[0], y[1]); w.y = pk2(y[2], y[3]); ((u32x2*)(XB + (size_t)row * D_))[lane + 64 * j] = w; } } }
        }
    }
}

__device__ __forceinline__ void attn_unit(LAS unsigned char* L, const bf16_t* Z, int unit, const float* sinks, bf16_t* O, float* DPO, float* DLSE, int tid, int wave, int lane) {
    int qcol, kcol, vcol, base, blk, dil, max_dist, grp = 0, hh = 0; float slope_u, sink = 0.f; bool isA;
    if (unit < 1024) {
        isA = true; blk = unit & 31; const int head = (unit >> 5) & 7, b = unit >> 8, kvh = head >> 2;
        qcol = ZQA + head * 64; kcol = ZKA + kvh * 64; vcol = ZVA + kvh * 64; base = b * SEQ_; dil = 1; max_dist = 127;
        slope_u = __builtin_amdgcn_exp2f(-8.0f * (float)(head + 1) / 20.0f); sink = sinks[head]; hh = head;
    } else {
        isA = false; const int u2 = unit - 1024; grp = u2 >> 9; const int u3 = u2 & 511;
        dil = (grp == 0) ? 1 : (grp == 1 ? 4 : 16); const int nbk = 32 / dil;
        blk = u3 % nbk; const int r = (u3 / nbk) % dil; hh = (u3 / 32) & 3; const int b = u3 >> 7;
        qcol = ZQD + grp * 256 + hh * 64; kcol = ZKD + grp * 256 + hh * 64; vcol = ZVD + grp * 256 + hh * 64; base = b * SEQ_ + r; max_dist = 128;
        slope_u = __builtin_amdgcn_exp2f(-8.0f * (float)(8 + 4 * grp + hh + 1) / 20.0f) * (float)dil;
    }
    LAS bf16_t* Qs = (LAS bf16_t*)L;
    LAS bf16_t* Ks = Qs + 128 * 72;
    LAS bf16_t* Vs = Ks + 272 * 72;
    for (int i = tid; i < 1024; i += 512) { const int r = i >> 3, c = i & 7; const size_t tok = (size_t)(base + (blk * 128 + r) * dil);
        *(LAS u32x4*)(Qs + r * 72 + c * 8) = *(const u32x4*)(Z + tok * NZ_ + qcol + c * 8); }
    {
        u32x4 kv[5], vv[5];
#pragma unroll
        for (int it = 0; it < 5; ++it) { const int i = tid + it * 512; const int r = i >> 3, c = i & 7; const int sub = blk * 128 - 128 + r; const bool ok = (i < 2176) && (r < 256) && (sub >= 0);
            kv[it] = (u32x4){0u, 0u, 0u, 0u}; vv[it] = (u32x4){0u, 0u, 0u, 0u};
            if (ok) { const size_t tok = (size_t)(base + sub * dil); kv[it] = *(const u32x4*)(Z + tok * NZ_ + kcol + c * 8); vv[it] = *(const u32x4*)(Z + tok * NZ_ + vcol + c * 8); } }
#pragma unroll
        for (int it = 0; it < 5; ++it) { const int i = tid + it * 512; const int r = i >> 3, c = i & 7;
            if (i < 2176) {
                *(LAS u32x4*)(Ks + r * 72 + c * 8) = kv[it];
                *(LAS u32x4*)(Vs + r * 72 + c * 8) = vv[it]; } }
    }
    __syncthreads();
    const int q0 = wave * 16, qi = lane & 15, g = lane >> 4;
    bf16x8 bq[2];
#pragma unroll
    for (int ks = 0; ks < 2; ++ks) bq[ks] = *(const LAS bf16x8*)(Qs + (q0 + qi) * 72 + ks * 32 + g * 8);
    f32x4 st[10];
#pragma unroll
    for (int i = 0; i < 10; ++i) { f32x4 acc = {0.f, 0.f, 0.f, 0.f};
#pragma unroll
        for (int ks = 0; ks < 2; ++ks) { const bf16x8 ak = *(const LAS bf16x8*)(Ks + ((wave + i) * 16 + qi) * 72 + ks * 32 + g * 8); acc = mfma16(ak, bq[ks], acc); }
        st[i] = acc; }
    float mx = -3.0e38f;
    const int q = q0 + qi;
#pragma unroll
    for (int i = 0; i < 10; ++i)
#pragma unroll
        for (int j = 0; j < 4; ++j) { const int kk = (wave + i) * 16 + 4 * g + j; const int dist = q + 128 - kk;
            const bool valid = (dist >= 0) && (dist <= max_dist) && (blk > 0 || kk >= 128);
            const float s = valid ? (st[i][j] * 0.125f - slope_u * (float)dist) : -1.0e30f; st[i][j] = s; mx = fmaxf(mx, s); }
    mx = fmaxf(mx, __shfl_xor(mx, 16)); mx = fmaxf(mx, __shfl_xor(mx, 32));
    if (isA) mx = fmaxf(mx, sink);
    float den = 0.f;
#pragma unroll
    for (int i = 0; i < 10; ++i)
#pragma unroll
        for (int j = 0; j < 4; ++j) { const float p = __builtin_amdgcn_exp2f((st[i][j] - mx) * LOG2E); st[i][j] = p; den += p; }
    den += __shfl_xor(den, 16); den += __shfl_xor(den, 32);
    if (isA) den += __builtin_amdgcn_exp2f((sink - mx) * LOG2E);
    f32x4 o[4];
#pragma unroll
    for (int ht = 0; ht < 4; ++ht) o[ht] = (f32x4){0.f, 0.f, 0.f, 0.f};
    const LAS bf16_t* vbase = Vs + (wave * 16 + 4 * g + (qi >> 2)) * 72 + 4 * (qi & 3);
#pragma unroll
    for (int i = 0; i < 5; ++i) {
        u32x4 pw; pw.x = pk2(st[2 * i][0], st[2 * i][1]); pw.y = pk2(st[2 * i][2], st[2 * i][3]); pw.z = pk2(st[2 * i + 1][0], st[2 * i + 1][1]); pw.w = pk2(st[2 * i + 1][2], st[2 * i + 1][3]);
        const bf16x8 bp = __builtin_bit_cast(bf16x8, pw);
#pragma unroll
        for (int ht = 0; ht < 4; ++ht) { const LAS bf16_t* vr = vbase + (2 * i * 16) * 72 + ht * 16;
            const u32x2 va = tr16(vr), vb = tr16(vr + 16 * 72);
            o[ht] = mfma16(mk8(va, vb), bp, o[ht]); } }
    const float inv = 1.0f / den;
    const size_t tok = (size_t)(base + (blk * 128 + q) * dil);
    if (isA) {
#pragma unroll
        for (int ht = 0; ht < 4; ++ht) { u32x2 w; w.x = pk2(o[ht][0] * inv, o[ht][1] * inv); w.y = pk2(o[ht][2] * inv, o[ht][3] * inv);
            *(u32x2*)(O + tok * NO_ + hh * 64 + ht * 16 + 4 * g) = w; }
    } else {
#pragma unroll
        for (int ht = 0; ht < 4; ++ht) *(f32x4*)(DPO + ((size_t)grp * T_ + tok) * 256 + hh * 64 + ht * 16 + 4 * g) = o[ht] * inv;
        if (g == 0) DLSE[((size_t)grp * T_ + tok) * 4 + hh] = mx + logf(den);
    }
    __syncthreads();
}

__device__ __forceinline__ void gmlp_unit(LAS unsigned char* L, const bf16_t* Z, int unit, const float* lng, const float* lnb, const float* ws_, const float* bs, bf16_t* O, int tid, int wave, int lane) {
    const int n = unit >> 2, grp = unit & 3, tok0 = n * 128;
    LAS float* stats = (LAS float*)L;
    LAS bf16_t* vnt = (LAS bf16_t*)(L + 1024);
    LAS bf16_t* Wc = vnt + 128 * 136;
    {
        u32x4 raw[16];
#pragma unroll
        for (int r = 0; r < 16; ++r) raw[r] = *(const u32x4*)(Z + (size_t)(tok0 + 16 * wave + r) * NZ_ + ZVB + lane * 8);
        float s[16], ss[16];
#pragma unroll
        for (int r = 0; r < 16; ++r) { const float x0 = bflo(raw[r].x), x1 = bfhi(raw[r].x), x2 = bflo(raw[r].y), x3 = bfhi(raw[r].y), x4 = bflo(raw[r].z), x5 = bfhi(raw[r].z), x6 = bflo(raw[r].w), x7 = bfhi(raw[r].w);
            s[r] = ((x0 + x1) + (x2 + x3)) + ((x4 + x5) + (x6 + x7)); ss[r] = ((x0 * x0 + x1 * x1) + (x2 * x2 + x3 * x3)) + ((x4 * x4 + x5 * x5) + (x6 * x6 + x7 * x7)); }
#pragma unroll
        for (int o = 1; o < 64; o <<= 1) {
#pragma unroll
            for (int r = 0; r < 16; ++r) { s[r] += __shfl_xor(s[r], o); ss[r] += __shfl_xor(ss[r], o); } }
        if (lane < 16) { float m = 0.f, q = 0.f;
#pragma unroll
            for (int r = 0; r < 16; ++r) if (lane == r) { m = s[r]; q = ss[r]; }
            m *= (1.f / 512.f); const float var = fmaxf(q * (1.f / 512.f) - m * m, 0.f);
            stats[(16 * wave + lane) * 2] = m; stats[(16 * wave + lane) * 2 + 1] = 1.f / sqrtf(var + LN_EPS); }
    }
#pragma unroll
    for (int it = 0; it < 8; ++it) { const int i = tid + it * 512; const int t = i >> 5, s4 = (i & 31) * 4;
        f32x4 w = *(const f32x4*)(ws_ + (size_t)(grp * 128 + t) * 128 + s4);
#pragma unroll
        for (int e = 0; e < 4; ++e) if (s4 + e > t) w[e] = 0.f;
        u32x2 p; p.x = pk2(w[0], w[1]); p.y = pk2(w[2], w[3]); *(LAS u32x2*)(Wc + t * 136 + s4) = p; }
    u32x4 vraw[4];
#pragma unroll
    for (int it = 0; it < 4; ++it) { const int i = tid + it * 512; const int s = i >> 4, c8 = (i & 15) * 8;
        vraw[it] = *(const u32x4*)(Z + (size_t)(tok0 + s) * NZ_ + ZVB + grp * 128 + c8); }
    __syncthreads();
#pragma unroll
    for (int it = 0; it < 4; ++it) { const int i = tid + it * 512; const int s = i >> 4, c8 = (i & 15) * 8;
        const u32x4 raw = vraw[it];
        const float mean = stats[s * 2], rstd = stats[s * 2 + 1];
        float x[8]; x[0] = bflo(raw.x); x[1] = bfhi(raw.x); x[2] = bflo(raw.y); x[3] = bfhi(raw.y); x[4] = bflo(raw.z); x[5] = bfhi(raw.z); x[6] = bflo(raw.w); x[7] = bfhi(raw.w);
        const f32x4 g0 = *(const f32x4*)(lng + grp * 128 + c8), g1 = *(const f32x4*)(lng + grp * 128 + c8 + 4), b0 = *(const f32x4*)(lnb + grp * 128 + c8), b1 = *(const f32x4*)(lnb + grp * 128 + c8 + 4);
        float y[8];
#pragma unroll
        for (int e = 0; e < 8; ++e) y[e] = (x[e] - mean) * rstd * (e < 4 ? g0[e & 3] : g1[e & 3]) + (e < 4 ? b0[e & 3] : b1[e & 3]);
        u32x4 w; w.x = pk2(y[0], y[1]); w.y = pk2(y[2], y[3]); w.z = pk2(y[4], y[5]); w.w = pk2(y[6], y[7]);
        *(LAS u32x4*)(vnt + s * 136 + c8) = w; }
    __syncthreads();
    const int qi = lane & 15, g = lane >> 4;
    const int t = 16 * wave + qi; const float bias = bs[grp * 128 + t];
    const size_t tok = (size_t)(tok0 + t);
    u32x2 ur[8];
#pragma unroll
    for (int ct = 0; ct < 8; ++ct) ur[ct] = *(const u32x2*)(Z + tok * NZ_ + ZUB + grp * 128 + 16 * ct + 4 * g);
    f32x4 acc[8];
#pragma unroll
    for (int ct = 0; ct < 8; ++ct) acc[ct] = (f32x4){0.f, 0.f, 0.f, 0.f};
#pragma unroll
    for (int ks = 0; ks < 4; ++ks) { const bf16x8 bw = *(const LAS bf16x8*)(Wc + (16 * wave + qi) * 136 + ks * 32 + g * 8);
#pragma unroll
        for (int ct = 0; ct < 8; ++ct) { const LAS bf16_t* vr = vnt + (ks * 32 + 8 * g + (qi >> 2)) * 136 + 16 * ct + 4 * (qi & 3);
            acc[ct] = mfma16(mk8(tr16(vr), tr16(vr + 4 * 136)), bw, acc[ct]); } }
#pragma unroll
    for (int ct = 0; ct < 8; ++ct) { const int c = 16 * ct + 4 * g;
        u32x2 w; w.x = pk2(bflo(ur[ct].x) * (acc[ct][0] + bias), bfhi(ur[ct].x) * (acc[ct][1] + bias));
        w.y = pk2(bflo(ur[ct].y) * (acc[ct][2] + bias), bfhi(ur[ct].y) * (acc[ct][3] + bias));
        *(u32x2*)(O + tok * NO_ + 512 + grp * 128 + c) = w; }
    __syncthreads();
}

__device__ __forceinline__ float hgrn_lb(const float* lbl, int layer, int c) { return layer == 0 ? 0.0f : 1.0f / (1.0f + expf(lbl[c] - lbl[512 + c])); }

__device__ __forceinline__ void hgrn_c1_unit(LAS unsigned char* L, const bf16_t* Z, int unit, const float* lbl, int layer, float* DS, float* DEC, int tid, int wave, int lane) {
    const int h = unit & 3, cg_ = unit >> 2, tok0 = cg_ * 64;
    const int k = tid & 127, qtr = tid >> 7;
    LAS float* qsum = (LAS float*)L;
    LAS bf16_t* kt = (LAS bf16_t*)(L + 2048);
    LAS bf16_t* vt = kt + 128 * 72;
    const float lb = hgrn_lb(lbl, layer, h * 128 + k);
    float G[16], kk[16]; float run = 0.f;
    unsigned vraw[16];
#pragma unroll
    for (int i = 0; i < 16; ++i) { const size_t tok = (size_t)(tok0 + 16 * qtr + i);
        const float zf = bf2f(Z[tok * NZ_ + ZFC + h * 128 + k]);
        vraw[i] = Z[tok * NZ_ + ZIC + h * 128 + k];
        const float e = fexp(-zf), sg = frcp(1.0f + e);
        const float f = lb + (1.0f - lb) * sg;
        run += logf(fmaxf(f, 1e-6f)); G[i] = run; kk[i] = (1.0f - lb) * e * sg; }
    qsum[qtr * 128 + k] = run;
    __syncthreads();
    float off = 0.f, tot = 0.f;
#pragma unroll
    for (int qq = 0; qq < 4; ++qq) { const float v = qsum[qq * 128 + k]; tot += v; if (qq < qtr) off += v; }
    unsigned kw[8], vw[8];
#pragma unroll
    for (int i = 0; i < 8; ++i) { const float a0 = kk[2 * i] * fexp(tot - (G[2 * i] + off)), a1 = kk[2 * i + 1] * fexp(tot - (G[2 * i + 1] + off));
        kw[i] = pk2(a0, a1); vw[i] = vraw[2 * i] | (vraw[2 * i + 1] << 16); }
    *(LAS u32x4*)(kt + k * 72 + 16 * qtr) = (u32x4){kw[0], kw[1], kw[2], kw[3]}; *(LAS u32x4*)(kt + k * 72 + 16 * qtr + 8) = (u32x4){kw[4], kw[5], kw[6], kw[7]};
    *(LAS u32x4*)(vt + k * 72 + 16 * qtr) = (u32x4){vw[0], vw[1], vw[2], vw[3]}; *(LAS u32x4*)(vt + k * 72 + 16 * qtr + 8) = (u32x4){vw[4], vw[5], vw[6], vw[7]};
    if (qtr == 0) DEC[(size_t)unit * 128 + k] = fexp(tot);
    __syncthreads();
    const int qi = lane & 15, g = lane >> 4;
    bf16x8 av[2];
#pragma unroll
    for (int ks = 0; ks < 2; ++ks) av[ks] = *(const LAS bf16x8*)(vt + (16 * wave + qi) * 72 + ks * 32 + g * 8);
    float* dst = DS + (size_t)unit * 16384;
#pragma unroll
    for (int ktile = 0; ktile < 8; ++ktile) { f32x4 acc = {0.f, 0.f, 0.f, 0.f};
#pragma unroll
        for (int ks = 0; ks < 2; ++ks) { const bf16x8 bk = *(const LAS bf16x8*)(kt + (16 * ktile + qi) * 72 + ks * 32 + g * 8); acc = mfma16(av[ks], bk, acc); }
#pragma unroll
        for (int j = 0; j < 4; ++j) dst[(16 * wave + 4 * g + j) * 128 + 16 * ktile + qi] = acc[j]; }
    __syncthreads();
}

__device__ __forceinline__ void hgrn_scan_phase(const float* DS, const float* DEC, bf16_t* HS, int tid, int bid, int G) {
    const int nth = G * 512;
    for (int p = bid * 512 + tid; p < 16 * 8192; p += nth) {
        const int bh = p >> 13, idx = (p & 8191) * 2, k = idx & 127, b = bh >> 2, h = bh & 3;
        f32x2 S = {0.f, 0.f};
#pragma unroll 16
        for (int c = 0; c < 64; ++c) { const size_t u = (size_t)(((b * 64 + c) << 2) | h);
            *(unsigned*)(HS + u * 16384 + idx) = pk2(S[0], S[1]);
            const f32x2 d = *(const f32x2*)(DEC + u * 128 + k), ds = *(const f32x2*)(DS + u * 16384 + idx);
            S = d * S + ds; }
    }
}

__device__ __forceinline__ void hgrn_c3_unit(LAS unsigned char* L, const bf16_t* Z, int unit, const float* lbl, int layer, const bf16_t* HS, const float* ng, bf16_t* O, int tid, int wave, int lane) {
    const int h = unit & 3, cg_ = unit >> 2, tok0 = cg_ * 64;
    const int k = tid & 127, qtr = tid >> 7;
    LAS float* qsum = (LAS float*)L;
    LAS bf16_t* kT = (LAS bf16_t*)(L + 2048);
    LAS bf16_t* qT = kT + 128 * 72;
    LAS bf16_t* qC = qT + 128 * 72;
    LAS bf16_t* vt = qC + 128 * 72;
    LAS float* oL = (LAS float*)(L + 2048 + 4 * 128 * 72 * 2);
    const float lb = hgrn_lb(lbl, layer, h * 128 + k);
    float G[16], kk[16], qv[16]; float run = 0.f;
    unsigned vraw[16];
#pragma unroll
    for (int i = 0; i < 16; ++i) { const size_t tok = (size_t)(tok0 + 16 * qtr + i);
        const float zf = bf2f(Z[tok * NZ_ + ZFC + h * 128 + k]);
        qv[i] = bf2f(Z[tok * NZ_ + ZQC + h * 128 + k]);
        vraw[i] = Z[tok * NZ_ + ZIC + h * 128 + k];
        const float e = fexp(-zf), sg = frcp(1.0f + e);
        const float f = lb + (1.0f - lb) * sg;
        run += logf(fmaxf(f, 1e-6f)); G[i] = run; kk[i] = (1.0f - lb) * e * sg; }
    qsum[qtr * 128 + k] = run;
    __syncthreads();
    float off = 0.f;
#pragma unroll
    for (int qq = 0; qq < 4; ++qq) { const float v = qsum[qq * 128 + k]; if (qq < qtr) off += v; }
    const float Gm = qsum[k] + qsum[128 + k];
    {
        unsigned kw[8], qw[8], cw[8];
#pragma unroll
        for (int i = 0; i < 8; ++i) { float a[2], b[2], c[2];
#pragma unroll
            for (int e = 0; e < 2; ++e) { const float Gi = G[2 * i + e] + off; const float d = fminf(fmaxf(Gi - Gm, -80.f), 80.f);
                a[e] = kk[2 * i + e] * fexp(-d); b[e] = qv[2 * i + e] * fexp(d); c[e] = qv[2 * i + e] * fexp(Gi); }
            kw[i] = pk2(a[0], a[1]); qw[i] = pk2(b[0], b[1]); cw[i] = pk2(c[0], c[1]); }
        *(LAS u32x4*)(kT + k * 72 + 16 * qtr) = (u32x4){kw[0], kw[1], kw[2], kw[3]}; *(LAS u32x4*)(kT + k * 72 + 16 * qtr + 8) = (u32x4){kw[4], kw[5], kw[6], kw[7]};
        *(LAS u32x4*)(qT + k * 72 + 16 * qtr) = (u32x4){qw[0], qw[1], qw[2], qw[3]}; *(LAS u32x4*)(qT + k * 72 + 16 * qtr + 8) = (u32x4){qw[4], qw[5], qw[6], qw[7]};
        *(LAS u32x4*)(qC + k * 72 + 16 * qtr) = (u32x4){cw[0], cw[1], cw[2], cw[3]}; *(LAS u32x4*)(qC + k * 72 + 16 * qtr + 8) = (u32x4){cw[4], cw[5], cw[6], cw[7]};
    }
    {
        unsigned vw[8];
#pragma unroll
        for (int i = 0; i < 8; ++i) vw[i] = vraw[2 * i] | (vraw[2 * i + 1] << 16);
        *(LAS u32x4*)(vt + k * 72 + 16 * qtr) = (u32x4){vw[0], vw[1], vw[2], vw[3]}; *(LAS u32x4*)(vt + k * 72 + 16 * qtr + 8) = (u32x4){vw[4], vw[5], vw[6], vw[7]};
    }
    __syncthreads();
    const int qi = lane & 15, g = lane >> 4, tt = wave & 3, vh = wave >> 2;
    const bf16_t* hs = HS + (size_t)unit * 16384;
    bf16x8 ahs[4][4];
#pragma unroll
    for (int ks = 0; ks < 4; ++ks)
#pragma unroll
        for (int v_ = 0; v_ < 4; ++v_) ahs[ks][v_] = *(const bf16x8*)(hs + (16 * (4 * vh + v_) + qi) * 128 + ks * 32 + g * 8);
    unsigned graw[8][2];
#pragma unroll
    for (int r = 0; r < 8; ++r) { const size_t tok = (size_t)(tok0 + 8 * wave + r); graw[r][0] = Z[tok * NZ_ + ZGC + h * 128 + lane]; graw[r][1] = Z[tok * NZ_ + ZGC + h * 128 + 64 + lane]; }
    f32x4 sc[4];
#pragma unroll
    for (int st = 0; st < 4; ++st) { sc[st] = (f32x4){0.f, 0.f, 0.f, 0.f};
        if (st <= tt) {
#pragma unroll
            for (int ks = 0; ks < 4; ++ks) { const int ro = (ks * 32 + 8 * g + (qi >> 2)) * 72 + 4 * (qi & 3);
                const bf16x8 a = mk8(tr16(kT + ro + 16 * st), tr16(kT + ro + 4 * 72 + 16 * st)), b = mk8(tr16(qT + ro + 16 * tt), tr16(qT + ro + 4 * 72 + 16 * tt));
                sc[st] = mfma16(a, b, sc[st]); }
#pragma unroll
            for (int j = 0; j < 4; ++j) if (16 * st + 4 * g + j > 16 * tt + qi) sc[st][j] = 0.f;
        } }
    f32x4 o[4];
#pragma unroll
    for (int v_ = 0; v_ < 4; ++v_) o[v_] = (f32x4){0.f, 0.f, 0.f, 0.f};
#pragma unroll
    for (int i = 0; i < 2; ++i) {
        u32x4 pw; pw.x = pk2(sc[2 * i][0], sc[2 * i][1]); pw.y = pk2(sc[2 * i][2], sc[2 * i][3]); pw.z = pk2(sc[2 * i + 1][0], sc[2 * i + 1][1]); pw.w = pk2(sc[2 * i + 1][2], sc[2 * i + 1][3]);
        const bf16x8 bp = __builtin_bit_cast(bf16x8, pw);
#pragma unroll
        for (int v_ = 0; v_ < 4; ++v_) { const LAS bf16_t* vr = vt + (16 * (4 * vh + v_) + qi) * 72 + 4 * g;
            const u32x2 va = *(const LAS u32x2*)(vr + (2 * i) * 16), vb = *(const LAS u32x2*)(vr + (2 * i + 1) * 16);
            o[v_] = mfma16(mk8(va, vb), bp, o[v_]); } }
#pragma unroll
    for (int ks = 0; ks < 4; ++ks) { const int ro = (ks * 32 + 8 * g + (qi >> 2)) * 72 + 4 * (qi & 3) + 16 * tt; const bf16x8 b = mk8(tr16(qC + ro), tr16(qC + ro + 4 * 72));
#pragma unroll
        for (int v_ = 0; v_ < 4; ++v_) o[v_] = mfma16(ahs[ks][v_], b, o[v_]); }
#pragma unroll
    for (int v_ = 0; v_ < 4; ++v_) *(LAS f32x4*)(oL + (16 * tt + qi) * 132 + 16 * (4 * vh + v_) + 4 * g) = o[v_];
    __syncthreads();
    const float ng0 = ng[h * 128 + lane], ng1 = ng[h * 128 + 64 + lane];
#pragma unroll
    for (int r = 0; r < 8; ++r) { const int t = 8 * wave + r;
        const float x0 = oL[t * 132 + lane], x1 = oL[t * 132 + 64 + lane];
        const float ss = wave_sum(x0 * x0 + x1 * x1);
        const float rs = 1.0f / sqrtf(ss * (1.f / 128.f) + LN_EPS);
        const size_t tok = (size_t)(tok0 + t);
        const float g0 = bf2f(graw[r][0]), g1 = bf2f(graw[r][1]);
        const float y0 = x0 * rs * ng0 * fsigmoid(g0), y1 = x1 * rs * ng1 * fsigmoid(g1);
        O[tok * NO_ + 1024 + h * 128 + lane] = (bf16_t)(pk2(y0, 0.f) & 0xffffu);
        O[tok * NO_ + 1024 + h * 128 + 64 + lane] = (bf16_t)(pk2(y1, 0.f) & 0xffffu); }
    __syncthreads();
}

__device__ __forceinline__ void dcomb_phase(const float* DPO, const float* DLSE, bf16_t* O, int tid, int bid, int G) {
    const int nth = G * 512;
#pragma unroll 4
    for (int i = bid * 512 + tid; i < T_ * 64; i += nth) { const int t = i >> 6, c4 = (i & 63) * 4, h = c4 >> 6;
        const float l0 = DLSE[((size_t)0 * T_ + t) * 4 + h], l1 = DLSE[((size_t)1 * T_ + t) * 4 + h], l2 = DLSE[((size_t)2 * T_ + t) * 4 + h];
        const float m = fmaxf(l0, fmaxf(l1, l2));
        float w0 = fexp(l0 - m), w1 = fexp(l1 - m), w2 = fexp(l2 - m); const float inv = 1.0f / (w0 + w1 + w2); w0 *= inv; w1 *= inv; w2 *= inv;
        const f32x4 a = *(const f32x4*)(DPO + ((size_t)0 * T_ + t) * 256 + c4), b = *(const f32x4*)(DPO + ((size_t)1 * T_ + t) * 256 + c4), c = *(const f32x4*)(DPO + ((size_t)2 * T_ + t) * 256 + c4);
        const f32x4 r = w0 * a + w1 * b + w2 * c;
        u32x2 w; w.x = pk2(r[0], r[1]); w.y = pk2(r[2], r[3]);
        *(u32x2*)(O + (size_t)t * NO_ + 1536 + c4) = w; }
}

constexpr int NPH_LAYER = 14, NPH = 2 * NPH_LAYER;
__global__ void __launch_bounds__(512, 2) hybrid_fwd(Args a) {
    extern __shared__ __attribute__((aligned(16))) unsigned char lds_raw[];
    LAS unsigned char* lds = (LAS unsigned char*)lds_raw;
    PTab pt = (PTab)(lds + 131072);
    if (threadIdx.x == 0) {
#pragma unroll
        for (int i = 0; i < 22; ++i) pt[i] = (unsigned long long)a.in[i];
        pt[22] = (unsigned long long)a.out; pt[23] = (unsigned long long)a.ws;
    }
    if (threadIdx.x < 8) ((LAS unsigned*)(lds + 131072 + 512))[threadIdx.x] = 0u;
    __syncthreads();
    const int ph_lo = a.ph_lo, ph_hi = a.ph_hi;
    unsigned pepoch = 0u; bool fast = false;
    if (threadIdx.x == 0 && blockIdx.x < 8) __hip_atomic_store((unsigned*)(a.ws + WS_CTL + WS_BAR + 15400) + blockIdx.x, xb_xcc_id(), __ATOMIC_RELAXED, __HIP_MEMORY_SCOPE_AGENT);
    XcdBarrier bar = xcd_barrier_post((unsigned*)(a.ws + WS_CTL + WS_BAR), (volatile LAS unsigned*)(lds + 131072 + 512));
    for (int ph = ph_lo; ph < ph_hi; ++ph) {
        const int l = ph / NPH_LAYER, p = ph - l * NPH_LAYER;
        pg8::StaticOrder S;
        int tid = threadIdx.x; asm volatile("" : "+v"(tid));
        int bid = blockIdx.x, G = gridDim.x; asm volatile("" : "+s"(bid), "+s"(G));
        const int lane = tid & 63, wave = __builtin_amdgcn_readfirstlane(tid >> 6);
        unsigned char* ws = (unsigned char*)ldptr(pt, 23);
#define P_X ((float*)ldptr(pt, 22))
#define P_XB ((bf16_t*)(ws + WS_XB))
#define P_ZH ((bf16_t*)(ws + WS_ZH))
#define P_GATE ((bf16_t*)(ws + WS_GATE))
#define P_O ((bf16_t*)(ws + WS_O))
#define P_DS ((float*)(ws + WS_GATE + 192 * MiB))
#define P_MRG ((bf16_t*)(ws + WS_DS))
#define P_DEC ((float*)(ws + WS_CTL))
#define P_HS ((bf16_t*)(ws + WS_HS))
#define P_DPO ((float*)(ws + WS_DPO))
#define P_DLSE ((float*)(ws + WS_DLSE))
        switch (p) {
        case 0: if (l == 0) convert_phase(pt, 0, lds, tid, wave, lane, bid, G); break;
        case 1: case 11: {
            const int s = (p == 1) ? 0 : 1; const int n_ = (p == 1) ? 2 * FF_ : 2 * FF_ + D_;
            pg8::Gemm g{P_XB, (const bf16_t*)(ws + WS_WGU + (size_t)s * 44 * MiB), T_, n_, D_}; S.init(T_, n_, G, bid);
            pg8::EpiSwiGLU E{p == 1 ? P_O : P_ZH, P_GATE}; pg8::gemm_phase(lds, g, S, E);
        } break;
        case 2: {
            pg8::Gemm g{P_O, (const bf16_t*)(ws + WS_WD), T_, D_, FF_}; S.init(T_, D_, G, bid);
            pg8::EpiResidT<false> E{P_X, P_XB, nullptr, ALPHA, 0.5f}; pg8::gemm_phase<pg8::EpiResidT<false>, true>(lds, g, S, E);
        } break;
        case 3: case 10: case 13: {
            const int which = (p == 3) ? 0 : (p == 10 ? 1 : 2);
            if (fast) ln_phase(P_X, P_XB, ldptr(pt, 2) + (size_t)(l * 3 + which) * D_, ldptr(pt, 3) + (size_t)(l * 3 + which) * D_, (l == 1 && p == 13), (8 * (bid & 7) + ((bid >> 3) & 7)) * 256 + (bid >> 6) * 64 + wave * 8, 1, 4, 2, lane);
            else ln_phase(P_X, P_XB, ldptr(pt, 2) + (size_t)(l * 3 + which) * D_, ldptr(pt, 3) + (size_t)(l * 3 + which) * D_, (l == 1 && p == 13), bid * 8 + wave, G * 8, 32 * G, (T_ + 32 * G - 1) / (32 * G), lane);
            if (p == 13 && l == 0) convert_phase(pt, 1, lds, tid, wave, lane, bid, G);
            if (p == 10) { int kp = PLE_; asm volatile("" : "+s"(kp)); pg8::Gemm g2{(const bf16_t*)(ws + WS_PB) + (size_t)l * T_ * PLE_, (const bf16_t*)(ws + WS_WPP), T_, D_, kp}; S.init(T_, D_, G, bid);
                pg8::EpiBf16 E2{P_GATE, D_}; pg8::gemm_phase(lds, g2, S, E2); }
        } break;
        case 4: {
            pg8::Gemm g{P_XB, (const bf16_t*)(ws + WS_WIN), T_, NZ_, D_}; S.init(T_, NZ_, G, bid);
            pg8::EpiZ E{P_ZH, P_GATE, 0}; pg8::gemm_phase(lds, g, S, E);
            if (fast) { panel_barrier((unsigned*)(ws + WS_CTL + WS_BAR + 16384) + 64 * (8 * (bid & 7) + ((bid >> 3) & 7)), pepoch);
                for (int h_ = 0; h_ < 4; ++h_) hgrn_c1_unit(lds, P_ZH, (((8 * (bid & 7) + ((bid >> 3) & 7)) * 4 + (bid >> 6)) << 2) | h_, ldptr(pt, 13), l, P_DS, P_DEC, tid, wave, lane); }
            else { xcd_barrier(bar); for (int u = bid; u < 1024; u += G) hgrn_c1_unit(lds, P_ZH, u, ldptr(pt, 13), l, P_DS, P_DEC, tid, wave, lane); }
        } break;
        case 5: {
            hgrn_scan_phase(P_DS, P_DEC, P_HS, tid, bid, G);
            for (int u = bid; u < 2560; u += G) attn_unit(lds, P_ZH, u, ldptr(pt, 8) + l * 8, P_O, P_DPO, P_DLSE, tid, wave, lane);
            for (int u = bid; u < 512; u += G) gmlp_unit(lds, P_ZH, u, ldptr(pt, 9) + l * 512, ldptr(pt, 10) + l * 512, ldptr(pt, 11) + (size_t)l * 65536, ldptr(pt, 12) + l * 512, P_O, tid, wave, lane);
        } break;
        case 6: break;
        case 7: {
            for (int u = bid; u < 1024; u += G) hgrn_c3_unit(lds, P_ZH, u, ldptr(pt, 13), l, P_HS, ldptr(pt, 14) + l * 512, P_O, tid, wave, lane);
            dcomb_phase(P_DPO, P_DLSE, P_O, tid, bid, G);
        } break;
        case 8: {
            { pg8::Gemm gg{P_XB, (const bf16_t*)(ws + WS_WIN) + (size_t)NZ_ * D_, T_, NGT_, D_}; S.init(T_, NGT_, G, bid);
              pg8::EpiZ Eg{P_ZH, P_GATE, 24}; pg8::gemm_phase(lds, gg, S, Eg); }
            if (fast) panel_barrier((unsigned*)(ws + WS_CTL + WS_BAR + 16384) + 64 * (8 * (bid & 7) + ((bid >> 3) & 7)), pepoch); else xcd_barrier(bar);
            pg8::Gemm g{P_O, (const bf16_t*)(ws + WS_WBR), T_, D_, NO_}; S.init(T_, D_, G, bid);
            pg8::EpiBR E{P_MRG, P_GATE}; pg8::gemm_phase(lds, g, S, E);
        } break;
        case 9: {
            pg8::Gemm g{P_MRG, (const bf16_t*)(ws + WS_WOUT), T_, D_, D_}; S.init(T_, D_, G, bid);
            pg8::EpiResidT<false> E{P_X, P_XB, nullptr, ALPHA, 1.0f}; pg8::gemm_phase(lds, g, S, E);
        } break;
        case 12: {
            pg8::Gemm g{P_ZH, (const bf16_t*)(ws + WS_WD + (size_t)22 * MiB), T_, D_, FF_}; S.init(T_, D_, G, bid);
            pg8::EpiResidT<true> E{P_X, P_XB, P_GATE, ALPHA, 0.5f}; pg8::gemm_phase<pg8::EpiResidT<true>, true>(lds, g, S, E);
        } break;
        default: break;
        }
        if (ph + 1 < ph_hi && p != 6) {
            if (ph_hi > 1000) { __threadfence(); cg::this_grid().sync(); }
            else if (fast && (p == 2 || p == 3 || p == 8 || p == 9 || p == 10 || p == 11 || (l == 1 && (p == 1 || p == 12))))
                panel_barrier((unsigned*)(ws + WS_CTL + WS_BAR + 16384) + 64 * (8 * (bid & 7) + ((bid >> 3) & 7)), pepoch);
            else xcd_barrier(bar);
            if (ph == 0) { if (threadIdx.x == 0 && xb_xcc_id() != xb_ld((unsigned*)(ws + WS_CTL + WS_BAR + 15400) + (blockIdx.x & 7))) (void)xb_add((unsigned*)(ws + WS_CTL + WS_BAR + 15360), 1u); }
            if (ph == 1) fast = (G == 256) && (__builtin_amdgcn_readfirstlane(xb_ld((unsigned*)(ws + WS_CTL + WS_BAR + 15360))) == 0u);
        }
    }
}

extern "C" void kernel_launch(void* const* d_in, const int* in_sizes, int n_in, void* d_out, int out_size, void* d_ws, size_t ws_size, hipStream_t stream) {
    static int grid = 0;
    if (grid == 0) {
        if (n_in != 22 || out_size != T_ * D_ || ws_size < WS_END) { fprintf(stderr, "kernel_launch: unexpected shapes (n_in %d out %d ws %zu need %zu)\n", n_in, out_size, ws_size, (size_t)WS_END); grid = -1; return; }
        int dev = 0, cus = 0, per_cu = 0;
        hipGetDevice(&dev); hipDeviceGetAttribute(&cus, hipDeviceAttributeMultiprocessorCount, dev);
        if (hipFuncSetAttribute((const void*)hybrid_fwd, hipFuncAttributeMaxDynamicSharedMemorySize, LDS_BYTES) != hipSuccess) { fprintf(stderr, "kernel_launch: hipFuncSetAttribute failed\n"); grid = -1; return; }
        hipOccupancyMaxActiveBlocksPerMultiprocessor(&per_cu, (const void*)hybrid_fwd, 512, LDS_BYTES);
        (void)hipGetLastError();
        if (per_cu < 1) per_cu = 1;
        grid = cus * 1;
    }
    if (grid < 0) return;
    if (hipMemsetAsync((char*)d_ws + WS_CTL + WS_BAR, 0, BAR_BYTES, stream) != hipSuccess) { fprintf(stderr, "kernel_launch: memset failed\n"); return; }
    Args a{};
    for (int i = 0; i < 22; ++i) a.in[i] = (const float*)d_in[i];
    a.out = (float*)d_out; a.ws = (unsigned char*)d_ws; a.ph_lo = 0; a.ph_hi = NPH;
    void* args[] = {&a};
    hipError_t e = hipLaunchCooperativeKernel((const void*)hybrid_fwd, dim3(grid), dim3(512), args, LDS_BYTES, stream);
    if (e != hipSuccess) fprintf(stderr, "cooperative launch failed: %s (grid %d)\n", hipGetErrorString(e), grid);
}
```

```cpp
#include <hip/hip_runtime.h>
#include <hip/hip_cooperative_groups.h>
#include <cstdio>
#include <cstdint>
namespace cg = cooperative_groups;

#define LAS __attribute__((address_space(3)))
typedef unsigned short bf16_t;
typedef short bf16x8 __attribute__((ext_vector_type(8)));
typedef float f32x4 __attribute__((ext_vector_type(4)));
typedef float f32x2 __attribute__((ext_vector_type(2)));
typedef unsigned u32x4 __attribute__((ext_vector_type(4)));
typedef unsigned u32x2 __attribute__((ext_vector_type(2)));

constexpr int T_ = 16384, SEQ_ = 4096, D_ = 2048, FF_ = 5632, NIN_ = 14336, NZ_ = 6144, NGT_ = 8192, NO_ = 1792, PLE_ = 256;
constexpr int ZQA = 0, ZKA = 512, ZVA = 640, ZUB = 768, ZVB = 1280, ZQC = 1792, ZFC = 2304, ZIC = 2816, ZGC = 3328, ZQD = 3840, ZKD = 4608, ZVD = 5376;
constexpr float LN_EPS = 1e-5f;
constexpr float ALPHA = 1.41421356237f;
constexpr float LOG2E = 1.44269504089f;

constexpr size_t MiB = 1u << 20;
constexpr size_t WS_CTL = 0;
constexpr size_t WS_BAR = 768 * 1024, BAR_BYTES = 32768;
constexpr size_t WS_WGU = 1 * MiB;
constexpr size_t WS_WPG = WS_WGU + 88 * MiB;
constexpr size_t WS_WD = WS_WPG + 8 * MiB;
constexpr size_t WS_WIN = WS_WD + 44 * MiB;
constexpr size_t WS_WBR = WS_WIN + 56 * MiB;
constexpr size_t WS_WOUT = WS_WBR + 7 * MiB;
constexpr size_t WS_WPP = WS_WOUT + 8 * MiB;
constexpr size_t WS_PB = WS_WPP + 1 * MiB;
constexpr size_t WS_XB = WS_PB + 16 * MiB;
constexpr size_t WS_ZH = WS_XB + 64 * MiB;
constexpr size_t WS_GATE = WS_ZH + 192 * MiB;
constexpr size_t WS_O = WS_GATE + 256 * MiB;
constexpr size_t WS_HS = WS_O + 56 * MiB;
constexpr size_t WS_DPO = WS_HS + 32 * MiB;
constexpr size_t WS_DLSE = WS_DPO + 48 * MiB;
constexpr size_t WS_DS = WS_DLSE + 1 * MiB;
constexpr size_t WS_END = WS_DS + 64 * MiB;
static_assert(WS_HS == WS_O + 56 * MiB && WS_DPO == WS_HS + 32 * MiB && WS_DLSE == WS_DPO + 48 * MiB && WS_DS == WS_DLSE + 1 * MiB && WS_END - WS_O >= 176 * MiB, "FFN1's H [T][5632] bf16 (176 MiB) overlays the contiguous O | HS | DPO | DLSE | dS span");

constexpr int LDS_BYTES = 147456;

__device__ __forceinline__ float bf2f(unsigned b) { return __uint_as_float(b << 16); }
__device__ __forceinline__ float bflo(unsigned w) { return __uint_as_float(w << 16); }
__device__ __forceinline__ float bfhi(unsigned w) { return __uint_as_float(w & 0xffff0000u); }
__device__ __forceinline__ unsigned pk2(float lo, float hi) { unsigned r; asm("v_cvt_pk_bf16_f32 %0, %1, %2" : "=v"(r) : "v"(lo), "v"(hi)); return r; }
__device__ __forceinline__ float fexp(float x) { return __builtin_amdgcn_exp2f(x * LOG2E); }
__device__ __forceinline__ float frcp(float x) { return __builtin_amdgcn_rcpf(x); }
__device__ __forceinline__ float fsigmoid(float x) { return frcp(1.0f + fexp(-x)); }
__device__ __forceinline__ float gelu_erf(float x) { return 0.5f * x * (1.0f + erff(x * 0.70710678118f)); }
__device__ __forceinline__ float gelu_fast(float v) {
    const float av = fabsf(v), t = frcp(av * 0.2316418882f + 1.0f);
    float q = t * 0.5307027145f + (-0.7265760135f); q = q * t + 0.7107068705f; q = q * t + (-0.142248368f); q = q * t + 0.127414796f; q = q * t;
    const float e = __builtin_amdgcn_exp2f((v * v) * (-0.72134752044f));
    const float m = v * (q * e);
    return v < 0.f ? m : v - m;
}
__device__ __forceinline__ float wave_sum(float v) {
#pragma unroll
    for (int o = 1; o < 64; o <<= 1) v += __shfl_xor(v, o);
    return v;
}
__device__ __forceinline__ f32x4 mfma16(bf16x8 a, bf16x8 b, f32x4 c) { return __builtin_amdgcn_mfma_f32_16x16x32_bf16(a, b, c, 0, 0, 0); }
typedef short s16x4 __attribute__((ext_vector_type(4)));
__device__ __forceinline__ u32x2 tr16(const LAS bf16_t* p) { const s16x4 r = __builtin_amdgcn_ds_read_tr16_b64_v4i16((LAS s16x4*)p); return __builtin_bit_cast(u32x2, r); }
__device__ __forceinline__ bf16x8 mk8(u32x2 a, u32x2 b) { u32x4 t = {a.x, a.y, b.x, b.y}; return __builtin_bit_cast(bf16x8, t); }

namespace pg8 {
constexpr int BM = 256, BK = 64, HALF = 128, HTB = HALF * BK * 2, STAGE_BYTES = 8 * HTB, NXCD = 8, WGM = 8;
__device__ __forceinline__ int lds_byte(int r, int c) { const int st = (r >> 4) * 2 + (c >> 5), rr = r & 15, cc = c & 31, ob = rr * 64 + cc * 2; return st * 1024 + (ob ^ (((ob >> 9) & 1) << 5)); }
__device__ __forceinline__ void stage_rc(int b, int& R, int& C) { const int st = b / 1024, sb = b % 1024, swz = sb ^ (((sb >> 9) & 1) << 5); R = (st >> 1) * 16 + swz / 64; C = (st & 1) * 32 + (swz % 64) / 2; }
__device__ __forceinline__ int perm32(int rho) { const int n = rho >> 4, i = rho & 15; return 8 * (i >> 2) + 4 * n + (i & 3); }
struct Unit { int pm, pn; };
struct Gemm { const bf16_t* A; const bf16_t* Bt; int M, N, K; };
struct StaticOrder {
    int nM, nN, nwg, G, c;
    __device__ void init(int M, int N, int G_, int c_) { nM = M / BM; nN = N / BM; nwg = nM * nN; G = G_; c = c_; }
    __device__ bool next(int i, Unit& u) const {
        const long L = (long)i * G + c; if (L >= nwg) return false;
        int wgid = (int)L; { const int q = nwg / NXCD, r = nwg % NXCD, xcd = wgid % NXCD, off = wgid / NXCD; wgid = (xcd < r ? xcd * (q + 1) : r * (q + 1) + (xcd - r) * q) + off; }
        const int nig = WGM * nN, gid = wgid / nig, fm = gid * WGM, gsz = (nM - fm) < WGM ? (nM - fm) : WGM;
        u.pm = fm + ((wgid % nig) % gsz); u.pn = (wgid % nig) / gsz; return true;
    }
};

struct EpiSwiGLU {
    static constexpr bool PERM = true, HAS_MID = false;
    bf16_t* H; bf16_t* PP;
    __device__ __forceinline__ void mid(int, f32x4 (&)[2][2][4][2], const Unit&, int, int, int, int) const {}
    __device__ __forceinline__ void operator()(const f32x4 (&acc)[2][2][4][2], const Unit& u, int wr, int wc, int fr, int fq) const {
        const int row0 = u.pm * BM + wr * 64 + fr;
        if (u.pn < 44) {
            const int col0 = u.pn * 128 + wc * 32 + 8 * fq;
#pragma unroll
            for (int ai = 0; ai < 2; ++ai)
#pragma unroll
                for (int m = 0; m < 4; ++m) {
                    bf16_t* rowp = H + (size_t)(row0 + ai * HALF + m * 16) * FF_ + col0;
                    float h[8];
#pragma unroll
                    for (int n = 0; n < 2; ++n)
#pragma unroll
                        for (int j = 0; j < 4; ++j) { const float g = acc[ai][0][m][n][j], up = acc[ai][1][m][n][j]; h[n * 4 + j] = g * fsigmoid(g) * up; }
                    u32x4 w; w.x = pk2(h[0], h[1]); w.y = pk2(h[2], h[3]); w.z = pk2(h[4], h[5]); w.w = pk2(h[6], h[7]);
                    *(u32x4*)rowp = w;
                    asm volatile("" ::: "memory"); __builtin_amdgcn_sched_barrier(0);
                }
        } else {
            const int col0 = (u.pn - 44) * BM + wc * 32 + 8 * fq;
#pragma unroll
            for (int am = 0; am < 4; ++am) { const int ai = am >> 1, mb = (am & 1) * 2;
                u32x4 pv[2][2];
#pragma unroll
                for (int mm = 0; mm < 2; ++mm)
#pragma unroll
                    for (int bj = 0; bj < 2; ++bj) pv[mm][bj] = *(const u32x4*)(PP + (size_t)(row0 + ai * HALF + (mb + mm) * 16) * D_ + col0 + bj * HALF);
#pragma unroll
                for (int mm = 0; mm < 2; ++mm) { const int m = mb + mm;
                    bf16_t* rowp = PP + (size_t)(row0 + ai * HALF + m * 16) * D_ + col0;
#pragma unroll
                    for (int bj = 0; bj < 2; ++bj) {
                        const u32x4 p = pv[mm][bj];
                        const f32x4 a0 = acc[ai][bj][m][0], a1 = acc[ai][bj][m][1];
                        u32x4 w;
                        w.x = pk2(fsigmoid(a0[0]) * bflo(p.x), fsigmoid(a0[1]) * bfhi(p.x)); w.y = pk2(fsigmoid(a0[2]) * bflo(p.y), fsigmoid(a0[3]) * bfhi(p.y));
                        w.z = pk2(fsigmoid(a1[0]) * bflo(p.z), fsigmoid(a1[1]) * bfhi(p.z)); w.w = pk2(fsigmoid(a1[2]) * bflo(p.w), fsigmoid(a1[3]) * bfhi(p.w));
                        *(u32x4*)(rowp + bj * HALF) = w;
                    }
                }
                asm volatile("" ::: "memory"); __builtin_amdgcn_sched_barrier(0);
            }
        }
    }
};
template <bool ADD> struct EpiResidT {
    static constexpr bool PERM = false, HAS_MID = false;
    float* Y; const bf16_t* XB; const bf16_t* PP; float a, b;
    __device__ __forceinline__ void mid(int, f32x4 (&)[2][2][4][2], const Unit&, int, int, int, int) const {}
    __device__ __forceinline__ void operator()(const f32x4 (&acc)[2][2][4][2], const Unit& u, int wr, int wc, int fr, int fq) const {
        const int row0 = u.pm * BM + wr * 64 + fr, col0 = u.pn * BM + wc * 32 + 4 * fq;
        constexpr int GM = ADD ? 2 : 4;
#pragma unroll
        for (int ai = 0; ai < 2; ++ai)
#pragma unroll
            for (int m0 = 0; m0 < 4; m0 += GM) {
                u32x2 xb[GM][2][2], pp[GM][2][2];
#pragma unroll
                for (int mm = 0; mm < GM; ++mm) { const size_t off = (size_t)(row0 + ai * HALF + (m0 + mm) * 16) * D_ + col0;
#pragma unroll
                    for (int bj = 0; bj < 2; ++bj)
#pragma unroll
                        for (int n = 0; n < 2; ++n) { xb[mm][bj][n] = *(const u32x2*)(XB + off + bj * HALF + n * 16); if (ADD) pp[mm][bj][n] = *(const u32x2*)(PP + off + bj * HALF + n * 16); } }
#pragma unroll
                for (int mm = 0; mm < GM; ++mm) { const int m = m0 + mm; const size_t off = (size_t)(row0 + ai * HALF + m * 16) * D_ + col0;
#pragma unroll
                    for (int bj = 0; bj < 2; ++bj)
#pragma unroll
                        for (int n = 0; n < 2; ++n) { const u32x2 x = xb[mm][bj][n]; const f32x4 s = acc[ai][bj][m][n];
                            f32x4 y; y[0] = a * bflo(x.x) + b * s[0]; y[1] = a * bfhi(x.x) + b * s[1]; y[2] = a * bflo(x.y) + b * s[2]; y[3] = a * bfhi(x.y) + b * s[3];
                            if (ADD) { const u32x2 q = pp[mm][bj][n]; y[0] += bflo(q.x); y[1] += bfhi(q.x); y[2] += bflo(q.y); y[3] += bfhi(q.y); }
                            *(f32x4*)(Y + off + bj * HALF + n * 16) = y; } }
                asm volatile("" ::: "memory"); __builtin_amdgcn_sched_barrier(0);
            }
    }
};
struct EpiZ {
    static constexpr bool PERM = true, HAS_MID = false;
    bf16_t* Z; bf16_t* GATE; int pn_off;
    __device__ __forceinline__ void mid(int, f32x4 (&)[2][2][4][2], const Unit&, int, int, int, int) const {}
    __device__ __forceinline__ void operator()(const f32x4 (&acc)[2][2][4][2], const Unit& u0, int wr, int wc, int fr, int fq) const {
        Unit u; u.pm = u0.pm; u.pn = u0.pn + pn_off;
        const int row0 = u.pm * BM + wr * 64 + fr;
        if (u.pn < 24) {
            const bool isgelu = (u.pn >= 3) && (u.pn <= 6);
            const int col0 = u.pn * BM + wc * 32 + 8 * fq;
#pragma unroll
            for (int ai = 0; ai < 2; ++ai)
#pragma unroll
                for (int m = 0; m < 4; ++m) {
                    bf16_t* rowp = Z + (size_t)(row0 + ai * HALF + m * 16) * NZ_ + col0;
#pragma unroll
                    for (int bj = 0; bj < 2; ++bj) {
                        f32x4 v0 = acc[ai][bj][m][0], v1 = acc[ai][bj][m][1];
                        if (isgelu) {
#pragma unroll
                            for (int j = 0; j < 4; ++j) { v0[j] = gelu_fast(v0[j]); v1[j] = gelu_fast(v1[j]); }
                        }
                        u32x4 w; w.x = pk2(v0[0], v0[1]); w.y = pk2(v0[2], v0[3]); w.z = pk2(v1[0], v1[1]); w.w = pk2(v1[2], v1[3]);
                        *(u32x4*)(rowp + bj * HALF) = w;
                    }
                    asm volatile("" ::: "memory"); __builtin_amdgcn_sched_barrier(0);
                }
        } else {
            const int mc0 = (u.pn - 24) * 64 + wc * 16 + 4 * fq;
#pragma unroll
            for (int ai = 0; ai < 2; ++ai)
#pragma unroll
                for (int m = 0; m < 4; ++m) {
                    bf16_t* rowp = GATE + (size_t)(row0 + ai * HALF + m * 16) * D_ + mc0;
                    f32x4 e[4];
#pragma unroll
                    for (int br = 0; br < 4; ++br)
#pragma unroll
                        for (int j = 0; j < 4; ++j) e[br][j] = fminf(1.0f + fexp(-acc[ai][br >> 1][m][br & 1][j]), 1e30f);
                    f32x4 i0, i1, i2, i3;
#pragma unroll
                    for (int j = 0; j < 4; ++j) { i0[j] = frcp(e[0][j]); i1[j] = frcp(e[1][j]); i2[j] = frcp(e[2][j]); i3[j] = frcp(e[3][j]); }
                    const f32x4 r0 = e[1] * i0, r1 = e[2] * i1, r2 = e[3] * i2;
                    u32x2 w;
                    w.x = pk2(r0[0], r0[1]); w.y = pk2(r0[2], r0[3]); *(u32x2*)(rowp) = w;
                    w.x = pk2(r1[0], r1[1]); w.y = pk2(r1[2], r1[3]); *(u32x2*)(rowp + (size_t)T_ * D_) = w;
                    w.x = pk2(r2[0], r2[1]); w.y = pk2(r2[2], r2[3]); *(u32x2*)(rowp + (size_t)2 * T_ * D_) = w;
                    w.x = pk2(i3[0], i3[1]); w.y = pk2(i3[2], i3[3]); *(u32x2*)(rowp + (size_t)3 * T_ * D_) = w;
                    asm volatile("" ::: "memory"); __builtin_amdgcn_sched_barrier(0);
                }
        }
    }
};
struct EpiBf16 {
    static constexpr bool PERM = true, HAS_MID = false;
    bf16_t* O; int ldc;
    __device__ __forceinline__ void mid(int, f32x4 (&)[2][2][4][2], const Unit&, int, int, int, int) const {}
    __device__ __forceinline__ void operator()(const f32x4 (&acc)[2][2][4][2], const Unit& u, int wr, int wc, int fr, int fq) const {
        const int row0 = u.pm * BM + wr * 64 + fr, col0 = u.pn * BM + wc * 32 + 8 * fq;
#pragma unroll
        for (int ai = 0; ai < 2; ++ai)
#pragma unroll
            for (int m = 0; m < 4; ++m) {
                bf16_t* rowp = O + (size_t)(row0 + ai * HALF + m * 16) * ldc + col0;
#pragma unroll
                for (int bj = 0; bj < 2; ++bj) {
                    const f32x4 v0 = acc[ai][bj][m][0], v1 = acc[ai][bj][m][1];
                    u32x4 w; w.x = pk2(v0[0], v0[1]); w.y = pk2(v0[2], v0[3]); w.z = pk2(v1[0], v1[1]); w.w = pk2(v1[2], v1[3]);
                    *(u32x4*)(rowp + bj * HALF) = w;
                }
                asm volatile("" ::: "memory"); __builtin_amdgcn_sched_barrier(0);
            }
    }
};
struct EpiBR {
    static constexpr bool PERM = true, HAS_MID = true;
    bf16_t* O; const bf16_t* GATE;
    __device__ __forceinline__ void scale(const bf16_t* plane, f32x4 (&acc)[2][2][4][2], const Unit& u, int wr, int wc, int fr, int fq) const {
        const int row0 = u.pm * BM + wr * 64 + fr, col0 = u.pn * BM + wc * 32 + 8 * fq;
        u32x4 r[2][4][2];
#pragma unroll
        for (int ai = 0; ai < 2; ++ai)
#pragma unroll
            for (int m = 0; m < 4; ++m)
#pragma unroll
                for (int bj = 0; bj < 2; ++bj) r[ai][m][bj] = *(const u32x4*)(plane + (size_t)(row0 + ai * HALF + m * 16) * D_ + col0 + bj * HALF);
#pragma unroll
        for (int ai = 0; ai < 2; ++ai)
#pragma unroll
            for (int m = 0; m < 4; ++m)
#pragma unroll
                for (int bj = 0; bj < 2; ++bj) { const u32x4 e = r[ai][m][bj];
                    acc[ai][bj][m][0] *= (f32x4){bflo(e.x), bfhi(e.x), bflo(e.y), bfhi(e.y)}; acc[ai][bj][m][1] *= (f32x4){bflo(e.z), bfhi(e.z), bflo(e.w), bfhi(e.w)}; }
    }
    __device__ __forceinline__ void mid(int t, f32x4 (&acc)[2][2][4][2], const Unit& u, int wr, int wc, int fr, int fq) const {
        if (t != 8 && t != 16 && t != 24) return;
        asm volatile("" : "+v"(fr), "+v"(fq));
        scale(GATE + (size_t)((t >> 3) - 1) * T_ * D_, acc, u, wr, wc, fr, fq);
    }
    __device__ __forceinline__ void operator()(f32x4 (&acc)[2][2][4][2], const Unit& u, int wr, int wc, int fr, int fq) const {
        scale(GATE + (size_t)3 * T_ * D_, acc, u, wr, wc, fr, fq);
        const int row0 = u.pm * BM + wr * 64 + fr, col0 = u.pn * BM + wc * 32 + 8 * fq;
#pragma unroll
        for (int ai = 0; ai < 2; ++ai)
#pragma unroll
            for (int m = 0; m < 4; ++m) {
                bf16_t* rowp = O + (size_t)(row0 + ai * HALF + m * 16) * D_ + col0;
#pragma unroll
                for (int bj = 0; bj < 2; ++bj) {
                    const f32x4 a0 = acc[ai][bj][m][0], a1 = acc[ai][bj][m][1];
                    u32x4 w; w.x = pk2(a0[0], a0[1]); w.y = pk2(a0[2], a0[3]); w.z = pk2(a1[0], a1[1]); w.w = pk2(a1[2], a1[3]);
                    *(u32x4*)(rowp + bj * HALF) = w;
                }
            }
    }
};

template <class Epi, bool KREV = false>
__device__ __forceinline__ void gemm_phase(LAS unsigned char* lds, const Gemm g, const StaticOrder& S, const Epi& E) {
    int tid = threadIdx.x; asm volatile("" : "+v"(tid));
    const int wid = __builtin_amdgcn_readfirstlane(tid >> 6), lane = tid & 63, wr = wid >> 2, wc = wid & 3, fr = lane & 15, fq = lane >> 4;
    const int K = g.K, nt = K / BK;
    unsigned voffA[2], voffB[2];
#pragma unroll
    for (int i = 0; i < 2; ++i) { int R, C; stage_rc(tid * 16 + i * 8192, R, C); const int Rb = Epi::PERM ? ((R & ~31) + perm32(R & 31)) : R;
        voffA[i] = (unsigned)(R * K + C) * 2u; voffB[i] = (unsigned)(Rb * K + C) * 2u; }
    const long kstep = KREV ? -(long)(BK * 2) : (long)(BK * 2);
    const size_t kbase = KREV ? (size_t)(nt - 1) * (BK * 2) : 0;
    const size_t hstep = (size_t)HALF * K * 2;
    const size_t tstep = 2 * hstep;
    const unsigned ldsw = (unsigned)wid * 1024u;
    const int aoff = lds_byte(wr * 64 + fr, fq * 8), boff = lds_byte(wc * 32 + fr, fq * 8);
#define PG8_SA(b, h) (((b) * 2 + (h)) * HTB)
#define PG8_SB(b, h) ((4 + (b) * 2 + (h)) * HTB)
#define PG8_STAGE(bufoff, gbase, voff) do { _Pragma("unroll") for (int _i = 0; _i < 2; ++_i) \
        __builtin_amdgcn_global_load_lds((const unsigned*)((const char*)(gbase) + (voff)[_i]), (LAS unsigned*)(lds + (bufoff) + ldsw + _i * 8192), 16, 0, 0); } while (0)
#define PG8_LDA(dst, b, h) do { _Pragma("unroll") for (int m = 0; m < 4; ++m) _Pragma("unroll") for (int k = 0; k < 2; ++k) dst[m][k] = *(const LAS bf16x8*)(lds + PG8_SA(b, h) + aoff + m * 2048 + k * 1024); } while (0)
#define PG8_LDB(dst, b, h) do { _Pragma("unroll") for (int n = 0; n < 2; ++n) _Pragma("unroll") for (int k = 0; k < 2; ++k) dst[n][k] = *(const LAS bf16x8*)(lds + PG8_SB(b, h) + boff + n * 2048 + k * 1024); } while (0)
#define PG8_MMA(ai, bj, At, Bt) do { __builtin_amdgcn_s_setprio(1); _Pragma("unroll") for (int m = 0; m < 4; ++m) _Pragma("unroll") for (int n = 0; n < 2; ++n) _Pragma("unroll") for (int k = 0; k < 2; ++k) \
        acc[ai][bj][m][n] = __builtin_amdgcn_mfma_f32_16x16x32_bf16(Bt[n][k], At[m][k], acc[ai][bj][m][n], 0, 0, 0); __builtin_amdgcn_s_setprio(0); } while (0)
#define PG8_WAIT_V(n) asm volatile("s_waitcnt vmcnt(" #n ")" ::: "memory")
#define PG8_WAIT_L(n) asm volatile("s_waitcnt lgkmcnt(" #n ")" ::: "memory")
#define PG8_BAR __builtin_amdgcn_s_barrier()
#define PG8_SCHED __builtin_amdgcn_sched_barrier(0)
    Unit cur, nxt; int ui = 0;
    if (!S.next(0, cur)) return;
    f32x4 acc[2][2][4][2];
#pragma unroll
    for (int a = 0; a < 2; ++a)
#pragma unroll
        for (int b = 0; b < 2; ++b)
#pragma unroll
            for (int m = 0; m < 4; ++m)
#pragma unroll
                for (int n = 0; n < 2; ++n) acc[a][b][m][n] = (f32x4){0.f, 0.f, 0.f, 0.f};
    bf16x8 At[4][2], B0[2][2], B1[2][2];
    const char* cA = (const char*)g.A + (size_t)cur.pm * tstep + kbase; const char* cB = (const char*)g.Bt + (size_t)cur.pn * tstep + kbase;
    PG8_STAGE(PG8_SB(0, 0), cB, voffB); PG8_STAGE(PG8_SB(0, 1), cB + hstep, voffB); PG8_STAGE(PG8_SA(0, 0), cA, voffA); PG8_STAGE(PG8_SA(0, 1), cA + hstep, voffA);
    if (wr == 1) PG8_BAR;
    PG8_WAIT_V(2); PG8_BAR;
    PG8_STAGE(PG8_SB(1, 0), cB + kstep, voffB); PG8_STAGE(PG8_SA(1, 0), cA + kstep, voffA); PG8_STAGE(PG8_SB(1, 1), cB + hstep + kstep, voffB);
    PG8_WAIT_V(6); PG8_BAR;
    for (;;) {
        const bool has_next = S.next(ui + 1, nxt);
        const char* nA = has_next ? (const char*)g.A + (size_t)nxt.pm * tstep + kbase : cA; const char* nB = has_next ? (const char*)g.Bt + (size_t)nxt.pn * tstep + kbase : cB;
        for (int t = 0; t < nt; t += 2) {
            const bool last = (t == nt - 2);
            const char* a1 = cA + (long)(t + 1) * kstep;
            const char* a2 = last ? nA : cA + (long)(t + 2) * kstep; const char* b2 = last ? nB : cB + (long)(t + 2) * kstep;
            const char* a3 = a2 + kstep; const char* b3 = b2 + kstep;
            if constexpr (Epi::HAS_MID) E.mid(t, acc, cur, wr, wc, fr, fq);
            PG8_LDB(B0, 0, 0); PG8_LDB(B1, 0, 1); PG8_SCHED; PG8_LDA(At, 0, 0); PG8_STAGE(PG8_SA(1, 1), a1 + hstep, voffA);
            PG8_WAIT_V(8); PG8_WAIT_L(0); PG8_BAR; PG8_MMA(0, 0, At, B0); PG8_MMA(0, 1, At, B1); PG8_BAR; PG8_SCHED;
            PG8_LDA(At, 0, 1); PG8_STAGE(PG8_SB(0, 0), b2, voffB); PG8_STAGE(PG8_SB(0, 1), b2 + hstep, voffB); PG8_STAGE(PG8_SA(0, 0), a2, voffA);
            PG8_WAIT_V(8); PG8_WAIT_L(0); PG8_BAR; PG8_MMA(1, 0, At, B0); PG8_MMA(1, 1, At, B1); PG8_BAR; PG8_SCHED;
            PG8_LDB(B0, 1, 0); PG8_LDB(B1, 1, 1); PG8_SCHED; PG8_LDA(At, 1, 0); PG8_STAGE(PG8_SA(0, 1), a2 + hstep, voffA);
            PG8_WAIT_V(8); PG8_WAIT_L(0); PG8_BAR; PG8_MMA(0, 0, At, B0); PG8_MMA(0, 1, At, B1); PG8_BAR; PG8_SCHED;
            PG8_LDA(At, 1, 1); PG8_STAGE(PG8_SB(1, 0), b3, voffB); PG8_STAGE(PG8_SB(1, 1), b3 + hstep, voffB); PG8_STAGE(PG8_SA(1, 0), a3, voffA);
            PG8_WAIT_V(8); PG8_WAIT_L(0); PG8_BAR; PG8_MMA(1, 0, At, B0); PG8_MMA(1, 1, At, B1); PG8_BAR; PG8_SCHED;
        }
        if (wr == 0) PG8_BAR;
#pragma unroll
        for (int a = 0; a < 2; ++a)
#pragma unroll
            for (int b = 0; b < 2; ++b)
#pragma unroll
                for (int m = 0; m < 4; ++m)
#pragma unroll
                    for (int n = 0; n < 2; ++n) asm volatile("" : "+v"(acc[a][b][m][n]));
        E(acc, cur, wr, wc, fr, fq);
        if (!has_next) break;
#pragma unroll
        for (int a = 0; a < 2; ++a)
#pragma unroll
            for (int b = 0; b < 2; ++b)
#pragma unroll
                for (int m = 0; m < 4; ++m)
#pragma unroll
                    for (int n = 0; n < 2; ++n) acc[a][b][m][n] = (f32x4){0.f, 0.f, 0.f, 0.f};
        cur = nxt; cA = nA; cB = nB; ++ui;
        if (wr == 1) PG8_BAR;
    }
    PG8_WAIT_V(0);
    PG8_BAR;
#undef PG8_SA
#undef PG8_SB
#undef PG8_STAGE
#undef PG8_LDA
#undef PG8_LDB
#undef PG8_MMA
#undef PG8_WAIT_V
#undef PG8_WAIT_L
#undef PG8_BAR
#undef PG8_SCHED
}
}

typedef __attribute__((address_space(1))) unsigned gu32;
#define XB_TMO      128
#define XB_XCNT(j)  (256  + 64 * (j))
#define XB_XSUB(j)  (1280 + 64 * (j))
#define XB_XGEN(j)  (2304 + 64 * (j))
#define XB_TOP      3328
#define XB_TOPGEN   3392
#define XCD_BAR_WORDS 3456
#define XB_SPIN_CAP (1u << 18)

__device__ __forceinline__ unsigned xb_ld(unsigned* p)              { return __hip_atomic_load(p, __ATOMIC_RELAXED, __HIP_MEMORY_SCOPE_AGENT); }
__device__ __forceinline__ unsigned xb_add(unsigned* p, unsigned v) { return __hip_atomic_fetch_add(p, v, __ATOMIC_RELAXED, __HIP_MEMORY_SCOPE_AGENT); }
__device__ __forceinline__ unsigned xb_xcc_id() { return (unsigned)__builtin_amdgcn_s_getreg((3 << 11) | 20) & 0xFu; }
#define XB_SPIN(cond, bar) do { unsigned _sp = 0; while (cond) { __builtin_amdgcn_s_sleep(1); \
    if ((++_sp & 255u) == 0u) { if (xb_ld(&(bar)[XB_TMO])) break; if (_sp > XB_SPIN_CAP) { atomicAdd(&(bar)[XB_TMO], 1u); break; } } } } while (0)

struct XcdBarrier {
    unsigned* bar; unsigned x;
    volatile LAS unsigned* st;
};

__device__ __forceinline__ XcdBarrier xcd_barrier_post(unsigned* bar, volatile LAS unsigned* st) {
    XcdBarrier b; b.bar = bar; b.x = xb_xcc_id(); b.st = st;
    if (threadIdx.x == 0) (void)xb_add(&bar[XB_XCNT(b.x)], 1u);
    return b;
}
__device__ __forceinline__ void xcd_barrier_complete(unsigned* bar, unsigned x, unsigned& nloc, unsigned& nx) {
    const unsigned G = gridDim.x * gridDim.y * gridDim.z;
    unsigned sum, cnt, mine, sp = 0u;
    for (;;) {
        sum = 0u; cnt = 0u; mine = 0u;
#pragma unroll
        for (unsigned j = 0; j < 16; ++j) { const unsigned c = xb_ld(&bar[XB_XCNT(j)]); sum += c; cnt += (c > 0u) ? 1u : 0u; mine = (j == x) ? c : mine; }
        if (sum == G) break;
        __builtin_amdgcn_s_sleep(1);
        if ((++sp & 255u) == 0u) { if (xb_ld(&bar[XB_TMO])) break; if (sp > XB_SPIN_CAP) { atomicAdd(&bar[XB_TMO], 1u); break; } }
    }
    nloc = mine > 0u ? mine : 1u; nx = cnt > 0u ? cnt : 1u;
}

__device__ __forceinline__ void xcd_barrier(const XcdBarrier& b) {
    asm volatile("s_waitcnt vmcnt(0)" ::: "memory");
    __syncthreads();
    if (threadIdx.x == 0) {
        unsigned* bar = b.bar;
        __builtin_amdgcn_s_waitcnt(0);
        unsigned nloc = b.st[0], nx = b.st[1];
        if (nloc == 0u) { xcd_barrier_complete(bar, b.x, nloc, nx); b.st[0] = nloc; b.st[1] = nx; }
        const unsigned old = xb_add(&bar[XB_XSUB(b.x)], 1u);
        const unsigned gen = old / nloc;
        if (old + 1u == (gen + 1u) * nloc) {
            __builtin_amdgcn_fence(__ATOMIC_RELEASE, "agent");
            asm volatile("s_waitcnt vmcnt(0)" ::: "memory");
            const unsigned og = xb_add(&bar[XB_TOP], 1u);
            const unsigned tg = og / nx;
            if (og + 1u == (tg + 1u) * nx) xb_add(&bar[XB_TOPGEN], 1u);
            else XB_SPIN(xb_ld(&bar[XB_TOPGEN]) == tg, bar);
            __builtin_amdgcn_fence(__ATOMIC_ACQUIRE, "agent");
            xb_add(&bar[XB_XGEN(b.x)], 1u);
            asm volatile("s_waitcnt vmcnt(0)" ::: "memory");
        } else {
            XB_SPIN(xb_ld(&bar[XB_XGEN(b.x)]) == gen, bar);
            __builtin_amdgcn_fence(__ATOMIC_ACQUIRE, "agent");
            asm volatile("s_waitcnt vmcnt(0)" ::: "memory");
        }
    }
    __syncthreads();
}


__device__ __forceinline__ void panel_barrier(unsigned* cnt, unsigned& epoch) {
    asm volatile("s_waitcnt vmcnt(0)" ::: "memory");
    __syncthreads();
    ++epoch;
    if (threadIdx.x == 0) {
        (void)xb_add(cnt, 1u);
        unsigned sp = 0u;
        while (xb_ld(cnt) < 4u * epoch) { __builtin_amdgcn_s_sleep(1); if (++sp > (1u << 22)) break; }
        __builtin_amdgcn_fence(__ATOMIC_ACQUIRE, "agent");
        asm volatile("s_waitcnt vmcnt(0)" ::: "memory");
    }
    __syncthreads();
}

struct Args { const float* in[22]; float* out; unsigned char* ws; int ph_lo, ph_hi; };

typedef LAS unsigned long long* PTab;
__device__ __forceinline__ const float* ldptr(PTab pt, int k) {
    const unsigned long long v = pt[k];
    const unsigned lo = __builtin_amdgcn_readfirstlane((unsigned)v), hi = __builtin_amdgcn_readfirstlane((unsigned)(v >> 32));
    return (const float*)(__attribute__((address_space(1))) const float*)(((unsigned long long)hi << 32) | lo);
}

__device__ __forceinline__ int conv_row(int n, int mode, int rowoff) {
    if (mode == 0) return rowoff + n;
    if (mode == 3) { const int br = n >> 11, mc = n & 2047, q = mc >> 6, mcl = mc & 63; return rowoff + 256 * q + 128 * (br >> 1) + 32 * (mcl >> 4) + 8 * ((mcl >> 2) & 3) + 4 * (br & 1) + (mcl & 3); }
    return (n >> 7) * 256 + (n & 127) + (mode == 2 ? 128 : 0);
}
__device__ __forceinline__ void conv_mat(const float* W, int ldw, int K, int N, bf16_t* WT, int pitch, int koff, int mode, int rowoff, int gw, int ngw, int lane) {
    const int nblk = N / 64, nitems = (K / 64) * nblk;
    const int c = lane & 15, q = lane >> 4;
    f32x4 v[16];
    if (gw < nitems) { const int kb = gw / nblk, nb = gw - kb * nblk; const float* src = W + (size_t)(64 * kb + 16 * q) * ldw + 64 * nb + 4 * c;
#pragma unroll
        for (int j = 0; j < 16; ++j) v[j] = __builtin_nontemporal_load((const f32x4*)(src + (size_t)j * ldw)); }
    for (int item = gw; item < nitems; item += ngw) {
        const int kb = item / nblk, nb = item - kb * nblk, k0 = 64 * kb, n0 = 64 * nb;
        u32x4 o[8];
#pragma unroll
        for (int i = 0; i < 4; ++i) {
            o[2 * i].x = pk2(v[0][i], v[1][i]); o[2 * i].y = pk2(v[2][i], v[3][i]); o[2 * i].z = pk2(v[4][i], v[5][i]); o[2 * i].w = pk2(v[6][i], v[7][i]);
            o[2 * i + 1].x = pk2(v[8][i], v[9][i]); o[2 * i + 1].y = pk2(v[10][i], v[11][i]); o[2 * i + 1].z = pk2(v[12][i], v[13][i]); o[2 * i + 1].w = pk2(v[14][i], v[15][i]);
        }
        const int nx = item + ngw;
        if (nx < nitems) { const int kb2 = nx / nblk, nb2 = nx - kb2 * nblk; const float* src = W + (size_t)(64 * kb2 + 16 * q) * ldw + 64 * nb2 + 4 * c;
#pragma unroll
            for (int j = 0; j < 16; ++j) v[j] = __builtin_nontemporal_load((const f32x4*)(src + (size_t)j * ldw)); }
        const int rb = conv_row(n0 + 4 * c, mode, rowoff);
#pragma unroll
        for (int i = 0; i < 4; ++i) {
            bf16_t* dst = WT + (size_t)(rb + i) * pitch + koff + k0 + 16 * q;
            *(u32x4*)dst = o[2 * i]; *(u32x4*)(dst + 8) = o[2 * i + 1];
        }
    }
}

__device__ __forceinline__ void convert_phase(PTab pt, int l, LAS unsigned char* lds, int tid, int wave, int lane, int bid, int G) {
    unsigned char* ws = (unsigned char*)ldptr(pt, 23);
    const int gw = bid * 8 + wave, ngw = G * 8;
    for (int s = 0; s < 2; ++s) {
        bf16_t* wgu = (bf16_t*)(ws + WS_WGU + (size_t)s * 44 * MiB);
        conv_mat(ldptr(pt, 4) + (size_t)(l * 2 + s) * D_ * FF_, FF_, D_, FF_, wgu, D_, 0, 1, 0, gw, ngw, lane);
        conv_mat(ldptr(pt, 5) + (size_t)(l * 2 + s) * D_ * FF_, FF_, D_, FF_, wgu, D_, 0, 2, 0, gw, ngw, lane);
        conv_mat(ldptr(pt, 6) + (size_t)(l * 2 + s) * D_ * FF_, D_, FF_, D_, (bf16_t*)(ws + WS_WD + (size_t)s * 22 * MiB), FF_, 0, 0, 0, gw, ngw, lane);
    }
    conv_mat(ldptr(pt, 7) + (size_t)l * D_ * NIN_, NIN_, D_, NZ_, (bf16_t*)(ws + WS_WIN), D_, 0, 0, 0, gw, ngw, lane);
    conv_mat(ldptr(pt, 7) + (size_t)l * D_ * NIN_ + NZ_, NIN_, D_, NGT_, (bf16_t*)(ws + WS_WIN), D_, 0, 3, NZ_, gw, ngw, lane);
    conv_mat(ldptr(pt, 15) + (size_t)l * 512 * D_, D_, 512, D_, (bf16_t*)(ws + WS_WBR), NO_, 0, 0, 0, gw, ngw, lane);
    conv_mat(ldptr(pt, 16) + (size_t)l * 512 * D_, D_, 512, D_, (bf16_t*)(ws + WS_WBR), NO_, 512, 0, 0, gw, ngw, lane);
    conv_mat(ldptr(pt, 17) + (size_t)l * 512 * D_, D_, 512, D_, (bf16_t*)(ws + WS_WBR), NO_, 1024, 0, 0, gw, ngw, lane);
    conv_mat(ldptr(pt, 18) + (size_t)l * 256 * D_, D_, 256, D_, (bf16_t*)(ws + WS_WBR), NO_, 1536, 0, 0, gw, ngw, lane);
    conv_mat(ldptr(pt, 19) + (size_t)l * D_ * D_, D_, D_, D_, (bf16_t*)(ws + WS_WOUT), D_, 0, 0, 0, gw, ngw, lane);
    conv_mat(ldptr(pt, 20) + (size_t)l * PLE_ * D_, D_, PLE_, D_, (bf16_t*)(ws + WS_WPP), PLE_, 0, 0, 0, gw, ngw, lane);
    conv_mat(ldptr(pt, 21) + (size_t)l * D_ * D_, D_, D_, D_, (bf16_t*)(ws + WS_WPG), D_, 0, 0, 0, gw, ngw, lane);
    if (l == 0) {
        const size_t gt = (size_t)bid * 512 + tid, nth = (size_t)G * 512;
        const f32x4* x4 = (const f32x4*)ldptr(pt, 0); u32x2* xb = (u32x2*)(ws + WS_XB);
        for (size_t i = gt; i < (size_t)T_ * D_ / 4; i += nth) { const f32x4 v = x4[i]; u32x2 w; w.x = pk2(v[0], v[1]); w.y = pk2(v[2], v[3]); xb[i] = w; }
        const f32x4* p4 = (const f32x4*)ldptr(pt, 1); u32x2* pb = (u32x2*)(ws + WS_PB);
        for (size_t i = gt; i < (size_t)2 * T_ * PLE_ / 4; i += nth) { const f32x4 v = p4[i]; u32x2 w; w.x = pk2(v[0], v[1]); w.y = pk2(v[2], v[3]); pb[i] = w; }
    }
}

__device__ __forceinline__ void ln_phase(float* X, bf16_t* XB, const float* g, const float* b, bool final_, int first, int rstep, int bstep, int nb, int lane) {
    const int ngw = rstep;
    for (int bi = 0, row0 = first; bi < nb; ++bi, row0 += bstep) {
        f32x4 v[4][8];
#pragma unroll
        for (int r = 0; r < 4; ++r) { const int row = min(row0 + r * ngw, T_ - 1); const f32x4* xr = (const f32x4*)(X + (size_t)row * D_) + lane;
#pragma unroll
            for (int j = 0; j < 8; ++j) v[r][j] = xr[64 * j]; }
        float mean[4], rstd[4];
#pragma unroll
        for (int r = 0; r < 4; ++r) { float s = 0.f;
#pragma unroll
            for (int j = 0; j < 8; ++j) s += (v[r][j][0] + v[r][j][1]) + (v[r][j][2] + v[r][j][3]);
            mean[r] = s; }
#pragma unroll
        for (int o = 1; o < 64; o <<= 1) {
#pragma unroll
            for (int r = 0; r < 4; ++r) mean[r] += __shfl_xor(mean[r], o); }
#pragma unroll
        for (int r = 0; r < 4; ++r) { mean[r] *= (1.f / D_); float s2 = 0.f;
#pragma unroll
            for (int j = 0; j < 8; ++j) { v[r][j] = v[r][j] - mean[r]; s2 += (v[r][j][0] * v[r][j][0] + v[r][j][1] * v[r][j][1]) + (v[r][j][2] * v[r][j][2] + v[r][j][3] * v[r][j][3]); }
            rstd[r] = s2; }
#pragma unroll
        for (int o = 1; o < 64; o <<= 1) {
#pragma unroll
            for (int r = 0; r < 4; ++r) rstd[r] += __shfl_xor(rstd[r], o); }
#pragma unroll
        for (int r = 0; r < 4; ++r) rstd[r] = 1.f / sqrtf(rstd[r] * (1.f / D_) + LN_EPS);
#pragma unroll
        for (int j = 0; j < 8; ++j) {
            const f32x4 gg = ((const f32x4*)g)[lane + 64 * j], bb = ((const f32x4*)b)[lane + 64 * j];
#pragma unroll
            for (int r = 0; r < 4; ++r) { const int row = row0 + r * ngw;
                if (row < T_) { const f32x4 y = v[r][j] * rstd[r] * gg + bb;
                    if (final_) ((f32x4*)(X + (size_t)row * D_))[lane + 64 * j] = y;
                    else { u32x2 w; w.x = pk2(y[0], y[1]); w.y = pk2(y[2], y[3]); ((u32x2*)(XB + (size_t)row * D_))[lane + 64 * j] = w; } } }
        }
    }
}

__device__ __forceinline__ void attn_unit(LAS unsigned char* L, const bf16_t* Z, int unit, const float* sinks, bf16_t* O, float* DPO, float* DLSE, int tid, int wave, int lane) {
    int qcol, kcol, vcol, base, blk, dil, max_dist, grp = 0, hh = 0; float slope_u, sink = 0.f; bool isA;
    if (unit < 1024) {
        isA = true; blk = unit & 31; const int head = (unit >> 5) & 7, b = unit >> 8, kvh = head >> 2;
        qcol = ZQA + head * 64; kcol = ZKA + kvh * 64; vcol = ZVA + kvh * 64; base = b * SEQ_; dil = 1; max_dist = 127;
        slope_u = __builtin_amdgcn_exp2f(-8.0f * (float)(head + 1) / 20.0f); sink = sinks[head]; hh = head;
    } else {
        isA = false; const int u2 = unit - 1024; grp = u2 >> 9; const int u3 = u2 & 511;
        dil = (grp == 0) ? 1 : (grp == 1 ? 4 : 16); const int nbk = 32 / dil;
        blk = u3 % nbk; const int r = (u3 / nbk) % dil; hh = (u3 / 32) & 3; const int b = u3 >> 7;
        qcol = ZQD + grp * 256 + hh * 64; kcol = ZKD + grp * 256 + hh * 64; vcol = ZVD + grp * 256 + hh * 64; base = b * SEQ_ + r; max_dist = 128;
        slope_u = __builtin_amdgcn_exp2f(-8.0f * (float)(8 + 4 * grp + hh + 1) / 20.0f) * (float)dil;
    }
    LAS bf16_t* Qs = (LAS bf16_t*)L;
    LAS bf16_t* Ks = Qs + 128 * 72;
    LAS bf16_t* Vs = Ks + 272 * 72;
    for (int i = tid; i < 1024; i += 512) { const int r = i >> 3, c = i & 7; const size_t tok = (size_t)(base + (blk * 128 + r) * dil);
        *(LAS u32x4*)(Qs + r * 72 + c * 8) = *(const u32x4*)(Z + tok * NZ_ + qcol + c * 8); }
    {
        u32x4 kv[5], vv[5];
#pragma unroll
        for (int it = 0; it < 5; ++it) { const int i = tid + it * 512; const int r = i >> 3, c = i & 7; const int sub = blk * 128 - 128 + r; const bool ok = (i < 2176) && (r < 256) && (sub >= 0);
            kv[it] = (u32x4){0u, 0u, 0u, 0u}; vv[it] = (u32x4){0u, 0u, 0u, 0u};
            if (ok) { const size_t tok = (size_t)(base + sub * dil); kv[it] = *(const u32x4*)(Z + tok * NZ_ + kcol + c * 8); vv[it] = *(const u32x4*)(Z + tok * NZ_ + vcol + c * 8); } }
#pragma unroll
        for (int it = 0; it < 5; ++it) { const int i = tid + it * 512; const int r = i >> 3, c = i & 7;
            if (i < 2176) {
                *(LAS u32x4*)(Ks + r * 72 + c * 8) = kv[it];
                *(LAS u32x4*)(Vs + r * 72 + c * 8) = vv[it]; } }
    }
    __syncthreads();
    const int q0 = wave * 16, qi = lane & 15, g = lane >> 4;
    bf16x8 bq[2];
#pragma unroll
    for (int ks = 0; ks < 2; ++ks) bq[ks] = *(const LAS bf16x8*)(Qs + (q0 + qi) * 72 + ks * 32 + g * 8);
    f32x4 st[10];
#pragma unroll
    for (int i = 0; i < 10; ++i) { f32x4 acc = {0.f, 0.f, 0.f, 0.f};
#pragma unroll
        for (int ks = 0; ks < 2; ++ks) { const bf16x8 ak = *(const LAS bf16x8*)(Ks + ((wave + i) * 16 + qi) * 72 + ks * 32 + g * 8); acc = mfma16(ak, bq[ks], acc); }
        st[i] = acc; }
    float mx = -3.0e38f;
    const int q = q0 + qi;
#pragma unroll
    for (int i = 0; i < 10; ++i)
#pragma unroll
        for (int j = 0; j < 4; ++j) { const int kk = (wave + i) * 16 + 4 * g + j; const int dist = q + 128 - kk;
            const bool valid = (dist >= 0) && (dist <= max_dist) && (blk > 0 || kk >= 128);
            const float s = valid ? (st[i][j] * 0.125f - slope_u * (float)dist) : -1.0e30f; st[i][j] = s; mx = fmaxf(mx, s); }
    mx = fmaxf(mx, __shfl_xor(mx, 16)); mx = fmaxf(mx, __shfl_xor(mx, 32));
    if (isA) mx = fmaxf(mx, sink);
    float den = 0.f;
#pragma unroll
    for (int i = 0; i < 10; ++i)
#pragma unroll
        for (int j = 0; j < 4; ++j) { const float p = __builtin_amdgcn_exp2f((st[i][j] - mx) * LOG2E); st[i][j] = p; den += p; }
    den += __shfl_xor(den, 16); den += __shfl_xor(den, 32);
    if (isA) den += __builtin_amdgcn_exp2f((sink - mx) * LOG2E);
    f32x4 o[4];
#pragma unroll
    for (int ht = 0; ht < 4; ++ht) o[ht] = (f32x4){0.f, 0.f, 0.f, 0.f};
    const LAS bf16_t* vbase = Vs + (wave * 16 + 4 * g + (qi >> 2)) * 72 + 4 * (qi & 3);
#pragma unroll
    for (int i = 0; i < 5; ++i) {
        u32x4 pw; pw.x = pk2(st[2 * i][0], st[2 * i][1]); pw.y = pk2(st[2 * i][2], st[2 * i][3]); pw.z = pk2(st[2 * i + 1][0], st[2 * i + 1][1]); pw.w = pk2(st[2 * i + 1][2], st[2 * i + 1][3]);
        const bf16x8 bp = __builtin_bit_cast(bf16x8, pw);
#pragma unroll
        for (int ht = 0; ht < 4; ++ht) { const LAS bf16_t* vr = vbase + (2 * i * 16) * 72 + ht * 16;
            const u32x2 va = tr16(vr), vb = tr16(vr + 16 * 72);
            o[ht] = mfma16(mk8(va, vb), bp, o[ht]); } }
    const float inv = 1.0f / den;
    const size_t tok = (size_t)(base + (blk * 128 + q) * dil);
    if (isA) {
#pragma unroll
        for (int ht = 0; ht < 4; ++ht) { u32x2 w; w.x = pk2(o[ht][0] * inv, o[ht][1] * inv); w.y = pk2(o[ht][2] * inv, o[ht][3] * inv);
            *(u32x2*)(O + tok * NO_ + hh * 64 + ht * 16 + 4 * g) = w; }
    } else {
#pragma unroll
        for (int ht = 0; ht < 4; ++ht) *(f32x4*)(DPO + ((size_t)grp * T_ + tok) * 256 + hh * 64 + ht * 16 + 4 * g) = o[ht] * inv;
        if (g == 0) DLSE[((size_t)grp * T_ + tok) * 4 + hh] = mx + logf(den);
    }
    __syncthreads();
}

__device__ __forceinline__ void gmlp_unit(LAS unsigned char* L, const bf16_t* Z, int unit, const float* lng, const float* lnb, const float* ws_, const float* bs, bf16_t* O, int tid, int wave, int lane) {
    const int n = unit >> 2, grp = unit & 3, tok0 = n * 128;
    LAS float* stats = (LAS float*)L;
    LAS bf16_t* vnt = (LAS bf16_t*)(L + 1024);
    LAS bf16_t* Wc = vnt + 128 * 136;
    {
        u32x4 raw[16];
#pragma unroll
        for (int r = 0; r < 16; ++r) raw[r] = *(const u32x4*)(Z + (size_t)(tok0 + 16 * wave + r) * NZ_ + ZVB + lane * 8);
        float s[16], ss[16];
#pragma unroll
        for (int r = 0; r < 16; ++r) { const float x0 = bflo(raw[r].x), x1 = bfhi(raw[r].x), x2 = bflo(raw[r].y), x3 = bfhi(raw[r].y), x4 = bflo(raw[r].z), x5 = bfhi(raw[r].z), x6 = bflo(raw[r].w), x7 = bfhi(raw[r].w);
            s[r] = ((x0 + x1) + (x2 + x3)) + ((x4 + x5) + (x6 + x7)); ss[r] = ((x0 * x0 + x1 * x1) + (x2 * x2 + x3 * x3)) + ((x4 * x4 + x5 * x5) + (x6 * x6 + x7 * x7)); }
#pragma unroll
        for (int o = 1; o < 64; o <<= 1) {
#pragma unroll
            for (int r = 0; r < 16; ++r) { s[r] += __shfl_xor(s[r], o); ss[r] += __shfl_xor(ss[r], o); } }
        if (lane < 16) { float m = 0.f, q = 0.f;
#pragma unroll
            for (int r = 0; r < 16; ++r) if (lane == r) { m = s[r]; q = ss[r]; }
            m *= (1.f / 512.f); const float var = fmaxf(q * (1.f / 512.f) - m * m, 0.f);
            stats[(16 * wave + lane) * 2] = m; stats[(16 * wave + lane) * 2 + 1] = 1.f / sqrtf(var + LN_EPS); }
    }
#pragma unroll
    for (int it = 0; it < 8; ++it) { const int i = tid + it * 512; const int t = i >> 5, s4 = (i & 31) * 4;
        f32x4 w = *(const f32x4*)(ws_ + (size_t)(grp * 128 + t) * 128 + s4);
#pragma unroll
        for (int e = 0; e < 4; ++e) if (s4 + e > t) w[e] = 0.f;
        u32x2 p; p.x = pk2(w[0], w[1]); p.y = pk2(w[2], w[3]); *(LAS u32x2*)(Wc + t * 136 + s4) = p; }
    u32x4 vraw[4];
#pragma unroll
    for (int it = 0; it < 4; ++it) { const int i = tid + it * 512; const int s = i >> 4, c8 = (i & 15) * 8;
        vraw[it] = *(const u32x4*)(Z + (size_t)(tok0 + s) * NZ_ + ZVB + grp * 128 + c8); }
    __syncthreads();
#pragma unroll
    for (int it = 0; it < 4; ++it) { const int i = tid + it * 512; const int s = i >> 4, c8 = (i & 15) * 8;
        const u32x4 raw = vraw[it];
        const float mean = stats[s * 2], rstd = stats[s * 2 + 1];
        float x[8]; x[0] = bflo(raw.x); x[1] = bfhi(raw.x); x[2] = bflo(raw.y); x[3] = bfhi(raw.y); x[4] = bflo(raw.z); x[5] = bfhi(raw.z); x[6] = bflo(raw.w); x[7] = bfhi(raw.w);
        const f32x4 g0 = *(const f32x4*)(lng + grp * 128 + c8), g1 = *(const f32x4*)(lng + grp * 128 + c8 + 4), b0 = *(const f32x4*)(lnb + grp * 128 + c8), b1 = *(const f32x4*)(lnb + grp * 128 + c8 + 4);
        float y[8];
#pragma unroll
        for (int e = 0; e < 8; ++e) y[e] = (x[e] - mean) * rstd * (e < 4 ? g0[e & 3] : g1[e & 3]) + (e < 4 ? b0[e & 3] : b1[e & 3]);
        u32x4 w; w.x = pk2(y[0], y[1]); w.y = pk2(y[2], y[3]); w.z = pk2(y[4], y[5]); w.w = pk2(y[6], y[7]);
        *(LAS u32x4*)(vnt + s * 136 + c8) = w; }
    __syncthreads();
    const int qi = lane & 15, g = lane >> 4;
    const int t = 16 * wave + qi; const float bias = bs[grp * 128 + t];
    const size_t tok = (size_t)(tok0 + t);
    u32x2 ur[8];
#pragma unroll
    for (int ct = 0; ct < 8; ++ct) ur[ct] = *(const u32x2*)(Z + tok * NZ_ + ZUB + grp * 128 + 16 * ct + 4 * g);
    f32x4 acc[8];
#pragma unroll
    for (int ct = 0; ct < 8; ++ct) acc[ct] = (f32x4){0.f, 0.f, 0.f, 0.f};
#pragma unroll
    for (int ks = 0; ks < 4; ++ks) { const bf16x8 bw = *(const LAS bf16x8*)(Wc + (16 * wave + qi) * 136 + ks * 32 + g * 8);
#pragma unroll
        for (int ct = 0; ct < 8; ++ct) { const LAS bf16_t* vr = vnt + (ks * 32 + 8 * g + (qi >> 2)) * 136 + 16 * ct + 4 * (qi & 3);
            acc[ct] = mfma16(mk8(tr16(vr), tr16(vr + 4 * 136)), bw, acc[ct]); } }
#pragma unroll
    for (int ct = 0; ct < 8; ++ct) { const int c = 16 * ct + 4 * g;
        u32x2 w; w.x = pk2(bflo(ur[ct].x) * (acc[ct][0] + bias), bfhi(ur[ct].x) * (acc[ct][1] + bias));
        w.y = pk2(bflo(ur[ct].y) * (acc[ct][2] + bias), bfhi(ur[ct].y) * (acc[ct][3] + bias));
        *(u32x2*)(O + tok * NO_ + 512 + grp * 128 + c) = w; }
    __syncthreads();
}

__device__ __forceinline__ float hgrn_lb(const float* lbl, int layer, int c) { return layer == 0 ? 0.0f : 1.0f / (1.0f + expf(lbl[c] - lbl[512 + c])); }

__device__ __forceinline__ void hgrn_c1_unit(LAS unsigned char* L, const bf16_t* Z, int unit, const float* lbl, int layer, float* DS, float* DEC, int tid, int wave, int lane) {
    const int h = unit & 3, cg_ = unit >> 2, tok0 = cg_ * 64;
    const int k = tid & 127, qtr = tid >> 7;
    LAS float* qsum = (LAS float*)L;
    LAS bf16_t* kt = (LAS bf16_t*)(L + 2048);
    LAS bf16_t* vt = kt + 128 * 72;
    const float lb = hgrn_lb(lbl, layer, h * 128 + k);
    float G[16], kk[16]; float run = 0.f;
    unsigned vraw[16];
#pragma unroll
    for (int i = 0; i < 16; ++i) { const size_t tok = (size_t)(tok0 + 16 * qtr + i);
        const float zf = bf2f(Z[tok * NZ_ + ZFC + h * 128 + k]);
        vraw[i] = Z[tok * NZ_ + ZIC + h * 128 + k];
        const float e = fexp(-zf), sg = frcp(1.0f + e);
        const float f = lb + (1.0f - lb) * sg;
        run += logf(fmaxf(f, 1e-6f)); G[i] = run; kk[i] = (1.0f - lb) * e * sg; }
    qsum[qtr * 128 + k] = run;
    __syncthreads();
    float off = 0.f, tot = 0.f;
#pragma unroll
    for (int qq = 0; qq < 4; ++qq) { const float v = qsum[qq * 128 + k]; tot += v; if (qq < qtr) off += v; }
    unsigned kw[8], vw[8];
#pragma unroll
    for (int i = 0; i < 8; ++i) { const float a0 = kk[2 * i] * fexp(tot - (G[2 * i] + off)), a1 = kk[2 * i + 1] * fexp(tot - (G[2 * i + 1] + off));
        kw[i] = pk2(a0, a1); vw[i] = vraw[2 * i] | (vraw[2 * i + 1] << 16); }
    *(LAS u32x4*)(kt + k * 72 + 16 * qtr) = (u32x4){kw[0], kw[1], kw[2], kw[3]}; *(LAS u32x4*)(kt + k * 72 + 16 * qtr + 8) = (u32x4){kw[4], kw[5], kw[6], kw[7]};
    *(LAS u32x4*)(vt + k * 72 + 16 * qtr) = (u32x4){vw[0], vw[1], vw[2], vw[3]}; *(LAS u32x4*)(vt + k * 72 + 16 * qtr + 8) = (u32x4){vw[4], vw[5], vw[6], vw[7]};
    if (qtr == 0) DEC[(size_t)unit * 128 + k] = fexp(tot);
    __syncthreads();
    const int qi = lane & 15, g = lane >> 4;
    bf16x8 av[2];
#pragma unroll
    for (int ks = 0; ks < 2; ++ks) av[ks] = *(const LAS bf16x8*)(vt + (16 * wave + qi) * 72 + ks * 32 + g * 8);
    float* dst = DS + (size_t)unit * 16384;
#pragma unroll
    for (int ktile = 0; ktile < 8; ++ktile) { f32x4 acc = {0.f, 0.f, 0.f, 0.f};
#pragma unroll
        for (int ks = 0; ks < 2; ++ks) { const bf16x8 bk = *(const LAS bf16x8*)(kt + (16 * ktile + qi) * 72 + ks * 32 + g * 8); acc = mfma16(av[ks], bk, acc); }
#pragma unroll
        for (int j = 0; j < 4; ++j) dst[(16 * wave + 4 * g + j) * 128 + 16 * ktile + qi] = acc[j]; }
    __syncthreads();
}

__device__ __forceinline__ void hgrn_scan_phase(const float* DS, const float* DEC, bf16_t* HS, int tid, int bid, int G) {
    const int nth = G * 512;
    for (int p = bid * 512 + tid; p < 16 * 8192; p += nth) {
        const int bh = p >> 13, idx = (p & 8191) * 2, k = idx & 127, b = bh >> 2, h = bh & 3;
        f32x2 S = {0.f, 0.f};
#pragma unroll 16
        for (int c = 0; c < 64; ++c) { const size_t u = (size_t)(((b * 64 + c) << 2) | h);
            *(unsigned*)(HS + u * 16384 + idx) = pk2(S[0], S[1]);
            const f32x2 d = *(const f32x2*)(DEC + u * 128 + k), ds = *(const f32x2*)(DS + u * 16384 + idx);
            S = d * S + ds; }
    }
}

__device__ __forceinline__ void hgrn_c3_unit(LAS unsigned char* L, const bf16_t* Z, int unit, const float* lbl, int layer, const bf16_t* HS, const float* ng, bf16_t* O, int tid, int wave, int lane) {
    const int h = unit & 3, cg_ = unit >> 2, tok0 = cg_ * 64;
    const int k = tid & 127, qtr = tid >> 7;
    LAS float* qsum = (LAS float*)L;
    LAS bf16_t* kT = (LAS bf16_t*)(L + 2048);
    LAS bf16_t* qT = kT + 128 * 72;
    LAS bf16_t* qC = qT + 128 * 72;
    LAS bf16_t* vt = qC + 128 * 72;
    LAS float* oL = (LAS float*)(L + 2048 + 4 * 128 * 72 * 2);
    const float lb = hgrn_lb(lbl, layer, h * 128 + k);
    float G[16], kk[16], qv[16]; float run = 0.f;
    unsigned vraw[16];
#pragma unroll
    for (int i = 0; i < 16; ++i) { const size_t tok = (size_t)(tok0 + 16 * qtr + i);
        const float zf = bf2f(Z[tok * NZ_ + ZFC + h * 128 + k]);
        qv[i] = bf2f(Z[tok * NZ_ + ZQC + h * 128 + k]);
        vraw[i] = Z[tok * NZ_ + ZIC + h * 128 + k];
        const float e = fexp(-zf), sg = frcp(1.0f + e);
        const float f = lb + (1.0f - lb) * sg;
        run += logf(fmaxf(f, 1e-6f)); G[i] = run; kk[i] = (1.0f - lb) * e * sg; }
    qsum[qtr * 128 + k] = run;
    __syncthreads();
    float off = 0.f;
#pragma unroll
    for (int qq = 0; qq < 4; ++qq) { const float v = qsum[qq * 128 + k]; if (qq < qtr) off += v; }
    const float Gm = qsum[k] + qsum[128 + k];
    {
        unsigned kw[8], qw[8], cw[8];
#pragma unroll
        for (int i = 0; i < 8; ++i) { float a[2], b[2], c[2];
#pragma unroll
            for (int e = 0; e < 2; ++e) { const float Gi = G[2 * i + e] + off; const float d = fminf(fmaxf(Gi - Gm, -80.f), 80.f);
                a[e] = kk[2 * i + e] * fexp(-d); b[e] = qv[2 * i + e] * fexp(d); c[e] = qv[2 * i + e] * fexp(Gi); }
            kw[i] = pk2(a[0], a[1]); qw[i] = pk2(b[0], b[1]); cw[i] = pk2(c[0], c[1]); }
        *(LAS u32x4*)(kT + k * 72 + 16 * qtr) = (u32x4){kw[0], kw[1], kw[2], kw[3]}; *(LAS u32x4*)(kT + k * 72 + 16 * qtr + 8) = (u32x4){kw[4], kw[5], kw[6], kw[7]};
        *(LAS u32x4*)(qT + k * 72 + 16 * qtr) = (u32x4){qw[0], qw[1], qw[2], qw[3]}; *(LAS u32x4*)(qT + k * 72 + 16 * qtr + 8) = (u32x4){qw[4], qw[5], qw[6], qw[7]};
        *(LAS u32x4*)(qC + k * 72 + 16 * qtr) = (u32x4){cw[0], cw[1], cw[2], cw[3]}; *(LAS u32x4*)(qC + k * 72 + 16 * qtr + 8) = (u32x4){cw[4], cw[5], cw[6], cw[7]};
    }
    {
        unsigned vw[8];
#pragma unroll
        for (int i = 0; i < 8; ++i) vw[i] = vraw[2 * i] | (vraw[2 * i + 1] << 16);
        *(LAS u32x4*)(vt + k * 72 + 16 * qtr) = (u32x4){vw[0], vw[1], vw[2], vw[3]}; *(LAS u32x4*)(vt + k * 72 + 16 * qtr + 8) = (u32x4){vw[4], vw[5], vw[6], vw[7]};
    }
    __syncthreads();
    const int qi = lane & 15, g = lane >> 4, tt = wave & 3, vh = wave >> 2;
    const bf16_t* hs = HS + (size_t)unit * 16384;
    bf16x8 ahs[4][4];
#pragma unroll
    for (int ks = 0; ks < 4; ++ks)
#pragma unroll
        for (int v_ = 0; v_ < 4; ++v_) ahs[ks][v_] = *(const bf16x8*)(hs + (16 * (4 * vh + v_) + qi) * 128 + ks * 32 + g * 8);
    unsigned graw[8][2];
#pragma unroll
    for (int r = 0; r < 8; ++r) { const size_t tok = (size_t)(tok0 + 8 * wave + r); graw[r][0] = Z[tok * NZ_ + ZGC + h * 128 + lane]; graw[r][1] = Z[tok * NZ_ + ZGC + h * 128 + 64 + lane]; }
    f32x4 sc[4];
#pragma unroll
    for (int st = 0; st < 4; ++st) { sc[st] = (f32x4){0.f, 0.f, 0.f, 0.f};
        if (st <= tt) {
#pragma unroll
            for (int ks = 0; ks < 4; ++ks) { const int ro = (ks * 32 + 8 * g + (qi >> 2)) * 72 + 4 * (qi & 3);
                const bf16x8 a = mk8(tr16(kT + ro + 16 * st), tr16(kT + ro + 4 * 72 + 16 * st)), b = mk8(tr16(qT + ro + 16 * tt), tr16(qT + ro + 4 * 72 + 16 * tt));
                sc[st] = mfma16(a, b, sc[st]); }
#pragma unroll
            for (int j = 0; j < 4; ++j) if (16 * st + 4 * g + j > 16 * tt + qi) sc[st][j] = 0.f;
        } }
    f32x4 o[4];
#pragma unroll
    for (int v_ = 0; v_ < 4; ++v_) o[v_] = (f32x4){0.f, 0.f, 0.f, 0.f};
#pragma unroll
    for (int i = 0; i < 2; ++i) {
        u32x4 pw; pw.x = pk2(sc[2 * i][0], sc[2 * i][1]); pw.y = pk2(sc[2 * i][2], sc[2 * i][3]); pw.z = pk2(sc[2 * i + 1][0], sc[2 * i + 1][1]); pw.w = pk2(sc[2 * i + 1][2], sc[2 * i + 1][3]);
        const bf16x8 bp = __builtin_bit_cast(bf16x8, pw);
#pragma unroll
        for (int v_ = 0; v_ < 4; ++v_) { const LAS bf16_t* vr = vt + (16 * (4 * vh + v_) + qi) * 72 + 4 * g;
            const u32x2 va = *(const LAS u32x2*)(vr + (2 * i) * 16), vb = *(const LAS u32x2*)(vr + (2 * i + 1) * 16);
            o[v_] = mfma16(mk8(va, vb), bp, o[v_]); } }
#pragma unroll
    for (int ks = 0; ks < 4; ++ks) { const int ro = (ks * 32 + 8 * g + (qi >> 2)) * 72 + 4 * (qi & 3) + 16 * tt; const bf16x8 b = mk8(tr16(qC + ro), tr16(qC + ro + 4 * 72));
#pragma unroll
        for (int v_ = 0; v_ < 4; ++v_) o[v_] = mfma16(ahs[ks][v_], b, o[v_]); }
#pragma unroll
    for (int v_ = 0; v_ < 4; ++v_) *(LAS f32x4*)(oL + (16 * tt + qi) * 132 + 16 * (4 * vh + v_) + 4 * g) = o[v_];
    __syncthreads();
    const float ng0 = ng[h * 128 + lane], ng1 = ng[h * 128 + 64 + lane];
#pragma unroll
    for (int r = 0; r < 8; ++r) { const int t = 8 * wave + r;
        const float x0 = oL[t * 132 + lane], x1 = oL[t * 132 + 64 + lane];
        const float ss = wave_sum(x0 * x0 + x1 * x1);
        const float rs = 1.0f / sqrtf(ss * (1.f / 128.f) + LN_EPS);
        const size_t tok = (size_t)(tok0 + t);
        const float g0 = bf2f(graw[r][0]), g1 = bf2f(graw[r][1]);
        const float y0 = x0 * rs * ng0 * fsigmoid(g0), y1 = x1 * rs * ng1 * fsigmoid(g1);
        O[tok * NO_ + 1024 + h * 128 + lane] = (bf16_t)(pk2(y0, 0.f) & 0xffffu);
        O[tok * NO_ + 1024 + h * 128 + 64 + lane] = (bf16_t)(pk2(y1, 0.f) & 0xffffu); }
    __syncthreads();
}

__device__ __forceinline__ void dcomb_phase(const float* DPO, const float* DLSE, bf16_t* O, int i0, int i1, int nth) {
#pragma unroll 4
    for (int i = i0; i < i1; i += nth) { const int t = i >> 6, c4 = (i & 63) * 4, h = c4 >> 6;
        const float l0 = DLSE[((size_t)0 * T_ + t) * 4 + h], l1 = DLSE[((size_t)1 * T_ + t) * 4 + h], l2 = DLSE[((size_t)2 * T_ + t) * 4 + h];
        const float m = fmaxf(l0, fmaxf(l1, l2));
        float w0 = fexp(l0 - m), w1 = fexp(l1 - m), w2 = fexp(l2 - m); const float inv = 1.0f / (w0 + w1 + w2); w0 *= inv; w1 *= inv; w2 *= inv;
        const f32x4 a = *(const f32x4*)(DPO + ((size_t)0 * T_ + t) * 256 + c4), b = *(const f32x4*)(DPO + ((size_t)1 * T_ + t) * 256 + c4), c = *(const f32x4*)(DPO + ((size_t)2 * T_ + t) * 256 + c4);
        const f32x4 r = w0 * a + w1 * b + w2 * c;
        u32x2 w; w.x = pk2(r[0], r[1]); w.y = pk2(r[2], r[3]);
        *(u32x2*)(O + (size_t)t * NO_ + 1536 + c4) = w; }
}

constexpr int NPH_LAYER = 14, NPH = 2 * NPH_LAYER;
__global__ void __launch_bounds__(512, 2) hybrid_fwd(Args a) {
    extern __shared__ __attribute__((aligned(16))) unsigned char lds_raw[];
    LAS unsigned char* lds = (LAS unsigned char*)lds_raw;
    PTab pt = (PTab)(lds + 131072);
    if (threadIdx.x == 0) {
#pragma unroll
        for (int i = 0; i < 22; ++i) pt[i] = (unsigned long long)a.in[i];
        pt[22] = (unsigned long long)a.out; pt[23] = (unsigned long long)a.ws;
    }
    if (threadIdx.x < 8) ((LAS unsigned*)(lds + 131072 + 512))[threadIdx.x] = 0u;
    __syncthreads();
    const int ph_lo = a.ph_lo, ph_hi = a.ph_hi;
    unsigned pepoch = 0u; bool fast = false;
    if (threadIdx.x == 0 && blockIdx.x < 8) __hip_atomic_store((unsigned*)(a.ws + WS_CTL + WS_BAR + 15400) + blockIdx.x, xb_xcc_id(), __ATOMIC_RELAXED, __HIP_MEMORY_SCOPE_AGENT);
    XcdBarrier bar = xcd_barrier_post((unsigned*)(a.ws + WS_CTL + WS_BAR), (volatile LAS unsigned*)(lds + 131072 + 512));
    for (int ph = ph_lo; ph < ph_hi; ++ph) {
        const int l = ph / NPH_LAYER, p = ph - l * NPH_LAYER;
        pg8::StaticOrder S;
        int tid = threadIdx.x; asm volatile("" : "+v"(tid));
        int bid = blockIdx.x, G = gridDim.x; asm volatile("" : "+s"(bid), "+s"(G));
        const int lane = tid & 63, wave = __builtin_amdgcn_readfirstlane(tid >> 6);
        unsigned char* ws = (unsigned char*)ldptr(pt, 23);
#define P_X ((float*)ldptr(pt, 22))
#define P_XB ((bf16_t*)(ws + WS_XB))
#define P_ZH ((bf16_t*)(ws + WS_ZH))
#define P_GATE ((bf16_t*)(ws + WS_GATE))
#define P_O ((bf16_t*)(ws + WS_O))
#define P_DS ((float*)(ws + WS_GATE + 192 * MiB))
#define P_MRG ((bf16_t*)(ws + WS_DS))
#define P_DEC ((float*)(ws + WS_CTL))
#define P_HS ((bf16_t*)(ws + WS_HS))
#define P_DPO ((float*)(ws + WS_DPO))
#define P_DLSE ((float*)(ws + WS_DLSE))
        switch (p) {
        case 0: if (l == 0) convert_phase(pt, 0, lds, tid, wave, lane, bid, G); break;
        case 1: case 11: {
            const int s = (p == 1) ? 0 : 1; const int n_ = (p == 1) ? 2 * FF_ : 2 * FF_ + D_;
            pg8::Gemm g{P_XB, (const bf16_t*)(ws + WS_WGU + (size_t)s * 44 * MiB), T_, n_, D_}; S.init(T_, n_, G, bid);
            pg8::EpiSwiGLU E{p == 1 ? P_O : P_ZH, P_GATE}; pg8::gemm_phase(lds, g, S, E);
        } break;
        case 2: {
            pg8::Gemm g{P_O, (const bf16_t*)(ws + WS_WD), T_, D_, FF_}; S.init(T_, D_, G, bid);
            pg8::EpiResidT<false> E{P_X, P_XB, nullptr, ALPHA, 0.5f}; pg8::gemm_phase<pg8::EpiResidT<false>, true>(lds, g, S, E);
        } break;
        case 3: case 10: case 13: {
            const int which = (p == 3) ? 0 : (p == 10 ? 1 : 2);
            if (fast) ln_phase(P_X, P_XB, ldptr(pt, 2) + (size_t)(l * 3 + which) * D_, ldptr(pt, 3) + (size_t)(l * 3 + which) * D_, (l == 1 && p == 13), (8 * (bid & 7) + ((bid >> 3) & 7)) * 256 + (bid >> 6) * 64 + wave * 8, 1, 4, 2, lane);
            else ln_phase(P_X, P_XB, ldptr(pt, 2) + (size_t)(l * 3 + which) * D_, ldptr(pt, 3) + (size_t)(l * 3 + which) * D_, (l == 1 && p == 13), bid * 8 + wave, G * 8, 32 * G, (T_ + 32 * G - 1) / (32 * G), lane);
            if (p == 13 && l == 0) convert_phase(pt, 1, lds, tid, wave, lane, bid, G);
            if (p == 10) { int kp = PLE_; asm volatile("" : "+s"(kp)); pg8::Gemm g2{(const bf16_t*)(ws + WS_PB) + (size_t)l * T_ * PLE_, (const bf16_t*)(ws + WS_WPP), T_, D_, kp}; S.init(T_, D_, G, bid);
                pg8::EpiBf16 E2{P_GATE, D_}; pg8::gemm_phase(lds, g2, S, E2); }
        } break;
        case 4: {
            pg8::Gemm g{P_XB, (const bf16_t*)(ws + WS_WIN), T_, NZ_, D_}; S.init(T_, NZ_, G, bid);
            pg8::EpiZ E{P_ZH, P_GATE, 0}; pg8::gemm_phase(lds, g, S, E);
            if (fast) { panel_barrier((unsigned*)(ws + WS_CTL + WS_BAR + 16384) + 64 * (8 * (bid & 7) + ((bid >> 3) & 7)), pepoch);
                for (int h_ = 0; h_ < 4; ++h_) hgrn_c1_unit(lds, P_ZH, (((8 * (bid & 7) + ((bid >> 3) & 7)) * 4 + (bid >> 6)) << 2) | h_, ldptr(pt, 13), l, P_DS, P_DEC, tid, wave, lane); }
            else { xcd_barrier(bar); for (int u = bid; u < 1024; u += G) hgrn_c1_unit(lds, P_ZH, u, ldptr(pt, 13), l, P_DS, P_DEC, tid, wave, lane); }
        } break;
        case 5: {
            hgrn_scan_phase(P_DS, P_DEC, P_HS, tid, bid, G);
            for (int u = bid; u < 2560; u += G) attn_unit(lds, P_ZH, u, ldptr(pt, 8) + l * 8, P_O, P_DPO, P_DLSE, tid, wave, lane);
            for (int u = bid; u < 512; u += G) gmlp_unit(lds, P_ZH, u, ldptr(pt, 9) + l * 512, ldptr(pt, 10) + l * 512, ldptr(pt, 11) + (size_t)l * 65536, ldptr(pt, 12) + l * 512, P_O, tid, wave, lane);
        } break;
        case 6: break;
        case 7: {
            for (int u = bid; u < 1024; u += G) hgrn_c3_unit(lds, P_ZH, u, ldptr(pt, 13), l, P_HS, ldptr(pt, 14) + l * 512, P_O, tid, wave, lane);
        } break;
        case 8: {
            if (fast) { const int r0 = (8 * (bid & 7) + ((bid >> 3) & 7)) * 256 + (bid >> 6) * 64;
                dcomb_phase(P_DPO, P_DLSE, P_O, r0 * 64 + tid, (r0 + 64) * 64, 512); }
            else dcomb_phase(P_DPO, P_DLSE, P_O, bid * 512 + tid, T_ * 64, G * 512);
            { pg8::Gemm gg{P_XB, (const bf16_t*)(ws + WS_WIN) + (size_t)NZ_ * D_, T_, NGT_, D_}; S.init(T_, NGT_, G, bid);
              pg8::EpiZ Eg{P_ZH, P_GATE, 24}; pg8::gemm_phase(lds, gg, S, Eg); }
            if (fast) panel_barrier((unsigned*)(ws + WS_CTL + WS_BAR + 16384) + 64 * (8 * (bid & 7) + ((bid >> 3) & 7)), pepoch); else xcd_barrier(bar);
            pg8::Gemm g{P_O, (const bf16_t*)(ws + WS_WBR), T_, D_, NO_}; S.init(T_, D_, G, bid);
            pg8::EpiBR E{P_MRG, P_GATE}; pg8::gemm_phase(lds, g, S, E);
        } break;
        case 9: {
            pg8::Gemm g{P_MRG, (const bf16_t*)(ws + WS_WOUT), T_, D_, D_}; S.init(T_, D_, G, bid);
            pg8::EpiResidT<false> E{P_X, P_XB, nullptr, ALPHA, 1.0f}; pg8::gemm_phase(lds, g, S, E);
        } break;
        case 12: {
            pg8::Gemm g{P_ZH, (const bf16_t*)(ws + WS_WD + (size_t)22 * MiB), T_, D_, FF_}; S.init(T_, D_, G, bid);
            pg8::EpiResidT<true> E{P_X, P_XB, P_GATE, ALPHA, 0.5f}; pg8::gemm_phase<pg8::EpiResidT<true>, true>(lds, g, S, E);
        } break;
        default: break;
        }
        if (ph + 1 < ph_hi && p != 6) {
            if (ph_hi > 1000) { __threadfence(); cg::this_grid().sync(); }
            else if (fast && (p == 2 || p == 3 || p == 8 || p == 9 || p == 10 || p == 11 || (l == 1 && (p == 1 || p == 12))))
                panel_barrier((unsigned*)(ws + WS_CTL + WS_BAR + 16384) + 64 * (8 * (bid & 7) + ((bid >> 3) & 7)), pepoch);
            else xcd_barrier(bar);
            if (ph == 0) { if (threadIdx.x == 0 && xb_xcc_id() != xb_ld((unsigned*)(ws + WS_CTL + WS_BAR + 15400) + (blockIdx.x & 7))) (void)xb_add((unsigned*)(ws + WS_CTL + WS_BAR + 15360), 1u); }
            if (ph == 1) fast = (G == 256) && (__builtin_amdgcn_readfirstlane(xb_ld((unsigned*)(ws + WS_CTL + WS_BAR + 15360))) == 0u);
        }
    }
}

extern "C" void kernel_launch(void* const* d_in, const int* in_sizes, int n_in, void* d_out, int out_size, void* d_ws, size_t ws_size, hipStream_t stream) {
    static int grid = 0;
    if (grid == 0) {
        if (n_in != 22 || out_size != T_ * D_ || ws_size < WS_END) { fprintf(stderr, "kernel_launch: unexpected shapes (n_in %d out %d ws %zu need %zu)\n", n_in, out_size, ws_size, (size_t)WS_END); grid = -1; return; }
        int dev = 0, cus = 0, per_cu = 0;
        hipGetDevice(&dev); hipDeviceGetAttribute(&cus, hipDeviceAttributeMultiprocessorCount, dev);
        if (hipFuncSetAttribute((const void*)hybrid_fwd, hipFuncAttributeMaxDynamicSharedMemorySize, LDS_BYTES) != hipSuccess) { fprintf(stderr, "kernel_launch: hipFuncSetAttribute failed\n"); grid = -1; return; }
        hipOccupancyMaxActiveBlocksPerMultiprocessor(&per_cu, (const void*)hybrid_fwd, 512, LDS_BYTES);
        (void)hipGetLastError();
        if (per_cu < 1) per_cu = 1;
        grid = cus * 1;
    }
    if (grid < 0) return;
    if (hipMemsetAsync((char*)d_ws + WS_CTL + WS_BAR, 0, BAR_BYTES, stream) != hipSuccess) { fprintf(stderr, "kernel_launch: memset failed\n"); return; }
    Args a{};
    for (int i = 0; i < 22; ++i) a.in[i] = (const float*)d_in[i];
    a.out = (float*)d_out; a.ws = (unsigned char*)d_ws; a.ph_lo = 0; a.ph_hi = NPH;
    void* args[] = {&a};
    hipError_t e = hipLaunchCooperativeKernel((const void*)hybrid_fwd, dim3(grid), dim3(512), args, LDS_BYTES, stream);
    if (e != hipSuccess) fprintf(stderr, "cooperative launch failed: %s (grid %d)\n", hipGetErrorString(e), grid);
}
```
